# Optimizing an MI355X kernel written in HIP

```python
import math
import jax, jax.numpy as jnp
from jax import lax
import numpy as np

D_MODEL = 1024
BATCH = 8
SEQ = 4096
DEPTH = 4

MEM_LEN = 256
EPS = 1e-6
DA_HEADS = 4
DA_HEAD_DIM = 64
DA_WIDTH = DA_HEADS * 2 * DA_HEAD_DIM
ROT_DIM = DA_HEAD_DIM // 4
ROPE_THETA = 500000.0
Q_BLOCK = 128
POOL_WINDOWS = (2, 4, 8, 16)
POOL_GROUPS = 4
POOL_GROUP_CH = 128
POOL_WIDTH = POOL_GROUPS * POOL_GROUP_CH
CHUNK = 128
SG_GROUPS = 4
SG_WIDTH = 512
SG_GROUP_CH = SG_WIDTH // SG_GROUPS
N_BRANCH = 3
BRANCH_WIDTH = 512
X_HEADS = 4
X_HEAD_DIM = D_MODEL // X_HEADS
PEER_HEADS = 8
N_KEYS = 128
N_EXPERTS = N_KEYS * N_KEYS
PEER_TOPK = 16
PEER_QDIM = 256
PEER_HALF = PEER_QDIM // 2
PEER_BLOCK = 128
IN_WIDTH = 3 * DA_WIDTH + POOL_WIDTH + 2 * SG_WIDTH + N_BRANCH * D_MODEL

kernel_name = "hybrid_diffattn_pool_sgmlp_peer"


def rmsnorm(x, g):
    xf = x.astype(jnp.float32)
    y = xf * lax.rsqrt(jnp.mean(xf * xf, axis=-1, keepdims=True) + EPS)
    return (y * g.astype(jnp.float32)).astype(x.dtype)


def layernorm(x, g, b):
    xf = x.astype(jnp.float32)
    mu = jnp.mean(xf, axis=-1, keepdims=True)
    var = jnp.mean(jnp.square(xf - mu), axis=-1, keepdims=True)
    y = (xf - mu) * lax.rsqrt(var + EPS) * g.astype(jnp.float32) + b.astype(jnp.float32)
    return y.astype(x.dtype)


def rope_tables(positions):
    inv = ROPE_THETA ** (-jnp.arange(0, ROT_DIM, 2, dtype=jnp.float32) / ROT_DIM)
    ang = positions.astype(jnp.float32)[..., None] * inv
    return jnp.cos(ang), jnp.sin(ang)


def apply_partial_rope(x, cos, sin):
    half = ROT_DIM // 2
    xf = x[..., :ROT_DIM].astype(jnp.float32)
    x1, x2 = xf[..., :half], xf[..., half:]
    c, s = cos[:, :, None, :], sin[:, :, None, :]
    rot = jnp.concatenate([x1 * c - x2 * s, x1 * s + x2 * c], axis=-1).astype(x.dtype)
    return jnp.concatenate([rot, x[..., ROT_DIM:]], axis=-1)


def diff_attention(q, k, v, cos, sin, lam_qk, subln_g, lam_init):
    B, S, _ = q.shape
    H, DH = DA_HEADS, DA_HEAD_DIM
    q = apply_partial_rope(q.reshape(B, S, H * 2, DH), cos, sin).reshape(B, S, H, 2, DH)
    k = apply_partial_rope(k.reshape(B, S, H * 2, DH), cos, sin).reshape(B, S, H, 2, DH)
    v = v.reshape(B, S, H, 2 * DH)
    lq = lam_qk.astype(jnp.float32)
    lam = jnp.exp(jnp.sum(lq[0] * lq[1])) - jnp.exp(jnp.sum(lq[2] * lq[3])) + lam_init
    nb = S // Q_BLOCK
    qb = q.reshape(B, nb, Q_BLOCK, H, 2, DH).transpose(1, 0, 3, 4, 2, 5)
    kt = k.transpose(0, 2, 3, 1, 4)
    vt = v.transpose(0, 2, 1, 3)
    key_pos = jnp.arange(S)
    scale = DH ** -0.5

    def block(args):
        qblk, start = args
        s = jnp.einsum('bhmqd,bhmkd->bhmqk', qblk, kt).astype(jnp.float32) * scale
        causal = key_pos[None, :] <= (start + jnp.arange(Q_BLOCK))[:, None]
        p = jax.nn.softmax(jnp.where(causal, s, -jnp.inf), axis=-1)
        a = p[:, :, 0] - lam * p[:, :, 1]
        return jnp.einsum('bhqk,bhkd->bhqd', a.astype(vt.dtype), vt)

    o = lax.map(block, (qb, jnp.arange(nb) * Q_BLOCK))
    o = o.transpose(1, 0, 3, 2, 4).reshape(B, S, H, 2 * DH)
    o = rmsnorm(o, subln_g) * (1.0 - lam_init)
    return o.reshape(B, S, H * 2 * DH)


def multiscale_pool(p, w_pool, pool_scale):
    B, S, _ = p.shape
    pg = p.reshape(B, S, POOL_GROUPS, POOL_GROUP_CH).astype(jnp.float32)
    cs = jnp.concatenate([jnp.zeros_like(pg[:, :1]), lax.cumsum(pg, axis=1)], axis=1)
    t = jnp.arange(S)
    groups = []
    for g, w in enumerate(POOL_WINDOWS):
        cg = cs[:, :, g]
        lo = jnp.maximum(t + 1 - w, 0)
        cnt = jnp.minimum(t + 1, w).astype(jnp.float32)
        mean = (cg[:, 1:] - cg[:, lo]) / cnt[None, :, None]
        groups.append(mean - pg[:, :, g])
    d = jnp.stack(groups, axis=2).astype(p.dtype)
    y = jnp.einsum('bsgc,gce->bsge', d, w_pool)
    return y.reshape(B, S, POOL_WIDTH) * pool_scale


def chunk_spatial_gate(u, v, ln_g, ln_b, w_s, b_s):
    B, S, _ = v.shape
    vn = layernorm(v, ln_g, ln_b).reshape(B, S // CHUNK, CHUNK, SG_GROUPS, SG_GROUP_CH)
    ws = w_s * jnp.tril(jnp.ones((CHUNK, CHUNK), w_s.dtype))
    mixed = jnp.einsum('gts,bnsgc->bntgc', ws, vn) + b_s.T[None, None, :, :, None]
    return u * mixed.reshape(B, S, SG_WIDTH)


def memory_cross_attention(h, m, w_q, w_kv, w_o):
    B, S, _ = h.shape
    M = m.shape[1]
    q = (h @ w_q).reshape(B, S, X_HEADS, X_HEAD_DIM)
    kv = (m @ w_kv).reshape(B, M, 2, X_HEADS, X_HEAD_DIM)
    s = jnp.einsum('bshd,bmhd->bhsm', q, kv[:, :, 0]).astype(jnp.float32) * (X_HEAD_DIM ** -0.5)
    p = jax.nn.softmax(s, axis=-1).astype(h.dtype)
    o = jnp.einsum('bhsm,bmhd->bshd', p, kv[:, :, 1])
    return o.reshape(B, S, D_MODEL) @ w_o


def peer_ffn(x, w_pq, sub_keys, peer_u, peer_v):
    B, S, D = x.shape
    q = jnp.einsum('bsd,dhk->bshk', x, w_pq).reshape(B, S, PEER_HEADS, 2, PEER_HALF)
    sc = jnp.einsum('bshpk,hpnk->bshpn', q, sub_keys).astype(jnp.float32)
    s_top, i_top = lax.top_k(sc, PEER_TOPK)
    cand = (s_top[..., 0, :, None] + s_top[..., 1, None, :]).reshape(B, S, PEER_HEADS, PEER_TOPK * PEER_TOPK)
    cand_idx = (i_top[..., 0, :, None] * N_KEYS + i_top[..., 1, None, :]).reshape(B, S, PEER_HEADS, PEER_TOPK * PEER_TOPK)
    f_s, f_pos = lax.top_k(cand, PEER_TOPK)
    e_idx = jnp.take_along_axis(cand_idx, f_pos, axis=-1)
    gates = jax.nn.softmax(f_s, axis=-1).astype(x.dtype)
    T = B * S
    nblk = T // PEER_BLOCK
    xt = x.reshape(nblk, PEER_BLOCK, D)
    it = e_idx.reshape(nblk, PEER_BLOCK, PEER_HEADS * PEER_TOPK)
    gt = gates.reshape(nblk, PEER_BLOCK, PEER_HEADS * PEER_TOPK)

    def blk(args):
        xb, ib, gb = args
        ub = peer_u[ib]
        a = jax.nn.gelu(jnp.einsum('td,ted->te', xb, ub), approximate=False)
        vb = peer_v[ib]
        return jnp.einsum('te,ted->td', a * gb, vb)

    return lax.map(blk, (xt, it, gt)).reshape(B, S, D)


def setup_inputs(seed: int = 0) -> dict:
    key = jax.random.key(seed)
    ks = jax.random.split(key, 32)
    L, D = DEPTH, D_MODEL

    def nrm(k, shape, scale):
        return jax.random.normal(k, shape, jnp.float32) * scale

    def gain(k, shape):
        return 1.0 + 0.05 * jax.random.normal(k, shape, jnp.float32)

    start = jax.random.randint(ks[2], (BATCH, 1), 0, 1024, dtype=jnp.int32)
    positions = (start + jnp.arange(SEQ, dtype=jnp.int32)[None, :]).astype(jnp.int32)
    return {
        'x': nrm(ks[0], (BATCH, SEQ, D), 1.0),
        'mem': nrm(ks[1], (BATCH, MEM_LEN, D), 1.0),
        'positions': positions,
        'g_mix': gain(ks[3], (L, D)),
        'w_in': nrm(ks[4], (L, D, IN_WIDTH), D ** -0.5),
        'lam_qk': nrm(ks[5], (L, 4, DA_HEAD_DIM), 0.1),
        'subln_g': gain(ks[6], (L, 2 * DA_HEAD_DIM)),
        'w_pool': nrm(ks[7], (L, POOL_GROUPS, POOL_GROUP_CH, POOL_GROUP_CH), POOL_GROUP_CH ** -0.5),
        'pool_scale': gain(ks[8], (L, POOL_WIDTH)),
        'sg_ln_g': gain(ks[9], (L, SG_WIDTH)),
        'sg_ln_b': nrm(ks[10], (L, SG_WIDTH), 0.02),
        'w_spatial': nrm(ks[11], (L, SG_GROUPS, CHUNK, CHUNK), 0.5 * CHUNK ** -0.5),
        'b_spatial': gain(ks[12], (L, SG_GROUPS, CHUNK)),
        'w_branch': nrm(ks[13], (L, N_BRANCH, BRANCH_WIDTH, D), BRANCH_WIDTH ** -0.5),
        'w_out': nrm(ks[14], (L, D, D), D ** -0.5),
        'g_cross': gain(ks[15], (L, D)),
        'g_mem': gain(ks[16], (L, D)),
        'w_xq': nrm(ks[17], (L, D, D), D ** -0.5),
        'w_xkv': nrm(ks[18], (L, D, 2 * D), D ** -0.5),
        'w_xo': nrm(ks[19], (L, D, D), D ** -0.5),
        'g_ffn': gain(ks[20], (L, D)),
        'w_pq': nrm(ks[21], (L, D, PEER_HEADS, PEER_QDIM), D ** -0.5),
        'sub_keys': nrm(ks[22], (L, PEER_HEADS, 2, N_KEYS, PEER_HALF), PEER_HALF ** -0.5),
        'peer_u': nrm(ks[23], (L, N_EXPERTS, D), D ** -0.5),
        'peer_v': nrm(ks[24], (L, N_EXPERTS, D), 0.2),
        'g_final': gain(ks[25], (D,)),
    }


def reference(x, mem, positions, g_mix, w_in, lam_qk, subln_g, w_pool, pool_scale, sg_ln_g, sg_ln_b, w_spatial, b_spatial, w_branch, w_out, g_cross, g_mem, w_xq, w_xkv, w_xo, g_ffn, w_pq, sub_keys, peer_u, peer_v, g_final):
    B, S, D = x.shape
    cos, sin = rope_tables(positions)
    sizes = (DA_WIDTH, DA_WIDTH, DA_WIDTH, POOL_WIDTH, SG_WIDTH, SG_WIDTH)
    pts = []
    acc = 0
    for sz in sizes:
        acc += sz
        pts.append(acc)
    for l in range(DEPTH):
        lam_init = 0.8 - 0.6 * math.exp(-0.3 * l)
        xn = rmsnorm(x, g_mix[l])
        z = xn @ w_in[l]
        q_a, k_a, v_a, p_in, u_in, v_in, gate_in = jnp.split(z, pts, axis=-1)
        a_out = diff_attention(q_a, k_a, v_a, cos, sin, lam_qk[l], subln_g[l], lam_init)
        p_out = multiscale_pool(p_in, w_pool[l], pool_scale[l])
        s_out = chunk_spatial_gate(u_in, v_in, sg_ln_g[l], sg_ln_b[l], w_spatial[l], b_spatial[l])
        branches = jnp.stack([a_out, p_out, s_out], axis=2)
        proj = jnp.einsum('bsnc,ncd->bsnd', branches, w_branch[l])
        gates = jax.nn.sigmoid(gate_in.reshape(B, S, N_BRANCH, D))
        merged = jnp.sum(gates * proj, axis=2)
        x = x + merged @ w_out[l]
        x = x + memory_cross_attention(rmsnorm(x, g_cross[l]), rmsnorm(mem, g_mem[l]), w_xq[l], w_xkv[l], w_xo[l])
        x = x + peer_ffn(rmsnorm(x, g_ffn[l]), w_pq[l], sub_keys[l], peer_u[l], peer_v[l])
    return rmsnorm(x, g_final)
```

```cpp
#include <hip/hip_runtime.h>
#include <stdint.h>
#include <math.h>

typedef unsigned short bf16_t;
typedef short bf16x8 __attribute__((ext_vector_type(8)));
typedef float f32x4 __attribute__((ext_vector_type(4)));
typedef float f32x2 __attribute__((ext_vector_type(2)));
typedef unsigned u32x4 __attribute__((ext_vector_type(4)));
typedef unsigned u32x2 __attribute__((ext_vector_type(2)));

constexpr int D = 1024, NB = 8, S = 4096, T = NB * S, L = 4, MEM = 256, MROWS = NB * MEM;
constexpr int INW = 6144, NEXP = 16384;
constexpr float EPS = 1e-6f;
constexpr float C2 = 0.125f * 1.4426950408889634f;
constexpr float SU = 256.f, SV = 32.f;
constexpr int NT = 512;

constexpr size_t MiB = 1u << 20;
constexpr size_t WS_CTL = 0, WS_ROPE = 1 * MiB, WS_SSP = 3 * MiB, WS_WSPT = 5 * MiB, WS_RSTDM = 6 * MiB, WS_WPOOLS = 7 * MiB, WS_KEYSB = 8 * MiB;
constexpr size_t WS_WIN = 10 * MiB, WS_WB0 = 58 * MiB, WS_WEFF = 62 * MiB, WS_WB2 = 66 * MiB, WS_WOUT = 70 * MiB, WS_GT = 78 * MiB, WS_YT = 142 * MiB;
constexpr size_t WS_SKT = 206 * MiB, WS_U8 = 222 * MiB, WS_V8 = 286 * MiB, WS_XB = 350 * MiB, WS_TI = 414 * MiB, WS_TG = 430 * MiB, WS_MX = 446 * MiB;
constexpr size_t WS_GTE = WS_MX, WS_QB = WS_MX + 192 * MiB, WS_KB = WS_MX + 224 * MiB, WS_VB = WS_MX + 256 * MiB, WS_PIN = WS_MX + 288 * MiB, WS_DP = WS_MX + 320 * MiB;
constexpr size_t WS_UIN = WS_MX + 352 * MiB, WS_VIN = WS_MX + 384 * MiB, WS_O1 = WS_MX + 416 * MiB, WS_O2 = WS_MX + 448 * MiB, WS_SO = WS_MX + 480 * MiB, WS_END = WS_MX + 512 * MiB;
constexpr size_t WS_AO = WS_QB, WS_MG = WS_KB, WS_SX = WS_MX, WS_PM = WS_O1, WS_SC = WS_MX;
constexpr size_t WS_MEMB = WS_MX, WS_WXQB = WS_MX + 4 * MiB, WS_WXOT = WS_MX + 12 * MiB, WS_WXKVT = WS_MX + 20 * MiB, WS_KV = WS_MX + 36 * MiB, WS_WB1T = WS_MX + 68 * MiB, WS_WPQB = WS_MX + 72 * MiB;
static_assert(WS_END <= 1024 * MiB, "workspace map");

struct Params { const void* in[26]; float* out; unsigned char* ws; };

__device__ __forceinline__ float bf2f(bf16_t v) { return __uint_as_float(((unsigned)v) << 16); }
__device__ __forceinline__ bf16_t f2bf(float f) { unsigned u = __float_as_uint(f); return (bf16_t)((u + 0x7fffu + ((u >> 16) & 1u)) >> 16); }
__device__ __forceinline__ unsigned pk2(float lo, float hi) { return (unsigned)f2bf(lo) | ((unsigned)f2bf(hi) << 16); }
__device__ __forceinline__ float wave_sum(float v) {
#pragma unroll
    for (int o = 32; o >= 1; o >>= 1) v += __shfl_xor(v, o);
    return v;
}
__device__ __forceinline__ float wave_max(float v) {
#pragma unroll
    for (int o = 32; o >= 1; o >>= 1) v = fmaxf(v, __shfl_xor(v, o));
    return v;
}
__device__ __forceinline__ float row_rstd(const float* ssp, int row) {
    const f32x4* p = (const f32x4*)(ssp + (size_t)row * 16);
    f32x4 a = p[0], b = p[1], c = p[2], d = p[3];
    float s = (a[0] + a[1] + a[2] + a[3]) + (b[0] + b[1] + b[2] + b[3]) + (c[0] + c[1] + c[2] + c[3]) + (d[0] + d[1] + d[2] + d[3]);
    return rsqrtf(s * (1.f / D) + EPS);
}
__device__ __forceinline__ float lam_init_of(int l) { return 0.8f - 0.6f * expf(-0.3f * (float)l); }

__device__ void tr_conv(const float* __restrict__ src, bf16_t* __restrict__ dst, int K, int N, const float* gain, int gmask, float gmul, int bid, int nb, float* tile) {
    const int tid = threadIdx.x, tx = tid & 63, ty = tid >> 6;
    const int tn = N / 64, nt = (K / 64) * tn;
    for (int it = bid; it < nt; it += nb) {
        const int k0 = (it / tn) * 64, n0 = (it % tn) * 64;
        __syncthreads();
#pragma unroll
        for (int i = 0; i < 8; ++i) { const int k = ty + 8 * i; float v = src[(size_t)(k0 + k) * N + n0 + tx]; if (gain) v *= gain[(k0 + k) & gmask] * gmul; tile[k * 65 + tx] = v; }
        __syncthreads();
#pragma unroll
        for (int i = 0; i < 8; ++i) { const int n = ty + 8 * i; dst[(size_t)(n0 + n) * K + k0 + tx] = f2bf(tile[tx * 65 + n]); }
    }
}
__device__ void conv_plain(const float* __restrict__ src, bf16_t* __restrict__ dst, size_t n, int bid, int nb) {
    const size_t n4 = n / 4;
    for (size_t i = (size_t)bid * NT + threadIdx.x; i < n4; i += (size_t)nb * NT) {
        const f32x4 v = ((const f32x4*)src)[i]; u32x2 w; w.x = pk2(v[0], v[1]); w.y = pk2(v[2], v[3]); ((u32x2*)dst)[i] = w;
    }
}
__device__ void conv_fp8(const float* __restrict__ src, unsigned* __restrict__ dst, const float* gain, float scale, int bid, int nb) {
    const size_t n4 = (size_t)NEXP * D / 4;
    for (size_t i = (size_t)bid * NT + threadIdx.x; i < n4; i += (size_t)nb * NT) {
        f32x4 v = ((const f32x4*)src)[i];
        if (gain) { const f32x4 g = ((const f32x4*)gain)[i & (D / 4 - 1)]; v = v * g; }
        v = v * scale;
        int w = __builtin_amdgcn_cvt_pk_fp8_f32(v[0], v[1], 0, false);
        w = __builtin_amdgcn_cvt_pk_fp8_f32(v[2], v[3], w, true);
        dst[i] = (unsigned)w;
    }
}

__device__ void stage_prologue0(const Params& p, int bid, int nb, float* lds) {
    unsigned char* ws = p.ws;
    const int tid = threadIdx.x, lane = tid & 63, wid = tid >> 6;
    for (int l = 0; l < L; ++l) {
        tr_conv((const float*)p.in[4] + (size_t)l * D * INW, (bf16_t*)(ws + WS_WIN) + (size_t)l * INW * D, D, INW, (const float*)p.in[3] + l * D, D - 1, 1.f, bid, nb, lds);
        const float* wb = (const float*)p.in[13] + (size_t)l * 3 * 512 * D;
        tr_conv(wb, (bf16_t*)(ws + WS_WB0) + (size_t)l * D * 512, 512, D, (const float*)p.in[6] + l * 128, 127, 1.f - lam_init_of(l), bid, nb, lds);
        tr_conv(wb + 512 * D, (bf16_t*)(ws + WS_WB1T) + (size_t)l * D * 512, 512, D, nullptr, 0, 1.f, bid, nb, lds);
        tr_conv(wb + 2 * 512 * D, (bf16_t*)(ws + WS_WB2) + (size_t)l * D * 512, 512, D, nullptr, 0, 1.f, bid, nb, lds);
        tr_conv((const float*)p.in[14] + (size_t)l * D * D, (bf16_t*)(ws + WS_WOUT) + (size_t)l * D * D, D, D, nullptr, 0, 1.f, bid, nb, lds);
        tr_conv((const float*)p.in[19] + (size_t)l * D * D, (bf16_t*)(ws + WS_WXOT) + (size_t)l * D * D, D, D, nullptr, 0, 1.f, bid, nb, lds);
        tr_conv((const float*)p.in[18] + (size_t)l * D * 2 * D, (bf16_t*)(ws + WS_WXKVT) + (size_t)l * 2 * D * D, D, 2 * D, (const float*)p.in[16] + l * D, D - 1, 1.f, bid, nb, lds);
        conv_fp8((const float*)p.in[23] + (size_t)l * NEXP * D, (unsigned*)(ws + WS_U8) + (size_t)l * NEXP * D / 4, (const float*)p.in[20] + l * D, SU, bid, nb);
        conv_fp8((const float*)p.in[24] + (size_t)l * NEXP * D, (unsigned*)(ws + WS_V8) + (size_t)l * NEXP * D / 4, nullptr, SV, bid, nb);
    }
    conv_plain((const float*)p.in[17], (bf16_t*)(ws + WS_WXQB), (size_t)L * D * D, bid, nb);
    conv_plain((const float*)p.in[21], (bf16_t*)(ws + WS_WPQB), (size_t)L * D * 2048, bid, nb);
    conv_plain((const float*)p.in[22], (bf16_t*)(ws + WS_KEYSB), (size_t)L * 8 * 2 * 128 * 128, bid, nb);
    for (int i = bid * NT + tid; i < L * 4 * 128 * 128; i += nb * NT) {
        const int e = i & 127, g = (i >> 14) & 3, l = i >> 16;
        ((bf16_t*)(ws + WS_WPOOLS))[i] = f2bf(((const float*)p.in[7])[i] * ((const float*)p.in[8])[l * 512 + g * 128 + e]);
        const int t = i & 127, s = (i >> 7) & 127, lg = i >> 14;
        ((float*)(ws + WS_WSPT))[i] = (s <= t) ? ((const float*)p.in[11])[(size_t)lg * 16384 + t * 128 + s] : 0.f;
    }
    for (int i = bid * NT + tid; i < T * 8; i += nb * NT) {
        const int j = i & 7, t = i >> 3;
        const double ang = (double)((const int*)p.in[2])[t] * pow(500000.0, -(double)j / 8.0);
        float* r = (float*)(ws + WS_ROPE) + (size_t)t * 16;
        r[j] = (float)cos(ang); r[8 + j] = (float)sin(ang);
    }
    for (int row = bid * 8 + wid; row < T + MROWS; row += nb * 8) {
        const bool ismem = row >= T; const int r = ismem ? row - T : row;
        const float* src = (ismem ? (const float*)p.in[1] : (const float*)p.in[0]) + (size_t)r * D;
        bf16_t* dstb = (bf16_t*)(ws + (ismem ? WS_MEMB : WS_XB)) + (size_t)r * D;
        float ss = 0.f;
#pragma unroll
        for (int i = 0; i < 4; ++i) {
            const f32x4 v = ((const f32x4*)src)[lane + 64 * i];
            ss += v[0] * v[0] + v[1] * v[1] + v[2] * v[2] + v[3] * v[3];
            u32x2 w; w.x = pk2(v[0], v[1]); w.y = pk2(v[2], v[3]); ((u32x2*)dstb)[lane + 64 * i] = w;
            if (!ismem) ((f32x4*)(p.out + (size_t)r * D))[lane + 64 * i] = v;
        }
        ss = wave_sum(ss);
        if (ismem) { if (lane == 0) ((float*)(ws + WS_RSTDM))[r] = rsqrtf(ss * (1.f / D) + EPS); }
        else if (lane < 16) ((float*)(ws + WS_SSP))[(size_t)r * 16 + lane] = (lane == 0) ? ss : 0.f;
    }
}

template <class Geom, class Epi>
__device__ __forceinline__ void gemm_simple(int nitems, int K, const Geom& geom, const Epi& epi, int bid, int nb) {
    const int tid = threadIdx.x, lane = tid & 63, wid = tid >> 6, wm = wid >> 1, wn = wid & 1, fr = lane & 15, fq = lane >> 4;
    for (int it = bid; it < nitems; it += nb) {
        const bf16_t* A; const bf16_t* Bt; int lda, ldb, grp, row0, col0;
        geom(it, A, lda, Bt, ldb, grp, row0, col0);
        f32x4 acc[2][4];
#pragma unroll
        for (int i = 0; i < 2; ++i)
#pragma unroll
            for (int j = 0; j < 4; ++j) acc[i][j] = (f32x4){0.f, 0.f, 0.f, 0.f};
        const bf16_t* ap = A + (size_t)(wm * 32 + fr) * lda + fq * 8;
        const bf16_t* bp = Bt + (size_t)(wn * 64 + fr) * ldb + fq * 8;
#pragma unroll 2
        for (int k0 = 0; k0 < K; k0 += 32) {
            bf16x8 a[2], b[4];
#pragma unroll
            for (int i = 0; i < 2; ++i) a[i] = *(const bf16x8*)(ap + (size_t)(i * 16) * lda + k0);
#pragma unroll
            for (int j = 0; j < 4; ++j) b[j] = *(const bf16x8*)(bp + (size_t)(j * 16) * ldb + k0);
#pragma unroll
            for (int i = 0; i < 2; ++i)
#pragma unroll
                for (int j = 0; j < 4; ++j) acc[i][j] = __builtin_amdgcn_mfma_f32_16x16x32_bf16(b[j], a[i], acc[i][j], 0, 0, 0);
        }
#pragma unroll
        for (int i = 0; i < 2; ++i) {
            const int row = row0 + wm * 32 + i * 16 + fr;
            const float rs = epi.prep(grp, row);
            float part = 0.f;
#pragma unroll
            for (int j = 0; j < 4; ++j) part += epi.apply(grp, row, col0 + wn * 64 + j * 16 + fq * 4, acc[i][j], rs, lane);
            epi.rowdone(grp, row, col0 + wn * 64, part, lane);
        }
    }
}

__device__ __forceinline__ void st_bf4(bf16_t* p, f32x4 v) { u32x2 w; w.x = pk2(v[0], v[1]); w.y = pk2(v[2], v[3]); *(u32x2*)p = w; }
__device__ __forceinline__ f32x4 ld_bf4(const bf16_t* p) { const u32x2 w = *(const u32x2*)p; return (f32x4){__uint_as_float(w.x << 16), __uint_as_float(w.x & 0xffff0000u), __uint_as_float(w.y << 16), __uint_as_float(w.y & 0xffff0000u)}; }

struct EpiWin {
    unsigned char* ws;
    __device__ __forceinline__ float prep(int, int row) const { return row_rstd((const float*)(ws + WS_SSP), row); }
    __device__ __forceinline__ float apply(int, int row, int col, f32x4 v, float rs, int lane) const {
        v = v * rs;
        if (col < 1024) {
            if ((col & 63) < 16) {
                const float* rp = (const float*)(ws + WS_ROPE) + (size_t)row * 16;
                const int j0 = (col & 7);
                const f32x4 cs = *(const f32x4*)(rp + j0), sn = *(const f32x4*)(rp + 8 + j0);
                f32x4 o;
#pragma unroll
                for (int e = 0; e < 4; ++e) o[e] = __shfl_xor(v[e], 32);
                const bool first = ((col & 15) < 8);
#pragma unroll
                for (int e = 0; e < 4; ++e) v[e] = first ? (v[e] * cs[e] - o[e] * sn[e]) : (o[e] * sn[e] + v[e] * cs[e]);
            }
            if (col < 512) { v = v * C2; st_bf4((bf16_t*)(ws + WS_QB) + (size_t)row * 512 + col, v); }
            else st_bf4((bf16_t*)(ws + WS_KB) + (size_t)row * 512 + (col - 512), v);
        } else if (col < 3072) {
            const int seg = (col - 1024) >> 9;
            const size_t base = seg == 0 ? WS_VB : seg == 1 ? WS_PIN : seg == 2 ? WS_UIN : WS_VIN;
            st_bf4((bf16_t*)(ws + base) + (size_t)row * 512 + ((col - 1024) & 511), v);
        } else {
#pragma unroll
            for (int e = 0; e < 4; ++e) v[e] = 1.f / (1.f + __expf(-v[e]));
            st_bf4((bf16_t*)(ws + WS_GTE) + (size_t)row * 3072 + (col - 3072), v);
        }
        return 0.f;
    }
    __device__ __forceinline__ void rowdone(int, int, int, float, int) const {}
};
struct EpiBranch {
    unsigned char* ws; int n;
    __device__ __forceinline__ float prep(int, int) const { return 1.f; }
    __device__ __forceinline__ float apply(int, int row, int col, f32x4 v, float, int) const {
        const f32x4 g = ld_bf4((const bf16_t*)(ws + WS_GTE) + (size_t)row * 3072 + n * 1024 + col);
        bf16_t* m = (bf16_t*)(ws + WS_MG) + (size_t)row * D + col;
        v = v * g; if (n > 0) v = v + ld_bf4(m);
        st_bf4(m, v);
        return 0.f;
    }
    __device__ __forceinline__ void rowdone(int, int, int, float, int) const {}
};
struct EpiResid {
    unsigned char* ws; float* x;
    __device__ __forceinline__ float prep(int, int) const { return 1.f; }
    __device__ __forceinline__ float apply(int, int row, int col, f32x4 v, float, int) const {
        float* xp = x + (size_t)row * D + col;
        v = v + *(const f32x4*)xp; *(f32x4*)xp = v;
        st_bf4((bf16_t*)(ws + WS_XB) + (size_t)row * D + col, v);
        return v[0] * v[0] + v[1] * v[1] + v[2] * v[2] + v[3] * v[3];
    }
    __device__ __forceinline__ void rowdone(int, int row, int colbase, float part, int lane) const {
        part += __shfl_xor(part, 16); part += __shfl_xor(part, 32);
        if ((lane >> 4) == 0) ((float*)(ws + WS_SSP))[(size_t)row * 16 + (colbase >> 6)] = part;
    }
};
struct EpiScaleF32 {
    unsigned char* ws; float* o; int ld; float mul;
    __device__ __forceinline__ float prep(int, int row) const { return row_rstd((const float*)(ws + WS_SSP), row) * mul; }
    __device__ __forceinline__ float apply(int, int row, int col, f32x4 v, float rs, int) const { *(f32x4*)(o + (size_t)row * ld + col) = v * rs; return 0.f; }
    __device__ __forceinline__ void rowdone(int, int, int, float, int) const {}
};
struct EpiKV {
    unsigned char* ws;
    __device__ __forceinline__ float prep(int, int row) const { return ((const float*)(ws + WS_RSTDM))[row]; }
    __device__ __forceinline__ float apply(int l, int row, int col, f32x4 v, float rs, int) const { st_bf4((bf16_t*)(ws + WS_KV) + ((size_t)l * MROWS + row) * 2048 + col, v * rs); return 0.f; }
    __device__ __forceinline__ void rowdone(int, int, int, float, int) const {}
};
struct EpiColGain {
    bf16_t* o; size_t gstride; int ld; const float* gain; int gdiv;
    __device__ __forceinline__ float prep(int, int) const { return 1.f; }
    __device__ __forceinline__ float apply(int grp, int row, int col, f32x4 v, float, int) const {
        if (gain) v = v * *(const f32x4*)(gain + (size_t)(grp / gdiv) * D + col);
        st_bf4(o + (size_t)grp * gstride + (size_t)row * ld + col, v);
        return 0.f;
    }
    __device__ __forceinline__ void rowdone(int, int, int, float, int) const {}
};

__device__ void stage_prologue1(const Params& p, int bid, int nb) {
    unsigned char* ws = p.ws;
    {
        auto geom = [=](int it, const bf16_t*& A, int& lda, const bf16_t*& Bt, int& ldb, int& grp, int& row0, int& col0) {
            const int l = it >> 8, tm = (it >> 4) & 15, tn = it & 15; grp = l; row0 = tm * 128; col0 = tn * 128; lda = D; ldb = D;
            A = (const bf16_t*)(ws + WS_MEMB) + (size_t)row0 * D; Bt = (const bf16_t*)(ws + WS_WXKVT) + ((size_t)l * 2048 + col0) * D; };
        gemm_simple(L * 256, D, geom, EpiKV{ws}, bid, nb);
    }
    {
        auto geom = [=](int it, const bf16_t*& A, int& lda, const bf16_t*& Bt, int& ldb, int& grp, int& row0, int& col0) {
            const int g = it >> 3, tn = it & 7, l = g >> 4, hp = g & 15; grp = g; row0 = 0; col0 = tn * 128; lda = 128; ldb = 2048;
            A = (const bf16_t*)(ws + WS_KEYSB) + (size_t)g * 16384; Bt = (const bf16_t*)(ws + WS_WPQB) + ((size_t)l * D + col0) * 2048 + hp * 128; };
        gemm_simple(L * 16 * 8, 128, geom, EpiColGain{(bf16_t*)(ws + WS_SKT), (size_t)128 * D, D, (const float*)p.in[20], 16}, bid, nb);
    }
    {
        auto geom = [=](int it, const bf16_t*& A, int& lda, const bf16_t*& Bt, int& ldb, int& grp, int& row0, int& col0) {
            const int lg = it >> 3, tm = it & 7, l = lg >> 2, g = lg & 3; grp = lg; row0 = tm * 128; col0 = 0; lda = 512; ldb = 128;
            A = (const bf16_t*)(ws + WS_WB1T) + ((size_t)l * D + row0) * 512 + g * 128; Bt = (const bf16_t*)(ws + WS_WPOOLS) + (size_t)lg * 16384; };
        struct EpiWeff { bf16_t* o; __device__ __forceinline__ float prep(int, int) const { return 1.f; }
            __device__ __forceinline__ float apply(int lg, int row, int col, f32x4 v, float, int) const { st_bf4(o + ((size_t)(lg >> 2) * D + row) * 512 + (lg & 3) * 128 + col, v); return 0.f; }
            __device__ __forceinline__ void rowdone(int, int, int, float, int) const {} };
        gemm_simple(L * 4 * 8, 128, geom, EpiWeff{(bf16_t*)(ws + WS_WEFF)}, bid, nb);
    }
}
__device__ void stage_prologue2(const Params& p, int bid, int nb) {
    unsigned char* ws = p.ws;
    {
        auto geom = [=](int it, const bf16_t*& A, int& lda, const bf16_t*& Bt, int& ldb, int& grp, int& row0, int& col0) {
            const int g = it >> 4, tm = (it >> 3) & 1, tn = it & 7, l = g >> 5, b = (g >> 2) & 7, h = g & 3; grp = g; row0 = tm * 128; col0 = tn * 128; lda = 2048; ldb = D;
            A = (const bf16_t*)(ws + WS_KV) + ((size_t)l * MROWS + b * 256 + row0) * 2048 + h * 256; Bt = (const bf16_t*)(ws + WS_WXQB) + ((size_t)l * D + col0) * D + h * 256; };
        gemm_simple(L * 32 * 16, 256, geom, EpiColGain{(bf16_t*)(ws + WS_GT), (size_t)256 * D, D, (const float*)p.in[15], 32}, bid, nb);
    }
    {
        auto geom = [=](int it, const bf16_t*& A, int& lda, const bf16_t*& Bt, int& ldb, int& grp, int& row0, int& col0) {
            const int g = it >> 4, tm = (it >> 1) & 7, tn = it & 1, l = g >> 5, b = (g >> 2) & 7, h = g & 3; grp = g; row0 = tm * 128; col0 = tn * 128; lda = D; ldb = 2048;
            A = (const bf16_t*)(ws + WS_WXOT) + ((size_t)l * D + row0) * D + h * 256; Bt = (const bf16_t*)(ws + WS_KV) + ((size_t)l * MROWS + b * 256 + col0) * 2048 + 1024 + h * 256; };
        struct EpiY { bf16_t* o; __device__ __forceinline__ float prep(int, int) const { return 1.f; }
            __device__ __forceinline__ float apply(int g, int row, int col, f32x4 v, float, int) const { st_bf4(o + ((size_t)(g >> 2) * D + row) * D + (g & 3) * 256 + col, v); return 0.f; }
            __device__ __forceinline__ void rowdone(int, int, int, float, int) const {} };
        gemm_simple(L * 32 * 16, 256, geom, EpiY{(bf16_t*)(ws + WS_YT)}, bid, nb);
    }
}

__device__ void stage_win(const Params& p, int l, int bid, int nb) {
    unsigned char* ws = p.ws;
    auto geom = [=](int it, const bf16_t*& A, int& lda, const bf16_t*& Bt, int& ldb, int& grp, int& row0, int& col0) {
        const int tm = it / 48, tn = it % 48; grp = 0; row0 = tm * 128; col0 = tn * 128; lda = D; ldb = D;
        A = (const bf16_t*)(ws + WS_XB) + (size_t)row0 * D; Bt = (const bf16_t*)(ws + WS_WIN) + ((size_t)l * INW + col0) * D; };
    gemm_simple(256 * 48, D, geom, EpiWin{ws}, bid, nb);
}
__device__ void stage_attn_naive(const Params& p, int bid, int nb) {
    unsigned char* ws = p.ws;
    const bf16_t* Q = (const bf16_t*)(ws + WS_QB); const bf16_t* Kb = (const bf16_t*)(ws + WS_KB); const bf16_t* Vb = (const bf16_t*)(ws + WS_VB);
    for (int it = bid; it < NB * 8 * (S / NT); it += nb) {
        const int qblk = it % (S / NT), hm = (it / (S / NT)) & 7, b = it / (8 * (S / NT));
        const int q = qblk * NT + threadIdx.x, h = hm >> 1, m = hm & 1;
        float qv[64], o[128];
        const bf16_t* qp = Q + ((size_t)b * S + q) * 512 + hm * 64;
#pragma unroll
        for (int d = 0; d < 64; d += 4) { const f32x4 v = ld_bf4(qp + d); qv[d] = v[0]; qv[d + 1] = v[1]; qv[d + 2] = v[2]; qv[d + 3] = v[3]; }
#pragma unroll
        for (int d = 0; d < 128; ++d) o[d] = 0.f;
        float mx = -INFINITY, lsum = 0.f;
        const int jmax = qblk * NT + NT - 1;
        const bf16_t* kp = Kb + (size_t)b * S * 512 + hm * 64; const bf16_t* vp = Vb + (size_t)b * S * 512 + h * 128;
        for (int j = 0; j <= jmax; ++j) {
            const unsigned* kr = (const unsigned*)(kp + (size_t)j * 512);
            float s = 0.f;
#pragma unroll
            for (int d = 0; d < 32; ++d) { const unsigned w = kr[d]; s += qv[2 * d] * __uint_as_float(w << 16) + qv[2 * d + 1] * __uint_as_float(w & 0xffff0000u); }
            if (j <= q) {
                if (s > mx) { const float f = exp2f(mx - s);
#pragma unroll
                    for (int d = 0; d < 128; ++d) o[d] *= f;
                    lsum *= f; mx = s; }
                const float pr = exp2f(s - mx); lsum += pr;
                const unsigned* vr = (const unsigned*)(vp + (size_t)j * 512);
#pragma unroll
                for (int d = 0; d < 64; ++d) { const unsigned w = vr[d]; o[2 * d] += pr * __uint_as_float(w << 16); o[2 * d + 1] += pr * __uint_as_float(w & 0xffff0000u); }
            }
        }
        const float inv = 1.f / lsum;
        bf16_t* op = (bf16_t*)(ws + (m == 0 ? WS_O1 : WS_O2)) + ((size_t)b * S + q) * 512 + h * 128;
#pragma unroll
        for (int d = 0; d < 128; d += 4) st_bf4(op + d, (f32x4){o[d] * inv, o[d + 1] * inv, o[d + 2] * inv, o[d + 3] * inv});
    }
}
__device__ void stage_pool_d(const Params& p, int bid, int nb) {
    unsigned char* ws = p.ws;
    const bf16_t* pin = (const bf16_t*)(ws + WS_PIN); bf16_t* dp = (bf16_t*)(ws + WS_DP);
    for (int i = bid * NT + threadIdx.x; i < T * 128; i += nb * NT) {
        const int c4 = (i & 127) * 4, t = i >> 7, s = t & (S - 1), g = c4 >> 7, w = 2 << g;
        const int cnt = (s + 1 < w) ? s + 1 : w;
        f32x4 sum = (f32x4){0.f, 0.f, 0.f, 0.f};
        for (int k = 0; k < cnt; ++k) sum = sum + ld_bf4(pin + (size_t)(t - k) * 512 + c4);
        const f32x4 self = ld_bf4(pin + (size_t)t * 512 + c4);
        st_bf4(dp + (size_t)t * 512 + c4, sum * (1.f / (float)cnt) - self);
    }
}
__device__ void stage_sgate(const Params& p, int l, int bid, int nb, float* lds) {
    unsigned char* ws = p.ws;
    float* vn = lds;
    float* wt = lds + 128 * 128;
    float* st = lds + 2 * 128 * 128;
    const int tid = threadIdx.x, lane = tid & 63, wid = tid >> 6;
    const bf16_t* vin = (const bf16_t*)(ws + WS_VIN); const bf16_t* uin = (const bf16_t*)(ws + WS_UIN); bf16_t* so = (bf16_t*)(ws + WS_SO);
    const float* lng = (const float*)p.in[9] + l * 512; const float* lnb = (const float*)p.in[10] + l * 512; const float* bsp = (const float*)p.in[12] + l * 512;
    for (int it = bid; it < (T / 128) * 4; it += nb) {
        const int ch = it >> 2, g = it & 3, t0 = ch * 128;
        __syncthreads();
        for (int r = wid; r < 128; r += 8) {
            const u32x4 w = *(const u32x4*)(vin + (size_t)(t0 + r) * 512 + lane * 8);
            float x[8]; x[0] = __uint_as_float(w.x << 16); x[1] = __uint_as_float(w.x & 0xffff0000u); x[2] = __uint_as_float(w.y << 16); x[3] = __uint_as_float(w.y & 0xffff0000u);
            x[4] = __uint_as_float(w.z << 16); x[5] = __uint_as_float(w.z & 0xffff0000u); x[6] = __uint_as_float(w.w << 16); x[7] = __uint_as_float(w.w & 0xffff0000u);
            float sm = 0.f;
#pragma unroll
            for (int e = 0; e < 8; ++e) sm += x[e];
            const float mu = wave_sum(sm) * (1.f / 512.f);
            float vr = 0.f;
#pragma unroll
            for (int e = 0; e < 8; ++e) vr += (x[e] - mu) * (x[e] - mu);
            vr = wave_sum(vr) * (1.f / 512.f);
            if (lane == 0) { st[2 * r] = mu; st[2 * r + 1] = rsqrtf(vr + EPS); }
        }
        __syncthreads();
        for (int i = tid; i < 128 * 32; i += NT) {
            const int s = i >> 5, c4 = (i & 31) * 4;
            const f32x4 v = ld_bf4(vin + (size_t)(t0 + s) * 512 + g * 128 + c4);
            const f32x4 gg = *(const f32x4*)(lng + g * 128 + c4), bb = *(const f32x4*)(lnb + g * 128 + c4);
            const float mu = st[2 * s], rs = st[2 * s + 1];
            *(f32x4*)(vn + s * 128 + c4) = (v - mu) * rs * gg + bb;
        }
        const float* wsrc = (const float*)(ws + WS_WSPT) + (size_t)(l * 4 + g) * 16384;
        for (int i = tid; i < 128 * 32; i += NT) *(f32x4*)(wt + i * 4) = *(const f32x4*)(wsrc + i * 4);
        __syncthreads();
        const int c = tid & 127, tq = tid >> 7;
        float acc[32];
#pragma unroll
        for (int i = 0; i < 32; ++i) acc[i] = 0.f;
        const int smax = tq * 32 + 31;
        for (int s = 0; s <= smax; ++s) {
            const float x = vn[s * 128 + c];
#pragma unroll
            for (int i = 0; i < 32; i += 4) { const f32x4 w = *(const f32x4*)(wt + s * 128 + tq * 32 + i); acc[i] += w[0] * x; acc[i + 1] += w[1] * x; acc[i + 2] += w[2] * x; acc[i + 3] += w[3] * x; }
        }
#pragma unroll
        for (int i = 0; i < 32; ++i) {
            const int t = tq * 32 + i; const size_t o = (size_t)(t0 + t) * 512 + g * 128 + c;
            so[o] = f2bf(bf2f(uin[o]) * (acc[i] + bsp[g * 128 + t]));
        }
    }
}
__device__ void stage_aout(const Params& p, int l, int bid, int nb) {
    unsigned char* ws = p.ws;
    const int lane = threadIdx.x & 63, wid = threadIdx.x >> 6;
    const float* lq = (const float*)p.in[5] + l * 256;
    float d1 = lq[lane] * lq[64 + lane], d2 = lq[128 + lane] * lq[192 + lane];
    d1 = wave_sum(d1); d2 = wave_sum(d2);
    const float lam = expf(d1) - expf(d2) + lam_init_of(l);
    for (int t = bid * 8 + wid; t < T; t += nb * 8) {
        const u32x4 a = *(const u32x4*)((const bf16_t*)(ws + WS_O1) + (size_t)t * 512 + lane * 8), b = *(const u32x4*)((const bf16_t*)(ws + WS_O2) + (size_t)t * 512 + lane * 8);
        float x[8];
#pragma unroll
        for (int e = 0; e < 4; ++e) { x[2 * e] = __uint_as_float(a[e] << 16) - lam * __uint_as_float(b[e] << 16); x[2 * e + 1] = __uint_as_float(a[e] & 0xffff0000u) - lam * __uint_as_float(b[e] & 0xffff0000u); }
        float ss = 0.f;
#pragma unroll
        for (int e = 0; e < 8; ++e) ss += x[e] * x[e];
        ss += __shfl_xor(ss, 1); ss += __shfl_xor(ss, 2); ss += __shfl_xor(ss, 4); ss += __shfl_xor(ss, 8);
        const float rs = rsqrtf(ss * (1.f / 128.f) + EPS);
        u32x4 w;
#pragma unroll
        for (int e = 0; e < 4; ++e) w[e] = pk2(x[2 * e] * rs, x[2 * e + 1] * rs);
        *(u32x4*)((bf16_t*)(ws + WS_AO) + (size_t)t * 512 + lane * 8) = w;
    }
}
__device__ void stage_branch(const Params& p, int l, int bid, int nb) {
    unsigned char* ws = p.ws;
#pragma unroll 1
    for (int n = 0; n < 3; ++n) {
        const size_t abase = n == 0 ? WS_AO : n == 1 ? WS_DP : WS_SO, bbase = n == 0 ? WS_WB0 : n == 1 ? WS_WEFF : WS_WB2;
        auto geom = [=](int it, const bf16_t*& A, int& lda, const bf16_t*& Bt, int& ldb, int& grp, int& row0, int& col0) {
            const int tm = it >> 3, tn = it & 7; grp = 0; row0 = tm * 128; col0 = tn * 128; lda = 512; ldb = 512;
            A = (const bf16_t*)(ws + abase) + (size_t)row0 * 512; Bt = (const bf16_t*)(ws + bbase) + ((size_t)l * D + col0) * 512; };
        gemm_simple(256 * 8, 512, geom, EpiBranch{ws, n}, bid, nb);
    }
}
__device__ void stage_resid_gemm(const Params& p, size_t a_off, size_t b_off, size_t b_batch_stride, int bid, int nb) {
    unsigned char* ws = p.ws;
    auto geom = [=](int it, const bf16_t*& A, int& lda, const bf16_t*& Bt, int& ldb, int& grp, int& row0, int& col0) {
        const int tm = it >> 3, tn = it & 7; grp = 0; row0 = tm * 128; col0 = tn * 128; lda = D; ldb = D;
        A = (const bf16_t*)(ws + a_off) + (size_t)row0 * D; Bt = (const bf16_t*)(ws + b_off) + (size_t)(row0 / S) * b_batch_stride + (size_t)col0 * D; };
    gemm_simple(256 * 8, D, geom, EpiResid{ws, p.out}, bid, nb);
}
__device__ void stage_xscore(const Params& p, int l, int bid, int nb) {
    unsigned char* ws = p.ws;
    auto geom = [=](int it, const bf16_t*& A, int& lda, const bf16_t*& Bt, int& ldb, int& grp, int& row0, int& col0) {
        const int tm = it >> 3, tn = it & 7; grp = 0; row0 = tm * 128; col0 = tn * 128; lda = D; ldb = D;
        A = (const bf16_t*)(ws + WS_XB) + (size_t)row0 * D; Bt = (const bf16_t*)(ws + WS_GT) + ((size_t)(l * NB + row0 / S) * D + col0) * D; };
    gemm_simple(256 * 8, D, geom, EpiScaleF32{ws, (float*)(ws + WS_SX), D, 1.f / 16.f}, bid, nb);
}
__device__ void stage_xsoftmax(const Params& p, int bid, int nb) {
    unsigned char* ws = p.ws;
    const int lane = threadIdx.x & 63, wid = threadIdx.x >> 6;
    for (int i = bid * 8 + wid; i < T * 4; i += nb * 8) {
        const f32x4 v = *(const f32x4*)((const float*)(ws + WS_SX) + (size_t)i * 256 + lane * 4);
        const float mx = wave_max(fmaxf(fmaxf(v[0], v[1]), fmaxf(v[2], v[3])));
        f32x4 e; e[0] = __expf(v[0] - mx); e[1] = __expf(v[1] - mx); e[2] = __expf(v[2] - mx); e[3] = __expf(v[3] - mx);
        const float inv = 1.f / wave_sum(e[0] + e[1] + e[2] + e[3]);
        st_bf4((bf16_t*)(ws + WS_PM) + (size_t)i * 256 + lane * 4, e * inv);
    }
}
__device__ void stage_pscore(const Params& p, int l, int bid, int nb) {
    unsigned char* ws = p.ws;
    auto geom = [=](int it, const bf16_t*& A, int& lda, const bf16_t*& Bt, int& ldb, int& grp, int& row0, int& col0) {
        const int tm = it >> 4, tn = it & 15; grp = 0; row0 = tm * 128; col0 = tn * 128; lda = D; ldb = D;
        A = (const bf16_t*)(ws + WS_XB) + (size_t)row0 * D; Bt = (const bf16_t*)(ws + WS_SKT) + ((size_t)l * 2048 + col0) * D; };
    gemm_simple(256 * 16, D, geom, EpiScaleF32{ws, (float*)(ws + WS_SC), 2048, 1.f}, bid, nb);
}
__device__ __forceinline__ unsigned key_of(float s, unsigned low) { const unsigned u = __float_as_uint(s); const unsigned k = (u & 0x80000000u) ? ~u : (u | 0x80000000u); return (k & ~255u) | low; }
__device__ __forceinline__ float val_of(unsigned key) { const unsigned k = key & ~255u; const unsigned u = (k & 0x80000000u) ? (k & 0x7fffffffu) : ~k; return __uint_as_float(u); }
__device__ __forceinline__ void ins16(unsigned (&l)[16], unsigned v) {
    if (v > l[15]) {
#pragma unroll
        for (int j = 15; j >= 1; --j) l[j] = (v > l[j - 1]) ? l[j - 1] : (l[j] > v ? l[j] : v);
        l[0] = l[0] > v ? l[0] : v;
    }
}
__device__ void stage_topk(const Params& p, int bid, int nb) {
    unsigned char* ws = p.ws;
    const float* sc = (const float*)(ws + WS_SC);
    for (int i = bid * NT + threadIdx.x; i < T * 8; i += nb * NT) {
        const float* row = sc + (size_t)i * 256;
        unsigned la[16], lb[16], lc[16];
#pragma unroll
        for (int j = 0; j < 16; ++j) { la[j] = 0u; lb[j] = 0u; lc[j] = 0u; }
        for (int n = 0; n < 128; n += 4) {
            const f32x4 a = *(const f32x4*)(row + n), b = *(const f32x4*)(row + 128 + n);
#pragma unroll
            for (int e = 0; e < 4; ++e) { ins16(la, key_of(a[e], 255u - (unsigned)(n + e))); ins16(lb, key_of(b[e], 255u - (unsigned)(n + e))); }
        }
        float sa[16], sb[16];
#pragma unroll
        for (int j = 0; j < 16; ++j) { sa[j] = val_of(la[j]); sb[j] = val_of(lb[j]); }
#pragma unroll
        for (int a = 0; a < 16; ++a)
#pragma unroll
            for (int b = 0; b < 16; ++b)
                if ((a + 1) * (b + 1) <= 16) ins16(lc, key_of(sa[a] + sb[b], 255u - (unsigned)(a * 16 + b)));
        float g[16]; float mx = val_of(lc[0]), sum = 0.f;
#pragma unroll
        for (int j = 0; j < 16; ++j) { g[j] = __expf(val_of(lc[j]) - mx); sum += g[j]; }
        const float inv = 1.f / sum;
        int* ti = (int*)(ws + WS_TI) + (size_t)i * 16; float* tg = (float*)(ws + WS_TG) + (size_t)i * 16;
#pragma unroll
        for (int j = 0; j < 16; ++j) {
            const int c = 255 - (int)(lc[j] & 255u), a = c >> 4, b = c & 15;
            unsigned ka = la[0], kb = lb[0];
#pragma unroll
            for (int q = 1; q < 16; ++q) { ka = (a == q) ? la[q] : ka; kb = (b == q) ? lb[q] : kb; }
            ti[j] = (255 - (int)(ka & 255u)) * 128 + (255 - (int)(kb & 255u));
            tg[j] = g[j] * inv;
        }
    }
}
__device__ __forceinline__ void cvt16(const u32x4 w, float (&f)[16]) {
#pragma unroll
    for (int i = 0; i < 4; ++i) { const f32x2 a = __builtin_amdgcn_cvt_pk_f32_fp8((int)w[i], false), b = __builtin_amdgcn_cvt_pk_f32_fp8((int)w[i], true); f[4 * i] = a.x; f[4 * i + 1] = a.y; f[4 * i + 2] = b.x; f[4 * i + 3] = b.y; }
}
__device__ void stage_experts(const Params& p, int l, int bid, int nb) {
    unsigned char* ws = p.ws;
    const int lane = threadIdx.x & 63, wid = threadIdx.x >> 6;
    const unsigned char* u8 = ws + WS_U8 + (size_t)l * NEXP * D; const unsigned char* v8 = ws + WS_V8 + (size_t)l * NEXP * D;
    const float* gfin = (const float*)p.in[25];
    for (int t = bid * 8 + wid; t < T; t += nb * 8) {
        const float rs = row_rstd((const float*)(ws + WS_SSP), t);
        float x[16];
        { const bf16_t* xp = (const bf16_t*)(ws + WS_XB) + (size_t)t * D + lane * 16; const u32x4 a = *(const u32x4*)xp, b = *(const u32x4*)(xp + 8);
#pragma unroll
          for (int e = 0; e < 4; ++e) { x[2 * e] = __uint_as_float(a[e] << 16); x[2 * e + 1] = __uint_as_float(a[e] & 0xffff0000u); x[8 + 2 * e] = __uint_as_float(b[e] << 16); x[9 + 2 * e] = __uint_as_float(b[e] & 0xffff0000u); } }
        const int* ti = (const int*)(ws + WS_TI) + (size_t)t * 128; const float* tg = (const float*)(ws + WS_TG) + (size_t)t * 128;
        const int e0 = ti[lane], e1 = ti[64 + lane]; const float g0 = tg[lane], g1 = tg[64 + lane];
        float a0 = 0.f, a1 = 0.f;
        for (int eb = 0; eb < 128; eb += 4) {
            u32x4 w[4];
#pragma unroll
            for (int k = 0; k < 4; ++k) { const int e = eb + k; const int idx = __shfl(e < 64 ? e0 : e1, e & 63); w[k] = *(const u32x4*)(u8 + (size_t)idx * D + lane * 16); }
#pragma unroll
            for (int k = 0; k < 4; ++k) { float f[16]; cvt16(w[k], f); float d = 0.f;
#pragma unroll
                for (int i = 0; i < 16; ++i) d += f[i] * x[i];
                d = wave_sum(d) * (rs * (1.f / SU));
                const float ge = 0.5f * d * (1.f + erff(d * 0.70710678118654752f));
                const int e = eb + k; if (e < 64) { if (lane == e) a0 = ge * g0; } else { if (lane == e - 64) a1 = ge * g1; } }
        }
        float acc[16];
#pragma unroll
        for (int i = 0; i < 16; ++i) acc[i] = 0.f;
        for (int eb = 0; eb < 128; eb += 4) {
            u32x4 w[4]; float av[4];
#pragma unroll
            for (int k = 0; k < 4; ++k) { const int e = eb + k; const int idx = __shfl(e < 64 ? e0 : e1, e & 63); av[k] = __shfl(e < 64 ? a0 : a1, e & 63); w[k] = *(const u32x4*)(v8 + (size_t)idx * D + lane * 16); }
#pragma unroll
            for (int k = 0; k < 4; ++k) { float f[16]; cvt16(w[k], f);
#pragma unroll
                for (int i = 0; i < 16; ++i) acc[i] += av[k] * f[i]; }
        }
        float* xr = p.out + (size_t)t * D + lane * 16;
        float ss = 0.f;
#pragma unroll
        for (int i = 0; i < 16; i += 4) { f32x4 v = *(const f32x4*)(xr + i); v[0] += acc[i] * (1.f / SV); v[1] += acc[i + 1] * (1.f / SV); v[2] += acc[i + 2] * (1.f / SV); v[3] += acc[i + 3] * (1.f / SV);
            acc[i] = v[0]; acc[i + 1] = v[1]; acc[i + 2] = v[2]; acc[i + 3] = v[3]; ss += v[0] * v[0] + v[1] * v[1] + v[2] * v[2] + v[3] * v[3]; }
        ss = wave_sum(ss);
        if (l == L - 1) {
            const float r = rsqrtf(ss * (1.f / D) + EPS);
#pragma unroll
            for (int i = 0; i < 16; i += 4) { const f32x4 g = *(const f32x4*)(gfin + lane * 16 + i); *(f32x4*)(xr + i) = (f32x4){acc[i] * r * g[0], acc[i + 1] * r * g[1], acc[i + 2] * r * g[2], acc[i + 3] * r * g[3]}; }
        } else {
#pragma unroll
            for (int i = 0; i < 16; i += 4) *(f32x4*)(xr + i) = (f32x4){acc[i], acc[i + 1], acc[i + 2], acc[i + 3]};
            bf16_t* xb = (bf16_t*)(ws + WS_XB) + (size_t)t * D + lane * 16; u32x4 w0, w1;
#pragma unroll
            for (int e = 0; e < 4; ++e) { w0[e] = pk2(acc[2 * e], acc[2 * e + 1]); w1[e] = pk2(acc[8 + 2 * e], acc[9 + 2 * e]); }
            *(u32x4*)xb = w0; *(u32x4*)(xb + 8) = w1;
            if (lane < 16) ((float*)(ws + WS_SSP))[(size_t)t * 16 + lane] = (lane == 0) ? ss : 0.f;
        }
    }
}

extern __shared__ __attribute__((aligned(16))) unsigned char dyn_lds[];
template <int ST> __global__ void __launch_bounds__(NT, 2) k_stage(Params p, int l) {
    const int bid = blockIdx.x, nb = gridDim.x;
    float* lds = (float*)dyn_lds;
    if (ST == 0) stage_prologue0(p, bid, nb, lds);
    if (ST == 1) stage_prologue1(p, bid, nb);
    if (ST == 2) stage_prologue2(p, bid, nb);
    if (ST == 3) stage_win(p, l, bid, nb);
    if (ST == 4) stage_attn_naive(p, bid, nb);
    if (ST == 5) stage_pool_d(p, bid, nb);
    if (ST == 6) stage_sgate(p, l, bid, nb, lds);
    if (ST == 7) stage_aout(p, l, bid, nb);
    if (ST == 8) stage_branch(p, l, bid, nb);
    if (ST == 9) stage_resid_gemm(p, WS_MG, WS_WOUT + (size_t)l * D * D * 2, 0, bid, nb);
    if (ST == 10) stage_xscore(p, l, bid, nb);
    if (ST == 11) stage_xsoftmax(p, bid, nb);
    if (ST == 12) stage_resid_gemm(p, WS_PM, WS_YT + (size_t)l * NB * D * D * 2, (size_t)D * D, bid, nb);
    if (ST == 13) stage_pscore(p, l, bid, nb);
    if (ST == 14) stage_topk(p, bid, nb);
    if (ST == 15) stage_experts(p, l, bid, nb);
}

extern "C" void kernel_launch(void* const* d_in, const int* in_sizes, int n_in, void* d_out, int out_size, void* d_ws, size_t ws_size, hipStream_t stream) {
    Params p{};
    for (int i = 0; i < 26; ++i) p.in[i] = d_in[i];
    p.out = (float*)d_out; p.ws = (unsigned char*)d_ws;
    const int G = 1024;
    constexpr size_t LDS_SG = (2 * 128 * 128 + 256) * 4;
    static bool attr_set = false;
    if (!attr_set) { hipFuncSetAttribute((const void*)k_stage<6>, hipFuncAttributeMaxDynamicSharedMemorySize, (int)LDS_SG); attr_set = true; }
    k_stage<0><<<G, NT, 64 * 65 * 4, stream>>>(p, 0);
    k_stage<1><<<G, NT, 0, stream>>>(p, 0);
    k_stage<2><<<G, NT, 0, stream>>>(p, 0);
    for (int l = 0; l < L; ++l) {
        k_stage<3><<<2048, NT, 0, stream>>>(p, l);
        k_stage<4><<<512, NT, 0, stream>>>(p, l);
        k_stage<5><<<G, NT, 0, stream>>>(p, l);
        k_stage<6><<<1024, NT, LDS_SG, stream>>>(p, l);
        k_stage<7><<<G, NT, 0, stream>>>(p, l);
        k_stage<8><<<2048, NT, 0, stream>>>(p, l);
        k_stage<9><<<2048, NT, 0, stream>>>(p, l);
        k_stage<10><<<2048, NT, 0, stream>>>(p, l);
        k_stage<11><<<G, NT, 0, stream>>>(p, l);
        k_stage<12><<<2048, NT, 0, stream>>>(p, l);
        k_stage<13><<<2048, NT, 0, stream>>>(p, l);
        k_stage<14><<<G, NT, 0, stream>>>(p, l);
        k_stage<15><<<G, NT, 0, stream>>>(p, l);
    }
}
```

```cpp
#include <hip/hip_runtime.h>
#ifndef PROBE
#define PROBE 0
#endif
#include <stdint.h>
#include <math.h>

typedef unsigned short bf16_t;
typedef short bf16x8 __attribute__((ext_vector_type(8)));
typedef float f32x4 __attribute__((ext_vector_type(4)));
typedef float f32x2 __attribute__((ext_vector_type(2)));
typedef unsigned u32x4 __attribute__((ext_vector_type(4)));
typedef unsigned u32x2 __attribute__((ext_vector_type(2)));

constexpr int D = 1024, NB = 8, S = 4096, T = NB * S, L = 4, MEM = 256, MROWS = NB * MEM;
constexpr int INW = 6144, NEXP = 16384;
constexpr float EPS = 1e-6f;
constexpr float C2 = 0.125f * 1.4426950408889634f;
constexpr float SU = 256.f, SV = 32.f;
constexpr float XS = 8.f;
constexpr float W8S = 256.f;
constexpr float GS = 16.f, YS = 16.f, PS = 256.f;
constexpr int NT = 512;

constexpr size_t MiB = 1u << 20;
constexpr size_t WS_CTL = 0, WS_ROPE = 1 * MiB, WS_SSP = 3 * MiB, WS_WSPT = 5 * MiB, WS_RSTDM = 6 * MiB, WS_WPOOLS = 7 * MiB, WS_KEYSB = 8 * MiB;
constexpr size_t WS_WIN = 10 * MiB, WS_WB0 = 58 * MiB, WS_WEFF = 62 * MiB, WS_WB2 = 66 * MiB, WS_WOUT = 70 * MiB, WS_GT = 78 * MiB, WS_YT = 142 * MiB;
constexpr size_t WS_SKT = 206 * MiB, WS_U8 = 222 * MiB, WS_V8 = 286 * MiB, WS_XB = 350 * MiB, WS_TI = 414 * MiB, WS_TG = 430 * MiB, WS_MX = 446 * MiB;
constexpr size_t WS_GTE = WS_MX, WS_QB = WS_MX + 192 * MiB, WS_KB = WS_MX + 224 * MiB, WS_VB = WS_MX + 256 * MiB, WS_PIN = WS_MX + 288 * MiB, WS_DP = WS_MX + 320 * MiB;
constexpr size_t WS_UIN = WS_MX + 352 * MiB, WS_VIN = WS_MX + 384 * MiB, WS_O1 = WS_MX + 416 * MiB, WS_O2 = WS_MX + 448 * MiB, WS_SO = WS_MX + 480 * MiB, WS_END = WS_MX + 512 * MiB;
constexpr size_t WS_PA = WS_END;
constexpr size_t WS_XQ8 = WS_PA + 32 * MiB;
constexpr size_t WS_AO = WS_QB, WS_MG = WS_KB, WS_SX = WS_MX, WS_PM = WS_O1, WS_SC = WS_MX;
constexpr size_t WS_MEMB = WS_MX, WS_WXQB = WS_MX + 4 * MiB, WS_WXOT = WS_MX + 12 * MiB, WS_WXKVT = WS_MX + 20 * MiB, WS_KV = WS_MX + 36 * MiB, WS_WB1T = WS_MX + 68 * MiB, WS_WPQB = WS_MX + 72 * MiB;
static_assert(WS_XQ8 + 32 * MiB <= 1024 * MiB, "workspace map");

struct Params { const void* in[26]; float* out; unsigned char* ws; };

__device__ __forceinline__ float bf2f(bf16_t v) { return __uint_as_float(((unsigned)v) << 16); }
__device__ __forceinline__ bf16_t f2bf(float f) { unsigned u = __float_as_uint(f); return (bf16_t)((u + 0x7fffu + ((u >> 16) & 1u)) >> 16); }
typedef __bf16 hwbf16x2 __attribute__((ext_vector_type(2)));
__device__ __forceinline__ unsigned pk2(float lo, float hi) { const f32x2 v = {lo, hi}; return __builtin_bit_cast(unsigned, __builtin_convertvector(v, hwbf16x2)); }
template <int CTRL> __device__ __forceinline__ float dppf(float v) { return __builtin_bit_cast(float, __builtin_amdgcn_update_dpp(0, __builtin_bit_cast(int, v), CTRL, 0xF, 0xF, true)); }
constexpr int DPP_X1 = 0xB1, DPP_X2 = 0x4E, DPP_HMIR = 0x141, DPP_MIR = 0x140, DPP_X8 = 0x128;
__device__ __forceinline__ float lx16(float v) { float r; asm volatile("ds_swizzle_b32 %0, %1 offset:swizzle(SWAP,16)\n\ts_waitcnt lgkmcnt(0)" : "=v"(r) : "v"(v)); return r; }
__device__ __forceinline__ float add_x32(float v) { const auto rr = __builtin_amdgcn_permlane32_swap(__float_as_uint(v), __float_as_uint(v), false, false); return __uint_as_float(rr[0]) + __uint_as_float(rr[1]); }
__device__ __forceinline__ float max_x32(float v) { const auto rr = __builtin_amdgcn_permlane32_swap(__float_as_uint(v), __float_as_uint(v), false, false); return fmaxf(__uint_as_float(rr[0]), __uint_as_float(rr[1])); }
__device__ __forceinline__ float sum16(float v) { v += dppf<DPP_X1>(v); v += dppf<DPP_X2>(v); v += dppf<DPP_HMIR>(v); v += dppf<DPP_MIR>(v); return v; }
__device__ __forceinline__ float max16(float v) { v = fmaxf(v, dppf<DPP_X1>(v)); v = fmaxf(v, dppf<DPP_X2>(v)); v = fmaxf(v, dppf<DPP_HMIR>(v)); v = fmaxf(v, dppf<DPP_MIR>(v)); return v; }
__device__ __forceinline__ float wave_sum(float v) { v = sum16(v); v += lx16(v); return add_x32(v); }
__device__ __forceinline__ float wave_max(float v) { v = max16(v); v = fmaxf(v, lx16(v)); return max_x32(v); }
__device__ __forceinline__ int tid_fresh() { unsigned w, ln; asm volatile("s_mov_b32 %0, m0\n\tv_mbcnt_lo_u32_b32 %1, -1, 0\n\tv_mbcnt_hi_u32_b32 %1, -1, %1" : "=s"(w), "=v"(ln)); return (int)((w << 6) | ln); }
__device__ __forceinline__ float row_rstd(const float* ssp, int row) {
    const f32x4* p = (const f32x4*)(ssp + (size_t)row * 16);
    f32x4 a = p[0], b = p[1], c = p[2], d = p[3];
    float s = (a[0] + a[1] + a[2] + a[3]) + (b[0] + b[1] + b[2] + b[3]) + (c[0] + c[1] + c[2] + c[3]) + (d[0] + d[1] + d[2] + d[3]);
    return rsqrtf(s * (1.f / D) + EPS);
}
__device__ __forceinline__ float lam_init_of(int l) { return 0.8f - 0.6f * expf(-0.3f * (float)l); }

__device__ __forceinline__ u32x2 pk8_fp8(f32x4 a, f32x4 b, float sc);
__device__ __forceinline__ u32x4 pk8(f32x4 a, f32x4 b);
__device__ __forceinline__ void tr_conv(const float* __restrict__ src, bf16_t* __restrict__ dst, int K, int N, const float* gain, int gmask, float gmul, int bid, int nb, float* tile, int ldd = 0, int lds_src = 0) {
    const int tidx = tid_fresh();
    const int tx = tidx & 63, ty = tidx >> 6;
    const int tn = N / 64, nt = (K / 64) * tn, sp = lds_src ? lds_src : N;
    float r[8], rn[8];
    int it = bid;
    if (it < nt) { const int k0 = (it / tn) * 64, n0 = (it % tn) * 64;
#pragma unroll
        for (int i = 0; i < 8; ++i) { const int k = ty + 8 * i; r[i] = src[(size_t)(k0 + k) * sp + n0 + tx]; if (gain) r[i] *= gain[(k0 + k) & gmask] * gmul; } }
    while (it < nt) {
        const int k0 = (it / tn) * 64, n0 = (it % tn) * 64, nx = it + nb;
        if (nx < nt) { const int k1 = (nx / tn) * 64, n1 = (nx % tn) * 64;
#pragma unroll
            for (int i = 0; i < 8; ++i) { const int k = ty + 8 * i; rn[i] = src[(size_t)(k1 + k) * sp + n1 + tx]; if (gain) rn[i] *= gain[(k1 + k) & gmask] * gmul; } }
        __syncthreads();
#pragma unroll
        for (int i = 0; i < 8; ++i) tile[(ty + 8 * i) * 65 + tx] = r[i];
        __syncthreads();
        { const int n = tidx >> 3, kq = (tidx & 7) * 8;
          f32x4 a, b;
#pragma unroll
          for (int e = 0; e < 4; ++e) { a[e] = tile[(kq + e) * 65 + n]; b[e] = tile[(kq + 4 + e) * 65 + n]; }
          *(u32x4*)(dst + (size_t)(n0 + n) * (ldd ? ldd : K) + k0 + kq) = pk8(a, b); }
#pragma unroll
        for (int i = 0; i < 8; ++i) r[i] = rn[i];
        it = nx;
    }
}
__device__ __forceinline__ void tr_conv8(const float* __restrict__ src, unsigned char* __restrict__ dst, int K, int N, const float* gain, float scale, int sp, int bid, int nb, float* tile) {
    const int tidx = tid_fresh();
    const int tx = tidx & 63, ty = tidx >> 6;
    const int tn = N / 64, nt = (K / 64) * tn;
    float r[8], rn[8];
    int it = bid;
    if (it < nt) { const int k0 = (it / tn) * 64, n0 = (it % tn) * 64;
#pragma unroll
        for (int i = 0; i < 8; ++i) { const int k = ty + 8 * i; r[i] = src[(size_t)(k0 + k) * sp + n0 + tx] * gain[k0 + k] * scale; } }
    while (it < nt) {
        const int k0 = (it / tn) * 64, n0 = (it % tn) * 64, nx = it + nb;
        if (nx < nt) { const int k1 = (nx / tn) * 64, n1 = (nx % tn) * 64;
#pragma unroll
            for (int i = 0; i < 8; ++i) { const int k = ty + 8 * i; rn[i] = src[(size_t)(k1 + k) * sp + n1 + tx] * gain[k1 + k] * scale; } }
        __syncthreads();
#pragma unroll
        for (int i = 0; i < 8; ++i) tile[(ty + 8 * i) * 65 + tx] = r[i];
        __syncthreads();
        { const int n = tidx >> 3, kq = (tidx & 7) * 8;
          f32x4 a, b;
#pragma unroll
          for (int e = 0; e < 4; ++e) { a[e] = tile[(kq + e) * 65 + n]; b[e] = tile[(kq + 4 + e) * 65 + n]; }
          *(u32x2*)(dst + (size_t)(n0 + n) * K + k0 + kq) = pk8_fp8(a, b, 1.f); }
#pragma unroll
        for (int i = 0; i < 8; ++i) r[i] = rn[i];
        it = nx;
    }
}
__device__ __forceinline__ void conv_plain(const float* __restrict__ src, bf16_t* __restrict__ dst, size_t n, int bid, int nb, const float* rowgain = nullptr) {
    const int tidx = tid_fresh();
    const size_t n4 = n / 4, st = (size_t)nb * NT;
    for (size_t i0 = (size_t)bid * NT + tidx; i0 < n4; i0 += 8 * st) {
        f32x4 v[8];
#pragma unroll
        for (int u = 0; u < 8; ++u) { const size_t i = i0 + u * st; v[u] = (i < n4) ? ((const f32x4*)src)[i] : (f32x4){0.f, 0.f, 0.f, 0.f}; }
#pragma unroll
        for (int u = 0; u < 8; ++u) { const size_t i = i0 + u * st; if (i < n4) { f32x4 x = v[u]; if (rowgain) x = x * rowgain[i >> 8];
            u32x2 w; w.x = pk2(x[0], x[1]); w.y = pk2(x[2], x[3]); ((u32x2*)dst)[i] = w; } }
    }
}
__device__ __forceinline__ void conv_fp8(const float* __restrict__ src, unsigned* __restrict__ dst, const float* gain, float scale, bool slice_major, int bid, int nb) {
    const int tidx = tid_fresh();
    const size_t n4 = (size_t)NEXP * D / 4, st = (size_t)nb * NT;
    for (size_t i0 = (size_t)bid * NT + tidx; i0 < n4; i0 += 8 * st) {
        f32x4 v[8];
#pragma unroll
        for (int u = 0; u < 8; ++u) { const size_t i = i0 + u * st; v[u] = (i < n4) ? ((const f32x4*)src)[i] : (f32x4){0.f, 0.f, 0.f, 0.f}; }
#pragma unroll
        for (int u = 0; u < 8; ++u) { const size_t i = i0 + u * st; if (i < n4) { f32x4 x = v[u];
            if (gain) { const f32x4 g = ((const f32x4*)gain)[i & (D / 4 - 1)]; x = x * g; }
            x = x * scale;
            int w = __builtin_amdgcn_cvt_pk_fp8_f32(x[0], x[1], 0, false);
            w = __builtin_amdgcn_cvt_pk_fp8_f32(x[2], x[3], w, true);
            size_t o = i;
            if (slice_major) { const size_t d = (i * 4) & (D - 1), e = (i * 4) >> 10; o = (((d >> 7) * NEXP + e) * 128 + (d & 127)) >> 2; }
            dst[o] = (unsigned)w; } }
    }
}

__device__ __forceinline__ void stage_prologue0(const Params& p, int bid, int nb, float* lds) {
    const int tidx = tid_fresh();
    unsigned char* ws = p.ws;
    const int tid = tidx, lane = tid & 63, wid = tid >> 6;
    for (int l = 0; l < L; ++l) {
        tr_conv((const float*)p.in[4] + (size_t)l * D * INW, (bf16_t*)(ws + WS_WIN) + (size_t)l * 3072 * D, D, 3072, (const float*)p.in[3] + l * D, D - 1, 1.f, bid, nb, lds, 0, INW);
        tr_conv8((const float*)p.in[4] + (size_t)l * D * INW + 3072, ws + WS_WIN + 24 * MiB + (size_t)l * 3072 * D, D, 3072, (const float*)p.in[3] + l * D, W8S, INW, bid, nb, lds);
        const float* wb = (const float*)p.in[13] + (size_t)l * 3 * 512 * D;
        bf16_t* wbr = (bf16_t*)(ws + WS_WB0) + (size_t)l * D * 1536;
        tr_conv(wb, wbr, 512, D, (const float*)p.in[6] + l * 128, 127, 1.f - lam_init_of(l), bid, nb, lds, 1536);
        tr_conv(wb + 512 * D, (bf16_t*)(ws + WS_WB1T) + (size_t)l * D * 512, 512, D, nullptr, 0, 1.f, bid, nb, lds);
        tr_conv(wb + 2 * 512 * D, wbr + 1024, 512, D, nullptr, 0, 1.f, bid, nb, lds, 1536);
        tr_conv((const float*)p.in[14] + (size_t)l * D * D, (bf16_t*)(ws + WS_WOUT) + (size_t)l * D * D, D, D, nullptr, 0, 1.f, bid, nb, lds);
        tr_conv((const float*)p.in[19] + (size_t)l * D * D, (bf16_t*)(ws + WS_WXOT) + (size_t)l * D * D, D, D, nullptr, 0, 1.f, bid, nb, lds);
        tr_conv((const float*)p.in[18] + (size_t)l * D * 2 * D, (bf16_t*)(ws + WS_WXKVT) + (size_t)l * 2 * D * D, D, 2 * D, (const float*)p.in[16] + l * D, D - 1, 1.f, bid, nb, lds);
        conv_fp8((const float*)p.in[23] + (size_t)l * NEXP * D, (unsigned*)(ws + WS_U8) + (size_t)l * NEXP * D / 4, (const float*)p.in[20] + l * D, SU, false, bid, nb);
        conv_fp8((const float*)p.in[24] + (size_t)l * NEXP * D, (unsigned*)(ws + WS_V8) + (size_t)l * NEXP * D / 4, nullptr, SV, true, bid, nb);
    }
    conv_plain((const float*)p.in[17], (bf16_t*)(ws + WS_WXQB), (size_t)L * D * D, bid, nb, (const float*)p.in[15]);
    conv_plain((const float*)p.in[21], (bf16_t*)(ws + WS_WPQB), (size_t)L * D * 2048, bid, nb);
    conv_plain((const float*)p.in[22], (bf16_t*)(ws + WS_KEYSB), (size_t)L * 8 * 2 * 128 * 128, bid, nb);
    for (int i = bid * NT + tid; i < L * 4 * 128 * 128; i += nb * NT) {
        const int e = i & 127, g = (i >> 14) & 3, l = i >> 16;
        ((bf16_t*)(ws + WS_WPOOLS))[i] = f2bf(((const float*)p.in[7])[i] * ((const float*)p.in[8])[l * 512 + g * 128 + e]);
        const int sx = i & 127, tx = (i >> 7) & 127;
        ((bf16_t*)(ws + WS_WSPT))[i] = f2bf((sx <= tx) ? ((const float*)p.in[11])[i] : 0.f);
    }
    for (int i = bid * NT + tid; i < T * 8; i += nb * NT) {
        const int j = i & 7, t = i >> 3;
        const double ang = (double)((const int*)p.in[2])[t] * pow(500000.0, -(double)j / 8.0);
        _Float16* r = (_Float16*)(ws + WS_ROPE) + (size_t)t * 16;
        r[j] = (_Float16)(float)cos(ang); r[8 + j] = (_Float16)(float)sin(ang);
    }
    for (int row = bid * 8 + wid; row < T + MROWS; row += nb * 8) {
        const bool ismem = row >= T; const int r = ismem ? row - T : row;
        const float* src = (ismem ? (const float*)p.in[1] : (const float*)p.in[0]) + (size_t)r * D;
        bf16_t* dstb = (bf16_t*)(ws + (ismem ? WS_MEMB : WS_XB)) + (size_t)r * D;
        float ss = 0.f;
#pragma unroll
        for (int i = 0; i < 4; ++i) {
            const f32x4 v = ((const f32x4*)src)[lane + 64 * i];
            ss += v[0] * v[0] + v[1] * v[1] + v[2] * v[2] + v[3] * v[3];
            u32x2 w; w.x = pk2(v[0], v[1]); w.y = pk2(v[2], v[3]); ((u32x2*)dstb)[lane + 64 * i] = w;
            if (!ismem) { int q = __builtin_amdgcn_cvt_pk_fp8_f32(v[0] * XS, v[1] * XS, 0, false); q = __builtin_amdgcn_cvt_pk_fp8_f32(v[2] * XS, v[3] * XS, q, true); ((unsigned*)(ws + WS_XQ8 + (size_t)r * D))[lane + 64 * i] = (unsigned)q; }
        }
        ss = wave_sum(ss);
        if (ismem) { if (lane == 0) ((float*)(ws + WS_RSTDM))[r] = rsqrtf(ss * (1.f / D) + EPS); }
        else if (lane < 16) ((float*)(ws + WS_SSP))[(size_t)r * 16 + lane] = (lane == 0) ? ss : 0.f;
    }
}

template <class Geom, class Epi>
__device__ __forceinline__ void gemm_simple(int nitems, int K, const Geom& geom, const Epi& epi, int bid, int nb) {
    const int tidx = tid_fresh();
    const int tid = tidx, lane = tid & 63, wid = tid >> 6, wm = wid >> 1, wn = wid & 1, fr = lane & 15, fq = lane >> 4;
    for (int it = bid; it < nitems; it += nb) {
        const bf16_t* A; const bf16_t* Bt; int lda, ldb, grp, row0, col0;
        geom(it, A, lda, Bt, ldb, grp, row0, col0);
        f32x4 acc[2][4];
#pragma unroll
        for (int i = 0; i < 2; ++i)
#pragma unroll
            for (int j = 0; j < 4; ++j) acc[i][j] = (f32x4){0.f, 0.f, 0.f, 0.f};
        const bf16_t* ap = A + (size_t)(wm * 32 + fr) * lda + fq * 8;
        const bf16_t* bp = Bt + (size_t)(wn * 64 + fr) * ldb + fq * 8;
#pragma unroll 2
        for (int k0 = 0; k0 < K; k0 += 32) {
            bf16x8 a[2], b[4];
#pragma unroll
            for (int i = 0; i < 2; ++i) a[i] = *(const bf16x8*)(ap + (size_t)(i * 16) * lda + k0);
#pragma unroll
            for (int j = 0; j < 4; ++j) b[j] = *(const bf16x8*)(bp + (size_t)(j * 16) * ldb + k0);
#pragma unroll
            for (int i = 0; i < 2; ++i)
#pragma unroll
                for (int j = 0; j < 4; ++j) acc[i][j] = __builtin_amdgcn_mfma_f32_16x16x32_bf16(b[j], a[i], acc[i][j], 0, 0, 0);
        }
#pragma unroll
        for (int i = 0; i < 2; ++i) {
            const int row = row0 + wm * 32 + i * 16 + fr;
            const float rs = epi.prep(grp, row);
            float part = 0.f;
#pragma unroll
            for (int j = 0; j < 4; ++j) part += epi.apply(grp, row, col0 + wn * 64 + j * 16 + fq * 4, acc[i][j], rs, lane);
            epi.rowdone(grp, row, col0 + wn * 64, part, lane);
        }
    }
}

__device__ __forceinline__ void st_bf4(bf16_t* p, f32x4 v) { u32x2 w; w.x = pk2(v[0], v[1]); w.y = pk2(v[2], v[3]); *(u32x2*)p = w; }
__device__ __forceinline__ f32x4 ld_bf4(const bf16_t* p) { const u32x2 w = *(const u32x2*)p; return (f32x4){__uint_as_float(w.x << 16), __uint_as_float(w.x & 0xffff0000u), __uint_as_float(w.y << 16), __uint_as_float(w.y & 0xffff0000u)}; }

struct EpiColGain {
    bf16_t* o; size_t gstride; int ld; const float* gain; int gdiv;
    __device__ __forceinline__ float prep(int, int) const { return 1.f; }
    __device__ __forceinline__ float apply(int grp, int row, int col, f32x4 v, float, int) const {
        if (gain) v = v * *(const f32x4*)(gain + (size_t)(grp / gdiv) * D + col);
        st_bf4(o + (size_t)grp * gstride + (size_t)row * ld + col, v);
        return 0.f;
    }
    __device__ __forceinline__ void rowdone(int, int, int, float, int) const {}
};

__device__ __forceinline__ void stage_prologue1(const Params& p, int bid, int nb) {
    unsigned char* ws = p.ws;
    {
        auto geom = [=](int it, const bf16_t*& A, int& lda, const bf16_t*& Bt, int& ldb, int& grp, int& row0, int& col0) {
            const int g = it >> 3, tn = it & 7, l = g >> 4, hp = g & 15; grp = g; row0 = 0; col0 = tn * 128; lda = 128; ldb = 2048;
            A = (const bf16_t*)(ws + WS_KEYSB) + (size_t)g * 16384; Bt = (const bf16_t*)(ws + WS_WPQB) + ((size_t)l * D + col0) * 2048 + hp * 128; };
        gemm_simple(L * 16 * 8, 128, geom, EpiColGain{(bf16_t*)(ws + WS_SKT), (size_t)128 * D, D, (const float*)p.in[20], 16}, bid, nb);
    }
    {
        auto geom = [=](int it, const bf16_t*& A, int& lda, const bf16_t*& Bt, int& ldb, int& grp, int& row0, int& col0) {
            const int lg = it >> 3, tm = it & 7, l = lg >> 2, g = lg & 3; grp = lg; row0 = tm * 128; col0 = 0; lda = 512; ldb = 128;
            A = (const bf16_t*)(ws + WS_WB1T) + ((size_t)l * D + row0) * 512 + g * 128; Bt = (const bf16_t*)(ws + WS_WPOOLS) + (size_t)lg * 16384; };
        struct EpiWeff { bf16_t* o; __device__ __forceinline__ float prep(int, int) const { return 1.f; }
            __device__ __forceinline__ float apply(int lg, int row, int col, f32x4 v, float, int) const { st_bf4(o + ((size_t)(lg >> 2) * D + row) * 1536 + 512 + (lg & 3) * 128 + col, v); return 0.f; }
            __device__ __forceinline__ void rowdone(int, int, int, float, int) const {} };
        gemm_simple(L * 4 * 8, 128, geom, EpiWeff{(bf16_t*)(ws + WS_WB0)}, bid, nb);
    }
}
namespace pg8 {
#define PG8_LAS __attribute__((address_space(3)))
constexpr int BM = 256, BK = 64, HALF = 128, HTB = HALF * BK * 2, STAGE_BYTES = 8 * HTB, NXCD = 8, WGM = 8;
__host__ __device__ __forceinline__ int lds_byte(int r, int c) { const int st = (r >> 4) * 2 + (c >> 5), rr = r & 15, cc = c & 31, ob = rr * 64 + cc * 2; return st * 1024 + (ob ^ (((ob >> 9) & 1) << 5)); }
__host__ __device__ __forceinline__ void stage_rc(int b, int& R, int& C) { const int st = b / 1024, sb = b % 1024, swz = sb ^ (((sb >> 9) & 1) << 5); R = (st >> 1) * 16 + swz / 64; C = (st & 1) * 32 + (swz % 64) / 2; }
__host__ __device__ __forceinline__ int perm32(int rho) { const int n = rho >> 4, i = rho & 15; return 8 * (i >> 2) + 4 * n + (i & 3); }
struct Unit { int pm, pn; };
struct Order {
    int nM, nN, nwg, G, c; const char* A; const char* Bt; size_t a_tile, b_tile, b_batch; int pm_per_batch;
    __device__ __forceinline__ void init(int M, int N, int G_, int c_, const void* A_, int lda, const void* Bt_, int ldb, size_t b_batch_bytes = 0, int pmpb = 1 << 30) {
        nM = M / BM; nN = N / BM; nwg = nM * nN; G = G_; c = c_; A = (const char*)A_; Bt = (const char*)Bt_; a_tile = (size_t)BM * lda * 2; b_tile = (size_t)BM * ldb * 2; b_batch = b_batch_bytes; pm_per_batch = pmpb; }
    __device__ __forceinline__ bool next(int i, Unit& u) const {
        const long Lx = (long)i * G + c; if (Lx >= nwg) return false;
        int wgid = (int)Lx; { const int q = nwg / NXCD, r = nwg % NXCD, xcd = wgid % NXCD, off = wgid / NXCD; wgid = (xcd < r ? xcd * (q + 1) : r * (q + 1) + (xcd - r) * q) + off; }
        const int nig = WGM * nN, gid = wgid / nig, fm = gid * WGM, gsz = (nM - fm) < WGM ? (nM - fm) : WGM;
        u.pm = fm + ((wgid % nig) % gsz); u.pn = (wgid % nig) / gsz; return true;
    }
    __device__ __forceinline__ const char* a_ptr(const Unit& u) const { return A + (size_t)u.pm * a_tile; }
    __device__ __forceinline__ const char* b_ptr(const Unit& u) const { return Bt + (size_t)u.pn * b_tile + (size_t)(u.pm / pm_per_batch) * b_batch; }
};
typedef int i32x8_t __attribute__((ext_vector_type(8))); typedef int i32x4_t __attribute__((ext_vector_type(4)));
__device__ __forceinline__ i32x8_t ld8_lds(const PG8_LAS unsigned char* p) { const i32x4_t lo = *(const PG8_LAS i32x4_t*)p, hi = *(const PG8_LAS i32x4_t*)(p + 1024); return __builtin_shufflevector(lo, hi, 0, 1, 2, 3, 4, 5, 6, 7); }
__device__ __forceinline__ void glds_s(const void* sbase, unsigned voff, unsigned lds_dst) { unsigned keep;
    asm volatile("s_mov_b32 %0, m0\n\ts_mov_b32 m0, %3\n\ts_nop 0\n\tglobal_load_lds_dwordx4 %1, %2\n\ts_mov_b32 m0, %0" : "=&s"(keep) : "v"(voff), "s"(sbase), "s"(lds_dst) : "memory"); }
struct NoHook { static constexpr bool ACTIVE = false; __device__ __forceinline__ void operator()(f32x4 (&)[2][2][4][2], const Unit&, int, int, int, int, int) const {} };
template <class Epi, class Sched, bool ALIGN_EPI, class Hook = NoHook, int SEG = 1 << 20, bool FP8 = false>
__device__ __forceinline__ void gemm_phase(PG8_LAS unsigned char* lds, const int K, const int lda, const int ldb, const Sched& S, const Epi& E, const long dA1 = 0, const long dA2 = 0, const Hook& H = Hook()) {
    const int tid = tid_fresh(), wid = __builtin_amdgcn_readfirstlane(tid >> 6), lane = tid & 63, wr = wid >> 2, wc = wid & 3, fr = lane & 15, fq = lane >> 4;
    const int nt = K / BK;
    int mxs = 0x7f7f7f7f; asm volatile("" : "+v"(mxs));
    (void)mxs;
    unsigned voffA, voffB;
    { int R, C; stage_rc(tid * 16, R, C); const int Rb = (R & ~31) + perm32(R & 31);
      voffA = (unsigned)(R * lda + C) * 2u; voffB = (unsigned)(Rb * ldb + C) * 2u; }
    const size_t p2A = (size_t)64 * lda * 2, p2B = (size_t)64 * ldb * 2;
    const size_t kstep = (size_t)(BK * 2);
    const size_t hstepA = (size_t)HALF * lda * 2, hstepB = (size_t)HALF * ldb * 2;
    const unsigned ldsw = (unsigned)wid * 1024u, ldsu = (unsigned)(unsigned long)lds;
    const int aoff = lds_byte(wr * 64 + fr, fq * 8), boff = lds_byte(wc * 32 + fr, fq * 8);
#define PG8_SA(b, h) (((b) * 2 + (h)) * HTB)
#define PG8_SB(b, h) ((4 + (b) * 2 + (h)) * HTB)
#define PG8_STAGE(bufoff, gbase, X) do { _Pragma("unroll") for (int _i = 0; _i < 2; ++_i) \
        pg8::glds_s((const void*)((const char*)(gbase) + _i * p2##X), voff##X, ldsu + (unsigned)(bufoff) + ldsw + (unsigned)(_i * 8192)); } while (0)
#define PG8_LD8(p_) pg8::ld8_lds((p_))
#define PG8_LDA(dst, b, h) do { _Pragma("unroll") for (int m = 0; m < 4; ++m) { if constexpr (FP8) dst##8[m] = PG8_LD8(lds + PG8_SA(b, h) + aoff + m * 2048); else { _Pragma("unroll") for (int k = 0; k < 2; ++k) dst[m][k] = *(const PG8_LAS bf16x8*)(lds + PG8_SA(b, h) + aoff + m * 2048 + k * 1024); } } } while (0)
#define PG8_LDB(dst, b, h) do { _Pragma("unroll") for (int n = 0; n < 2; ++n) { if constexpr (FP8) dst##8[n] = PG8_LD8(lds + PG8_SB(b, h) + boff + n * 2048); else { _Pragma("unroll") for (int k = 0; k < 2; ++k) dst[n][k] = *(const PG8_LAS bf16x8*)(lds + PG8_SB(b, h) + boff + n * 2048 + k * 1024); } } } while (0)
#define PG8_MMA(ai, bj, At, Bt) do { __builtin_amdgcn_s_setprio(1); _Pragma("unroll") for (int m = 0; m < 4; ++m) _Pragma("unroll") for (int n = 0; n < 2; ++n) { \
        if constexpr (FP8) asm volatile("v_mfma_scale_f32_16x16x128_f8f6f4 %0, %1, %2, %0, %3, %3 op_sel_hi:[0,0,0]" : "+v"(acc[ai][bj][m][n]) : "v"(Bt##8[n]), "v"(At##8[m]), "v"(mxs)); \
        else { _Pragma("unroll") for (int k = 0; k < 2; ++k) acc[ai][bj][m][n] = __builtin_amdgcn_mfma_f32_16x16x32_bf16(Bt[n][k], At[m][k], acc[ai][bj][m][n], 0, 0, 0); } } \
        __builtin_amdgcn_s_setprio(0); } while (0)
#define PG8_WAIT_V(n) asm volatile("s_waitcnt vmcnt(" #n ")" ::: "memory")
#define PG8_WAIT_L(n) asm volatile("s_waitcnt lgkmcnt(" #n ")" ::: "memory")
#define PG8_BAR __builtin_amdgcn_s_barrier()
#define PG8_SCHED __builtin_amdgcn_sched_barrier(0)
    Unit cur, nxt; int ui = 0;
    if (!S.next(0, cur)) return;
    f32x4 acc[2][2][4][2];
#pragma unroll
    for (int a = 0; a < 2; ++a)
#pragma unroll
        for (int b = 0; b < 2; ++b)
#pragma unroll
            for (int m = 0; m < 4; ++m)
#pragma unroll
                for (int n = 0; n < 2; ++n) acc[a][b][m][n] = (f32x4){0.f, 0.f, 0.f, 0.f};
    typedef int i32x8_ __attribute__((ext_vector_type(8))); typedef int i32x4_ __attribute__((ext_vector_type(4)));
    bf16x8 At[4][2], B0[2][2], B1[2][2]; i32x8_ At8[4], B08[2], B18[2];
    (void)At; (void)B0; (void)B1; (void)At8; (void)B08; (void)B18;
    const char* cA = S.a_ptr(cur); const char* cB = S.b_ptr(cur);
    PG8_STAGE(PG8_SB(0, 0), cB, B); PG8_STAGE(PG8_SB(0, 1), cB + hstepB, B); PG8_STAGE(PG8_SA(0, 0), cA, A); PG8_STAGE(PG8_SA(0, 1), cA + hstepA, A);
    if (wr == 1) PG8_BAR;
    PG8_WAIT_V(2); PG8_BAR;
    PG8_STAGE(PG8_SB(1, 0), cB + kstep, B); PG8_STAGE(PG8_SA(1, 0), cA + kstep, A); PG8_STAGE(PG8_SB(1, 1), cB + hstepB + kstep, B); PG8_STAGE(PG8_SA(1, 1), cA + kstep + hstepA, A);
    PG8_WAIT_V(8); PG8_BAR;
    bool stores = false;
    for (;;) {
        const bool has_next = S.next(ui + 1, nxt);
        const char* nA = has_next ? S.a_ptr(nxt) : cA; const char* nB = has_next ? S.b_ptr(nxt) : cB;
        for (int t = 0; t < nt; t += 2) {
            const bool last = (t == nt - 2);
#define PG8_AOFF(tile) ((long)(tile) * (long)kstep + ((tile) >= 2 * SEG ? dA2 : (tile) >= SEG ? dA1 : 0l))
            if (Hook::ACTIVE && (t == SEG || t == 2 * SEG)) { const int th = tid_fresh(); H(acc, cur, t, wr, wc, th & 15, (th >> 4) & 3); }
            const char* a1 = cA + PG8_AOFF(t + 1);
            const char* a2 = last ? nA : cA + PG8_AOFF(t + 2); const char* b2 = last ? nB : cB + (size_t)(t + 2) * kstep;
            const char* a3 = last ? nA + kstep : cA + PG8_AOFF(t + 3); const char* b3 = b2 + kstep;
            const bool head = (t == 0), drain = head && stores;
            PG8_LDB(B0, 0, 0); PG8_LDB(B1, 0, 1); PG8_SCHED; PG8_LDA(At, 0, 0); if (!head) PG8_STAGE(PG8_SA(1, 1), a1 + hstepA, A);
            if (drain) { if constexpr (Epi::NST >= 16) PG8_WAIT_V(16); else if constexpr (Epi::NST >= 8) PG8_WAIT_V(8); else PG8_WAIT_V(0); } else PG8_WAIT_V(8);
            PG8_WAIT_L(0); PG8_BAR; PG8_MMA(0, 0, At, B0); PG8_MMA(0, 1, At, B1); PG8_BAR; PG8_SCHED;
            PG8_LDA(At, 0, 1); PG8_STAGE(PG8_SB(0, 0), b2, B); PG8_STAGE(PG8_SB(0, 1), b2 + hstepB, B); PG8_STAGE(PG8_SA(0, 0), a2, A);
            if (!drain) PG8_WAIT_V(8);
            PG8_WAIT_L(0); PG8_BAR; PG8_MMA(1, 0, At, B0); PG8_MMA(1, 1, At, B1); PG8_BAR; PG8_SCHED;
            PG8_LDB(B0, 1, 0); PG8_LDB(B1, 1, 1); PG8_SCHED; PG8_LDA(At, 1, 0); PG8_STAGE(PG8_SA(0, 1), a2 + hstepA, A);
            if (!drain) PG8_WAIT_V(8);
            PG8_WAIT_L(0); PG8_BAR; PG8_MMA(0, 0, At, B0); PG8_MMA(0, 1, At, B1); PG8_BAR; PG8_SCHED;
            PG8_LDA(At, 1, 1); PG8_STAGE(PG8_SB(1, 0), b3, B); PG8_STAGE(PG8_SB(1, 1), b3 + hstepB, B); PG8_STAGE(PG8_SA(1, 0), a3, A);
            if (!drain) PG8_WAIT_V(8);
            PG8_WAIT_L(0); PG8_BAR; PG8_MMA(1, 0, At, B0); PG8_MMA(1, 1, At, B1); if (drain) PG8_WAIT_V(8); PG8_BAR; PG8_SCHED;
        }
        PG8_STAGE(PG8_SA(1, 1), nA + kstep + hstepA, A); PG8_SCHED;
        if constexpr (FP8) asm volatile("s_nop 15\n\ts_nop 7" ::: "memory");
        if constexpr (ALIGN_EPI) { if (wr == 0) PG8_BAR; }
        { const int te = tid_fresh(); E(acc, cur, wr, wc, te & 15, (te >> 4) & 3); }
        if (!has_next) break;
        stores = true;
#pragma unroll
        for (int a = 0; a < 2; ++a)
#pragma unroll
            for (int b = 0; b < 2; ++b)
#pragma unroll
                for (int m = 0; m < 4; ++m)
#pragma unroll
                    for (int n = 0; n < 2; ++n) acc[a][b][m][n] = (f32x4){0.f, 0.f, 0.f, 0.f};
        cur = nxt; cA = nA; cB = nB; ++ui;
        if constexpr (ALIGN_EPI) { if (wr == 1) PG8_BAR; }
    }
    PG8_WAIT_V(0);
    if constexpr (!ALIGN_EPI) { if (wr == 0) PG8_BAR; }
    PG8_BAR;
#undef PG8_AOFF
#undef PG8_SA
#undef PG8_SB
#undef PG8_STAGE
#undef PG8_LDA
#undef PG8_LD8
#undef PG8_LDB
#undef PG8_MMA
#undef PG8_WAIT_V
#undef PG8_WAIT_L
#undef PG8_BAR
#undef PG8_SCHED
}
}

__device__ __forceinline__ float rstd_q(const float* ssp, int row, int fq) {
    const f32x4 a = *(const f32x4*)(ssp + (size_t)row * 16 + 4 * fq);
    float s = (a[0] + a[1]) + (a[2] + a[3]); s += lx16(s); s = add_x32(s);
    return rsqrtf(s * (1.f / D) + EPS);
}
__device__ __forceinline__ void rstd8(const float* ssp, int row0, int fq, float mul, float (&rs)[2][4]) {
    f32x4 a[2][4];
#pragma unroll
    for (int ai = 0; ai < 2; ++ai)
#pragma unroll
        for (int m = 0; m < 4; ++m) a[ai][m] = *(const f32x4*)(ssp + (size_t)(row0 + ai * 128 + m * 16) * 16 + 4 * fq);
#pragma unroll
    for (int ai = 0; ai < 2; ++ai)
#pragma unroll
        for (int m = 0; m < 4; ++m) { float s = (a[ai][m][0] + a[ai][m][1]) + (a[ai][m][2] + a[ai][m][3]); s += lx16(s); s = add_x32(s); rs[ai][m] = rsqrtf(s * (1.f / D) + EPS) * mul; }
}
__device__ __forceinline__ u32x4 pk8(f32x4 a, f32x4 b) { u32x4 w; w.x = pk2(a[0], a[1]); w.y = pk2(a[2], a[3]); w.z = pk2(b[0], b[1]); w.w = pk2(b[2], b[3]); return w; }
__device__ __forceinline__ u32x2 pk8_fp8(f32x4 a, f32x4 b, float sc) {
    int q0 = __builtin_amdgcn_cvt_pk_fp8_f32(a[0] * sc, a[1] * sc, 0, false); q0 = __builtin_amdgcn_cvt_pk_fp8_f32(a[2] * sc, a[3] * sc, q0, true);
    int q1 = __builtin_amdgcn_cvt_pk_fp8_f32(b[0] * sc, b[1] * sc, 0, false); q1 = __builtin_amdgcn_cvt_pk_fp8_f32(b[2] * sc, b[3] * sc, q1, true);
    return (u32x2){(unsigned)q0, (unsigned)q1};
}
__device__ __forceinline__ void up8(u32x4 w, f32x4& a, f32x4& b) {
    a = (f32x4){__uint_as_float(w.x << 16), __uint_as_float(w.x & 0xffff0000u), __uint_as_float(w.y << 16), __uint_as_float(w.y & 0xffff0000u)};
    b = (f32x4){__uint_as_float(w.z << 16), __uint_as_float(w.z & 0xffff0000u), __uint_as_float(w.w << 16), __uint_as_float(w.w & 0xffff0000u)}; }
struct LaneTr {
    int addr, tr, tq;
    __device__ __forceinline__ LaneTr(int fr, int fq) { const int L = fq * 16 + fr; tr = L >> 2; tq = L & 3; addr = (tq * 16 + tr) * 4; }
    __device__ __forceinline__ u32x4 operator()(u32x4 w) const {
        return (u32x4){(unsigned)__builtin_amdgcn_ds_bpermute(addr, (int)w.x), (unsigned)__builtin_amdgcn_ds_bpermute(addr, (int)w.y), (unsigned)__builtin_amdgcn_ds_bpermute(addr, (int)w.z), (unsigned)__builtin_amdgcn_ds_bpermute(addr, (int)w.w)}; }
};
typedef _Float16 f16x2_t __attribute__((ext_vector_type(2)));
__device__ __forceinline__ u32x4 swz16x4(u32x4 a) { unsigned r0, r1, r2, r3;
    asm volatile("ds_swizzle_b32 %0, %4 offset:swizzle(SWAP,16)\n\tds_swizzle_b32 %1, %5 offset:swizzle(SWAP,16)\n\tds_swizzle_b32 %2, %6 offset:swizzle(SWAP,16)\n\tds_swizzle_b32 %3, %7 offset:swizzle(SWAP,16)\n\ts_waitcnt lgkmcnt(0)"
                 : "=&v"(r0), "=&v"(r1), "=&v"(r2), "=&v"(r3) : "v"(a.x), "v"(a.y), "v"(a.z), "v"(a.w));
    return (u32x4){r0, r1, r2, r3}; }
__device__ __forceinline__ f32x4 swz16f4(f32x4 a) { return __builtin_bit_cast(f32x4, swz16x4(__builtin_bit_cast(u32x4, a))); }
__device__ __forceinline__ float h2f_lo(unsigned w) { return (float)__builtin_bit_cast(f16x2_t, w)[0]; }
__device__ __forceinline__ float h2f_hi(unsigned w) { return (float)__builtin_bit_cast(f16x2_t, w)[1]; }
struct GEpiWin {
    unsigned char* ws;
    static constexpr int NST = 16;
    __device__ __forceinline__ void operator()(const f32x4 (&acc)[2][2][4][2], const pg8::Unit& u, int wr, int wc, int fr, int fq) const {
        const int pn = u.pn, row0 = u.pm * 256 + wr * 64 + fr;
        const LaneTr ltr(fr, fq); const int rowt = u.pm * 256 + wr * 64 + ltr.tr, ct = 32 * wc + 8 * ltr.tq;
        const float* ssp = (const float*)(ws + WS_SSP);
        if (pn < 4) {
            const bool rot = (wc & 1) == 0;
            bf16_t* dst = (bf16_t*)(ws + (pn < 2 ? WS_QB : WS_KB)) + (pn & 1) * 256 + ct;
            float rs8[2][4]; rstd8(ssp, row0, fq, pn < 2 ? C2 : 1.f, rs8);
            u32x4 tb[2][4];
#pragma unroll
            for (int ai = 0; ai < 2; ++ai)
#pragma unroll
                for (int m = 0; m < 4; ++m) tb[ai][m] = rot ? *(const u32x4*)(ws + WS_ROPE + (size_t)(row0 + ai * 128 + m * 16) * 32 + (fq & 1) * 16) : (u32x4){0u, 0u, 0u, 0u};
#pragma unroll
            for (int ai = 0; ai < 2; ++ai)
#pragma unroll
                for (int m = 0; m < 4; ++m) { const int row = rowt + ai * 128 + m * 16; const float rs = rs8[ai][m];
                    f32x4 c0 = (f32x4){1.f, 1.f, 1.f, 1.f}, c1 = c0, s0 = (f32x4){0.f, 0.f, 0.f, 0.f}, s1 = s0;
                    if (rot) { const u32x4 mine = tb[ai][m]; const u32x4 oth = swz16x4(mine);
                        const u32x4 cw = (fq & 1) ? oth : mine, sw = (fq & 1) ? mine : oth;
                        c0 = (f32x4){h2f_lo(cw.x), h2f_hi(cw.x), h2f_lo(cw.y), h2f_hi(cw.y)}; c1 = (f32x4){h2f_lo(cw.z), h2f_hi(cw.z), h2f_lo(cw.w), h2f_hi(cw.w)};
                        s0 = (f32x4){h2f_lo(sw.x), h2f_hi(sw.x), h2f_lo(sw.y), h2f_hi(sw.y)}; s1 = (f32x4){h2f_lo(sw.z), h2f_hi(sw.z), h2f_lo(sw.w), h2f_hi(sw.w)}; }
#pragma unroll
                    for (int bj = 0; bj < 2; ++bj) { f32x4 v0 = acc[ai][bj][m][0], v1 = acc[ai][bj][m][1];
                        if (rot) { const f32x4 o0 = swz16f4(v0), o1 = swz16f4(v1);
                            if (fq == 0) { v0 = v0 * c0 - o0 * s0; v1 = v1 * c1 - o1 * s1; } else if (fq == 1) { v0 = o0 * s0 + v0 * c0; v1 = o1 * s1 + v1 * c1; } }
                        *(u32x4*)(dst + (size_t)row * 512 + bj * 128) = ltr(pk8(v0 * rs, v1 * rs)); } }
        } else if (pn < 12) {
            const int seg = (pn - 4) >> 1; const size_t base = seg == 0 ? WS_VB : seg == 1 ? WS_PIN : seg == 2 ? WS_UIN : WS_VIN;
            bf16_t* dst = (bf16_t*)(ws + base) + (pn & 1) * 256 + ct;
            float rs[2][4]; rstd8(ssp, row0, fq, 1.f, rs);
#pragma unroll
            for (int ai = 0; ai < 2; ++ai)
#pragma unroll
                for (int m = 0; m < 4; ++m) { const int row = rowt + ai * 128 + m * 16;
#pragma unroll
                    for (int bj = 0; bj < 2; ++bj) *(u32x4*)(dst + (size_t)row * 512 + bj * 128) = ltr(pk8(acc[ai][bj][m][0] * rs[ai][m], acc[ai][bj][m][1] * rs[ai][m])); }
        }
    }
};
__device__ __forceinline__ size_t gate_off(int pm, int pn, int wid, int lane) { return (((size_t)(pm * 12 + pn) * 8 + wid) << 14) + (size_t)lane * 16; }
#define GATE_FRAG(ai, bj, m) ((((ai) * 2 + (bj)) * 4 + (m)) * 1024)
struct GEpiGate {
    unsigned char* ws;
    static constexpr int NST = 16;
    __device__ __forceinline__ void operator()(const f32x4 (&acc)[2][2][4][2], const pg8::Unit& u, int wr, int wc, int fr, int fq) const {
        const int row0 = u.pm * 256 + wr * 64 + fr;
        unsigned char* dst = ws + WS_GTE + gate_off(u.pm, u.pn, wr * 4 + wc, fq * 16 + fr);
        float rs8[2][4]; rstd8((const float*)(ws + WS_SSP), row0, fq, -1.4426950408889634f / (XS * W8S), rs8);
#pragma unroll
        for (int ai = 0; ai < 2; ++ai)
#pragma unroll
            for (int m = 0; m < 4; ++m) { const float rs = rs8[ai][m];
#pragma unroll
                for (int bj = 0; bj < 2; ++bj) { f32x4 v0 = acc[ai][bj][m][0] * rs, v1 = acc[ai][bj][m][1] * rs;
#pragma unroll
                    for (int e = 0; e < 4; ++e) { v0[e] = 1.f + __builtin_amdgcn_exp2f(fminf(v0[e], 60.f)); v1[e] = 1.f + __builtin_amdgcn_exp2f(fminf(v1[e], 60.f)); }
                    *(u32x4*)(dst + GATE_FRAG(ai, bj, m)) = pk8(v0, v1); } }
    }
};
__device__ __forceinline__ f32x4 rcp4(f32x4 v) { return (f32x4){__builtin_amdgcn_rcpf(fmaxf(v[0], 1e-30f)), __builtin_amdgcn_rcpf(fmaxf(v[1], 1e-30f)), __builtin_amdgcn_rcpf(fmaxf(v[2], 1e-30f)), __builtin_amdgcn_rcpf(fmaxf(v[3], 1e-30f))}; }
struct BranchHook {
    static constexpr bool ACTIVE = true; unsigned char* ws;
    __device__ __forceinline__ void operator()(f32x4 (&acc)[2][2][4][2], const pg8::Unit& u, int t, int wr, int wc, int fr, int fq) const {
        int lane = fq * 16 + fr;
        asm volatile("" : "+v"(lane));
        const unsigned char* gpa = ws + WS_GTE + gate_off(u.pm, u.pn + ((t == 8) ? 0 : 4), wr * 4 + wc, lane); const unsigned char* gpb = gpa + ((size_t)4 * 8 << 14);
#pragma unroll
        for (int ai = 0; ai < 2; ++ai) {
            u32x4 ga[4][2], gb[4][2];
#pragma unroll
            for (int m = 0; m < 4; ++m)
#pragma unroll
                for (int bj = 0; bj < 2; ++bj) { ga[m][bj] = *(const u32x4*)(gpa + GATE_FRAG(ai, bj, m)); gb[m][bj] = *(const u32x4*)(gpb + GATE_FRAG(ai, bj, m)); }
            __builtin_amdgcn_sched_barrier(0);
#pragma unroll
            for (int m = 0; m < 4; ++m)
#pragma unroll
                for (int bj = 0; bj < 2; ++bj) { f32x4 a0, a1, b0, b1; up8(ga[m][bj], a0, a1); up8(gb[m][bj], b0, b1);
                    acc[ai][bj][m][0] = acc[ai][bj][m][0] * (b0 * rcp4(a0)); acc[ai][bj][m][1] = acc[ai][bj][m][1] * (b1 * rcp4(a1)); }
            __builtin_amdgcn_sched_barrier(0);
        }
    }
};
struct GEpiBranch {
    unsigned char* ws;
    static constexpr int NST = 8;
    __device__ __forceinline__ void operator()(const f32x4 (&acc)[2][2][4][2], const pg8::Unit& u, int wr, int wc, int fr, int fq) const {
        const LaneTr ltr(fr, fq); const int row0 = u.pm * 256 + wr * 64 + ltr.tr, col0 = u.pn * 256 + 32 * wc + 8 * ltr.tq;
#pragma unroll
        for (int ai = 0; ai < 2; ++ai) {
            u32x4 g[4][2];
#pragma unroll
            for (int m = 0; m < 4; ++m)
#pragma unroll
                for (int bj = 0; bj < 2; ++bj) g[m][bj] = *(const u32x4*)(ws + WS_GTE + gate_off(u.pm, u.pn + 8, wr * 4 + wc, fq * 16 + fr) + GATE_FRAG(ai, bj, m));
#pragma unroll
            for (int m = 0; m < 4; ++m) { const int row = row0 + ai * 128 + m * 16;
#pragma unroll
                for (int bj = 0; bj < 2; ++bj) { const int col = col0 + bj * 128;
                    f32x4 g0, g1; up8(g[m][bj], g0, g1);
                    *(u32x4*)((bf16_t*)(ws + WS_MG) + (size_t)row * D + col) = ltr(pk8(acc[ai][bj][m][0] * rcp4(g0), acc[ai][bj][m][1] * rcp4(g1))); } }
        }
    }
};
struct GEpiResid {
    unsigned char* ws; bool q8; float ascale;
    static constexpr int NST = 16;
    __device__ __forceinline__ void operator()(const f32x4 (&acc)[2][2][4][2], const pg8::Unit& u, int wr, int wc, int fr, int fq) const {
        const int row0 = u.pm * 256 + wr * 64 + fr, col0 = u.pn * 256 + 32 * wc + 8 * fq;
#pragma unroll
        for (int ai = 0; ai < 2; ++ai) {
            u32x4 xin[4][2];
#pragma unroll
            for (int m = 0; m < 4; ++m)
#pragma unroll
                for (int bj = 0; bj < 2; ++bj) xin[m][bj] = *(const u32x4*)((const bf16_t*)(ws + WS_XB) + (size_t)(row0 + ai * 128 + m * 16) * D + col0 + bj * 128);
#pragma unroll
            for (int m = 0; m < 4; ++m) { const int row = row0 + ai * 128 + m * 16; float part = 0.f;
#pragma unroll
                for (int bj = 0; bj < 2; ++bj) { f32x4 x0, x1; up8(xin[m][bj], x0, x1);
                    const u32x4 w = pk8(acc[ai][bj][m][0] * ascale + x0, acc[ai][bj][m][1] * ascale + x1);
                    *(u32x4*)((bf16_t*)(ws + WS_XB) + (size_t)row * D + col0 + bj * 128) = w;
                    f32x4 v0, v1; up8(w, v0, v1);
                    if (q8) { int q0 = __builtin_amdgcn_cvt_pk_fp8_f32(v0[0] * XS, v0[1] * XS, 0, false); q0 = __builtin_amdgcn_cvt_pk_fp8_f32(v0[2] * XS, v0[3] * XS, q0, true);
                        int q1 = __builtin_amdgcn_cvt_pk_fp8_f32(v1[0] * XS, v1[1] * XS, 0, false); q1 = __builtin_amdgcn_cvt_pk_fp8_f32(v1[2] * XS, v1[3] * XS, q1, true);
                        *(u32x2*)(ws + WS_XQ8 + (size_t)row * D + col0 + bj * 128) = (u32x2){(unsigned)q0, (unsigned)q1}; }
                    part += (v0[0] * v0[0] + v0[1] * v0[1]) + (v0[2] * v0[2] + v0[3] * v0[3]) + (v1[0] * v1[0] + v1[1] * v1[1]) + (v1[2] * v1[2] + v1[3] * v1[3]); }
                part += lx16(part); part = add_x32(part);
                if (fq == 0) ((float*)(ws + WS_SSP))[(size_t)row * 16 + u.pn * 4 + wc] = part; }
        }
    }
};
typedef _Float16 f16x8 __attribute__((ext_vector_type(8)));
struct GEpiScaleF16 {
    unsigned char* ws; _Float16* o; int ld;
    static constexpr int NST = 16;
    __device__ __forceinline__ void operator()(const f32x4 (&acc)[2][2][4][2], const pg8::Unit& u, int wr, int wc, int fr, int fq) const {
        const int row0 = u.pm * 256 + wr * 64 + fr;
        const LaneTr ltr(fr, fq); const int rowt = u.pm * 256 + wr * 64 + ltr.tr, col0 = u.pn * 256 + 32 * wc + 8 * ltr.tq;
        float rs8[2][4]; rstd8((const float*)(ws + WS_SSP), row0, fq, 1.f, rs8);
#pragma unroll
        for (int ai = 0; ai < 2; ++ai)
#pragma unroll
            for (int m = 0; m < 4; ++m) { const int row = rowt + ai * 128 + m * 16; const float rs = rs8[ai][m];
#pragma unroll
                for (int bj = 0; bj < 2; ++bj) { const f32x4 a = acc[ai][bj][m][0] * rs, b = acc[ai][bj][m][1] * rs;
                    const f16x8 h = (f16x8){(_Float16)a[0], (_Float16)a[1], (_Float16)a[2], (_Float16)a[3], (_Float16)b[0], (_Float16)b[1], (_Float16)b[2], (_Float16)b[3]};
                    *(u32x4*)(o + (size_t)row * ld + col0 + bj * 128) = ltr(__builtin_bit_cast(u32x4, h)); } }
    }
};
typedef PG8_LAS unsigned char* lds_t;
struct GEpiXSoftmax {
    unsigned char* ws; lds_t part;
    static constexpr int NST = 16;
    __device__ __forceinline__ void operator()(const f32x4 (&acc)[2][2][4][2], const pg8::Unit& u, int wr, int wc, int fr, int fq) const {
        const int row0 = u.pm * 256 + wr * 64 + fr, col0 = u.pn * 256 + 32 * wc + 8 * fq;
        f32x4 (&ex)[2][2][4][2] = const_cast<f32x4 (&)[2][2][4][2]>(acc);
        PG8_LAS f32x2* pt = (PG8_LAS f32x2*)part;
        float rs[2][4], mw[2][4];
#pragma unroll
        for (int ai = 0; ai < 2; ++ai)
#pragma unroll
            for (int m = 0; m < 4; ++m) { const int row = row0 + ai * 128 + m * 16; rs[ai][m] = rstd_q((const float*)(ws + WS_SSP), row, fq) * (1.4426950408889634f / (16.f * XS * GS));
                float mx = -INFINITY;
#pragma unroll
                for (int bj = 0; bj < 2; ++bj)
#pragma unroll
                    for (int n = 0; n < 2; ++n)
#pragma unroll
                        for (int e = 0; e < 4; ++e) mx = fmaxf(mx, acc[ai][bj][m][n][e]);
                mx *= rs[ai][m];
                mx = fmaxf(mx, lx16(mx)); mx = max_x32(mx);
                float sm = 0.f;
#pragma unroll
                for (int bj = 0; bj < 2; ++bj)
#pragma unroll
                    for (int n = 0; n < 2; ++n)
#pragma unroll
                        for (int e = 0; e < 4; ++e) { const float x = __builtin_amdgcn_exp2f(acc[ai][bj][m][n][e] * rs[ai][m] - mx); ex[ai][bj][m][n][e] = x; sm += x; }
                sm += lx16(sm); sm = add_x32(sm);
                mw[ai][m] = mx;
                if (fq == 0) pt[(wr * 64 + fr + ai * 128 + m * 16) * 4 + wc] = (f32x2){mx, sm}; }
        asm volatile("s_waitcnt lgkmcnt(0)" ::: "memory");
        __builtin_amdgcn_s_barrier();
#pragma unroll
        for (int ai = 0; ai < 2; ++ai)
#pragma unroll
            for (int m = 0; m < 4; ++m) { const int row = row0 + ai * 128 + m * 16;
                const PG8_LAS f32x2* pr = pt + (wr * 64 + fr + ai * 128 + m * 16) * 4;
                const f32x2 p0 = pr[0], p1 = pr[1], p2 = pr[2], p3 = pr[3];
                const float M = fmaxf(fmaxf(p0.x, p1.x), fmaxf(p2.x, p3.x));
                const float tot = (p0.y * __builtin_amdgcn_exp2f(p0.x - M) + p1.y * __builtin_amdgcn_exp2f(p1.x - M)) + (p2.y * __builtin_amdgcn_exp2f(p2.x - M) + p3.y * __builtin_amdgcn_exp2f(p3.x - M));
                const float f = __builtin_amdgcn_exp2f(mw[ai][m] - M) * (PS / tot);
#pragma unroll
                for (int bj = 0; bj < 2; ++bj) *(u32x2*)(ws + WS_PM + (size_t)row * D + col0 + bj * 128) = pk8_fp8(ex[ai][bj][m][0], ex[ai][bj][m][1], f); }
    }
};
__device__ __forceinline__ void fstage_win(const Params& p, int l, lds_t lds, int bid, int nb) {
    { pg8::Order O; O.init(T, 3072, nb, bid, p.ws + WS_XB, D, p.ws + WS_WIN + (size_t)l * 3072 * D * 2, D);
      pg8::gemm_phase<GEpiWin, pg8::Order, true>(lds, D, D, D, O, GEpiWin{p.ws}); }
    { pg8::Order O; O.init(T, 3072, nb, bid, p.ws + WS_XQ8, D / 2, p.ws + WS_WIN + 24 * MiB + (size_t)l * 3072 * D, D / 2);
      pg8::gemm_phase<GEpiGate, pg8::Order, true, pg8::NoHook, 1 << 20, true>(lds, D / 2, D / 2, D / 2, O, GEpiGate{p.ws}); }
}
template <bool HOOKS = true>
__device__ __forceinline__ void fstage_branch(const Params& p, int l, lds_t lds, int bid, int nb) {
    pg8::Order O; O.init(T, D, nb, bid, p.ws + WS_AO, 512, p.ws + WS_WB0 + (size_t)l * D * 1536 * 2, 1536);
    const long d1 = (long)WS_DP - (long)WS_AO - 8 * 128, d2 = (long)WS_SO - (long)WS_AO - 16 * 128;
    if constexpr (HOOKS) pg8::gemm_phase<GEpiBranch, pg8::Order, true, BranchHook, 8>(lds, 1536, 512, 1536, O, GEpiBranch{p.ws}, d1, d2, BranchHook{p.ws});
    else pg8::gemm_phase<GEpiBranch, pg8::Order, true, pg8::NoHook, 8>(lds, 1536, 512, 1536, O, GEpiBranch{p.ws}, d1, d2);
}
__device__ __forceinline__ void fstage_resid_out(const Params& p, int l, lds_t lds, int bid, int nb) {
    pg8::Order O; O.init(T, D, nb, bid, p.ws + WS_MG, D, p.ws + WS_WOUT + (size_t)l * D * D * 2, D);
    pg8::gemm_phase<GEpiResid, pg8::Order, true>(lds, D, D, D, O, GEpiResid{p.ws, true, 1.f});
}
__device__ __forceinline__ void fstage_resid_cross(const Params& p, int l, lds_t lds, int bid, int nb) {
    pg8::Order O; O.init(T, D, nb, bid, p.ws + WS_PM, D / 2, p.ws + WS_YT + (size_t)l * NB * D * D, D / 2, (size_t)D * D, S / 256);
    pg8::gemm_phase<GEpiResid, pg8::Order, true, pg8::NoHook, 1 << 20, true>(lds, D / 2, D / 2, D / 2, O, GEpiResid{p.ws, true, 1.f / (PS * YS)});
}
__device__ __forceinline__ void fstage_xscore(const Params& p, int l, lds_t lds, int bid, int nb) {
    pg8::Order O; O.init(T, D, nb, bid, p.ws + WS_XQ8, D / 2, p.ws + WS_GT + (size_t)l * NB * D * D, D / 2, (size_t)D * D, S / 256);
    pg8::gemm_phase<GEpiXSoftmax, pg8::Order, true, pg8::NoHook, 1 << 20, true>(lds, D / 2, D / 2, D / 2, O, GEpiXSoftmax{p.ws, lds + 131072});
}


struct GEpiKV {
    unsigned char* ws;
    static constexpr int NST = 16;
    __device__ __forceinline__ void operator()(const f32x4 (&acc)[2][2][4][2], const pg8::Unit& u, int wr, int wc, int fr, int fq) const {
        asm volatile("" : "+v"(fr), "+v"(fq));
        const int row0 = u.pm * 256 + wr * 64 + fr, l = u.pn >> 3, col0 = (u.pn & 7) * 256 + 32 * wc + 8 * fq;
        float rs8[2][4];
#pragma unroll
        for (int ai = 0; ai < 2; ++ai)
#pragma unroll
            for (int m = 0; m < 4; ++m) rs8[ai][m] = ((const float*)(ws + WS_RSTDM))[row0 + ai * 128 + m * 16];
#pragma unroll
        for (int ai = 0; ai < 2; ++ai)
#pragma unroll
            for (int m = 0; m < 4; ++m) { const int row = row0 + ai * 128 + m * 16; const float rs = rs8[ai][m];
#pragma unroll
                for (int bj = 0; bj < 2; ++bj) *(u32x4*)((bf16_t*)(ws + WS_KV) + ((size_t)l * MROWS + row) * 2048 + col0 + bj * 128) = pk8(acc[ai][bj][m][0] * rs, acc[ai][bj][m][1] * rs); }
    }
};
struct OrderG : pg8::Order {
    unsigned char* ws;
    __device__ __forceinline__ const char* a_ptr(const pg8::Unit& u) const { const int l = u.pm >> 5, b = (u.pm >> 2) & 7, h = u.pm & 3; return (const char*)(ws + WS_KV) + (((size_t)l * MROWS + b * 256) * 2048 + h * 256) * 2; }
    __device__ __forceinline__ const char* b_ptr(const pg8::Unit& u) const { const int l = u.pm >> 5, h = u.pm & 3; return (const char*)(ws + WS_WXQB) + (((size_t)l * D + u.pn * 256) * D + h * 256) * 2; }
};
struct GEpiG {
    unsigned char* ws;
    static constexpr int NST = 16;
    __device__ __forceinline__ void operator()(const f32x4 (&acc)[2][2][4][2], const pg8::Unit& u, int wr, int wc, int fr, int fq) const {
        asm volatile("" : "+v"(fr), "+v"(fq));
        const int lb = u.pm >> 2, h = u.pm & 3, r0 = wr * 64 + fr, col0 = u.pn * 256 + 32 * wc + 8 * fq;
#pragma unroll
        for (int ai = 0; ai < 2; ++ai)
#pragma unroll
            for (int m = 0; m < 4; ++m)
#pragma unroll
                for (int bj = 0; bj < 2; ++bj) *(u32x2*)(ws + WS_GT + ((size_t)lb * D + h * 256 + r0 + ai * 128 + m * 16) * D + col0 + bj * 128) = pk8_fp8(acc[ai][bj][m][0], acc[ai][bj][m][1], GS);
    }
};
struct OrderY : pg8::Order {
    unsigned char* ws;
    __device__ __forceinline__ const char* a_ptr(const pg8::Unit& u) const { const int l = u.pn >> 5, h = u.pn & 3; return (const char*)(ws + WS_WXOT) + (((size_t)l * D + u.pm * 256) * D + h * 256) * 2; }
    __device__ __forceinline__ const char* b_ptr(const pg8::Unit& u) const { const int l = u.pn >> 5, b = (u.pn >> 2) & 7, h = u.pn & 3; return (const char*)(ws + WS_KV) + (((size_t)l * MROWS + b * 256) * 2048 + 1024 + h * 256) * 2; }
};
struct GEpiY {
    unsigned char* ws;
    static constexpr int NST = 16;
    __device__ __forceinline__ void operator()(const f32x4 (&acc)[2][2][4][2], const pg8::Unit& u, int wr, int wc, int fr, int fq) const {
        asm volatile("" : "+v"(fr), "+v"(fq));
        const int lb = u.pn >> 2, h = u.pn & 3, row0 = u.pm * 256 + wr * 64 + fr, col0 = h * 256 + 32 * wc + 8 * fq;
#pragma unroll
        for (int ai = 0; ai < 2; ++ai)
#pragma unroll
            for (int m = 0; m < 4; ++m)
#pragma unroll
                for (int bj = 0; bj < 2; ++bj) *(u32x2*)(ws + WS_YT + ((size_t)lb * D + row0 + ai * 128 + m * 16) * D + col0 + bj * 128) = pk8_fp8(acc[ai][bj][m][0], acc[ai][bj][m][1], YS);
    }
};
__device__ __forceinline__ void fstage_kv(const Params& p, lds_t lds, int bid, int nb) {
    pg8::Order O; O.init(MROWS, L * 2048, nb, bid, p.ws + WS_MEMB, D, p.ws + WS_WXKVT, D);
    pg8::gemm_phase<GEpiKV, pg8::Order, true>(lds, D, D, D, O, GEpiKV{p.ws});
}
__device__ __forceinline__ void fstage_g(const Params& p, lds_t lds, int bid, int nb) {
    OrderG O; O.init(128 * 256, D, nb, bid, nullptr, 2048, nullptr, D); O.ws = p.ws;
    pg8::gemm_phase<GEpiG, OrderG, true>(lds, 256, 2048, D, O, GEpiG{p.ws});
}
__device__ __forceinline__ void fstage_y(const Params& p, lds_t lds, int bid, int nb) {
    OrderY O; O.init(D, 128 * 256, nb, bid, nullptr, D, nullptr, 2048); O.ws = p.ws;
    pg8::gemm_phase<GEpiY, OrderY, true>(lds, 256, D, 2048, O, GEpiY{p.ws});
}

#include <hip/hip_bf16.h>
namespace attn_body {
using bf16=__hip_bfloat16;
using bf16x8=__attribute__((ext_vector_type(8)))short;
using s16x4=__attribute__((ext_vector_type(4)))short;
using f32x16=__attribute__((ext_vector_type(16)))float;
using u32x4=__attribute__((ext_vector_type(4)))unsigned;
constexpr int SEQ=4096,D=64,DM=512;
constexpr int NW=8,QBLK=32,QB=QBLK*NW,KVBLK=64,NQB=SEQ/QB;
constexpr int ATTN_PITCH=DM, ATTN_UNIT_ROWS=QB;
__device__ __forceinline__ int crow(int r,int hi){return (r&3)+8*(r>>2)+4*hi;}
#define SBAR() __builtin_amdgcn_sched_barrier(0)
__device__ __forceinline__ void cmask(f32x16&p0,f32x16&p1,int jb,int qrel,int hi){
  const float NEG=-INFINITY; int kb=64*jb+4*hi;
  #pragma unroll
  for(int r=0;r<16;++r){int kv=kb+(r&3)+8*(r>>2); if(kv>qrel)p0[r]=NEG; if(kv+32>qrel)p1[r]=NEG;}
}

constexpr int NSLOT=3, SLOTB=8192;
constexpr int LDS_K=0, LDS_V=NSLOT*SLOTB, LDS_WS=3*NSLOT*SLOTB, LDS_OST=LDS_WS+NW*64*4, LDS_BYTES=LDS_OST+NW*8192;
constexpr float C2=0.125f*1.4426950408889634f;
__device__ __forceinline__ void glds16(const void*gsrc,unsigned lds_dst){unsigned keep;
  asm volatile("s_mov_b32 %0, m0\n\ts_mov_b32 m0, %2\n\ts_nop 0\n\tglobal_load_lds_dwordx4 %1, off\n\ts_mov_b32 m0, %0":"=&s"(keep):"v"(gsrc),"s"(lds_dst):"memory");}
__device__ __forceinline__ float max3f(float a,float b,float c){float r;asm("v_max3_f32 %0, %1, %2, %3":"=v"(r):"v"(a),"v"(b),"v"(c));return r;}
__device__ __forceinline__ float max2f(float a,float b){float r;asm("v_max_f32_e32 %0, %1, %2":"=v"(r):"v"(a),"v"(b));return r;}
__device__ __forceinline__ float fadd_s(float a,float b){float r;asm("v_add_f32_e32 %0, %1, %2":"=v"(r):"v"(a),"v"(b));return r;}
__device__ __forceinline__ float fsub_s(float a,float b){float r;asm("v_sub_f32_e32 %0, %1, %2":"=v"(r):"v"(a),"v"(b));return r;}
typedef float f32x2_t __attribute__((ext_vector_type(2))); typedef __bf16 bf16x2_t __attribute__((ext_vector_type(2)));
__device__ __forceinline__ unsigned cvtpk_s(float lo,float hi){f32x2_t v={lo,hi};bf16x2_t b=__builtin_convertvector(v,bf16x2_t);return __builtin_bit_cast(unsigned,b);}
#define WAIT_BAR(N) asm volatile("s_waitcnt vmcnt(" #N ") lgkmcnt(0)\n\ts_barrier":::"memory")

__device__ __forceinline__ void qkt(f32x16&p0,f32x16&p1,const char*Kslot,const bf16x8*qr,const f32x16&negm,int r32,int hi){
  const char*kb=Kslot+hi*1024+r32*16;
  #pragma unroll
  for(int d0=0;d0<4;++d0){
    const bf16x8 b0=*reinterpret_cast<const bf16x8*>(kb+d0*2048);
    const bf16x8 b1=*reinterpret_cast<const bf16x8*>(kb+d0*2048+512);
    if(d0==0){p0=__builtin_amdgcn_mfma_f32_32x32x16_bf16(b0,qr[0],negm,0,0,0);p1=__builtin_amdgcn_mfma_f32_32x32x16_bf16(b1,qr[0],negm,0,0,0);}
    else{p0=__builtin_amdgcn_mfma_f32_32x32x16_bf16(b0,qr[d0],p0,0,0,0);p1=__builtin_amdgcn_mfma_f32_32x32x16_bf16(b1,qr[d0],p1,0,0,0);}}
}
typedef __attribute__((address_space(3))) const char* lds_cptr;
typedef short v4i16_t __attribute__((ext_vector_type(4)));
__device__ __forceinline__ void kload8(bf16x8*kf,lds_cptr kp){
  kf[0]=*(const __attribute__((address_space(3))) bf16x8*)(kp);      kf[1]=*(const __attribute__((address_space(3))) bf16x8*)(kp+512);
  kf[2]=*(const __attribute__((address_space(3))) bf16x8*)(kp+2048); kf[3]=*(const __attribute__((address_space(3))) bf16x8*)(kp+2560);
  kf[4]=*(const __attribute__((address_space(3))) bf16x8*)(kp+4096); kf[5]=*(const __attribute__((address_space(3))) bf16x8*)(kp+4608);
  kf[6]=*(const __attribute__((address_space(3))) bf16x8*)(kp+6144); kf[7]=*(const __attribute__((address_space(3))) bf16x8*)(kp+6656);
}
__device__ __forceinline__ void kload2(bf16x8*kf,lds_cptr kp,int j){ kf[2*j]=*(const __attribute__((address_space(3))) bf16x8*)(kp+j*2048); kf[2*j+1]=*(const __attribute__((address_space(3))) bf16x8*)(kp+j*2048+512); }
__device__ __forceinline__ s16x4 vtr(lds_cptr p){ return __builtin_bit_cast(s16x4,__builtin_amdgcn_ds_read_tr16_b64_v4i16((__attribute__((address_space(3))) v4i16_t*)p)); }
__device__ __forceinline__ float rowmax(const f32x16&p0,const f32x16&p1){
  float a=max3f(p0[0],p0[1],p1[0]),b=max3f(p0[2],p0[3],p1[1]);a=max3f(a,p1[2],p1[3]);
  #pragma unroll
  for(int r=4;r<16;r+=4){a=max3f(a,p0[r],p0[r+1]);b=max3f(b,p0[r+2],p0[r+3]);a=max3f(a,p1[r],p1[r+1]);b=max3f(b,p1[r+2],p1[r+3]);}
  const float m=max2f(a,b);
  auto rr=__builtin_amdgcn_permlane32_swap(__float_as_uint(m),__float_as_uint(m),false,false);
  return max2f(__uint_as_float(rr[0]),__uint_as_float(rr[1]));
}
__device__ __forceinline__ void pv(f32x16*o,int vb,bf16x8 pa0,bf16x8 pa1,bf16x8 pa2,bf16x8 pa3){
  #pragma unroll
  for(int d0=0;d0<4;++d0){s16x4 lo[4],hi[4];
    #pragma unroll
    for(int ks=0;ks<4;++ks){
      asm volatile("ds_read_b64_tr_b16 %0,%1 offset:%c2":"=&v"(lo[ks]):"v"(vb),"i"(d0*4096+ks*1024):"memory");
      asm volatile("ds_read_b64_tr_b16 %0,%1 offset:%c2":"=&v"(hi[ks]):"v"(vb),"i"(d0*4096+ks*1024+512):"memory");}
    asm volatile("s_waitcnt lgkmcnt(0)":::"memory");SBAR();
    #define PK(k) (bf16x8){lo[k][0],lo[k][1],lo[k][2],lo[k][3],hi[k][0],hi[k][1],hi[k][2],hi[k][3]}
    o[d0]=__builtin_amdgcn_mfma_f32_32x32x16_bf16(pa0,PK(0),o[d0],0,0,0);
    o[d0]=__builtin_amdgcn_mfma_f32_32x32x16_bf16(pa1,PK(1),o[d0],0,0,0);
    o[d0]=__builtin_amdgcn_mfma_f32_32x32x16_bf16(pa2,PK(2),o[d0],0,0,0);
    o[d0]=__builtin_amdgcn_mfma_f32_32x32x16_bf16(pa3,PK(3),o[d0],0,0,0);
    #undef PK
  }
}

#ifndef ATTN_STORE16
#define ATTN_STORE16(p,v) (*(u32x4*)(p)=(v))
#endif
template<int THRL> __device__ __forceinline__ void attn_unit(int b,int qcol,int kcol,int vcol,int ocol,int qb,const bf16*Q,const bf16*__restrict__ K,const bf16*__restrict__ V,bf16*O,char*shm){
  const int tid=tid_fresh(),lane=tid&63,r32=lane&31,hi=lane>>5; const int wid=__builtin_amdgcn_readfirstlane(tid>>6);
  const long rowbase=(long)b*SEQ; const int q0=qb*QB;
  const bf16*Qw=Q+(rowbase+q0+wid*QBLK)*DM+qcol;
  const bf16*Kh=K+rowbase*DM+kcol,*Vh=V+rowbase*DM+vcol;
  const unsigned lds0=(unsigned)(uintptr_t)shm;
  float*wsf=(float*)(shm+LDS_WS)+wid*64;
  const bf16*ksrc=Kh+(long)lane*DM+wid*8;
  const bf16*vsrc=Vh+(long)(16*(wid&3)+(lane>>2))*DM+(wid>>2)*32+(lane&3)*8;
  const unsigned kdst=lds0+LDS_K+wid*1024, vdst=lds0+LDS_V+wid*1024;
  #define DMA_K(t,slot) glds16(ksrc+(long)(t)*KVBLK*DM,(unsigned)__builtin_amdgcn_readfirstlane(kdst+(slot)))
  #define DMA_V(t,slot) do{ glds16(vsrc+(long)(t)*KVBLK*DM,(unsigned)__builtin_amdgcn_readfirstlane(vdst+2*(slot))); glds16(vsrc+64+(long)(t)*KVBLK*DM,(unsigned)__builtin_amdgcn_readfirstlane(vdst+2*(slot)+8192)); }while(0)
  const int vb0=(int)(lds0+LDS_V)+((lane>>4)&1)*32+(lane&3)*8+(4*hi+((lane&15)>>2))*64;
  const char*Kbase=shm+LDS_K; bf16x8 kf[8];
  const lds_cptr shm3=(lds_cptr)shm; const lds_cptr kp0=shm3+LDS_K+hi*1024+r32*16; const lds_cptr vp0=shm3+LDS_V+((lane>>4)&1)*32+(lane&3)*8+(4*hi+((lane&15)>>2))*64;
  const int NT=(q0+QB)/KVBLK;
  DMA_K(0,0);DMA_V(0,0);DMA_K(1,SLOTB);
  bf16x8 qr[4];
  #pragma unroll
  for(int d0=0;d0<4;++d0)qr[d0]=*reinterpret_cast<const bf16x8*>(&Qw[(long)r32*DM+d0*16+hi*8]);
  float mhat=0.f,l_reg=0.f;f32x16 o[4];f32x16 negm;{float z_=0.f;asm volatile("":"+v"(z_));o[0]=(f32x16)(z_);o[1]=(f32x16)(z_);o[2]=(f32x16)(z_);o[3]=(f32x16)(z_);negm=(f32x16)(z_);}asm volatile("":"+v"(negm));
  const int qrel=wid*QBLK+r32;
  #define CMASK(P0,P1,t) do{int jb_=(t)-(NT-4); if(jb_>=0)cmask(P0,P1,jb_,qrel,hi);}while(0)
  bool resc=false;
  #define START(P0,P1) do{ const float rm=rowmax(P0,P1); resc=false; \
    { const float dl=rm; mhat=fadd_s(mhat,dl); \
      _Pragma("unroll") for(int r=0;r<16;++r){P0[r]=fsub_s(P0[r],dl);P1[r]=fsub_s(P1[r],dl);} \
      _Pragma("unroll") for(int r=0;r<16;++r)negm[r]=-mhat; asm volatile("":"+v"(negm)); } \
    _Pragma("unroll") for(int r=0;r<16;++r)P0[r]=__builtin_amdgcn_exp2f(P0[r]); }while(0)
  #define RESC() do{ if(resc){ asm volatile("s_waitcnt lgkmcnt(0)":::"memory"); \
      _Pragma("unroll") for(int d_=0;d_<4;++d_) _Pragma("unroll") for(int r=0;r<16;++r)o[d_][r]*=wsf[crow(r,hi)]; } }while(0)
  f32x16 pA0,pA1,pB0,pB1;
  int sl_prev=0,sl_cur=0,sl_next=SLOTB;
  #define ROT() do{sl_prev=sl_cur;sl_cur=sl_next;sl_next=(sl_next==(NSLOT-1)*SLOTB)?0:sl_next+SLOTB;}while(0)
  DMA_K(2,2*SLOTB);
  WAIT_BAR(4);
  qkt(pA0,pA1,Kbase,qr,negm,r32,hi);asm volatile("s_nop 15\n\ts_nop 7":"+v"(pA0),"+v"(pA1));CMASK(pA0,pA1,0);
  START(pA0,pA1);
  _Pragma("unroll") for(int r=0;r<16;++r)pA1[r]=__builtin_amdgcn_exp2f(pA1[r]);
  WAIT_BAR(0);
  DMA_K(3,0);DMA_V(1,SLOTB);
  ROT();
  kload8(kf,kp0+sl_cur);
  WAIT_BAR(3);
  s16x4 vlo[8],vhi[8]; u32x4 pw0,pw1,pw2,pw3;
  #define PKW(P,B) cvtpk_s(P[B],P[B+1])
  #define PAF(k) __builtin_bit_cast(bf16x8,pw##k)
  #define VFR(i) (bf16x8){vlo[i][0],vlo[i][1],vlo[i][2],vlo[i][3],vhi[i][0],vhi[i][1],vhi[i][2],vhi[i][3]}
  #define PIN(x) asm volatile("":"+v"(x))
  #define MX3(a,b,c) __builtin_fmaxf(__builtin_fmaxf((a),(b)),(c))
  #define GAPA(MF,A0,A1,A2,A3,W0,W1,PW) do{ MF; sacc+=A0; sacc+=A1; sacc+=A2; sacc+=A3; PIN(sacc); W0; W1; PIN(PW); SBAR(); }while(0)
  #define EX(v) __builtin_amdgcn_exp2f(v)
  #define GAPB(MF,X,B) do{ MF; X[B]=EX(X[B]); X[B+1]=EX(X[B+1]); X[B+2]=EX(X[B+2]); X[B+3]=EX(X[B+3]); PIN(X); SBAR(); }while(0)
  #define VRD(i) do{ vlo[i]=vtr(vp_+(((i)>>2)*4096+((i)&3)*1024)); vhi[i]=vtr(vp_+(((i)>>2)*4096+((i)&3)*1024+512)); }while(0)
  #define VRD2(i) do{ vlo[i]=vtr(vp_+((((i)>>2)+2)*4096+((i)&3)*1024)); vhi[i]=vtr(vp_+((((i)>>2)+2)*4096+((i)&3)*1024+512)); SBAR(); }while(0)
  #define KRD(G,j) do{ if(G){ kload2(kf,kp0+sl_next,j); SBAR(); } }while(0)
  #define STEP(C0,C1,P0,P1,t,GK,GV,GL) do{ SBAR(); \
    const lds_cptr vp_=vp0+2*sl_prev; \
    VRD(0); SBAR(); float sacc=(P0[0]+P0[1]); \
    GAPA(C0=__builtin_amdgcn_mfma_f32_32x32x16_bf16(kf[0],qr[0],negm,0,0,0), P0[2],P0[3],P0[4],P0[5],     pw0[0]=PKW(P0,0), pw0[1]=PKW(P0,2), pw0); \
    VRD(4); SBAR(); GAPA(C1=__builtin_amdgcn_mfma_f32_32x32x16_bf16(kf[1],qr[0],negm,0,0,0), P0[6],P0[7],P0[8],P0[9],     pw0[2]=PKW(P0,4), pw0[3]=PKW(P0,6), pw0); \
    VRD(1); SBAR(); GAPA(C0=__builtin_amdgcn_mfma_f32_32x32x16_bf16(kf[2],qr[1],C0,0,0,0),   P0[10],P0[11],P0[12],P0[13], pw1[0]=PKW(P0,8), pw1[1]=PKW(P0,10), pw1); \
    VRD(5); SBAR(); GAPA(C1=__builtin_amdgcn_mfma_f32_32x32x16_bf16(kf[3],qr[1],C1,0,0,0),   P0[14],P0[15],P1[0],P1[1],   pw1[2]=PKW(P0,12),pw1[3]=PKW(P0,14), pw1); \
    VRD(2); SBAR(); GAPA(C0=__builtin_amdgcn_mfma_f32_32x32x16_bf16(kf[4],qr[2],C0,0,0,0),   P1[2],P1[3],P1[4],P1[5],     pw2[0]=PKW(P1,0), pw2[1]=PKW(P1,2), pw2); \
    VRD(6); SBAR(); GAPA(C1=__builtin_amdgcn_mfma_f32_32x32x16_bf16(kf[5],qr[2],C1,0,0,0),   P1[6],P1[7],P1[8],P1[9],     pw2[2]=PKW(P1,4), pw2[3]=PKW(P1,6), pw2); \
    VRD(3); SBAR(); GAPA(C0=__builtin_amdgcn_mfma_f32_32x32x16_bf16(kf[6],qr[3],C0,0,0,0),   P1[10],P1[11],P1[12],P1[13], pw3[0]=PKW(P1,8), pw3[1]=PKW(P1,10), pw3); \
    VRD(7); SBAR(); GAPA(C1=__builtin_amdgcn_mfma_f32_32x32x16_bf16(kf[7],qr[3],C1,0,0,0),   P1[14],P1[15],0.f,0.f,       pw3[2]=PKW(P1,12),pw3[3]=PKW(P1,14), pw3); \
    l_reg+=sacc; \
    if(GK){DMA_K((t)+3,sl_cur);} if(GV){DMA_V((t)+1,sl_next);} \
    CMASK(C0,C1,t); \
    { float a=MX3(C0[0],C0[1],C1[0]),b=MX3(C0[2],C0[3],C1[1]); a=MX3(a,C1[2],C1[3]); \
      _Pragma("unroll") for(int r=4;r<16;r+=4){a=MX3(a,C0[r],C0[r+1]);b=MX3(b,C0[r+2],C0[r+3]);a=MX3(a,C1[r],C1[r+1]);b=MX3(b,C1[r+2],C1[r+3]);} \
      float rm=__builtin_fmaxf(a,b); { auto rr=__builtin_amdgcn_permlane32_swap(__float_as_uint(rm),__float_as_uint(rm),false,false); rm=__builtin_fmaxf(__uint_as_float(rr[0]),__uint_as_float(rr[1])); } \
      resc=false; \
      if(__builtin_expect(__any(rm>(float)THRL),0)){ const float dl=__builtin_fmaxf(rm,0.f); mhat+=dl; \
        _Pragma("unroll") for(int r=0;r<16;++r){C0[r]-=dl;C1[r]-=dl;} \
        _Pragma("unroll") for(int r=0;r<16;++r)negm[r]=-mhat; asm volatile("":"+v"(negm)); \
        const float f=__builtin_amdgcn_exp2f(-dl); l_reg*=f; if(hi==0)wsf[r32]=f; resc=true; } } \
    SBAR(); \
    GAPB(o[0]=__builtin_amdgcn_mfma_f32_32x32x16_bf16(PAF(0),VFR(0),o[0],0,0,0), C0,0); VRD2(0); \
    GAPB(o[1]=__builtin_amdgcn_mfma_f32_32x32x16_bf16(PAF(0),VFR(4),o[1],0,0,0), C0,4); VRD2(4); \
    KRD(GL,0); GAPB(o[0]=__builtin_amdgcn_mfma_f32_32x32x16_bf16(PAF(1),VFR(1),o[0],0,0,0), C0,8); VRD2(1); \
    KRD(GL,1); GAPB(o[1]=__builtin_amdgcn_mfma_f32_32x32x16_bf16(PAF(1),VFR(5),o[1],0,0,0), C0,12); VRD2(5); \
    KRD(GL,2); GAPB(o[0]=__builtin_amdgcn_mfma_f32_32x32x16_bf16(PAF(2),VFR(2),o[0],0,0,0), C1,0); VRD2(2); \
    KRD(GL,3); GAPB(o[1]=__builtin_amdgcn_mfma_f32_32x32x16_bf16(PAF(2),VFR(6),o[1],0,0,0), C1,4); VRD2(6); \
    GAPB(o[0]=__builtin_amdgcn_mfma_f32_32x32x16_bf16(PAF(3),VFR(3),o[0],0,0,0), C1,8); VRD2(3); \
    GAPB(o[1]=__builtin_amdgcn_mfma_f32_32x32x16_bf16(PAF(3),VFR(7),o[1],0,0,0), C1,12); VRD2(7); \
    o[2]=__builtin_amdgcn_mfma_f32_32x32x16_bf16(PAF(0),VFR(0),o[2],0,0,0); o[3]=__builtin_amdgcn_mfma_f32_32x32x16_bf16(PAF(0),VFR(4),o[3],0,0,0); SBAR(); \
    o[2]=__builtin_amdgcn_mfma_f32_32x32x16_bf16(PAF(1),VFR(1),o[2],0,0,0); o[3]=__builtin_amdgcn_mfma_f32_32x32x16_bf16(PAF(1),VFR(5),o[3],0,0,0); SBAR(); \
    o[2]=__builtin_amdgcn_mfma_f32_32x32x16_bf16(PAF(2),VFR(2),o[2],0,0,0); o[3]=__builtin_amdgcn_mfma_f32_32x32x16_bf16(PAF(2),VFR(6),o[3],0,0,0); SBAR(); \
    o[2]=__builtin_amdgcn_mfma_f32_32x32x16_bf16(PAF(3),VFR(3),o[2],0,0,0); o[3]=__builtin_amdgcn_mfma_f32_32x32x16_bf16(PAF(3),VFR(7),o[3],0,0,0); SBAR(); \
    }while(0)
  int t=1;
  #undef CMASK
  #define CMASK(P0,P1,t) do{}while(0)
  for(;t+5<NT;t+=2){
    STEP(pB0,pB1,pA0,pA1,t,true,true,true);     WAIT_BAR(3); RESC(); ROT();
    STEP(pA0,pA1,pB0,pB1,t+1,true,true,true);   WAIT_BAR(3); RESC(); ROT();
  }
  #undef CMASK
  #define CMASK(P0,P1,t) do{int jb_=(t)-(NT-4); if(jb_>=0)cmask(P0,P1,jb_,qrel,hi);}while(0)
  #define ENDW(tt) do{ if((tt)+3<NT){WAIT_BAR(3);} else if((tt)+2<NT){WAIT_BAR(2);} else {WAIT_BAR(0);} }while(0)
  for(;t+1<NT;t+=2){
    STEP(pB0,pB1,pA0,pA1,t,(t+3<NT),(t+1<NT),(t+1<NT));       ENDW(t);   RESC(); ROT();
    STEP(pA0,pA1,pB0,pB1,t+1,(t+4<NT),(t+2<NT),(t+2<NT));     ENDW(t+1); RESC(); ROT();
  }
  STEP(pB0,pB1,pA0,pA1,NT-1,false,false,false); RESC();
  { float sacc=pB0[0]+pB0[1]; _Pragma("unroll") for(int r=2;r<16;++r)sacc+=pB0[r]; _Pragma("unroll") for(int r=0;r<16;++r)sacc+=pB1[r]; l_reg+=sacc;
    pw0=(u32x4){PKW(pB0,0),PKW(pB0,2),PKW(pB0,4),PKW(pB0,6)};pw1=(u32x4){PKW(pB0,8),PKW(pB0,10),PKW(pB0,12),PKW(pB0,14)};pw2=(u32x4){PKW(pB1,0),PKW(pB1,2),PKW(pB1,4),PKW(pB1,6)};pw3=(u32x4){PKW(pB1,8),PKW(pB1,10),PKW(pB1,12),PKW(pB1,14)};
    SBAR(); pv(o,vb0+2*sl_cur,PAF(0),PAF(1),PAF(2),PAF(3)); }
  #undef PKW
  #undef PAF
  #undef VFR
  #undef PIN
  #undef MX3
  #undef GAPA
  #undef GAPB
  #undef EX
  #undef VRD
  #undef VRD2
  #undef KRD
  #undef STEP
  #undef ENDW
  {auto rr=__builtin_amdgcn_permlane32_swap(__float_as_uint(l_reg),__float_as_uint(l_reg),false,false);l_reg=__uint_as_float(rr[0])+__uint_as_float(rr[1]);}
  if(hi==0)wsf[32+r32]=l_reg;asm volatile("s_waitcnt lgkmcnt(0)":::"memory");
  float rli[16];
  #pragma unroll
  for(int r=0;r<16;++r)rli[r]=__builtin_amdgcn_rcpf(wsf[32+crow(r,hi)]);
  bf16*Ow=O+(rowbase+q0+wid*QBLK)*DM+ocol;
  { bf16*stg=(bf16*)(shm+LDS_OST)+wid*4096;
    #pragma unroll
    for(int r=0;r<16;++r){const int orow=crow(r,hi);
      #pragma unroll
      for(int d0=0;d0<4;++d0)stg[orow*128+d0*32+r32]=__float2bfloat16(o[d0][r]*rli[r]);}
    asm volatile("s_waitcnt lgkmcnt(0)":::"memory");
    #pragma unroll
    for(int i=0;i<8;++i){const int row=i*4+(lane>>4),ch=lane&15; const u32x4 v=*(const u32x4*)(stg+row*128+ch*8); ATTN_STORE16(Ow+(long)row*DM+ch*8,v);} }
  asm volatile("s_waitcnt lgkmcnt(0)\n\ts_barrier":::"memory");
  #undef DMA_K
  #undef DMA_V
  #undef CMASK
  #undef START
  #undef RESC
  #undef ROT
}
constexpr int ATTN_LDS_BYTES=LDS_BYTES;
#undef SBAR
#undef WAIT_BAR
}

__device__ __forceinline__ void fstage_attn(const Params& p, int l, char* lds) {
    const int G = gridDim.x, bx = blockIdx.x;
    const int vcu = (G % 8 == 0) ? (bx % 8) * (G / 8) + bx / 8 : bx;
    const attn_body::bf16* Q = (const attn_body::bf16*)(p.ws + WS_QB); const attn_body::bf16* K = (const attn_body::bf16*)(p.ws + WS_KB); const attn_body::bf16* V = (const attn_body::bf16*)(p.ws + WS_VB);
    for (int k = vcu; k < 256; k += G) {
        const int s = k & 7, h = (k >> 3) & 3, b = k >> 5;
#pragma unroll 1
        for (int i = 0; i < 4; ++i) {
            const int qb = (i & 2) ? 15 - s : s, m = i & 1;
            attn_body::bf16* O = (attn_body::bf16*)(p.ws + (m == 0 ? WS_O1 : WS_O2));
            attn_body::attn_unit<8>(b, (2 * h + m) * 64, (2 * h + m) * 64, h * 128, h * 128, qb, Q, K, V, O, lds);
        }
    }
    asm volatile("s_waitcnt vmcnt(0)" ::: "memory");
    __syncthreads();
    int vc2 = vcu; asm volatile("" : "+s"(vc2));
    for (int k = vc2; k < 256; k += G) {
        const int s = k & 7, h = (k >> 3) & 3, b = k >> 5;
        const int tid = tid_fresh(), lane = tid & 63, wid = tid >> 6;
        const float* lq = (const float*)p.in[5] + l * 256;
        float d1 = lq[lane] * lq[64 + lane], d2 = lq[128 + lane] * lq[192 + lane];
        d1 = wave_sum(d1); d2 = wave_sum(d2);
        const float lam = expf(d1) - expf(d2) + lam_init_of(l);
#pragma unroll 2
        for (int it = 0; it < 16; ++it) {
            const int qb = (it & 8) ? 15 - s : s, r = (it & 7) * 32 + wid * 4 + (lane >> 4);
            const size_t o = ((size_t)b * S + qb * 256 + r) * 512 + h * 128 + (lane & 15) * 8;
            const u32x4 a = *(const u32x4*)((const bf16_t*)(p.ws + WS_O1) + o), c = *(const u32x4*)((const bf16_t*)(p.ws + WS_O2) + o);
            float x[8];
#pragma unroll
            for (int e = 0; e < 4; ++e) { x[2 * e] = __uint_as_float(a[e] << 16) - lam * __uint_as_float(c[e] << 16); x[2 * e + 1] = __uint_as_float(a[e] & 0xffff0000u) - lam * __uint_as_float(c[e] & 0xffff0000u); }
            float ss = 0.f;
#pragma unroll
            for (int e = 0; e < 8; ++e) ss += x[e] * x[e];
            ss = sum16(ss);
            const float rs = rsqrtf(ss * (1.f / 128.f) + EPS);
            u32x4 w;
#pragma unroll
            for (int e = 0; e < 4; ++e) w[e] = pk2(x[2 * e] * rs, x[2 * e + 1] * rs);
            *(u32x4*)((bf16_t*)(p.ws + WS_AO) + o) = w;
        }
    }
}


__device__ __forceinline__ void fstage_sgate(const Params& p, int l, lds_t lds) {
    unsigned char* ws = p.ws;
    const int tid = tid_fresh(), lane = tid & 63, wid = __builtin_amdgcn_readfirstlane(tid >> 6), fr = lane & 15, fq = lane >> 4;
    constexpr int VP = 132;
    PG8_LAS bf16_t* vnT = (PG8_LAS bf16_t*)lds;
    PG8_LAS float* st = (PG8_LAS float*)(lds + 512 * VP * 2);
    const bf16_t* vin = (const bf16_t*)(ws + WS_VIN); const bf16_t* uin = (const bf16_t*)(ws + WS_UIN); bf16_t* so = (bf16_t*)(ws + WS_SO);
    const float* lng = (const float*)p.in[9] + l * 512; const float* lnb = (const float*)p.in[10] + l * 512; const float* bsp = (const float*)p.in[12] + l * 512;
    const bf16_t* wsm = (const bf16_t*)(ws + WS_WSPT) + (size_t)l * 4 * 16384;
    for (int ch = blockIdx.x; ch < T / 128; ch += gridDim.x) {
        const int t0 = ch * 128;
        __syncthreads();
#pragma unroll 4
        for (int i = 0; i < 16; ++i) {
            const int row = wid * 16 + i;
            f32x4 a, b; up8(*(const u32x4*)(vin + (size_t)(t0 + row) * 512 + lane * 8), a, b);
            const float mu = wave_sum((a[0] + a[1]) + (a[2] + a[3]) + (b[0] + b[1]) + (b[2] + b[3])) * (1.f / 512.f);
            a = a - mu; b = b - mu;
            const float vr = wave_sum((a[0] * a[0] + a[1] * a[1]) + (a[2] * a[2] + a[3] * a[3]) + (b[0] * b[0] + b[1] * b[1]) + (b[2] * b[2] + b[3] * b[3])) * (1.f / 512.f);
            if (lane == 0) { st[2 * row] = mu; st[2 * row + 1] = rsqrtf(vr + EPS); }
        }
        __syncthreads();
        {
            const int cp = tid & 255, pb = tid >> 8;
            const float g0 = lng[2 * cp], g1 = lng[2 * cp + 1], b0 = lnb[2 * cp], b1 = lnb[2 * cp + 1];
#pragma unroll 2
            for (int blk = 0; blk < 8; ++blk) {
                const int s0 = (pb * 8 + blk) * 8;
                unsigned w[8];
#pragma unroll
                for (int e = 0; e < 8; ++e) w[e] = *(const unsigned*)(vin + (size_t)(t0 + s0 + e) * 512 + 2 * cp);
                float y0[8], y1[8];
#pragma unroll
                for (int e = 0; e < 8; ++e) { const float mu = st[2 * (s0 + e)], rs = st[2 * (s0 + e) + 1];
                    y0[e] = (__uint_as_float(w[e] << 16) - mu) * rs * g0 + b0; y1[e] = (__uint_as_float(w[e] & 0xffff0000u) - mu) * rs * g1 + b1; }
                PG8_LAS u32x2* d0 = (PG8_LAS u32x2*)(vnT + (2 * cp) * VP + s0); PG8_LAS u32x2* d1 = (PG8_LAS u32x2*)(vnT + (2 * cp + 1) * VP + s0);
                d0[0] = (u32x2){pk2(y0[0], y0[1]), pk2(y0[2], y0[3])}; d0[1] = (u32x2){pk2(y0[4], y0[5]), pk2(y0[6], y0[7])};
                d1[0] = (u32x2){pk2(y1[0], y1[1]), pk2(y1[2], y1[3])}; d1[1] = (u32x2){pk2(y1[4], y1[5]), pk2(y1[6], y1[7])};
            }
        }
        __syncthreads();
        const int nks = (16 * wid + 16 + 31) >> 5;
        const int trow = t0 + 16 * wid + fr;
#pragma unroll 1
        for (int g = 0; g < 4; ++g) {
            f32x4 acc[8];
#pragma unroll
            for (int nt = 0; nt < 8; ++nt) acc[nt] = (f32x4){0.f, 0.f, 0.f, 0.f};
            const bf16_t* wrow = wsm + ((size_t)g * 128 + 16 * wid + fr) * 128 + fq * 8;
#pragma unroll 1
            for (int ks = 0; ks < nks; ++ks) {
                const bf16x8 af = *(const bf16x8*)(wrow + ks * 32);
#pragma unroll
                for (int nt = 0; nt < 8; ++nt) {
                    const PG8_LAS u32x2* bp = (const PG8_LAS u32x2*)(vnT + (g * 128 + nt * 16 + fr) * VP + ks * 32 + fq * 8);
                    const u32x2 lo = bp[0], hi = bp[1];
                    const bf16x8 bf = __builtin_bit_cast(bf16x8, (u32x4){lo.x, lo.y, hi.x, hi.y});
                    acc[nt] = __builtin_amdgcn_mfma_f32_16x16x32_bf16(bf, af, acc[nt], 0, 0, 0);
                }
            }
            const float bs = bsp[g * 128 + 16 * wid + fr];
#pragma unroll
            for (int nt = 0; nt < 8; ++nt) { const size_t o = (size_t)trow * 512 + g * 128 + nt * 16 + fq * 4; st_bf4(so + o, ld_bf4(uin + o) * (acc[nt] + bs)); }
        }
    }
}

__device__ __forceinline__ void stage_pool_d(const Params& p, int bid, int nb) {
    const int tidx = tid_fresh();
    unsigned char* ws = p.ws;
    const unsigned char* pin = ws + WS_PIN; unsigned char* dp = ws + WS_DP;
    for (int i = bid * NT + tidx; i < (T / 8) * 64; i += nb * NT) {
        const int c8 = (i & 63) * 8, t0 = (i >> 6) * 8, s0 = t0 & (S - 1), g = c8 >> 7, w = 2 << g;
        const unsigned ob = (unsigned)(t0 * 512 + c8) * 2u;
        u32x4 pv[16], cv[8];
#pragma unroll
        for (int k = 1; k <= 16; ++k) pv[k - 1] = (k <= w && k <= s0) ? *(const u32x4*)(pin + (ob - (unsigned)k * 1024u)) : (u32x4){0u, 0u, 0u, 0u};
#pragma unroll
        for (int j = 0; j < 8; ++j) cv[j] = *(const u32x4*)(pin + (ob + (unsigned)j * 1024u));
        f32x4 s0v = (f32x4){0.f, 0.f, 0.f, 0.f}, s1v = s0v, a, b;
#pragma unroll
        for (int k = 0; k < 16; ++k) { up8(pv[k], a, b); s0v = s0v + a; s1v = s1v + b; }
#pragma unroll
        for (int j = 0; j < 8; ++j) {
            f32x4 ca, cb; up8(cv[j], ca, cb); s0v = s0v + ca; s1v = s1v + cb;
            u32x4 lv = pv[(15 - j) & 15];
            if (g == 2) lv = pv[7 - j];
            if (g == 1) lv = (j < 4) ? pv[3 - (j & 3)] : cv[(j - 4) & 7];
            if (g == 0) lv = (j < 2) ? pv[1 - (j & 1)] : cv[(j - 2) & 7];
            up8(lv, a, b); s0v = s0v - a; s1v = s1v - b;
            const int sj = s0 + j + 1; const float inv = 1.f / (float)(sj < w ? sj : w);
            *(u32x4*)(dp + (ob + (unsigned)j * 1024u)) = pk8(s0v * inv - ca, s1v * inv - cb);
        }
    }
}
__device__ __forceinline__ void stage_aout(const Params& p, int l, int bid, int nb) {
    const int tidx = tid_fresh();
    unsigned char* ws = p.ws;
    const int lane = tidx & 63, wid = tidx >> 6;
    const float* lq = (const float*)p.in[5] + l * 256;
    float d1 = lq[lane] * lq[64 + lane], d2 = lq[128 + lane] * lq[192 + lane];
    d1 = wave_sum(d1); d2 = wave_sum(d2);
    const float lam = expf(d1) - expf(d2) + lam_init_of(l);
    for (int t = bid * 8 + wid; t < T; t += nb * 8) {
        const u32x4 a = *(const u32x4*)((const bf16_t*)(ws + WS_O1) + (size_t)t * 512 + lane * 8), b = *(const u32x4*)((const bf16_t*)(ws + WS_O2) + (size_t)t * 512 + lane * 8);
        float x[8];
#pragma unroll
        for (int e = 0; e < 4; ++e) { x[2 * e] = __uint_as_float(a[e] << 16) - lam * __uint_as_float(b[e] << 16); x[2 * e + 1] = __uint_as_float(a[e] & 0xffff0000u) - lam * __uint_as_float(b[e] & 0xffff0000u); }
        float ss = 0.f;
#pragma unroll
        for (int e = 0; e < 8; ++e) ss += x[e] * x[e];
        ss = sum16(ss);
        const float rs = rsqrtf(ss * (1.f / 128.f) + EPS);
        u32x4 w;
#pragma unroll
        for (int e = 0; e < 4; ++e) w[e] = pk2(x[2 * e] * rs, x[2 * e + 1] * rs);
        *(u32x4*)((bf16_t*)(ws + WS_AO) + (size_t)t * 512 + lane * 8) = w;
    }
}
__device__ __forceinline__ unsigned key_of(float s, unsigned low) { const unsigned u = __float_as_uint(s); const unsigned k = (u & 0x80000000u) ? ~u : (u | 0x80000000u); return (k & ~255u) | low; }
__device__ __forceinline__ float val_of(unsigned key) { const unsigned k = key & ~255u; const unsigned u = (k & 0x80000000u) ? (k & 0x7fffffffu) : ~k; return __uint_as_float(u); }
__device__ __forceinline__ void sort16_desc(unsigned (&a)[16]) {
#pragma unroll
    for (int k = 2; k <= 16; k <<= 1)
#pragma unroll
        for (int j = k >> 1; j > 0; j >>= 1)
#pragma unroll
            for (int i = 0; i < 16; ++i) { const int l = i ^ j; if (l > i) { const unsigned hi = a[i] > a[l] ? a[i] : a[l], lo = a[i] > a[l] ? a[l] : a[i];
                if ((i & k) == 0) { a[i] = hi; a[l] = lo; } else { a[i] = lo; a[l] = hi; } } }
}
__device__ __forceinline__ void merge_top16(unsigned (&r)[16], const unsigned (&b)[16]) {
#pragma unroll
    for (int i = 0; i < 16; ++i) r[i] = r[i] > b[15 - i] ? r[i] : b[15 - i];
#pragma unroll
    for (int j = 8; j > 0; j >>= 1)
#pragma unroll
        for (int i = 0; i < 16; ++i) { const int l = i ^ j; if (l > i) { const unsigned hi = r[i] > r[l] ? r[i] : r[l], lo = r[i] > r[l] ? r[l] : r[i]; r[i] = hi; r[l] = lo; } }
}
__device__ __forceinline__ constexpr int cand_pair(int q) {
    int c = 0;
    for (int a = 0; a < 16; ++a) for (int b = 0; b < 16; ++b) if ((a + 1) * (b + 1) <= 16) { if (c == q) return a * 16 + b; ++c; }
    return -1;
}
template <class Sched>
__device__ __forceinline__ void topk_local(const Params& p, const Sched& O, lds_t lds) {
    const int tidx = tid_fresh(), lane = tidx & 63, wid = __builtin_amdgcn_readfirstlane(tidx >> 6);
    unsigned char* ws = p.ws;
    const _Float16* sc = (const _Float16*)(ws + WS_SC);
    constexpr int PITCH = 272;
    PG8_LAS unsigned char* st = lds + wid * (64 * PITCH);
#pragma unroll 1
    for (int bi = wid; ; bi += 8) {
        pg8::Unit u; if (!O.next(bi >> 2, u)) break;
        const int t0 = u.pm * 256 + (bi & 3) * 64, head = u.pn;
        unsigned la[16], lb[16], blk[16];
#pragma unroll
        for (int h = 0; h < 2; ++h) {
            unsigned (&top)[16] = h == 0 ? la : lb;
            u32x4 w[16];
#pragma unroll
            for (int q = 0; q < 16; ++q) w[q] = *(const u32x4*)(sc + (size_t)(t0 + 4 * q + (lane >> 4)) * 2048 + head * 256 + h * 128 + (lane & 15) * 8);
#pragma unroll
            for (int q = 0; q < 16; ++q) *(PG8_LAS u32x4*)(st + (4 * q + (lane >> 4)) * PITCH + (lane & 15) * 16) = w[q];
#pragma unroll
            for (int n0 = 0; n0 < 128; n0 += 16) {
                const f16x8 h0 = *(const PG8_LAS f16x8*)(st + lane * PITCH + n0 * 2), h1 = *(const PG8_LAS f16x8*)(st + lane * PITCH + n0 * 2 + 16);
#pragma unroll
                for (int e = 0; e < 8; ++e) { blk[e] = key_of((float)h0[e], 255u - (unsigned)(n0 + e)); blk[8 + e] = key_of((float)h1[e], 255u - (unsigned)(n0 + 8 + e)); }
                sort16_desc(blk);
                if (n0 == 0) {
#pragma unroll
                    for (int e = 0; e < 16; ++e) top[e] = blk[e];
                } else merge_top16(top, blk);
            }
        }
        const int i = (t0 + lane) * 8 + head;
        float sa[16], sb[16];
#pragma unroll
        for (int j = 0; j < 16; ++j) { sa[j] = val_of(la[j]); sb[j] = val_of(lb[j]); }
        unsigned lc[16];
#pragma unroll
        for (int q0 = 0; q0 < 64; q0 += 16) {
#pragma unroll
            for (int e = 0; e < 16; ++e) { const int ab = cand_pair(q0 + e); blk[e] = (ab >= 0) ? key_of(sa[ab >= 0 ? (ab >> 4) : 0] + sb[ab >= 0 ? (ab & 15) : 0], 255u - (unsigned)(ab >= 0 ? ab : 0)) : 0u; }
            sort16_desc(blk);
            if (q0 == 0) {
#pragma unroll
                for (int e = 0; e < 16; ++e) lc[e] = blk[e];
            } else merge_top16(lc, blk);
        }
        float g[16]; const float mx = val_of(lc[0]); float sum = 0.f;
#pragma unroll
        for (int j = 0; j < 16; ++j) { g[j] = __expf(val_of(lc[j]) - mx); sum += g[j]; }
        const float inv = 1.f / sum;
        int* ti = (int*)(ws + WS_TI) + (size_t)i * 16;
        int eo[16];
#pragma unroll
        for (int j = 0; j < 16; ++j) {
            const int c = 255 - (int)(lc[j] & 255u), a = c >> 4, b = c & 15;
            unsigned ka = la[0], kb = lb[0];
#pragma unroll
            for (int q = 1; q < 16; ++q) { ka = (a == q) ? la[q] : ka; kb = (b == q) ? lb[q] : kb; }
            const _Float16 gh = (_Float16)(g[j] * inv);
            eo[j] = ((255 - (int)(ka & 255u)) * 128 + (255 - (int)(kb & 255u))) | ((int)__builtin_bit_cast(unsigned short, gh) << 16);
        }
#pragma unroll
        for (int j = 0; j < 16; j += 4) *(int __attribute__((ext_vector_type(4)))*)(ti + j) = (int __attribute__((ext_vector_type(4)))){eo[j], eo[j + 1], eo[j + 2], eo[j + 3]};
    }
}
__device__ __forceinline__ void fstage_pscore(const Params& p, int l, lds_t lds, int bid, int nb) {
    pg8::Order O; O.init(T, 2048, nb, bid, p.ws + WS_XB, D, p.ws + WS_SKT + (size_t)l * 2048 * D * 2, D);
    pg8::gemm_phase<GEpiScaleF16, pg8::Order, true>(lds, D, D, D, O, GEpiScaleF16{p.ws, (_Float16*)(p.ws + WS_SC), 2048});
    topk_local(p, O, lds);
}
#define XB_TMO      128
#define XB_XCNT(j)  (256  + 64 * (j))
#define XB_XSUB(j)  (1280 + 64 * (j))
#define XB_XGEN(j)  (2304 + 64 * (j))
#define XB_TOP      3328
#define XB_TOPGEN   3392
#define XCD_BAR_WORDS 3456
#define XB_SPIN_CAP (1u << 18)
#define LAS __attribute__((address_space(3)))

__device__ __forceinline__ unsigned xb_ld(unsigned* p)              { return __hip_atomic_load(p, __ATOMIC_RELAXED, __HIP_MEMORY_SCOPE_AGENT); }
__device__ __forceinline__ unsigned xb_add(unsigned* p, unsigned v) { return __hip_atomic_fetch_add(p, v, __ATOMIC_RELAXED, __HIP_MEMORY_SCOPE_AGENT); }
__device__ __forceinline__ unsigned xb_xcc_id() { return (unsigned)__builtin_amdgcn_s_getreg((3 << 11) | 20) & 0xFu; }
#define XB_SPIN(cond, bar) do { unsigned _sp = 0; while (cond) { __builtin_amdgcn_s_sleep(1); \
    if ((++_sp & 255u) == 0u) { if (xb_ld(&(bar)[XB_TMO])) break; if (_sp > XB_SPIN_CAP) { atomicAdd(&(bar)[XB_TMO], 1u); break; } } } } while (0)

struct XcdBarrier {
    unsigned* bar; unsigned x;
    volatile LAS unsigned* st;
};

__device__ __forceinline__ XcdBarrier xcd_barrier_post(unsigned* bar, volatile LAS unsigned* st) {
    XcdBarrier b; b.bar = bar; b.x = xb_xcc_id(); b.st = st;
    if (tid_fresh() == 0) (void)xb_add(&bar[XB_XCNT(b.x)], 1u);
    return b;
}
__device__ __forceinline__ void xcd_barrier_complete(unsigned* bar, unsigned x, unsigned& nloc, unsigned& nx) {
    const unsigned G = gridDim.x * gridDim.y * gridDim.z;
    unsigned sum, cnt, mine, sp = 0u;
    for (;;) {
        sum = 0u; cnt = 0u; mine = 0u;
#pragma unroll
        for (unsigned j = 0; j < 16; ++j) { const unsigned c = xb_ld(&bar[XB_XCNT(j)]); sum += c; cnt += (c > 0u) ? 1u : 0u; mine = (j == x) ? c : mine; }
        if (sum == G) break;
        __builtin_amdgcn_s_sleep(1);
        if ((++sp & 255u) == 0u) { if (xb_ld(&bar[XB_TMO])) break; if (sp > XB_SPIN_CAP) { atomicAdd(&bar[XB_TMO], 1u); break; } }
    }
    nloc = mine > 0u ? mine : 1u; nx = cnt > 0u ? cnt : 1u;
}

__device__ __forceinline__ void xcd_barrier(const XcdBarrier& b) {
    asm volatile("s_waitcnt vmcnt(0)" ::: "memory");
    __syncthreads();
    if (tid_fresh() == 0) {
        unsigned* bar = b.bar;
        __builtin_amdgcn_s_waitcnt(0);
        unsigned nloc = b.st[0], nx = b.st[1];
        if (nloc == 0u) { xcd_barrier_complete(bar, b.x, nloc, nx); b.st[0] = nloc; b.st[1] = nx; }
        const unsigned old = xb_add(&bar[XB_XSUB(b.x)], 1u);
        const unsigned gen = old / nloc;
        if (old + 1u == (gen + 1u) * nloc) {
            __builtin_amdgcn_fence(__ATOMIC_RELEASE, "agent");
            asm volatile("s_waitcnt vmcnt(0)" ::: "memory");
            const unsigned og = xb_add(&bar[XB_TOP], 1u);
            const unsigned tg = og / nx;
            if (og + 1u == (tg + 1u) * nx) xb_add(&bar[XB_TOPGEN], 1u);
            else XB_SPIN(xb_ld(&bar[XB_TOPGEN]) == tg, bar);
            __builtin_amdgcn_fence(__ATOMIC_ACQUIRE, "agent");
            xb_add(&bar[XB_XGEN(b.x)], 1u);
            asm volatile("s_waitcnt vmcnt(0)" ::: "memory");
        } else {
            XB_SPIN(xb_ld(&bar[XB_XGEN(b.x)]) == gen, bar);
            __builtin_amdgcn_fence(__ATOMIC_ACQUIRE, "agent");
            asm volatile("s_waitcnt vmcnt(0)" ::: "memory");
        }
    }
    __syncthreads();
}


constexpr int PQ_CH = 16, PQ_NCH = T / PQ_CH;
constexpr int CW_PQ = 16384;
constexpr size_t CTL_ZERO_BYTES = 131072;
__device__ __forceinline__ unsigned pq_pull(unsigned* head, int lane) {
    unsigned c = 0; if (lane == 0) c = __hip_atomic_fetch_add(head, 1u, __ATOMIC_RELAXED, __HIP_MEMORY_SCOPE_AGENT);
    return (unsigned)__builtin_amdgcn_readfirstlane((int)c);
}
__device__ __forceinline__ f32x2 gelu_pk(f32x2 v) {
    const f32x2 av = __builtin_elementwise_abs(v), d = av * 0.2316418882f + 1.0f;
    f32x2 t; t.x = __builtin_amdgcn_rcpf(d.x); t.y = __builtin_amdgcn_rcpf(d.y);
    f32x2 q = t * 0.5307027145f + (-0.7265760135f); q = q * t + 0.7107068705f; q = q * t + (-0.142248368f); q = q * t + 0.127414796f; q = q * t;
    const f32x2 s = (v * v) * (-0.72134752044f);
    f32x2 e; e.x = __builtin_amdgcn_exp2f(s.x); e.y = __builtin_amdgcn_exp2f(s.y);
    const f32x2 m = v * (q * e), r = v - m;
    f32x2 o; o.x = v.x < 0.f ? m.x : r.x; o.y = v.y < 0.f ? m.y : r.y; return o;
}
__device__ __forceinline__ float gelu_erf(float d) { return 0.5f * d * (1.f + erff(d * 0.70710678118654752f)); }

constexpr unsigned ENT_INVALID = 0xffffffffu;
typedef long i64x2 __attribute__((ext_vector_type(2)));
__device__ __forceinline__ void fstage_peer_u(const Params& p, int l, int qsel, lds_t lds, unsigned imask = 16383u, size_t aoff = 0, bool skipg = false) {
    unsigned char* ws = p.ws;
    const int tid = tid_fresh(), lane = tid & 63, wid = __builtin_amdgcn_readfirstlane(tid >> 6), n = lane & 15, kq = lane >> 4;
    const unsigned char* u8 = ws + WS_U8 + (size_t)l * NEXP * D;
    unsigned* heads = (unsigned*)(ws + WS_CTL) + CW_PQ + ((qsel * 2 + 0) * 8) * 64;
    const int myx = (int)(xb_xcc_id() & 7u);
    float* Aout = (float*)(ws + WS_PA + aoff);
    constexpr int RB_BYTES = 16 * 1024, LIST_MAX = 400, WREG = RB_BYTES + (LIST_MAX + 16) * 8;
    PG8_LAS unsigned char* rbuf = lds + wid * WREG;
    PG8_LAS unsigned* ent = (PG8_LAS unsigned*)(rbuf + RB_BYTES);
    PG8_LAS float* gl = (PG8_LAS float*)(rbuf + RB_BYTES + (LIST_MAX + 16) * 4);
#pragma unroll 1
    for (int s8 = 0; s8 < 8; ++s8) {
        const int k = (myx + s8) & 7;
        unsigned c = pq_pull(heads + k * 64, lane);
#pragma unroll 1
        for (;;) {
            if (c >= (unsigned)PQ_NCH) break;
            const int t0 = (int)c * PQ_CH;
            unsigned c_next = c; bool pulled = false;
            int mxs = 0x7f7f7f7f; asm volatile("" : "+v"(mxs));
            pg8::i32x8_t xf8[8];
            { const unsigned char* xp = ws + WS_XQ8 + (size_t)(t0 + n) * D + kq * 16;
#pragma unroll
              for (int i = 0; i < 8; ++i) { const pg8::i32x4_t lo = *(const pg8::i32x4_t*)(xp + (2 * i) * 64), hi = *(const pg8::i32x4_t*)(xp + (2 * i + 1) * 64); xf8[i] = __builtin_shufflevector(lo, hi, 0, 1, 2, 3, 4, 5, 6, 7); } }
            const float rs = row_rstd((const float*)(ws + WS_SSP), t0 + n) * (1.f / (SU * XS));
            float* ao = Aout + (size_t)(t0 + n) * 128;
            int i_next = 0;
#pragma unroll 1
            while (i_next < 16) {
                int e0v[16], e1v[16];
                { const int* ti = (const int*)(ws + WS_TI) + (size_t)t0 * 128;
#pragma unroll
                  for (int i = 0; i < 16; ++i) { e0v[i] = ti[i * 128 + lane]; e1v[i] = ti[i * 128 + 64 + lane]; } }
                int cnt = 0; int i_end = 16;
#pragma unroll
                for (int i = 0; i < 16; ++i) {
                    if (i >= i_next && i < i_end) {
                        if (cnt > LIST_MAX - 128) { i_end = i; }
                        else {
                            const int e0 = e0v[i] & 16383, e1 = e1v[i] & 16383;
                            const bool s0 = (e0 >> 11) == k, s1 = (e1 >> 11) == k;
                            const unsigned long long m0 = __ballot(s0), m1 = __ballot(s1);
                            const int b0 = (int)__builtin_amdgcn_mbcnt_hi((unsigned)(m0 >> 32), __builtin_amdgcn_mbcnt_lo((unsigned)m0, 0u));
                            const int b1 = (int)__builtin_amdgcn_mbcnt_hi((unsigned)(m1 >> 32), __builtin_amdgcn_mbcnt_lo((unsigned)m1, 0u));
                            const int c0 = __builtin_popcountll(m0);
                            if (s0) { ent[cnt + b0] = ((unsigned)i << 21) | ((unsigned)lane << 14) | (unsigned)e0; gl[cnt + b0] = (float)__builtin_bit_cast(_Float16, (unsigned short)((unsigned)e0v[i] >> 16)); }
                            if (s1) { ent[cnt + c0 + b1] = ((unsigned)i << 21) | ((unsigned)(64 + lane) << 14) | (unsigned)e1; gl[cnt + c0 + b1] = (float)__builtin_bit_cast(_Float16, (unsigned short)((unsigned)e1v[i] >> 16)); }
                            cnt += c0 + __builtin_popcountll(m1);
                        }
                    }
                }
                i_next = i_end;
                if (cnt == 0) continue;
                if (lane < 16) ent[cnt + lane] = ENT_INVALID;
                const int ng = skipg ? 0 : ((cnt + 15) >> 4);
                u32x4 W[16];
#define PU_LOAD(g_) do { const PG8_LAS u32x4* ep_ = (const PG8_LAS u32x4*)(ent + (g_) * 16); const u32x4 q0_ = ep_[0], q1_ = ep_[1], q2_ = ep_[2], q3_ = ep_[3]; \
                    _Pragma("unroll") for (int q = 0; q < 16; ++q) { const unsigned e_ = (q < 4) ? q0_[q & 3] : (q < 8) ? q1_[q & 3] : (q < 12) ? q2_[q & 3] : q3_[q & 3]; \
                        const unsigned iq_ = (e_ == ENT_INVALID) ? 0u : (e_ & imask); W[q] = *(const u32x4*)(u8 + (size_t)iq_ * D + lane * 16); } } while (0)
                if (!pulled) { pulled = true; c_next = pq_pull(heads + k * 64, lane); }
                if (ng > 0) PU_LOAD(0);
#pragma unroll 1
                for (int g = 0; g < ng; ++g) {
#pragma unroll
                    for (int q = 0; q < 16; ++q) *(PG8_LAS u32x4*)(rbuf + q * 1024 + ((lane ^ q) * 16)) = W[q];
                    if (g + 1 < ng) PU_LOAD(g + 1);
                    f32x4 acc;
                    const PG8_LAS unsigned char* fp = rbuf + n * 1024;
#pragma unroll
                    for (int Lb = 0; Lb < 16; Lb += 4) {
                        pg8::i32x4_t fa[4];
#pragma unroll
                        for (int L = 0; L < 4; ++L) fa[L] = *(const PG8_LAS pg8::i32x4_t*)(fp + ((((Lb + L) * 4 + kq) ^ n) * 16));
                        __builtin_amdgcn_sched_barrier(0);
                        const pg8::i32x8_t a0 = __builtin_shufflevector(fa[0], fa[1], 0, 1, 2, 3, 4, 5, 6, 7), a1 = __builtin_shufflevector(fa[2], fa[3], 0, 1, 2, 3, 4, 5, 6, 7);
                        if (Lb == 0) asm volatile("v_mfma_scale_f32_16x16x128_f8f6f4 %0, %1, %2, 0, %3, %3 op_sel_hi:[0,0,0]" : "=v"(acc) : "v"(a0), "v"(xf8[0]), "v"(mxs));
                        else asm volatile("v_mfma_scale_f32_16x16x128_f8f6f4 %0, %1, %2, %0, %3, %3 op_sel_hi:[0,0,0]" : "+v"(acc) : "v"(a0), "v"(xf8[Lb >> 1]), "v"(mxs));
                        asm volatile("v_mfma_scale_f32_16x16x128_f8f6f4 %0, %1, %2, %0, %3, %3 op_sel_hi:[0,0,0]" : "+v"(acc) : "v"(a1), "v"(xf8[(Lb >> 1) + 1]), "v"(mxs));
                        __builtin_amdgcn_sched_barrier(0);
                    }
                    asm volatile("s_nop 15\n\ts_nop 7" : "+v"(acc) :: "memory");
                    {
                        const u32x4 e4 = *(const PG8_LAS u32x4*)(ent + g * 16 + 4 * kq); const f32x4 g4 = *(const PG8_LAS f32x4*)(gl + g * 16 + 4 * kq);
#pragma unroll
                        for (int r = 0; r < 4; r += 2) { const f32x2 ge = gelu_pk((f32x2){acc[r] * rs, acc[r + 1] * rs});
                            if (e4[r] != ENT_INVALID && (int)(e4[r] >> 21) == n) ao[(e4[r] >> 14) & 127u] = ge.x * g4[r];
                            if (e4[r + 1] != ENT_INVALID && (int)(e4[r + 1] >> 21) == n) ao[(e4[r + 1] >> 14) & 127u] = ge.y * g4[r + 1]; }
                    }
                }
#undef PU_LOAD
            }
            if (!pulled) c_next = pq_pull(heads + k * 64, lane);
            c = c_next;
        }
    }
}

constexpr float AS = 32.f;
__device__ __forceinline__ void tr4x4(unsigned a, unsigned b, unsigned c, unsigned d, unsigned& o0, unsigned& o1, unsigned& o2, unsigned& o3) {
    const unsigned p0 = __builtin_amdgcn_perm(b, a, 0x05010400u), p1 = __builtin_amdgcn_perm(b, a, 0x07030602u), p2 = __builtin_amdgcn_perm(d, c, 0x05010400u), p3 = __builtin_amdgcn_perm(d, c, 0x07030602u);
    o0 = __builtin_amdgcn_perm(p2, p0, 0x05040100u); o1 = __builtin_amdgcn_perm(p2, p0, 0x07060302u); o2 = __builtin_amdgcn_perm(p3, p1, 0x05040100u); o3 = __builtin_amdgcn_perm(p3, p1, 0x07060302u);
}
__device__ __forceinline__ void fstage_peer_v(const Params& p, int l, int qsel, bool dry, lds_t lds, int imask = 16383) {
    unsigned char* ws = p.ws;
    const int tid = tid_fresh(), lane = tid & 63, wid = __builtin_amdgcn_readfirstlane(tid >> 6), n = lane & 15, kq = lane >> 4, n8 = n & 7, h = n >> 3;
    const unsigned char* v8 = ws + WS_V8 + (size_t)l * NEXP * D;
    unsigned* heads = (unsigned*)(ws + WS_CTL) + CW_PQ + ((qsel * 2 + 1) * 8) * 64;
    const int myx = (int)(xb_xcc_id() & 7u);
    PG8_LAS int* til = (PG8_LAS int*)(lds + wid * 8192);
#pragma unroll 1
    for (int s8 = 0; s8 < 8; ++s8) {
        const int k = (myx + s8) & 7;
#pragma unroll 1
        for (;;) {
            const unsigned c = pq_pull(heads + k * 64, lane);
            if (c >= (unsigned)PQ_NCH) break;
            const int t0 = (int)c * PQ_CH;
            unsigned koff = (unsigned)n8 * 16u; asm volatile("" : "+v"(koff));
            const unsigned char* vb = v8 + (size_t)k * NEXP * 128;
            { const int* ti = (const int*)(ws + WS_TI) + (size_t)t0 * 128; int ev[32];
#pragma unroll
              for (int i = 0; i < 32; ++i) ev[i] = ti[i * 64 + lane];
#pragma unroll
              for (int i = 0; i < 32; ++i) til[i * 64 + lane] = ev[i] & (imask & 16383); }
            u32x4 R[4][8];
            typedef int i32x4 __attribute__((ext_vector_type(4)));
#define PV_ISSUE(b, slot) do { const PG8_LAS i32x4* ip_ = (const PG8_LAS i32x4*)(til + ((b) >> 1) * 128 + ((b) & 1) * 64 + h * 32 + kq * 8); const i32x4 i0_ = ip_[0], i1_ = ip_[1]; \
                _Pragma("unroll") for (int e_ = 0; e_ < 4; ++e_) { R[slot][e_] = *(const u32x4*)(vb + ((unsigned)i0_[e_] * 128u + koff)); R[slot][4 + e_] = *(const u32x4*)(vb + ((unsigned)i1_[e_] * 128u + koff)); } } while (0)
#define PV_COMPUTE(tok8, aq, slot) do { const long aop_ = ((n >> 1) == (tok8)) ? (aq) : 0l; \
                _Pragma("unroll") for (int c_ = 0; c_ < 4; ++c_) { unsigned lo_[4], hi_[4]; \
                    tr4x4(R[slot][0][c_], R[slot][1][c_], R[slot][2][c_], R[slot][3][c_], lo_[0], lo_[1], lo_[2], lo_[3]); \
                    tr4x4(R[slot][4][c_], R[slot][5][c_], R[slot][6][c_], R[slot][7][c_], hi_[0], hi_[1], hi_[2], hi_[3]); \
                    _Pragma("unroll") for (int j_ = 0; j_ < 4; ++j_) { const long b_ = (long)(((unsigned long)hi_[j_] << 32) | (unsigned long)lo_[j_]); \
                        acc[4 * c_ + j_] = __builtin_amdgcn_mfma_f32_16x16x32_fp8_fp8(aop_, b_, acc[4 * c_ + j_], 0, 0, 0); } } } while (0)
#pragma unroll
            for (int b = 0; b < 3; ++b) PV_ISSUE(b, b);
#pragma unroll 1
            for (int ps = 0; ps < 2; ++ps) {
                f32x4 acc[16];
#pragma unroll
                for (int j = 0; j < 16; ++j) acc[j] = (f32x4){0.f, 0.f, 0.f, 0.f};
                long aq0, aq1;
                { const float* ap = (const float*)(ws + WS_PA) + (size_t)(t0 + ps * 8 + (n >> 1)) * 128 + (n & 1) * 32 + kq * 8;
                  const f32x4 a0 = *(const f32x4*)ap, a1 = *(const f32x4*)(ap + 4), a2 = *(const f32x4*)(ap + 64), a3 = *(const f32x4*)(ap + 68);
                  int w0 = __builtin_amdgcn_cvt_pk_fp8_f32(a0[0] * AS, a0[1] * AS, 0, false); w0 = __builtin_amdgcn_cvt_pk_fp8_f32(a0[2] * AS, a0[3] * AS, w0, true);
                  int w1 = __builtin_amdgcn_cvt_pk_fp8_f32(a1[0] * AS, a1[1] * AS, 0, false); w1 = __builtin_amdgcn_cvt_pk_fp8_f32(a1[2] * AS, a1[3] * AS, w1, true);
                  int w2 = __builtin_amdgcn_cvt_pk_fp8_f32(a2[0] * AS, a2[1] * AS, 0, false); w2 = __builtin_amdgcn_cvt_pk_fp8_f32(a2[2] * AS, a2[3] * AS, w2, true);
                  int w3 = __builtin_amdgcn_cvt_pk_fp8_f32(a3[0] * AS, a3[1] * AS, 0, false); w3 = __builtin_amdgcn_cvt_pk_fp8_f32(a3[2] * AS, a3[3] * AS, w3, true);
                  aq0 = (long)(((unsigned long)(unsigned)w1 << 32) | (unsigned long)(unsigned)w0); aq1 = (long)(((unsigned long)(unsigned)w3 << 32) | (unsigned long)(unsigned)w2); }
#pragma unroll 1
                for (int b0 = 0; b0 < 16; b0 += 4) {
#pragma unroll
                    for (int s = 0; s < 4; ++s) {
                        const int bn = ps * 16 + b0 + s + 3;
                        if (bn < 32) PV_ISSUE(bn, (s + 3) & 3);
                        PV_COMPUTE((b0 + s) >> 1, (s & 1) ? aq1 : aq0, s);
                    }
                }
                int n8e = n8, kqe = kq; asm volatile("" : "+v"(n8e), "+v"(kqe));
                const int t = t0 + ps * 8 + 2 * kqe + h;
                float o[16];
#pragma unroll
                for (int j = 0; j < 16; ++j) { const float send = h ? acc[j][1] : acc[j][2]; const float recv = dppf<DPP_X8>(send); o[j] = (h ? acc[j][3] : acc[j][0]) + recv; }
                bf16_t* xr = (bf16_t*)(ws + WS_XB) + (size_t)t * D + k * 128 + n8e * 16;
                const float sc = 1.f / (SV * AS);
                float ss = 0.f;
#pragma unroll
                for (int g = 0; g < 2; ++g) {
                    f32x4 v0, v1; up8(*(const u32x4*)(xr + g * 8), v0, v1);
                    v0[0] += o[8 * g + 0] * sc; v0[1] += o[8 * g + 1] * sc; v0[2] += o[8 * g + 2] * sc; v0[3] += o[8 * g + 3] * sc;
                    v1[0] += o[8 * g + 4] * sc; v1[1] += o[8 * g + 5] * sc; v1[2] += o[8 * g + 6] * sc; v1[3] += o[8 * g + 7] * sc;
                    const u32x4 wq = pk8(v0, v1); up8(wq, v0, v1);
                    if (!dry) { *(u32x4*)(xr + g * 8) = wq; *(u32x2*)(ws + WS_XQ8 + (size_t)t * D + k * 128 + n8e * 16 + g * 8) = pk8_fp8(v0, v1, XS); }
                    ss += (v0[0] * v0[0] + v0[1] * v0[1]) + (v0[2] * v0[2] + v0[3] * v0[3]) + (v1[0] * v1[0] + v1[1] * v1[1]) + (v1[2] * v1[2] + v1[3] * v1[3]);
                }
                ss += dppf<DPP_X1>(ss); ss += dppf<DPP_X2>(ss); ss += dppf<DPP_HMIR>(ss);
                if (n8e < 2 && !dry) ((float*)(ws + WS_SSP))[(size_t)t * 16 + 2 * k + n8e] = (n8e == 0) ? ss : 0.f;
            }
#undef PV_ISSUE
#undef PV_COMPUTE
        }
    }
}
__device__ __forceinline__ void fstage_final_norm(const Params& p) {
    const int tid = tid_fresh(), lane = tid & 63, wid = tid >> 6;
    const float* gfin = (const float*)p.in[25];
    for (int t = blockIdx.x * 8 + wid; t < T; t += gridDim.x * 8) {
        const float r = row_rstd((const float*)(p.ws + WS_SSP), t);
        const bf16_t* xr = (const bf16_t*)(p.ws + WS_XB) + (size_t)t * D; float* o = p.out + (size_t)t * D;
#pragma unroll
        for (int i = 0; i < 2; ++i) { f32x4 a, b; up8(*(const u32x4*)(xr + (lane + 64 * i) * 8), a, b);
            const f32x4 g0 = *(const f32x4*)(gfin + (lane + 64 * i) * 8), g1 = *(const f32x4*)(gfin + (lane + 64 * i) * 8 + 4);
            *(f32x4*)(o + (lane + 64 * i) * 8) = a * r * g0; *(f32x4*)(o + (lane + 64 * i) * 8 + 4) = b * r * g1; }
    }
}

extern __shared__ __attribute__((aligned(16))) unsigned char dyn_lds[];
constexpr int LDS_BYTES = 163840;
constexpr int LDS_BARW = LDS_BYTES - 64;

__device__ __forceinline__ Params ldp() {
    Params r;
#if defined(__HIP_DEVICE_COMPILE__)
    const __attribute__((address_space(4))) unsigned long long* k = (const __attribute__((address_space(4))) unsigned long long*)__builtin_amdgcn_kernarg_segment_ptr();
    asm volatile("" : "+s"(k));
#pragma unroll
    for (int i = 0; i < 26; ++i) r.in[i] = (const void*)(const __attribute__((address_space(1))) void*)k[i];
    r.out = (float*)(__attribute__((address_space(1))) float*)k[26]; r.ws = (unsigned char*)(__attribute__((address_space(1))) unsigned char*)k[27];
#endif
    return r;
}
__device__ __forceinline__ int rep_of(int k) { int n = (PROBE == k) ? 2 : 1; asm volatile("" : "+s"(n)); return n; }
#if PROBE == 0
#define REP(k) for (int r_ = 0, n_ = 1; r_ < 1; ++r_)
#else
#define REP(k) for (int r_ = 0, n_ = rep_of(k); r_ < n_; ++r_)
#endif
#define PH(call) do { const Params q = ldp(); int bid = bid0, nb = nb0, l = l0; asm volatile("" : "+s"(bid), "+s"(nb), "+s"(l)); (void)l; call; } while (0)
__global__ void __launch_bounds__(NT, 2) mega(Params p_unused) {
    const int bid0 = blockIdx.x, nb0 = gridDim.x; int l0 = 0;
    float* lds = (float*)dyn_lds; const lds_t ldsp = (lds_t)dyn_lds;
    { const int w0_ = __builtin_amdgcn_readfirstlane((int)(threadIdx.x >> 6)); asm volatile("s_mov_b32 m0, %0" :: "s"(w0_)); }
    if (tid_fresh() == 0) *(uint4*)(dyn_lds + LDS_BARW) = make_uint4(0u, 0u, 0u, 0u);
    __syncthreads();
    { const Params q = ldp(); (void)xcd_barrier_post((unsigned*)(q.ws + WS_CTL), (volatile LAS unsigned*)(dyn_lds + LDS_BARW)); }
#define GRID_BAR() do { const Params q = ldp(); XcdBarrier b_; b_.bar = (unsigned*)(q.ws + WS_CTL); b_.x = xb_xcc_id(); b_.st = (volatile LAS unsigned*)(dyn_lds + LDS_BARW); xcd_barrier(b_); if (PROBE == 20) xcd_barrier(b_); } while (0)
    REP(1) { PH(stage_prologue0(q, bid, nb, lds)); GRID_BAR(); }
    REP(2) { PH(stage_prologue1(q, bid, nb)); PH(fstage_kv(q, ldsp, bid, nb)); GRID_BAR();
    PH(fstage_g(q, ldsp, bid, nb)); PH(fstage_y(q, ldsp, bid, nb));     GRID_BAR(); }

#pragma unroll 1
    for (l0 = 0; l0 < L; ++l0) {
        REP(9) { PH(fstage_win(q, l, ldsp, bid, nb)); GRID_BAR(); }
        REP(7) { PH(fstage_attn(q, l, (char*)dyn_lds)); } REP(4) { PH(stage_pool_d(q, bid, nb)); PH(fstage_sgate(q, l, ldsp)); } GRID_BAR();
#if PROBE == 21
        PH(fstage_branch<false>(q, l, ldsp, bid, nb)); GRID_BAR();
#endif
        REP(10) { PH(fstage_branch(q, l, ldsp, bid, nb)); GRID_BAR(); }
        PH(fstage_resid_out(q, l, ldsp, bid, nb)); GRID_BAR();
        REP(11) { PH(fstage_xscore(q, l, ldsp, bid, nb)); GRID_BAR(); }
        PH(fstage_resid_cross(q, l, ldsp, bid, nb)); GRID_BAR();
        REP(12) { PH(fstage_pscore(q, l, ldsp, bid, nb)); GRID_BAR(); }
        REP(13) { PH(fstage_peer_u(q, l, l + 4 * r_, ldsp)); GRID_BAR(); }
#if PROBE == 15
        PH(fstage_peer_u(q, l, l + 4, ldsp, 255u, 16 * MiB)); GRID_BAR();
#endif
#if PROBE == 17
        { int sk_ = 1; asm volatile("" : "+s"(sk_)); PH(fstage_peer_u(q, l, l + 4, ldsp, 16383u, 16 * MiB, sk_ != 0)); GRID_BAR(); }
#endif
        REP(14) { bool dry_ = (r_ == 0 && n_ == 2); PH(fstage_peer_v(q, l, l + 4 * r_, dry_, ldsp)); GRID_BAR(); }
#if PROBE == 16
        PH(fstage_peer_v(q, l, l + 4, true, ldsp, 255)); GRID_BAR();
#endif
    }
    PH(fstage_final_norm(q));
}

extern "C" void kernel_launch(void* const* d_in, const int* in_sizes, int n_in, void* d_out, int out_size, void* d_ws, size_t ws_size, hipStream_t stream) {
    Params p{};
    for (int i = 0; i < 26; ++i) p.in[i] = d_in[i];
    p.out = (float*)d_out; p.ws = (unsigned char*)d_ws;
    static int grid = 0;
    if (!grid) {
        int dev = 0, cus = 0, per_cu = 0;
        (void)hipGetDevice(&dev);
        (void)hipDeviceGetAttribute(&cus, hipDeviceAttributeMultiprocessorCount, dev);
        (void)hipFuncSetAttribute((const void*)mega, hipFuncAttributeMaxDynamicSharedMemorySize, LDS_BYTES);
        (void)hipOccupancyMaxActiveBlocksPerMultiprocessor(&per_cu, mega, NT, LDS_BYTES);
        grid = cus * (per_cu < 1 ? per_cu : 1);
    }
    (void)hipMemsetAsync(p.ws + WS_CTL, 0, CTL_ZERO_BYTES, stream);
    mega<<<grid, NT, LDS_BYTES, stream>>>(p);
}
```

```cpp
#include <hip/hip_runtime.h>
#ifndef PROBE
#define PROBE 0
#endif
#include <stdint.h>
#include <math.h>

typedef unsigned short bf16_t;
typedef short bf16x8 __attribute__((ext_vector_type(8)));
typedef float f32x4 __attribute__((ext_vector_type(4)));
typedef float f32x2 __attribute__((ext_vector_type(2)));
typedef unsigned u32x4 __attribute__((ext_vector_type(4)));
typedef unsigned u32x2 __attribute__((ext_vector_type(2)));

constexpr int D = 1024, NB = 8, S = 4096, T = NB * S, L = 4, MEM = 256, MROWS = NB * MEM;
constexpr int INW = 6144, NEXP = 16384;
constexpr float EPS = 1e-6f;
constexpr float C2 = 0.125f * 1.4426950408889634f;
constexpr float SU = 256.f, SV = 32.f;
constexpr float XS = 8.f;
constexpr float W8S = 256.f;
constexpr float GS = 16.f, YS = 16.f, PS = 256.f;
constexpr int NT = 512;

constexpr size_t MiB = 1u << 20;
constexpr size_t WS_CTL = 0, WS_ROPE = 1 * MiB, WS_SSP = 3 * MiB, WS_WSPT = 5 * MiB, WS_RSTDM = 6 * MiB, WS_WPOOLS = 7 * MiB, WS_KEYSB = 8 * MiB;
constexpr size_t WS_WIN = 10 * MiB, WS_WB0 = 58 * MiB, WS_WEFF = 62 * MiB, WS_WB2 = 66 * MiB, WS_WOUT = 70 * MiB, WS_GT = 78 * MiB, WS_YT = 142 * MiB;
constexpr size_t WS_SKT = 206 * MiB, WS_U8 = 222 * MiB, WS_V8 = 286 * MiB, WS_XB = 350 * MiB, WS_TI = 414 * MiB, WS_TG = 430 * MiB, WS_MX = 446 * MiB;
constexpr size_t WS_GTE = WS_MX, WS_QB = WS_MX + 192 * MiB, WS_KB = WS_MX + 224 * MiB, WS_VB = WS_MX + 256 * MiB, WS_PIN = WS_MX + 288 * MiB, WS_DP = WS_MX + 320 * MiB;
constexpr size_t WS_UIN = WS_MX + 352 * MiB, WS_VIN = WS_MX + 384 * MiB, WS_O1 = WS_MX + 416 * MiB, WS_O2 = WS_MX + 448 * MiB, WS_SO = WS_MX + 480 * MiB, WS_END = WS_MX + 512 * MiB;
constexpr size_t WS_PA = WS_END;
constexpr size_t WS_XQ8 = WS_PA + 32 * MiB;
constexpr size_t WS_AO = WS_QB, WS_MG = WS_KB, WS_SX = WS_MX, WS_PM = WS_O1, WS_SC = WS_MX;
constexpr size_t WS_MEMB = WS_MX, WS_WXQB = WS_MX + 4 * MiB, WS_WXOT = WS_MX + 12 * MiB, WS_WXKVT = WS_MX + 20 * MiB, WS_KV = WS_MX + 36 * MiB, WS_WB1T = WS_MX + 68 * MiB, WS_WPQB = WS_MX + 72 * MiB;
static_assert(WS_XQ8 + 32 * MiB <= 1024 * MiB, "workspace map");

struct Params { const void* in[26]; float* out; unsigned char* ws; };

__device__ __forceinline__ float bf2f(bf16_t v) { return __uint_as_float(((unsigned)v) << 16); }
__device__ __forceinline__ bf16_t f2bf(float f) { unsigned u = __float_as_uint(f); return (bf16_t)((u + 0x7fffu + ((u >> 16) & 1u)) >> 16); }
typedef __bf16 hwbf16x2 __attribute__((ext_vector_type(2)));
__device__ __forceinline__ unsigned pk2(float lo, float hi) { const f32x2 v = {lo, hi}; return __builtin_bit_cast(unsigned, __builtin_convertvector(v, hwbf16x2)); }
template <int CTRL> __device__ __forceinline__ float dppf(float v) { return __builtin_bit_cast(float, __builtin_amdgcn_update_dpp(0, __builtin_bit_cast(int, v), CTRL, 0xF, 0xF, true)); }
constexpr int DPP_X1 = 0xB1, DPP_X2 = 0x4E, DPP_HMIR = 0x141, DPP_MIR = 0x140, DPP_X8 = 0x128;
__device__ __forceinline__ float lx16(float v) { float r; asm volatile("ds_swizzle_b32 %0, %1 offset:swizzle(SWAP,16)\n\ts_waitcnt lgkmcnt(0)" : "=v"(r) : "v"(v)); return r; }
__device__ __forceinline__ float add_x32(float v) { const auto rr = __builtin_amdgcn_permlane32_swap(__float_as_uint(v), __float_as_uint(v), false, false); return __uint_as_float(rr[0]) + __uint_as_float(rr[1]); }
__device__ __forceinline__ float max_x32(float v) { const auto rr = __builtin_amdgcn_permlane32_swap(__float_as_uint(v), __float_as_uint(v), false, false); return fmaxf(__uint_as_float(rr[0]), __uint_as_float(rr[1])); }
__device__ __forceinline__ float sum16(float v) { v += dppf<DPP_X1>(v); v += dppf<DPP_X2>(v); v += dppf<DPP_HMIR>(v); v += dppf<DPP_MIR>(v); return v; }
__device__ __forceinline__ float max16(float v) { v = fmaxf(v, dppf<DPP_X1>(v)); v = fmaxf(v, dppf<DPP_X2>(v)); v = fmaxf(v, dppf<DPP_HMIR>(v)); v = fmaxf(v, dppf<DPP_MIR>(v)); return v; }
__device__ __forceinline__ float wave_sum(float v) { v = sum16(v); v += lx16(v); return add_x32(v); }
__device__ __forceinline__ float wave_max(float v) { v = max16(v); v = fmaxf(v, lx16(v)); return max_x32(v); }
__device__ __forceinline__ int tid_fresh() { unsigned w, ln; asm volatile("s_mov_b32 %0, m0\n\tv_mbcnt_lo_u32_b32 %1, -1, 0\n\tv_mbcnt_hi_u32_b32 %1, -1, %1" : "=s"(w), "=v"(ln)); return (int)((w << 6) | ln); }
__device__ __forceinline__ float row_rstd(const float* ssp, int row) {
    const f32x4* p = (const f32x4*)(ssp + (size_t)row * 16);
    f32x4 a = p[0], b = p[1], c = p[2], d = p[3];
    float s = (a[0] + a[1] + a[2] + a[3]) + (b[0] + b[1] + b[2] + b[3]) + (c[0] + c[1] + c[2] + c[3]) + (d[0] + d[1] + d[2] + d[3]);
    return rsqrtf(s * (1.f / D) + EPS);
}
__device__ __forceinline__ float lam_init_of(int l) { return 0.8f - 0.6f * expf(-0.3f * (float)l); }

__device__ __forceinline__ u32x2 pk8_fp8(f32x4 a, f32x4 b, float sc);
__device__ __forceinline__ u32x4 pk8(f32x4 a, f32x4 b);
__device__ __forceinline__ void tr_conv(const float* __restrict__ src, bf16_t* __restrict__ dst, int K, int N, const float* gain, int gmask, float gmul, int bid, int nb, float* tile, int ldd = 0, int lds_src = 0) {
    const int tidx = tid_fresh();
    const int tx = tidx & 63, ty = tidx >> 6;
    const int tn = N / 64, nt = (K / 64) * tn, sp = lds_src ? lds_src : N;
    float r[8], rn[8];
    int it = bid;
    if (it < nt) { const int k0 = (it / tn) * 64, n0 = (it % tn) * 64;
#pragma unroll
        for (int i = 0; i < 8; ++i) { const int k = ty + 8 * i; r[i] = src[(size_t)(k0 + k) * sp + n0 + tx]; if (gain) r[i] *= gain[(k0 + k) & gmask] * gmul; } }
    while (it < nt) {
        const int k0 = (it / tn) * 64, n0 = (it % tn) * 64, nx = it + nb;
        if (nx < nt) { const int k1 = (nx / tn) * 64, n1 = (nx % tn) * 64;
#pragma unroll
            for (int i = 0; i < 8; ++i) { const int k = ty + 8 * i; rn[i] = src[(size_t)(k1 + k) * sp + n1 + tx]; if (gain) rn[i] *= gain[(k1 + k) & gmask] * gmul; } }
        __syncthreads();
#pragma unroll
        for (int i = 0; i < 8; ++i) tile[(ty + 8 * i) * 65 + tx] = r[i];
        __syncthreads();
        { const int n = tidx >> 3, kq = (tidx & 7) * 8;
          f32x4 a, b;
#pragma unroll
          for (int e = 0; e < 4; ++e) { a[e] = tile[(kq + e) * 65 + n]; b[e] = tile[(kq + 4 + e) * 65 + n]; }
          *(u32x4*)(dst + (size_t)(n0 + n) * (ldd ? ldd : K) + k0 + kq) = pk8(a, b); }
#pragma unroll
        for (int i = 0; i < 8; ++i) r[i] = rn[i];
        it = nx;
    }
}
__device__ __forceinline__ void tr_conv8(const float* __restrict__ src, unsigned char* __restrict__ dst, int K, int N, const float* gain, float scale, int sp, int bid, int nb, float* tile) {
    const int tidx = tid_fresh();
    const int tx = tidx & 63, ty = tidx >> 6;
    const int tn = N / 64, nt = (K / 64) * tn;
    float r[8], rn[8];
    int it = bid;
    if (it < nt) { const int k0 = (it / tn) * 64, n0 = (it % tn) * 64;
#pragma unroll
        for (int i = 0; i < 8; ++i) { const int k = ty + 8 * i; r[i] = src[(size_t)(k0 + k) * sp + n0 + tx] * gain[k0 + k] * scale; } }
    while (it < nt) {
        const int k0 = (it / tn) * 64, n0 = (it % tn) * 64, nx = it + nb;
        if (nx < nt) { const int k1 = (nx / tn) * 64, n1 = (nx % tn) * 64;
#pragma unroll
            for (int i = 0; i < 8; ++i) { const int k = ty + 8 * i; rn[i] = src[(size_t)(k1 + k) * sp + n1 + tx] * gain[k1 + k] * scale; } }
        __syncthreads();
#pragma unroll
        for (int i = 0; i < 8; ++i) tile[(ty + 8 * i) * 65 + tx] = r[i];
        __syncthreads();
        { const int n = tidx >> 3, kq = (tidx & 7) * 8;
          f32x4 a, b;
#pragma unroll
          for (int e = 0; e < 4; ++e) { a[e] = tile[(kq + e) * 65 + n]; b[e] = tile[(kq + 4 + e) * 65 + n]; }
          *(u32x2*)(dst + (size_t)(n0 + n) * K + k0 + kq) = pk8_fp8(a, b, 1.f); }
#pragma unroll
        for (int i = 0; i < 8; ++i) r[i] = rn[i];
        it = nx;
    }
}
__device__ __forceinline__ void conv_plain(const float* __restrict__ src, bf16_t* __restrict__ dst, size_t n, int bid, int nb, const float* rowgain = nullptr) {
    const int tidx = tid_fresh();
    const size_t n4 = n / 4, st = (size_t)nb * NT;
    for (size_t i0 = (size_t)bid * NT + tidx; i0 < n4; i0 += 8 * st) {
        f32x4 v[8];
#pragma unroll
        for (int u = 0; u < 8; ++u) { const size_t i = i0 + u * st; v[u] = (i < n4) ? ((const f32x4*)src)[i] : (f32x4){0.f, 0.f, 0.f, 0.f}; }
#pragma unroll
        for (int u = 0; u < 8; ++u) { const size_t i = i0 + u * st; if (i < n4) { f32x4 x = v[u]; if (rowgain) x = x * rowgain[i >> 8];
            u32x2 w; w.x = pk2(x[0], x[1]); w.y = pk2(x[2], x[3]); ((u32x2*)dst)[i] = w; } }
    }
}
__device__ __forceinline__ void conv_fp8(const float* __restrict__ src, unsigned* __restrict__ dst, const float* gain, float scale, bool slice_major, int bid, int nb) {
    const int tidx = tid_fresh();
    const size_t n4 = (size_t)NEXP * D / 4, st = (size_t)nb * NT;
    for (size_t i0 = (size_t)bid * NT + tidx; i0 < n4; i0 += 8 * st) {
        f32x4 v[8];
#pragma unroll
        for (int u = 0; u < 8; ++u) { const size_t i = i0 + u * st; v[u] = (i < n4) ? ((const f32x4*)src)[i] : (f32x4){0.f, 0.f, 0.f, 0.f}; }
#pragma unroll
        for (int u = 0; u < 8; ++u) { const size_t i = i0 + u * st; if (i < n4) { f32x4 x = v[u];
            if (gain) { const f32x4 g = ((const f32x4*)gain)[i & (D / 4 - 1)]; x = x * g; }
            x = x * scale;
            int w = __builtin_amdgcn_cvt_pk_fp8_f32(x[0], x[1], 0, false);
            w = __builtin_amdgcn_cvt_pk_fp8_f32(x[2], x[3], w, true);
            size_t o = i;
            if (slice_major) { const size_t d = (i * 4) & (D - 1), e = (i * 4) >> 10; o = (((d >> 7) * NEXP + e) * 128 + (d & 127)) >> 2; }
            dst[o] = (unsigned)w; } }
    }
}

__device__ __forceinline__ void stage_prologue0(const Params& p, int bid, int nb, float* lds) {
    const int tidx = tid_fresh();
    unsigned char* ws = p.ws;
    const int tid = tidx, lane = tid & 63, wid = tid >> 6;
    for (int l = 0; l < L; ++l) {
        tr_conv((const float*)p.in[4] + (size_t)l * D * INW, (bf16_t*)(ws + WS_WIN) + (size_t)l * 3072 * D, D, 3072, (const float*)p.in[3] + l * D, D - 1, 1.f, bid, nb, lds, 0, INW);
        tr_conv8((const float*)p.in[4] + (size_t)l * D * INW + 3072, ws + WS_WIN + 24 * MiB + (size_t)l * 3072 * D, D, 3072, (const float*)p.in[3] + l * D, W8S, INW, bid, nb, lds);
        const float* wb = (const float*)p.in[13] + (size_t)l * 3 * 512 * D;
        bf16_t* wbr = (bf16_t*)(ws + WS_WB0) + (size_t)l * D * 1536;
        tr_conv(wb, wbr, 512, D, (const float*)p.in[6] + l * 128, 127, 1.f - lam_init_of(l), bid, nb, lds, 1536);
        tr_conv(wb + 512 * D, (bf16_t*)(ws + WS_WB1T) + (size_t)l * D * 512, 512, D, nullptr, 0, 1.f, bid, nb, lds);
        tr_conv(wb + 2 * 512 * D, wbr + 1024, 512, D, nullptr, 0, 1.f, bid, nb, lds, 1536);
        tr_conv((const float*)p.in[14] + (size_t)l * D * D, (bf16_t*)(ws + WS_WOUT) + (size_t)l * D * D, D, D, nullptr, 0, 1.f, bid, nb, lds);
        tr_conv((const float*)p.in[19] + (size_t)l * D * D, (bf16_t*)(ws + WS_WXOT) + (size_t)l * D * D, D, D, nullptr, 0, 1.f, bid, nb, lds);
        tr_conv((const float*)p.in[18] + (size_t)l * D * 2 * D, (bf16_t*)(ws + WS_WXKVT) + (size_t)l * 2 * D * D, D, 2 * D, (const float*)p.in[16] + l * D, D - 1, 1.f, bid, nb, lds);
        conv_fp8((const float*)p.in[23] + (size_t)l * NEXP * D, (unsigned*)(ws + WS_U8) + (size_t)l * NEXP * D / 4, (const float*)p.in[20] + l * D, SU, false, bid, nb);
        conv_fp8((const float*)p.in[24] + (size_t)l * NEXP * D, (unsigned*)(ws + WS_V8) + (size_t)l * NEXP * D / 4, nullptr, SV, true, bid, nb);
    }
    conv_plain((const float*)p.in[17], (bf16_t*)(ws + WS_WXQB), (size_t)L * D * D, bid, nb, (const float*)p.in[15]);
    conv_plain((const float*)p.in[21], (bf16_t*)(ws + WS_WPQB), (size_t)L * D * 2048, bid, nb);
    conv_plain((const float*)p.in[22], (bf16_t*)(ws + WS_KEYSB), (size_t)L * 8 * 2 * 128 * 128, bid, nb);
    for (int i = bid * NT + tid; i < L * 4 * 128 * 128; i += nb * NT) {
        const int e = i & 127, g = (i >> 14) & 3, l = i >> 16;
        ((bf16_t*)(ws + WS_WPOOLS))[i] = f2bf(((const float*)p.in[7])[i] * ((const float*)p.in[8])[l * 512 + g * 128 + e]);
        const int sx = i & 127, tx = (i >> 7) & 127;
        ((bf16_t*)(ws + WS_WSPT))[i] = f2bf((sx <= tx) ? ((const float*)p.in[11])[i] : 0.f);
    }
    for (int i = bid * NT + tid; i < T * 8; i += nb * NT) {
        const int j = i & 7, t = i >> 3;
        const double ang = (double)((const int*)p.in[2])[t] * pow(500000.0, -(double)j / 8.0);
        _Float16* r = (_Float16*)(ws + WS_ROPE) + (size_t)t * 16;
        r[j] = (_Float16)(float)cos(ang); r[8 + j] = (_Float16)(float)sin(ang);
    }
    for (int row = bid * 8 + wid; row < T + MROWS; row += nb * 8) {
        const bool ismem = row >= T; const int r = ismem ? row - T : row;
        const float* src = (ismem ? (const float*)p.in[1] : (const float*)p.in[0]) + (size_t)r * D;
        bf16_t* dstb = (bf16_t*)(ws + (ismem ? WS_MEMB : WS_XB)) + (size_t)r * D;
        float ss = 0.f;
#pragma unroll
        for (int i = 0; i < 4; ++i) {
            const f32x4 v = ((const f32x4*)src)[lane + 64 * i];
            ss += v[0] * v[0] + v[1] * v[1] + v[2] * v[2] + v[3] * v[3];
            u32x2 w; w.x = pk2(v[0], v[1]); w.y = pk2(v[2], v[3]); ((u32x2*)dstb)[lane + 64 * i] = w;
            if (!ismem) { int q = __builtin_amdgcn_cvt_pk_fp8_f32(v[0] * XS, v[1] * XS, 0, false); q = __builtin_amdgcn_cvt_pk_fp8_f32(v[2] * XS, v[3] * XS, q, true); ((unsigned*)(ws + WS_XQ8 + (size_t)r * D))[lane + 64 * i] = (unsigned)q; }
        }
        ss = wave_sum(ss);
        if (ismem) { if (lane == 0) ((float*)(ws + WS_RSTDM))[r] = rsqrtf(ss * (1.f / D) + EPS); }
        else if (lane < 16) ((float*)(ws + WS_SSP))[(size_t)r * 16 + lane] = (lane == 0) ? ss : 0.f;
    }
}

template <class Geom, class Epi>
__device__ __forceinline__ void gemm_simple(int nitems, int K, const Geom& geom, const Epi& epi, int bid, int nb) {
    const int tidx = tid_fresh();
    const int tid = tidx, lane = tid & 63, wid = tid >> 6, wm = wid >> 1, wn = wid & 1, fr = lane & 15, fq = lane >> 4;
    for (int it = bid; it < nitems; it += nb) {
        const bf16_t* A; const bf16_t* Bt; int lda, ldb, grp, row0, col0;
        geom(it, A, lda, Bt, ldb, grp, row0, col0);
        f32x4 acc[2][4];
#pragma unroll
        for (int i = 0; i < 2; ++i)
#pragma unroll
            for (int j = 0; j < 4; ++j) acc[i][j] = (f32x4){0.f, 0.f, 0.f, 0.f};
        const bf16_t* ap = A + (size_t)(wm * 32 + fr) * lda + fq * 8;
        const bf16_t* bp = Bt + (size_t)(wn * 64 + fr) * ldb + fq * 8;
#pragma unroll 2
        for (int k0 = 0; k0 < K; k0 += 32) {
            bf16x8 a[2], b[4];
#pragma unroll
            for (int i = 0; i < 2; ++i) a[i] = *(const bf16x8*)(ap + (size_t)(i * 16) * lda + k0);
#pragma unroll
            for (int j = 0; j < 4; ++j) b[j] = *(const bf16x8*)(bp + (size_t)(j * 16) * ldb + k0);
#pragma unroll
            for (int i = 0; i < 2; ++i)
#pragma unroll
                for (int j = 0; j < 4; ++j) acc[i][j] = __builtin_amdgcn_mfma_f32_16x16x32_bf16(b[j], a[i], acc[i][j], 0, 0, 0);
        }
#pragma unroll
        for (int i = 0; i < 2; ++i) {
            const int row = row0 + wm * 32 + i * 16 + fr;
            const float rs = epi.prep(grp, row);
            float part = 0.f;
#pragma unroll
            for (int j = 0; j < 4; ++j) part += epi.apply(grp, row, col0 + wn * 64 + j * 16 + fq * 4, acc[i][j], rs, lane);
            epi.rowdone(grp, row, col0 + wn * 64, part, lane);
        }
    }
}

__device__ __forceinline__ void st_bf4(bf16_t* p, f32x4 v) { u32x2 w; w.x = pk2(v[0], v[1]); w.y = pk2(v[2], v[3]); *(u32x2*)p = w; }
__device__ __forceinline__ f32x4 ld_bf4(const bf16_t* p) { const u32x2 w = *(const u32x2*)p; return (f32x4){__uint_as_float(w.x << 16), __uint_as_float(w.x & 0xffff0000u), __uint_as_float(w.y << 16), __uint_as_float(w.y & 0xffff0000u)}; }

struct EpiColGain {
    bf16_t* o; size_t gstride; int ld; const float* gain; int gdiv;
    __device__ __forceinline__ float prep(int, int) const { return 1.f; }
    __device__ __forceinline__ float apply(int grp, int row, int col, f32x4 v, float, int) const {
        if (gain) v = v * *(const f32x4*)(gain + (size_t)(grp / gdiv) * D + col);
        st_bf4(o + (size_t)grp * gstride + (size_t)row * ld + col, v);
        return 0.f;
    }
    __device__ __forceinline__ void rowdone(int, int, int, float, int) const {}
};

__device__ __forceinline__ void stage_prologue1(const Params& p, int bid, int nb) {
    unsigned char* ws = p.ws;
    {
        auto geom = [=](int it, const bf16_t*& A, int& lda, const bf16_t*& Bt, int& ldb, int& grp, int& row0, int& col0) {
            const int g = it >> 3, tn = it & 7, l = g >> 4, hp = g & 15; grp = g; row0 = 0; col0 = tn * 128; lda = 128; ldb = 2048;
            A = (const bf16_t*)(ws + WS_KEYSB) + (size_t)g * 16384; Bt = (const bf16_t*)(ws + WS_WPQB) + ((size_t)l * D + col0) * 2048 + hp * 128; };
        gemm_simple(L * 16 * 8, 128, geom, EpiColGain{(bf16_t*)(ws + WS_SKT), (size_t)128 * D, D, (const float*)p.in[20], 16}, bid, nb);
    }
    {
        auto geom = [=](int it, const bf16_t*& A, int& lda, const bf16_t*& Bt, int& ldb, int& grp, int& row0, int& col0) {
            const int lg = it >> 3, tm = it & 7, l = lg >> 2, g = lg & 3; grp = lg; row0 = tm * 128; col0 = 0; lda = 512; ldb = 128;
            A = (const bf16_t*)(ws + WS_WB1T) + ((size_t)l * D + row0) * 512 + g * 128; Bt = (const bf16_t*)(ws + WS_WPOOLS) + (size_t)lg * 16384; };
        struct EpiWeff { bf16_t* o; __device__ __forceinline__ float prep(int, int) const { return 1.f; }
            __device__ __forceinline__ float apply(int lg, int row, int col, f32x4 v, float, int) const { st_bf4(o + ((size_t)(lg >> 2) * D + row) * 1536 + 512 + (lg & 3) * 128 + col, v); return 0.f; }
            __device__ __forceinline__ void rowdone(int, int, int, float, int) const {} };
        gemm_simple(L * 4 * 8, 128, geom, EpiWeff{(bf16_t*)(ws + WS_WB0)}, bid, nb);
    }
}
namespace pg8 {
#define PG8_LAS __attribute__((address_space(3)))
constexpr int BM = 256, BK = 64, HALF = 128, HTB = HALF * BK * 2, STAGE_BYTES = 8 * HTB, NXCD = 8, WGM = 8;
__host__ __device__ __forceinline__ int lds_byte(int r, int c) { const int st = (r >> 4) * 2 + (c >> 5), rr = r & 15, cc = c & 31, ob = rr * 64 + cc * 2; return st * 1024 + (ob ^ (((ob >> 9) & 1) << 5)); }
__host__ __device__ __forceinline__ void stage_rc(int b, int& R, int& C) { const int st = b / 1024, sb = b % 1024, swz = sb ^ (((sb >> 9) & 1) << 5); R = (st >> 1) * 16 + swz / 64; C = (st & 1) * 32 + (swz % 64) / 2; }
__host__ __device__ __forceinline__ int perm32(int rho) { const int n = rho >> 4, i = rho & 15; return 8 * (i >> 2) + 4 * n + (i & 3); }
struct Unit { int pm, pn; };
struct Order {
    int nM, nN, nwg, G, c; const char* A; const char* Bt; size_t a_tile, b_tile, b_batch; int pm_per_batch;
    __device__ __forceinline__ void init(int M, int N, int G_, int c_, const void* A_, int lda, const void* Bt_, int ldb, size_t b_batch_bytes = 0, int pmpb = 1 << 30) {
        nM = M / BM; nN = N / BM; nwg = nM * nN; G = G_; c = c_; A = (const char*)A_; Bt = (const char*)Bt_; a_tile = (size_t)BM * lda * 2; b_tile = (size_t)BM * ldb * 2; b_batch = b_batch_bytes; pm_per_batch = pmpb; }
    __device__ __forceinline__ bool next(int i, Unit& u) const {
        const long Lx = (long)i * G + c; if (Lx >= nwg) return false;
        int wgid = (int)Lx; { const int q = nwg / NXCD, r = nwg % NXCD, xcd = wgid % NXCD, off = wgid / NXCD; wgid = (xcd < r ? xcd * (q + 1) : r * (q + 1) + (xcd - r) * q) + off; }
        const int nig = WGM * nN, gid = wgid / nig, fm = gid * WGM, gsz = (nM - fm) < WGM ? (nM - fm) : WGM;
        u.pm = fm + ((wgid % nig) % gsz); u.pn = (wgid % nig) / gsz; return true;
    }
    __device__ __forceinline__ const char* a_ptr(const Unit& u) const { return A + (size_t)u.pm * a_tile; }
    __device__ __forceinline__ const char* b_ptr(const Unit& u) const { return Bt + (size_t)u.pn * b_tile + (size_t)(u.pm / pm_per_batch) * b_batch; }
};
typedef int i32x8_t __attribute__((ext_vector_type(8))); typedef int i32x4_t __attribute__((ext_vector_type(4)));
__device__ __forceinline__ i32x8_t ld8_lds(const PG8_LAS unsigned char* p) { const i32x4_t lo = *(const PG8_LAS i32x4_t*)p, hi = *(const PG8_LAS i32x4_t*)(p + 1024); return __builtin_shufflevector(lo, hi, 0, 1, 2, 3, 4, 5, 6, 7); }
__device__ __forceinline__ void glds_s(const void* sbase, unsigned voff, unsigned lds_dst) { unsigned keep;
    asm volatile("s_mov_b32 %0, m0\n\ts_mov_b32 m0, %3\n\ts_nop 0\n\tglobal_load_lds_dwordx4 %1, %2\n\ts_mov_b32 m0, %0" : "=&s"(keep) : "v"(voff), "s"(sbase), "s"(lds_dst) : "memory"); }
struct NoHook { static constexpr bool ACTIVE = false; __device__ __forceinline__ void operator()(f32x4 (&)[2][2][4][2], const Unit&, int, int, int, int, int) const {} };
template <class Epi, class Sched, bool ALIGN_EPI, class Hook = NoHook, int SEG = 1 << 20, bool FP8 = false>
__device__ __forceinline__ void gemm_phase(PG8_LAS unsigned char* lds, const int K, const int lda, const int ldb, const Sched& S, const Epi& E, const long dA1 = 0, const long dA2 = 0, const Hook& H = Hook()) {
    const int tid = tid_fresh(), wid = __builtin_amdgcn_readfirstlane(tid >> 6), lane = tid & 63, wr = wid >> 2, wc = wid & 3, fr = lane & 15, fq = lane >> 4;
    const int nt = K / BK;
    int mxs = 0x7f7f7f7f; asm volatile("" : "+v"(mxs));
    (void)mxs;
    unsigned voffA, voffB;
    { int R, C; stage_rc(tid * 16, R, C); const int Rb = (R & ~31) + perm32(R & 31);
      voffA = (unsigned)(R * lda + C) * 2u; voffB = (unsigned)(Rb * ldb + C) * 2u; }
    const size_t p2A = (size_t)64 * lda * 2, p2B = (size_t)64 * ldb * 2;
    const size_t kstep = (size_t)(BK * 2);
    const size_t hstepA = (size_t)HALF * lda * 2, hstepB = (size_t)HALF * ldb * 2;
    const unsigned ldsw = (unsigned)wid * 1024u, ldsu = (unsigned)(unsigned long)lds;
    const int aoff = lds_byte(wr * 64 + fr, fq * 8), boff = lds_byte(wc * 32 + fr, fq * 8);
#define PG8_SA(b, h) (((b) * 2 + (h)) * HTB)
#define PG8_SB(b, h) ((4 + (b) * 2 + (h)) * HTB)
#define PG8_STAGE(bufoff, gbase, X) do { _Pragma("unroll") for (int _i = 0; _i < 2; ++_i) \
        pg8::glds_s((const void*)((const char*)(gbase) + _i * p2##X), voff##X, ldsu + (unsigned)(bufoff) + ldsw + (unsigned)(_i * 8192)); } while (0)
#define PG8_LD8(p_) pg8::ld8_lds((p_))
#define PG8_LDA(dst, b, h) do { _Pragma("unroll") for (int m = 0; m < 4; ++m) { if constexpr (FP8) dst##8[m] = PG8_LD8(lds + PG8_SA(b, h) + aoff + m * 2048); else { _Pragma("unroll") for (int k = 0; k < 2; ++k) dst[m][k] = *(const PG8_LAS bf16x8*)(lds + PG8_SA(b, h) + aoff + m * 2048 + k * 1024); } } } while (0)
#define PG8_LDB(dst, b, h) do { _Pragma("unroll") for (int n = 0; n < 2; ++n) { if constexpr (FP8) dst##8[n] = PG8_LD8(lds + PG8_SB(b, h) + boff + n * 2048); else { _Pragma("unroll") for (int k = 0; k < 2; ++k) dst[n][k] = *(const PG8_LAS bf16x8*)(lds + PG8_SB(b, h) + boff + n * 2048 + k * 1024); } } } while (0)
#define PG8_MMA(ai, bj, At, Bt) do { __builtin_amdgcn_s_setprio(1); _Pragma("unroll") for (int m = 0; m < 4; ++m) _Pragma("unroll") for (int n = 0; n < 2; ++n) { \
        if constexpr (FP8) asm volatile("v_mfma_scale_f32_16x16x128_f8f6f4 %0, %1, %2, %0, %3, %3 op_sel_hi:[0,0,0]" : "+v"(acc[ai][bj][m][n]) : "v"(Bt##8[n]), "v"(At##8[m]), "v"(mxs)); \
        else { _Pragma("unroll") for (int k = 0; k < 2; ++k) acc[ai][bj][m][n] = __builtin_amdgcn_mfma_f32_16x16x32_bf16(Bt[n][k], At[m][k], acc[ai][bj][m][n], 0, 0, 0); } } \
        __builtin_amdgcn_s_setprio(0); } while (0)
#define PG8_WAIT_V(n) asm volatile("s_waitcnt vmcnt(" #n ")" ::: "memory")
#define PG8_WAIT_L(n) asm volatile("s_waitcnt lgkmcnt(" #n ")" ::: "memory")
#define PG8_BAR __builtin_amdgcn_s_barrier()
#define PG8_SCHED __builtin_amdgcn_sched_barrier(0)
    Unit cur, nxt; int ui = 0;
    if (!S.next(0, cur)) return;
    f32x4 acc[2][2][4][2];
#pragma unroll
    for (int a = 0; a < 2; ++a)
#pragma unroll
        for (int b = 0; b < 2; ++b)
#pragma unroll
            for (int m = 0; m < 4; ++m)
#pragma unroll
                for (int n = 0; n < 2; ++n) acc[a][b][m][n] = (f32x4){0.f, 0.f, 0.f, 0.f};
    typedef int i32x8_ __attribute__((ext_vector_type(8))); typedef int i32x4_ __attribute__((ext_vector_type(4)));
    bf16x8 At[4][2], B0[2][2], B1[2][2]; i32x8_ At8[4], B08[2], B18[2];
    (void)At; (void)B0; (void)B1; (void)At8; (void)B08; (void)B18;
    const char* cA = S.a_ptr(cur); const char* cB = S.b_ptr(cur);
    PG8_STAGE(PG8_SB(0, 0), cB, B); PG8_STAGE(PG8_SB(0, 1), cB + hstepB, B); PG8_STAGE(PG8_SA(0, 0), cA, A); PG8_STAGE(PG8_SA(0, 1), cA + hstepA, A);
    if (wr == 1) PG8_BAR;
    PG8_WAIT_V(2); PG8_BAR;
    PG8_STAGE(PG8_SB(1, 0), cB + kstep, B); PG8_STAGE(PG8_SA(1, 0), cA + kstep, A); PG8_STAGE(PG8_SB(1, 1), cB + hstepB + kstep, B); PG8_STAGE(PG8_SA(1, 1), cA + kstep + hstepA, A);
    PG8_WAIT_V(8); PG8_BAR;
    bool stores = false;
    for (;;) {
        const bool has_next = S.next(ui + 1, nxt);
        const char* nA = has_next ? S.a_ptr(nxt) : cA; const char* nB = has_next ? S.b_ptr(nxt) : cB;
        for (int t = 0; t < nt; t += 2) {
            const bool last = (t == nt - 2);
#define PG8_AOFF(tile) ((long)(tile) * (long)kstep + ((tile) >= 2 * SEG ? dA2 : (tile) >= SEG ? dA1 : 0l))
            if (Hook::ACTIVE && (t == SEG || t == 2 * SEG)) { const int th = tid_fresh(); H(acc, cur, t, wr, wc, th & 15, (th >> 4) & 3); }
            const char* a1 = cA + PG8_AOFF(t + 1);
            const char* a2 = last ? nA : cA + PG8_AOFF(t + 2); const char* b2 = last ? nB : cB + (size_t)(t + 2) * kstep;
            const char* a3 = last ? nA + kstep : cA + PG8_AOFF(t + 3); const char* b3 = b2 + kstep;
            const bool head = (t == 0), drain = head && stores;
            PG8_LDB(B0, 0, 0); PG8_LDB(B1, 0, 1); PG8_SCHED; PG8_LDA(At, 0, 0); if (!head) PG8_STAGE(PG8_SA(1, 1), a1 + hstepA, A);
            if (drain) { if constexpr (Epi::NST >= 16) PG8_WAIT_V(16); else if constexpr (Epi::NST >= 8) PG8_WAIT_V(8); else PG8_WAIT_V(0); } else PG8_WAIT_V(8);
            PG8_WAIT_L(0); PG8_BAR; PG8_MMA(0, 0, At, B0); PG8_MMA(0, 1, At, B1); PG8_BAR; PG8_SCHED;
            PG8_LDA(At, 0, 1); PG8_STAGE(PG8_SB(0, 0), b2, B); PG8_STAGE(PG8_SB(0, 1), b2 + hstepB, B); PG8_STAGE(PG8_SA(0, 0), a2, A);
            if (!drain) PG8_WAIT_V(8);
            PG8_WAIT_L(0); PG8_BAR; PG8_MMA(1, 0, At, B0); PG8_MMA(1, 1, At, B1); PG8_BAR; PG8_SCHED;
            PG8_LDB(B0, 1, 0); PG8_LDB(B1, 1, 1); PG8_SCHED; PG8_LDA(At, 1, 0); PG8_STAGE(PG8_SA(0, 1), a2 + hstepA, A);
            if (!drain) PG8_WAIT_V(8);
            PG8_WAIT_L(0); PG8_BAR; PG8_MMA(0, 0, At, B0); PG8_MMA(0, 1, At, B1); PG8_BAR; PG8_SCHED;
            PG8_LDA(At, 1, 1); PG8_STAGE(PG8_SB(1, 0), b3, B); PG8_STAGE(PG8_SB(1, 1), b3 + hstepB, B); PG8_STAGE(PG8_SA(1, 0), a3, A);
            if (!drain) PG8_WAIT_V(8);
            PG8_WAIT_L(0); PG8_BAR; PG8_MMA(1, 0, At, B0); PG8_MMA(1, 1, At, B1); if (drain) PG8_WAIT_V(8); PG8_BAR; PG8_SCHED;
        }
        PG8_STAGE(PG8_SA(1, 1), nA + kstep + hstepA, A); PG8_SCHED;
        if constexpr (FP8) asm volatile("s_nop 15\n\ts_nop 7" ::: "memory");
        if constexpr (ALIGN_EPI) { if (wr == 0) PG8_BAR; }
        { const int te = tid_fresh(); E(acc, cur, wr, wc, te & 15, (te >> 4) & 3); }
        if (!has_next) break;
        stores = true;
#pragma unroll
        for (int a = 0; a < 2; ++a)
#pragma unroll
            for (int b = 0; b < 2; ++b)
#pragma unroll
                for (int m = 0; m < 4; ++m)
#pragma unroll
                    for (int n = 0; n < 2; ++n) acc[a][b][m][n] = (f32x4){0.f, 0.f, 0.f, 0.f};
        cur = nxt; cA = nA; cB = nB; ++ui;
        if constexpr (ALIGN_EPI) { if (wr == 1) PG8_BAR; }
    }
    PG8_WAIT_V(0);
    if constexpr (!ALIGN_EPI) { if (wr == 0) PG8_BAR; }
    PG8_BAR;
#undef PG8_AOFF
#undef PG8_SA
#undef PG8_SB
#undef PG8_STAGE
#undef PG8_LDA
#undef PG8_LD8
#undef PG8_LDB
#undef PG8_MMA
#undef PG8_WAIT_V
#undef PG8_WAIT_L
#undef PG8_BAR
#undef PG8_SCHED
}
}

__device__ __forceinline__ float rstd_q(const float* ssp, int row, int fq) {
    const f32x4 a = *(const f32x4*)(ssp + (size_t)row * 16 + 4 * fq);
    float s = (a[0] + a[1]) + (a[2] + a[3]); s += lx16(s); s = add_x32(s);
    return rsqrtf(s * (1.f / D) + EPS);
}
__device__ __forceinline__ void rstd8(const float* ssp, int row0, int fq, float mul, float (&rs)[2][4]) {
    f32x4 a[2][4];
#pragma unroll
    for (int ai = 0; ai < 2; ++ai)
#pragma unroll
        for (int m = 0; m < 4; ++m) a[ai][m] = *(const f32x4*)(ssp + (size_t)(row0 + ai * 128 + m * 16) * 16 + 4 * fq);
#pragma unroll
    for (int ai = 0; ai < 2; ++ai)
#pragma unroll
        for (int m = 0; m < 4; ++m) { float s = (a[ai][m][0] + a[ai][m][1]) + (a[ai][m][2] + a[ai][m][3]); s += lx16(s); s = add_x32(s); rs[ai][m] = rsqrtf(s * (1.f / D) + EPS) * mul; }
}
__device__ __forceinline__ u32x4 pk8(f32x4 a, f32x4 b) { u32x4 w; w.x = pk2(a[0], a[1]); w.y = pk2(a[2], a[3]); w.z = pk2(b[0], b[1]); w.w = pk2(b[2], b[3]); return w; }
__device__ __forceinline__ u32x2 pk8_fp8(f32x4 a, f32x4 b, float sc) {
    int q0 = __builtin_amdgcn_cvt_pk_fp8_f32(a[0] * sc, a[1] * sc, 0, false); q0 = __builtin_amdgcn_cvt_pk_fp8_f32(a[2] * sc, a[3] * sc, q0, true);
    int q1 = __builtin_amdgcn_cvt_pk_fp8_f32(b[0] * sc, b[1] * sc, 0, false); q1 = __builtin_amdgcn_cvt_pk_fp8_f32(b[2] * sc, b[3] * sc, q1, true);
    return (u32x2){(unsigned)q0, (unsigned)q1};
}
__device__ __forceinline__ void up8(u32x4 w, f32x4& a, f32x4& b) {
    a = (f32x4){__uint_as_float(w.x << 16), __uint_as_float(w.x & 0xffff0000u), __uint_as_float(w.y << 16), __uint_as_float(w.y & 0xffff0000u)};
    b = (f32x4){__uint_as_float(w.z << 16), __uint_as_float(w.z & 0xffff0000u), __uint_as_float(w.w << 16), __uint_as_float(w.w & 0xffff0000u)}; }
struct LaneTr {
    int addr, tr, tq;
    __device__ __forceinline__ LaneTr(int fr, int fq) { const int L = fq * 16 + fr; tr = L >> 2; tq = L & 3; addr = (tq * 16 + tr) * 4; }
    __device__ __forceinline__ u32x4 operator()(u32x4 w) const {
        return (u32x4){(unsigned)__builtin_amdgcn_ds_bpermute(addr, (int)w.x), (unsigned)__builtin_amdgcn_ds_bpermute(addr, (int)w.y), (unsigned)__builtin_amdgcn_ds_bpermute(addr, (int)w.z), (unsigned)__builtin_amdgcn_ds_bpermute(addr, (int)w.w)}; }
};
typedef _Float16 f16x2_t __attribute__((ext_vector_type(2)));
__device__ __forceinline__ u32x4 swz16x4(u32x4 a) { unsigned r0, r1, r2, r3;
    asm volatile("ds_swizzle_b32 %0, %4 offset:swizzle(SWAP,16)\n\tds_swizzle_b32 %1, %5 offset:swizzle(SWAP,16)\n\tds_swizzle_b32 %2, %6 offset:swizzle(SWAP,16)\n\tds_swizzle_b32 %3, %7 offset:swizzle(SWAP,16)\n\ts_waitcnt lgkmcnt(0)"
                 : "=&v"(r0), "=&v"(r1), "=&v"(r2), "=&v"(r3) : "v"(a.x), "v"(a.y), "v"(a.z), "v"(a.w));
    return (u32x4){r0, r1, r2, r3}; }
__device__ __forceinline__ f32x4 swz16f4(f32x4 a) { return __builtin_bit_cast(f32x4, swz16x4(__builtin_bit_cast(u32x4, a))); }
__device__ __forceinline__ float h2f_lo(unsigned w) { return (float)__builtin_bit_cast(f16x2_t, w)[0]; }
__device__ __forceinline__ float h2f_hi(unsigned w) { return (float)__builtin_bit_cast(f16x2_t, w)[1]; }
struct GEpiWin {
    unsigned char* ws;
    static constexpr int NST = 16;
    __device__ __forceinline__ void operator()(const f32x4 (&acc)[2][2][4][2], const pg8::Unit& u, int wr, int wc, int fr, int fq) const {
        const int pn = u.pn, row0 = u.pm * 256 + wr * 64 + fr;
        const LaneTr ltr(fr, fq); const int rowt = u.pm * 256 + wr * 64 + ltr.tr, ct = 32 * wc + 8 * ltr.tq;
        const float* ssp = (const float*)(ws + WS_SSP);
        if (pn < 4) {
            const bool rot = (wc & 1) == 0;
            bf16_t* dst = (bf16_t*)(ws + (pn < 2 ? WS_QB : WS_KB)) + (pn & 1) * 256 + ct;
            float rs8[2][4]; rstd8(ssp, row0, fq, pn < 2 ? C2 : 1.f, rs8);
            u32x4 tb[2][4];
#pragma unroll
            for (int ai = 0; ai < 2; ++ai)
#pragma unroll
                for (int m = 0; m < 4; ++m) tb[ai][m] = rot ? *(const u32x4*)(ws + WS_ROPE + (size_t)(row0 + ai * 128 + m * 16) * 32 + (fq & 1) * 16) : (u32x4){0u, 0u, 0u, 0u};
#pragma unroll
            for (int ai = 0; ai < 2; ++ai)
#pragma unroll
                for (int m = 0; m < 4; ++m) { const int row = rowt + ai * 128 + m * 16; const float rs = rs8[ai][m];
                    f32x4 c0 = (f32x4){1.f, 1.f, 1.f, 1.f}, c1 = c0, s0 = (f32x4){0.f, 0.f, 0.f, 0.f}, s1 = s0;
                    if (rot) { const u32x4 mine = tb[ai][m]; const u32x4 oth = swz16x4(mine);
                        const u32x4 cw = (fq & 1) ? oth : mine, sw = (fq & 1) ? mine : oth;
                        c0 = (f32x4){h2f_lo(cw.x), h2f_hi(cw.x), h2f_lo(cw.y), h2f_hi(cw.y)}; c1 = (f32x4){h2f_lo(cw.z), h2f_hi(cw.z), h2f_lo(cw.w), h2f_hi(cw.w)};
                        s0 = (f32x4){h2f_lo(sw.x), h2f_hi(sw.x), h2f_lo(sw.y), h2f_hi(sw.y)}; s1 = (f32x4){h2f_lo(sw.z), h2f_hi(sw.z), h2f_lo(sw.w), h2f_hi(sw.w)}; }
#pragma unroll
                    for (int bj = 0; bj < 2; ++bj) { f32x4 v0 = acc[ai][bj][m][0], v1 = acc[ai][bj][m][1];
                        if (rot) { const f32x4 o0 = swz16f4(v0), o1 = swz16f4(v1);
                            if (fq == 0) { v0 = v0 * c0 - o0 * s0; v1 = v1 * c1 - o1 * s1; } else if (fq == 1) { v0 = o0 * s0 + v0 * c0; v1 = o1 * s1 + v1 * c1; } }
                        *(u32x4*)(dst + (size_t)row * 512 + bj * 128) = ltr(pk8(v0 * rs, v1 * rs)); } }
        } else if (pn < 12) {
            const int seg = (pn - 4) >> 1; const size_t base = seg == 0 ? WS_VB : seg == 1 ? WS_PIN : seg == 2 ? WS_UIN : WS_VIN;
            bf16_t* dst = (bf16_t*)(ws + base) + (pn & 1) * 256 + ct;
            float rs[2][4]; rstd8(ssp, row0, fq, 1.f, rs);
#pragma unroll
            for (int ai = 0; ai < 2; ++ai)
#pragma unroll
                for (int m = 0; m < 4; ++m) { const int row = rowt + ai * 128 + m * 16;
#pragma unroll
                    for (int bj = 0; bj < 2; ++bj) *(u32x4*)(dst + (size_t)row * 512 + bj * 128) = ltr(pk8(acc[ai][bj][m][0] * rs[ai][m], acc[ai][bj][m][1] * rs[ai][m])); }
        }
    }
};
__device__ __forceinline__ size_t gate_off(int pm, int pn, int wid, int lane) { return (((size_t)(pm * 12 + pn) * 8 + wid) << 14) + (size_t)lane * 16; }
#define GATE_FRAG(ai, bj, m) ((((ai) * 2 + (bj)) * 4 + (m)) * 1024)
struct OrderGate : pg8::Order {
    __device__ __forceinline__ bool next(int i, pg8::Unit& u) const { pg8::Unit t; if (!pg8::Order::next(i / 3, t)) return false; u.pm = t.pm; u.pn = t.pn + 4 * (2 - i % 3); return true; }
};
struct GEpiGate {
    unsigned char* ws;
    static constexpr int NST = 8;
    __device__ __forceinline__ void operator()(const f32x4 (&acc)[2][2][4][2], const pg8::Unit& u, int wr, int wc, int fr, int fq) const {
        const int row0 = u.pm * 256 + wr * 64 + fr, gi = u.pn >> 2;
        unsigned char* dst = ws + WS_GTE + gate_off(u.pm, u.pn, wr * 4 + wc, fq * 16 + fr);
        const size_t slot4 = (size_t)4 * 8 << 14;
        float rs8[2][4]; rstd8((const float*)(ws + WS_SSP), row0, fq, -1.4426950408889634f / (XS * W8S), rs8);
#pragma unroll
        for (int ai = 0; ai < 2; ++ai) {
            u32x4 fa[4][2], fb[4][2];
#pragma unroll
            for (int m = 0; m < 4; ++m)
#pragma unroll
                for (int bj = 0; bj < 2; ++bj) { fa[m][bj] = (u32x4){0u, 0u, 0u, 0u}; fb[m][bj] = fa[m][bj];
                    if (gi == 1) fa[m][bj] = *(const u32x4*)(dst + slot4 + GATE_FRAG(ai, bj, m));
                    if (gi == 0) { fa[m][bj] = *(const u32x4*)(dst + 2 * slot4 + GATE_FRAG(ai, bj, m)); fb[m][bj] = *(const u32x4*)(dst + slot4 + GATE_FRAG(ai, bj, m)); } }
#pragma unroll
            for (int m = 0; m < 4; ++m) { const float rs = rs8[ai][m];
#pragma unroll
                for (int bj = 0; bj < 2; ++bj) { f32x4 v0 = acc[ai][bj][m][0] * rs, v1 = acc[ai][bj][m][1] * rs;
#pragma unroll
                    for (int e = 0; e < 4; ++e) { v0[e] = 1.f + __builtin_amdgcn_exp2f(fminf(v0[e], 60.f)); v1[e] = 1.f + __builtin_amdgcn_exp2f(fminf(v1[e], 60.f)); }
                    if (gi != 2) { f32x4 a0, a1; up8(fa[m][bj], a0, a1); v0 = v0 * a0; v1 = v1 * a1; }
                    if (gi == 0) { f32x4 b0, b1; up8(fb[m][bj], b0, b1); v0 = v0 * b0; v1 = v1 * b1; }
#pragma unroll
                    for (int e = 0; e < 4; ++e) { v0[e] = __builtin_amdgcn_rcpf(v0[e]); v1[e] = __builtin_amdgcn_rcpf(v1[e]); }
                    *(u32x4*)(dst + GATE_FRAG(ai, bj, m)) = pk8(v0, v1); } }
        }
    }
};
__device__ __forceinline__ f32x4 rcp4(f32x4 v) { return (f32x4){__builtin_amdgcn_rcpf(fmaxf(v[0], 1e-30f)), __builtin_amdgcn_rcpf(fmaxf(v[1], 1e-30f)), __builtin_amdgcn_rcpf(fmaxf(v[2], 1e-30f)), __builtin_amdgcn_rcpf(fmaxf(v[3], 1e-30f))}; }
struct BranchHook {
    static constexpr bool ACTIVE = true; unsigned char* ws;
    __device__ __forceinline__ void operator()(f32x4 (&acc)[2][2][4][2], const pg8::Unit& u, int t, int wr, int wc, int fr, int fq) const {
        int lane = fq * 16 + fr;
        asm volatile("" : "+v"(lane));
        const unsigned char* gp = ws + WS_GTE + gate_off(u.pm, u.pn + ((t == 8) ? 0 : 4), wr * 4 + wc, lane);
        u32x4 ga[2][4][2];
#pragma unroll
        for (int ai = 0; ai < 2; ++ai)
#pragma unroll
            for (int m = 0; m < 4; ++m)
#pragma unroll
                for (int bj = 0; bj < 2; ++bj) ga[ai][m][bj] = *(const u32x4*)(gp + GATE_FRAG(ai, bj, m));
        __builtin_amdgcn_sched_barrier(0);
#pragma unroll
        for (int ai = 0; ai < 2; ++ai)
#pragma unroll
            for (int m = 0; m < 4; ++m)
#pragma unroll
                for (int bj = 0; bj < 2; ++bj) { f32x4 a0, a1; up8(ga[ai][m][bj], a0, a1); acc[ai][bj][m][0] = acc[ai][bj][m][0] * a0; acc[ai][bj][m][1] = acc[ai][bj][m][1] * a1; }
        __builtin_amdgcn_sched_barrier(0);
    }
};
struct GEpiBranch {
    unsigned char* ws;
    static constexpr int NST = 8;
    __device__ __forceinline__ void operator()(const f32x4 (&acc)[2][2][4][2], const pg8::Unit& u, int wr, int wc, int fr, int fq) const {
        const LaneTr ltr(fr, fq); const int row0 = u.pm * 256 + wr * 64 + ltr.tr, col0 = u.pn * 256 + 32 * wc + 8 * ltr.tq;
#pragma unroll
        for (int ai = 0; ai < 2; ++ai) {
            u32x4 g[4][2];
#pragma unroll
            for (int m = 0; m < 4; ++m)
#pragma unroll
                for (int bj = 0; bj < 2; ++bj) g[m][bj] = *(const u32x4*)(ws + WS_GTE + gate_off(u.pm, u.pn + 8, wr * 4 + wc, fq * 16 + fr) + GATE_FRAG(ai, bj, m));
#pragma unroll
            for (int m = 0; m < 4; ++m) { const int row = row0 + ai * 128 + m * 16;
#pragma unroll
                for (int bj = 0; bj < 2; ++bj) { const int col = col0 + bj * 128;
                    f32x4 g0, g1; up8(g[m][bj], g0, g1);
                    *(u32x4*)((bf16_t*)(ws + WS_MG) + (size_t)row * D + col) = ltr(pk8(acc[ai][bj][m][0] * g0, acc[ai][bj][m][1] * g1)); } }
        }
    }
};
struct GEpiResid {
    unsigned char* ws; bool q8; float ascale;
    static constexpr int NST = 16;
    __device__ __forceinline__ void operator()(const f32x4 (&acc)[2][2][4][2], const pg8::Unit& u, int wr, int wc, int fr, int fq) const {
        const int row0 = u.pm * 256 + wr * 64 + fr, col0 = u.pn * 256 + 32 * wc + 8 * fq;
#pragma unroll
        for (int ai = 0; ai < 2; ++ai) {
            u32x4 xin[4][2];
#pragma unroll
            for (int m = 0; m < 4; ++m)
#pragma unroll
                for (int bj = 0; bj < 2; ++bj) xin[m][bj] = *(const u32x4*)((const bf16_t*)(ws + WS_XB) + (size_t)(row0 + ai * 128 + m * 16) * D + col0 + bj * 128);
#pragma unroll
            for (int m = 0; m < 4; ++m) { const int row = row0 + ai * 128 + m * 16; float part = 0.f;
#pragma unroll
                for (int bj = 0; bj < 2; ++bj) { f32x4 x0, x1; up8(xin[m][bj], x0, x1);
                    const u32x4 w = pk8(acc[ai][bj][m][0] * ascale + x0, acc[ai][bj][m][1] * ascale + x1);
                    *(u32x4*)((bf16_t*)(ws + WS_XB) + (size_t)row * D + col0 + bj * 128) = w;
                    f32x4 v0, v1; up8(w, v0, v1);
                    if (q8) { int q0 = __builtin_amdgcn_cvt_pk_fp8_f32(v0[0] * XS, v0[1] * XS, 0, false); q0 = __builtin_amdgcn_cvt_pk_fp8_f32(v0[2] * XS, v0[3] * XS, q0, true);
                        int q1 = __builtin_amdgcn_cvt_pk_fp8_f32(v1[0] * XS, v1[1] * XS, 0, false); q1 = __builtin_amdgcn_cvt_pk_fp8_f32(v1[2] * XS, v1[3] * XS, q1, true);
                        *(u32x2*)(ws + WS_XQ8 + (size_t)row * D + col0 + bj * 128) = (u32x2){(unsigned)q0, (unsigned)q1}; }
                    part += (v0[0] * v0[0] + v0[1] * v0[1]) + (v0[2] * v0[2] + v0[3] * v0[3]) + (v1[0] * v1[0] + v1[1] * v1[1]) + (v1[2] * v1[2] + v1[3] * v1[3]); }
                part += lx16(part); part = add_x32(part);
                if (fq == 0) ((float*)(ws + WS_SSP))[(size_t)row * 16 + u.pn * 4 + wc] = part; }
        }
    }
};
typedef _Float16 f16x8 __attribute__((ext_vector_type(8)));
struct GEpiScaleF16 {
    unsigned char* ws; _Float16* o; int ld;
    static constexpr int NST = 16;
    __device__ __forceinline__ void operator()(const f32x4 (&acc)[2][2][4][2], const pg8::Unit& u, int wr, int wc, int fr, int fq) const {
        const int row0 = u.pm * 256 + wr * 64 + fr;
        const LaneTr ltr(fr, fq); const int rowt = u.pm * 256 + wr * 64 + ltr.tr, col0 = u.pn * 256 + 32 * wc + 8 * ltr.tq;
        float rs8[2][4]; rstd8((const float*)(ws + WS_SSP), row0, fq, 1.f, rs8);
#pragma unroll
        for (int ai = 0; ai < 2; ++ai)
#pragma unroll
            for (int m = 0; m < 4; ++m) { const int row = rowt + ai * 128 + m * 16; const float rs = rs8[ai][m];
#pragma unroll
                for (int bj = 0; bj < 2; ++bj) { const f32x4 a = acc[ai][bj][m][0] * rs, b = acc[ai][bj][m][1] * rs;
                    const f16x8 h = (f16x8){(_Float16)a[0], (_Float16)a[1], (_Float16)a[2], (_Float16)a[3], (_Float16)b[0], (_Float16)b[1], (_Float16)b[2], (_Float16)b[3]};
                    *(u32x4*)(o + (size_t)row * ld + col0 + bj * 128) = ltr(__builtin_bit_cast(u32x4, h)); } }
    }
};
typedef PG8_LAS unsigned char* lds_t;
struct GEpiXSoftmax {
    unsigned char* ws; lds_t part;
    static constexpr int NST = 16;
    __device__ __forceinline__ void operator()(const f32x4 (&acc)[2][2][4][2], const pg8::Unit& u, int wr, int wc, int fr, int fq) const {
        const int row0 = u.pm * 256 + wr * 64 + fr, col0 = u.pn * 256 + 32 * wc + 8 * fq;
        f32x4 (&ex)[2][2][4][2] = const_cast<f32x4 (&)[2][2][4][2]>(acc);
        PG8_LAS f32x2* pt = (PG8_LAS f32x2*)part;
        float rs[2][4], mw[2][4];
#pragma unroll
        for (int ai = 0; ai < 2; ++ai)
#pragma unroll
            for (int m = 0; m < 4; ++m) { const int row = row0 + ai * 128 + m * 16; rs[ai][m] = rstd_q((const float*)(ws + WS_SSP), row, fq) * (1.4426950408889634f / (16.f * XS * GS));
                float mx = -INFINITY;
#pragma unroll
                for (int bj = 0; bj < 2; ++bj)
#pragma unroll
                    for (int n = 0; n < 2; ++n)
#pragma unroll
                        for (int e = 0; e < 4; ++e) mx = fmaxf(mx, acc[ai][bj][m][n][e]);
                mx *= rs[ai][m];
                mx = fmaxf(mx, lx16(mx)); mx = max_x32(mx);
                float sm = 0.f;
#pragma unroll
                for (int bj = 0; bj < 2; ++bj)
#pragma unroll
                    for (int n = 0; n < 2; ++n)
#pragma unroll
                        for (int e = 0; e < 4; ++e) { const float x = __builtin_amdgcn_exp2f(acc[ai][bj][m][n][e] * rs[ai][m] - mx); ex[ai][bj][m][n][e] = x; sm += x; }
                sm += lx16(sm); sm = add_x32(sm);
                mw[ai][m] = mx;
                if (fq == 0) pt[(wr * 64 + fr + ai * 128 + m * 16) * 4 + wc] = (f32x2){mx, sm}; }
        asm volatile("s_waitcnt lgkmcnt(0)" ::: "memory");
        __builtin_amdgcn_s_barrier();
#pragma unroll
        for (int ai = 0; ai < 2; ++ai)
#pragma unroll
            for (int m = 0; m < 4; ++m) { const int row = row0 + ai * 128 + m * 16;
                const PG8_LAS f32x2* pr = pt + (wr * 64 + fr + ai * 128 + m * 16) * 4;
                const f32x2 p0 = pr[0], p1 = pr[1], p2 = pr[2], p3 = pr[3];
                const float M = fmaxf(fmaxf(p0.x, p1.x), fmaxf(p2.x, p3.x));
                const float tot = (p0.y * __builtin_amdgcn_exp2f(p0.x - M) + p1.y * __builtin_amdgcn_exp2f(p1.x - M)) + (p2.y * __builtin_amdgcn_exp2f(p2.x - M) + p3.y * __builtin_amdgcn_exp2f(p3.x - M));
                const float f = __builtin_amdgcn_exp2f(mw[ai][m] - M) * (PS / tot);
#pragma unroll
                for (int bj = 0; bj < 2; ++bj) *(u32x2*)(ws + WS_PM + (size_t)row * D + col0 + bj * 128) = pk8_fp8(ex[ai][bj][m][0], ex[ai][bj][m][1], f); }
    }
};
__device__ __forceinline__ void fstage_win(const Params& p, int l, lds_t lds, int bid, int nb) {
    { pg8::Order O; O.init(T, 3072, nb, bid, p.ws + WS_XB, D, p.ws + WS_WIN + (size_t)l * 3072 * D * 2, D);
      pg8::gemm_phase<GEpiWin, pg8::Order, true>(lds, D, D, D, O, GEpiWin{p.ws}); }
    { OrderGate O; O.init(T, 1024, nb, bid, p.ws + WS_XQ8, D / 2, p.ws + WS_WIN + 24 * MiB + (size_t)l * 3072 * D, D / 2);
      pg8::gemm_phase<GEpiGate, OrderGate, true, pg8::NoHook, 1 << 20, true>(lds, D / 2, D / 2, D / 2, O, GEpiGate{p.ws}); }
}
template <bool HOOKS = true>
__device__ __forceinline__ void fstage_branch(const Params& p, int l, lds_t lds, int bid, int nb) {
    pg8::Order O; O.init(T, D, nb, bid, p.ws + WS_AO, 512, p.ws + WS_WB0 + (size_t)l * D * 1536 * 2, 1536);
    const long d1 = (long)WS_DP - (long)WS_AO - 8 * 128, d2 = (long)WS_SO - (long)WS_AO - 16 * 128;
    if constexpr (HOOKS) pg8::gemm_phase<GEpiBranch, pg8::Order, true, BranchHook, 8>(lds, 1536, 512, 1536, O, GEpiBranch{p.ws}, d1, d2, BranchHook{p.ws});
    else pg8::gemm_phase<GEpiBranch, pg8::Order, true, pg8::NoHook, 8>(lds, 1536, 512, 1536, O, GEpiBranch{p.ws}, d1, d2);
}
__device__ __forceinline__ void fstage_resid_out(const Params& p, int l, lds_t lds, int bid, int nb) {
    pg8::Order O; O.init(T, D, nb, bid, p.ws + WS_MG, D, p.ws + WS_WOUT + (size_t)l * D * D * 2, D);
    pg8::gemm_phase<GEpiResid, pg8::Order, true>(lds, D, D, D, O, GEpiResid{p.ws, true, 1.f});
}
__device__ __forceinline__ void fstage_resid_cross(const Params& p, int l, lds_t lds, int bid, int nb) {
    pg8::Order O; O.init(T, D, nb, bid, p.ws + WS_PM, D / 2, p.ws + WS_YT + (size_t)l * NB * D * D, D / 2, (size_t)D * D, S / 256);
    pg8::gemm_phase<GEpiResid, pg8::Order, true, pg8::NoHook, 1 << 20, true>(lds, D / 2, D / 2, D / 2, O, GEpiResid{p.ws, true, 1.f / (PS * YS)});
}
__device__ __forceinline__ void fstage_xscore(const Params& p, int l, lds_t lds, int bid, int nb) {
    pg8::Order O; O.init(T, D, nb, bid, p.ws + WS_XQ8, D / 2, p.ws + WS_GT + (size_t)l * NB * D * D, D / 2, (size_t)D * D, S / 256);
    pg8::gemm_phase<GEpiXSoftmax, pg8::Order, true, pg8::NoHook, 1 << 20, true>(lds, D / 2, D / 2, D / 2, O, GEpiXSoftmax{p.ws, lds + 131072});
}


struct GEpiKV {
    unsigned char* ws;
    static constexpr int NST = 16;
    __device__ __forceinline__ void operator()(const f32x4 (&acc)[2][2][4][2], const pg8::Unit& u, int wr, int wc, int fr, int fq) const {
        asm volatile("" : "+v"(fr), "+v"(fq));
        const int row0 = u.pm * 256 + wr * 64 + fr, l = u.pn >> 3, col0 = (u.pn & 7) * 256 + 32 * wc + 8 * fq;
        float rs8[2][4];
#pragma unroll
        for (int ai = 0; ai < 2; ++ai)
#pragma unroll
            for (int m = 0; m < 4; ++m) rs8[ai][m] = ((const float*)(ws + WS_RSTDM))[row0 + ai * 128 + m * 16];
#pragma unroll
        for (int ai = 0; ai < 2; ++ai)
#pragma unroll
            for (int m = 0; m < 4; ++m) { const int row = row0 + ai * 128 + m * 16; const float rs = rs8[ai][m];
#pragma unroll
                for (int bj = 0; bj < 2; ++bj) *(u32x4*)((bf16_t*)(ws + WS_KV) + ((size_t)l * MROWS + row) * 2048 + col0 + bj * 128) = pk8(acc[ai][bj][m][0] * rs, acc[ai][bj][m][1] * rs); }
    }
};
struct OrderG : pg8::Order {
    unsigned char* ws;
    __device__ __forceinline__ const char* a_ptr(const pg8::Unit& u) const { const int l = u.pm >> 5, b = (u.pm >> 2) & 7, h = u.pm & 3; return (const char*)(ws + WS_KV) + (((size_t)l * MROWS + b * 256) * 2048 + h * 256) * 2; }
    __device__ __forceinline__ const char* b_ptr(const pg8::Unit& u) const { const int l = u.pm >> 5, h = u.pm & 3; return (const char*)(ws + WS_WXQB) + (((size_t)l * D + u.pn * 256) * D + h * 256) * 2; }
};
struct GEpiG {
    unsigned char* ws;
    static constexpr int NST = 16;
    __device__ __forceinline__ void operator()(const f32x4 (&acc)[2][2][4][2], const pg8::Unit& u, int wr, int wc, int fr, int fq) const {
        asm volatile("" : "+v"(fr), "+v"(fq));
        const int lb = u.pm >> 2, h = u.pm & 3, r0 = wr * 64 + fr, col0 = u.pn * 256 + 32 * wc + 8 * fq;
#pragma unroll
        for (int ai = 0; ai < 2; ++ai)
#pragma unroll
            for (int m = 0; m < 4; ++m)
#pragma unroll
                for (int bj = 0; bj < 2; ++bj) *(u32x2*)(ws + WS_GT + ((size_t)lb * D + h * 256 + r0 + ai * 128 + m * 16) * D + col0 + bj * 128) = pk8_fp8(acc[ai][bj][m][0], acc[ai][bj][m][1], GS);
    }
};
struct OrderY : pg8::Order {
    unsigned char* ws;
    __device__ __forceinline__ const char* a_ptr(const pg8::Unit& u) const { const int l = u.pn >> 5, h = u.pn & 3; return (const char*)(ws + WS_WXOT) + (((size_t)l * D + u.pm * 256) * D + h * 256) * 2; }
    __device__ __forceinline__ const char* b_ptr(const pg8::Unit& u) const { const int l = u.pn >> 5, b = (u.pn >> 2) & 7, h = u.pn & 3; return (const char*)(ws + WS_KV) + (((size_t)l * MROWS + b * 256) * 2048 + 1024 + h * 256) * 2; }
};
struct GEpiY {
    unsigned char* ws;
    static constexpr int NST = 16;
    __device__ __forceinline__ void operator()(const f32x4 (&acc)[2][2][4][2], const pg8::Unit& u, int wr, int wc, int fr, int fq) const {
        asm volatile("" : "+v"(fr), "+v"(fq));
        const int lb = u.pn >> 2, h = u.pn & 3, row0 = u.pm * 256 + wr * 64 + fr, col0 = h * 256 + 32 * wc + 8 * fq;
#pragma unroll
        for (int ai = 0; ai < 2; ++ai)
#pragma unroll
            for (int m = 0; m < 4; ++m)
#pragma unroll
                for (int bj = 0; bj < 2; ++bj) *(u32x2*)(ws + WS_YT + ((size_t)lb * D + row0 + ai * 128 + m * 16) * D + col0 + bj * 128) = pk8_fp8(acc[ai][bj][m][0], acc[ai][bj][m][1], YS);
    }
};
__device__ __forceinline__ void fstage_kv(const Params& p, lds_t lds, int bid, int nb) {
    pg8::Order O; O.init(MROWS, L * 2048, nb, bid, p.ws + WS_MEMB, D, p.ws + WS_WXKVT, D);
    pg8::gemm_phase<GEpiKV, pg8::Order, true>(lds, D, D, D, O, GEpiKV{p.ws});
}
__device__ __forceinline__ void fstage_g(const Params& p, lds_t lds, int bid, int nb) {
    OrderG O; O.init(128 * 256, D, nb, bid, nullptr, 2048, nullptr, D); O.ws = p.ws;
    pg8::gemm_phase<GEpiG, OrderG, true>(lds, 256, 2048, D, O, GEpiG{p.ws});
}
__device__ __forceinline__ void fstage_y(const Params& p, lds_t lds, int bid, int nb) {
    OrderY O; O.init(D, 128 * 256, nb, bid, nullptr, D, nullptr, 2048); O.ws = p.ws;
    pg8::gemm_phase<GEpiY, OrderY, true>(lds, 256, D, 2048, O, GEpiY{p.ws});
}

#include <hip/hip_bf16.h>
namespace attn_body {
using bf16=__hip_bfloat16;
using bf16x8=__attribute__((ext_vector_type(8)))short;
using s16x4=__attribute__((ext_vector_type(4)))short;
using f32x16=__attribute__((ext_vector_type(16)))float;
using u32x4=__attribute__((ext_vector_type(4)))unsigned;
constexpr int SEQ=4096,D=64,DM=512;
constexpr int NW=8,QBLK=32,QB=QBLK*NW,KVBLK=64,NQB=SEQ/QB;
constexpr int ATTN_PITCH=DM, ATTN_UNIT_ROWS=QB;
__device__ __forceinline__ int crow(int r,int hi){return (r&3)+8*(r>>2)+4*hi;}
#define SBAR() __builtin_amdgcn_sched_barrier(0)
__device__ __forceinline__ void cmask(f32x16&p0,f32x16&p1,int jb,int qrel,int hi){
  const float NEG=-INFINITY; int kb=64*jb+4*hi;
  #pragma unroll
  for(int r=0;r<16;++r){int kv=kb+(r&3)+8*(r>>2); if(kv>qrel)p0[r]=NEG; if(kv+32>qrel)p1[r]=NEG;}
}

constexpr int NSLOT=3, SLOTB=8192;
constexpr int LDS_K=0, LDS_V=NSLOT*SLOTB, LDS_WS=3*NSLOT*SLOTB, LDS_OST=LDS_WS+NW*64*4, LDS_BYTES=LDS_OST+NW*8192;
constexpr float C2=0.125f*1.4426950408889634f;
__device__ __forceinline__ void glds16(const void*gsrc,unsigned lds_dst){unsigned keep;
  asm volatile("s_mov_b32 %0, m0\n\ts_mov_b32 m0, %2\n\ts_nop 0\n\tglobal_load_lds_dwordx4 %1, off\n\ts_mov_b32 m0, %0":"=&s"(keep):"v"(gsrc),"s"(lds_dst):"memory");}
__device__ __forceinline__ float max3f(float a,float b,float c){float r;asm("v_max3_f32 %0, %1, %2, %3":"=v"(r):"v"(a),"v"(b),"v"(c));return r;}
__device__ __forceinline__ float max2f(float a,float b){float r;asm("v_max_f32_e32 %0, %1, %2":"=v"(r):"v"(a),"v"(b));return r;}
__device__ __forceinline__ float fadd_s(float a,float b){float r;asm("v_add_f32_e32 %0, %1, %2":"=v"(r):"v"(a),"v"(b));return r;}
__device__ __forceinline__ float fsub_s(float a,float b){float r;asm("v_sub_f32_e32 %0, %1, %2":"=v"(r):"v"(a),"v"(b));return r;}
typedef float f32x2_t __attribute__((ext_vector_type(2))); typedef __bf16 bf16x2_t __attribute__((ext_vector_type(2)));
__device__ __forceinline__ unsigned cvtpk_s(float lo,float hi){f32x2_t v={lo,hi};bf16x2_t b=__builtin_convertvector(v,bf16x2_t);return __builtin_bit_cast(unsigned,b);}
#define WAIT_BAR(N) asm volatile("s_waitcnt vmcnt(" #N ") lgkmcnt(0)\n\ts_barrier":::"memory")

__device__ __forceinline__ void qkt(f32x16&p0,f32x16&p1,const char*Kslot,const bf16x8*qr,const f32x16&negm,int r32,int hi){
  const char*kb=Kslot+hi*1024+r32*16;
  #pragma unroll
  for(int d0=0;d0<4;++d0){
    const bf16x8 b0=*reinterpret_cast<const bf16x8*>(kb+d0*2048);
    const bf16x8 b1=*reinterpret_cast<const bf16x8*>(kb+d0*2048+512);
    if(d0==0){p0=__builtin_amdgcn_mfma_f32_32x32x16_bf16(b0,qr[0],negm,0,0,0);p1=__builtin_amdgcn_mfma_f32_32x32x16_bf16(b1,qr[0],negm,0,0,0);}
    else{p0=__builtin_amdgcn_mfma_f32_32x32x16_bf16(b0,qr[d0],p0,0,0,0);p1=__builtin_amdgcn_mfma_f32_32x32x16_bf16(b1,qr[d0],p1,0,0,0);}}
}
typedef __attribute__((address_space(3))) const char* lds_cptr;
typedef short v4i16_t __attribute__((ext_vector_type(4)));
__device__ __forceinline__ void kload8(bf16x8*kf,lds_cptr kp){
  kf[0]=*(const __attribute__((address_space(3))) bf16x8*)(kp);      kf[1]=*(const __attribute__((address_space(3))) bf16x8*)(kp+512);
  kf[2]=*(const __attribute__((address_space(3))) bf16x8*)(kp+2048); kf[3]=*(const __attribute__((address_space(3))) bf16x8*)(kp+2560);
  kf[4]=*(const __attribute__((address_space(3))) bf16x8*)(kp+4096); kf[5]=*(const __attribute__((address_space(3))) bf16x8*)(kp+4608);
  kf[6]=*(const __attribute__((address_space(3))) bf16x8*)(kp+6144); kf[7]=*(const __attribute__((address_space(3))) bf16x8*)(kp+6656);
}
__device__ __forceinline__ void kload2(bf16x8*kf,lds_cptr kp,int j){ kf[2*j]=*(const __attribute__((address_space(3))) bf16x8*)(kp+j*2048); kf[2*j+1]=*(const __attribute__((address_space(3))) bf16x8*)(kp+j*2048+512); }
__device__ __forceinline__ s16x4 vtr(lds_cptr p){ return __builtin_bit_cast(s16x4,__builtin_amdgcn_ds_read_tr16_b64_v4i16((__attribute__((address_space(3))) v4i16_t*)p)); }
__device__ __forceinline__ float rowmax(const f32x16&p0,const f32x16&p1){
  float a=max3f(p0[0],p0[1],p1[0]),b=max3f(p0[2],p0[3],p1[1]);a=max3f(a,p1[2],p1[3]);
  #pragma unroll
  for(int r=4;r<16;r+=4){a=max3f(a,p0[r],p0[r+1]);b=max3f(b,p0[r+2],p0[r+3]);a=max3f(a,p1[r],p1[r+1]);b=max3f(b,p1[r+2],p1[r+3]);}
  const float m=max2f(a,b);
  auto rr=__builtin_amdgcn_permlane32_swap(__float_as_uint(m),__float_as_uint(m),false,false);
  return max2f(__uint_as_float(rr[0]),__uint_as_float(rr[1]));
}
__device__ __forceinline__ void pv(f32x16*o,int vb,bf16x8 pa0,bf16x8 pa1,bf16x8 pa2,bf16x8 pa3){
  #pragma unroll
  for(int d0=0;d0<4;++d0){s16x4 lo[4],hi[4];
    #pragma unroll
    for(int ks=0;ks<4;++ks){
      asm volatile("ds_read_b64_tr_b16 %0,%1 offset:%c2":"=&v"(lo[ks]):"v"(vb),"i"(d0*4096+ks*1024):"memory");
      asm volatile("ds_read_b64_tr_b16 %0,%1 offset:%c2":"=&v"(hi[ks]):"v"(vb),"i"(d0*4096+ks*1024+512):"memory");}
    asm volatile("s_waitcnt lgkmcnt(0)":::"memory");SBAR();
    #define PK(k) (bf16x8){lo[k][0],lo[k][1],lo[k][2],lo[k][3],hi[k][0],hi[k][1],hi[k][2],hi[k][3]}
    o[d0]=__builtin_amdgcn_mfma_f32_32x32x16_bf16(pa0,PK(0),o[d0],0,0,0);
    o[d0]=__builtin_amdgcn_mfma_f32_32x32x16_bf16(pa1,PK(1),o[d0],0,0,0);
    o[d0]=__builtin_amdgcn_mfma_f32_32x32x16_bf16(pa2,PK(2),o[d0],0,0,0);
    o[d0]=__builtin_amdgcn_mfma_f32_32x32x16_bf16(pa3,PK(3),o[d0],0,0,0);
    #undef PK
  }
}

#ifndef ATTN_STORE16
#define ATTN_STORE16(p,v) (*(u32x4*)(p)=(v))
#endif
template<int THRL> __device__ __forceinline__ void attn_unit(int b,int qcol,int kcol,int vcol,int ocol,int qb,const bf16*Q,const bf16*__restrict__ K,const bf16*__restrict__ V,bf16*O,char*shm){
  const int tid=tid_fresh(),lane=tid&63,r32=lane&31,hi=lane>>5; const int wid=__builtin_amdgcn_readfirstlane(tid>>6);
  const long rowbase=(long)b*SEQ; const int q0=qb*QB;
  const bf16*Qw=Q+(rowbase+q0+wid*QBLK)*DM+qcol;
  const bf16*Kh=K+rowbase*DM+kcol,*Vh=V+rowbase*DM+vcol;
  const unsigned lds0=(unsigned)(uintptr_t)shm;
  float*wsf=(float*)(shm+LDS_WS)+wid*64;
  const bf16*ksrc=Kh+(long)lane*DM+wid*8;
  const bf16*vsrc=Vh+(long)(16*(wid&3)+(lane>>2))*DM+(wid>>2)*32+(lane&3)*8;
  const unsigned kdst=lds0+LDS_K+wid*1024, vdst=lds0+LDS_V+wid*1024;
  #define DMA_K(t,slot) glds16(ksrc+(long)(t)*KVBLK*DM,(unsigned)__builtin_amdgcn_readfirstlane(kdst+(slot)))
  #define DMA_V(t,slot) do{ glds16(vsrc+(long)(t)*KVBLK*DM,(unsigned)__builtin_amdgcn_readfirstlane(vdst+2*(slot))); glds16(vsrc+64+(long)(t)*KVBLK*DM,(unsigned)__builtin_amdgcn_readfirstlane(vdst+2*(slot)+8192)); }while(0)
  const int vb0=(int)(lds0+LDS_V)+((lane>>4)&1)*32+(lane&3)*8+(4*hi+((lane&15)>>2))*64;
  const char*Kbase=shm+LDS_K; bf16x8 kf[8];
  const lds_cptr shm3=(lds_cptr)shm; const lds_cptr kp0=shm3+LDS_K+hi*1024+r32*16; const lds_cptr vp0=shm3+LDS_V+((lane>>4)&1)*32+(lane&3)*8+(4*hi+((lane&15)>>2))*64;
  const int NT=(q0+QB)/KVBLK;
  DMA_K(0,0);DMA_V(0,0);DMA_K(1,SLOTB);
  bf16x8 qr[4];
  #pragma unroll
  for(int d0=0;d0<4;++d0)qr[d0]=*reinterpret_cast<const bf16x8*>(&Qw[(long)r32*DM+d0*16+hi*8]);
  float mhat=0.f,l_reg=0.f;f32x16 o[4];f32x16 negm;{float z_=0.f;asm volatile("":"+v"(z_));o[0]=(f32x16)(z_);o[1]=(f32x16)(z_);o[2]=(f32x16)(z_);o[3]=(f32x16)(z_);negm=(f32x16)(z_);}asm volatile("":"+v"(negm));
  const int qrel=wid*QBLK+r32;
  #define CMASK(P0,P1,t) do{int jb_=(t)-(NT-4); if(jb_>=0)cmask(P0,P1,jb_,qrel,hi);}while(0)
  bool resc=false;
  #define START(P0,P1) do{ const float rm=rowmax(P0,P1); resc=false; \
    { const float dl=rm; mhat=fadd_s(mhat,dl); \
      _Pragma("unroll") for(int r=0;r<16;++r){P0[r]=fsub_s(P0[r],dl);P1[r]=fsub_s(P1[r],dl);} \
      _Pragma("unroll") for(int r=0;r<16;++r)negm[r]=-mhat; asm volatile("":"+v"(negm)); } \
    _Pragma("unroll") for(int r=0;r<16;++r)P0[r]=__builtin_amdgcn_exp2f(P0[r]); }while(0)
  #define RESC() do{ if(resc){ asm volatile("s_waitcnt lgkmcnt(0)":::"memory"); \
      _Pragma("unroll") for(int d_=0;d_<4;++d_) _Pragma("unroll") for(int r=0;r<16;++r)o[d_][r]*=wsf[crow(r,hi)]; } }while(0)
  f32x16 pA0,pA1,pB0,pB1;
  int sl_prev=0,sl_cur=0,sl_next=SLOTB;
  #define ROT() do{sl_prev=sl_cur;sl_cur=sl_next;sl_next=(sl_next==(NSLOT-1)*SLOTB)?0:sl_next+SLOTB;}while(0)
  DMA_K(2,2*SLOTB);
  WAIT_BAR(4);
  qkt(pA0,pA1,Kbase,qr,negm,r32,hi);asm volatile("s_nop 15\n\ts_nop 7":"+v"(pA0),"+v"(pA1));CMASK(pA0,pA1,0);
  START(pA0,pA1);
  _Pragma("unroll") for(int r=0;r<16;++r)pA1[r]=__builtin_amdgcn_exp2f(pA1[r]);
  WAIT_BAR(0);
  DMA_K(3,0);DMA_V(1,SLOTB);
  ROT();
  kload8(kf,kp0+sl_cur);
  WAIT_BAR(3);
  s16x4 vlo[8],vhi[8]; u32x4 pw0,pw1,pw2,pw3;
  #define PKW(P,B) cvtpk_s(P[B],P[B+1])
  #define PAF(k) __builtin_bit_cast(bf16x8,pw##k)
  #define VFR(i) (bf16x8){vlo[i][0],vlo[i][1],vlo[i][2],vlo[i][3],vhi[i][0],vhi[i][1],vhi[i][2],vhi[i][3]}
  #define PIN(x) asm volatile("":"+v"(x))
  #define MX3(a,b,c) __builtin_fmaxf(__builtin_fmaxf((a),(b)),(c))
  #define GAPA(MF,A0,A1,A2,A3,W0,W1,PW) do{ MF; sacc+=A0; sacc+=A1; sacc+=A2; sacc+=A3; PIN(sacc); W0; W1; PIN(PW); SBAR(); }while(0)
  #define EX(v) __builtin_amdgcn_exp2f(v)
  #define GAPB(MF,X,B) do{ MF; X[B]=EX(X[B]); X[B+1]=EX(X[B+1]); X[B+2]=EX(X[B+2]); X[B+3]=EX(X[B+3]); PIN(X); SBAR(); }while(0)
  #define VRD(i) do{ vlo[i]=vtr(vp_+(((i)>>2)*4096+((i)&3)*1024)); vhi[i]=vtr(vp_+(((i)>>2)*4096+((i)&3)*1024+512)); }while(0)
  #define VRD2(i) do{ vlo[i]=vtr(vp_+((((i)>>2)+2)*4096+((i)&3)*1024)); vhi[i]=vtr(vp_+((((i)>>2)+2)*4096+((i)&3)*1024+512)); SBAR(); }while(0)
  #define KRD(G,j) do{ if(G){ kload2(kf,kp0+sl_next,j); SBAR(); } }while(0)
  #define STEP(C0,C1,P0,P1,t,GK,GV,GL) do{ SBAR(); \
    const lds_cptr vp_=vp0+2*sl_prev; \
    VRD(0); SBAR(); float sacc=(P0[0]+P0[1]); \
    GAPA(C0=__builtin_amdgcn_mfma_f32_32x32x16_bf16(kf[0],qr[0],negm,0,0,0), P0[2],P0[3],P0[4],P0[5],     pw0[0]=PKW(P0,0), pw0[1]=PKW(P0,2), pw0); \
    VRD(4); SBAR(); GAPA(C1=__builtin_amdgcn_mfma_f32_32x32x16_bf16(kf[1],qr[0],negm,0,0,0), P0[6],P0[7],P0[8],P0[9],     pw0[2]=PKW(P0,4), pw0[3]=PKW(P0,6), pw0); \
    VRD(1); SBAR(); GAPA(C0=__builtin_amdgcn_mfma_f32_32x32x16_bf16(kf[2],qr[1],C0,0,0,0),   P0[10],P0[11],P0[12],P0[13], pw1[0]=PKW(P0,8), pw1[1]=PKW(P0,10), pw1); \
    VRD(5); SBAR(); GAPA(C1=__builtin_amdgcn_mfma_f32_32x32x16_bf16(kf[3],qr[1],C1,0,0,0),   P0[14],P0[15],P1[0],P1[1],   pw1[2]=PKW(P0,12),pw1[3]=PKW(P0,14), pw1); \
    VRD(2); SBAR(); GAPA(C0=__builtin_amdgcn_mfma_f32_32x32x16_bf16(kf[4],qr[2],C0,0,0,0),   P1[2],P1[3],P1[4],P1[5],     pw2[0]=PKW(P1,0), pw2[1]=PKW(P1,2), pw2); \
    VRD(6); SBAR(); GAPA(C1=__builtin_amdgcn_mfma_f32_32x32x16_bf16(kf[5],qr[2],C1,0,0,0),   P1[6],P1[7],P1[8],P1[9],     pw2[2]=PKW(P1,4), pw2[3]=PKW(P1,6), pw2); \
    VRD(3); SBAR(); GAPA(C0=__builtin_amdgcn_mfma_f32_32x32x16_bf16(kf[6],qr[3],C0,0,0,0),   P1[10],P1[11],P1[12],P1[13], pw3[0]=PKW(P1,8), pw3[1]=PKW(P1,10), pw3); \
    VRD(7); SBAR(); GAPA(C1=__builtin_amdgcn_mfma_f32_32x32x16_bf16(kf[7],qr[3],C1,0,0,0),   P1[14],P1[15],0.f,0.f,       pw3[2]=PKW(P1,12),pw3[3]=PKW(P1,14), pw3); \
    l_reg+=sacc; \
    if(GK){DMA_K((t)+3,sl_cur);} if(GV){DMA_V((t)+1,sl_next);} \
    CMASK(C0,C1,t); \
    { float a=MX3(C0[0],C0[1],C1[0]),b=MX3(C0[2],C0[3],C1[1]); a=MX3(a,C1[2],C1[3]); \
      _Pragma("unroll") for(int r=4;r<16;r+=4){a=MX3(a,C0[r],C0[r+1]);b=MX3(b,C0[r+2],C0[r+3]);a=MX3(a,C1[r],C1[r+1]);b=MX3(b,C1[r+2],C1[r+3]);} \
      float rm=__builtin_fmaxf(a,b); { auto rr=__builtin_amdgcn_permlane32_swap(__float_as_uint(rm),__float_as_uint(rm),false,false); rm=__builtin_fmaxf(__uint_as_float(rr[0]),__uint_as_float(rr[1])); } \
      resc=false; \
      if(__builtin_expect(__any(rm>(float)THRL),0)){ const float dl=__builtin_fmaxf(rm,0.f); mhat+=dl; \
        _Pragma("unroll") for(int r=0;r<16;++r){C0[r]-=dl;C1[r]-=dl;} \
        _Pragma("unroll") for(int r=0;r<16;++r)negm[r]=-mhat; asm volatile("":"+v"(negm)); \
        const float f=__builtin_amdgcn_exp2f(-dl); l_reg*=f; if(hi==0)wsf[r32]=f; resc=true; } } \
    SBAR(); \
    GAPB(o[0]=__builtin_amdgcn_mfma_f32_32x32x16_bf16(PAF(0),VFR(0),o[0],0,0,0), C0,0); VRD2(0); \
    GAPB(o[1]=__builtin_amdgcn_mfma_f32_32x32x16_bf16(PAF(0),VFR(4),o[1],0,0,0), C0,4); VRD2(4); \
    KRD(GL,0); GAPB(o[0]=__builtin_amdgcn_mfma_f32_32x32x16_bf16(PAF(1),VFR(1),o[0],0,0,0), C0,8); VRD2(1); \
    KRD(GL,1); GAPB(o[1]=__builtin_amdgcn_mfma_f32_32x32x16_bf16(PAF(1),VFR(5),o[1],0,0,0), C0,12); VRD2(5); \
    KRD(GL,2); GAPB(o[0]=__builtin_amdgcn_mfma_f32_32x32x16_bf16(PAF(2),VFR(2),o[0],0,0,0), C1,0); VRD2(2); \
    KRD(GL,3); GAPB(o[1]=__builtin_amdgcn_mfma_f32_32x32x16_bf16(PAF(2),VFR(6),o[1],0,0,0), C1,4); VRD2(6); \
    GAPB(o[0]=__builtin_amdgcn_mfma_f32_32x32x16_bf16(PAF(3),VFR(3),o[0],0,0,0), C1,8); VRD2(3); \
    GAPB(o[1]=__builtin_amdgcn_mfma_f32_32x32x16_bf16(PAF(3),VFR(7),o[1],0,0,0), C1,12); VRD2(7); \
    o[2]=__builtin_amdgcn_mfma_f32_32x32x16_bf16(PAF(0),VFR(0),o[2],0,0,0); o[3]=__builtin_amdgcn_mfma_f32_32x32x16_bf16(PAF(0),VFR(4),o[3],0,0,0); SBAR(); \
    o[2]=__builtin_amdgcn_mfma_f32_32x32x16_bf16(PAF(1),VFR(1),o[2],0,0,0); o[3]=__builtin_amdgcn_mfma_f32_32x32x16_bf16(PAF(1),VFR(5),o[3],0,0,0); SBAR(); \
    o[2]=__builtin_amdgcn_mfma_f32_32x32x16_bf16(PAF(2),VFR(2),o[2],0,0,0); o[3]=__builtin_amdgcn_mfma_f32_32x32x16_bf16(PAF(2),VFR(6),o[3],0,0,0); SBAR(); \
    o[2]=__builtin_amdgcn_mfma_f32_32x32x16_bf16(PAF(3),VFR(3),o[2],0,0,0); o[3]=__builtin_amdgcn_mfma_f32_32x32x16_bf16(PAF(3),VFR(7),o[3],0,0,0); SBAR(); \
    }while(0)
  int t=1;
  #undef CMASK
  #define CMASK(P0,P1,t) do{}while(0)
  for(;t+5<NT;t+=2){
    STEP(pB0,pB1,pA0,pA1,t,true,true,true);     WAIT_BAR(3); RESC(); ROT();
    STEP(pA0,pA1,pB0,pB1,t+1,true,true,true);   WAIT_BAR(3); RESC(); ROT();
  }
  #undef CMASK
  #define CMASK(P0,P1,t) do{int jb_=(t)-(NT-4); if(jb_>=0)cmask(P0,P1,jb_,qrel,hi);}while(0)
  #define ENDW(tt) do{ if((tt)+3<NT){WAIT_BAR(3);} else if((tt)+2<NT){WAIT_BAR(2);} else {WAIT_BAR(0);} }while(0)
  for(;t+1<NT;t+=2){
    STEP(pB0,pB1,pA0,pA1,t,(t+3<NT),(t+1<NT),(t+1<NT));       ENDW(t);   RESC(); ROT();
    STEP(pA0,pA1,pB0,pB1,t+1,(t+4<NT),(t+2<NT),(t+2<NT));     ENDW(t+1); RESC(); ROT();
  }
  STEP(pB0,pB1,pA0,pA1,NT-1,false,false,false); RESC();
  { float sacc=pB0[0]+pB0[1]; _Pragma("unroll") for(int r=2;r<16;++r)sacc+=pB0[r]; _Pragma("unroll") for(int r=0;r<16;++r)sacc+=pB1[r]; l_reg+=sacc;
    pw0=(u32x4){PKW(pB0,0),PKW(pB0,2),PKW(pB0,4),PKW(pB0,6)};pw1=(u32x4){PKW(pB0,8),PKW(pB0,10),PKW(pB0,12),PKW(pB0,14)};pw2=(u32x4){PKW(pB1,0),PKW(pB1,2),PKW(pB1,4),PKW(pB1,6)};pw3=(u32x4){PKW(pB1,8),PKW(pB1,10),PKW(pB1,12),PKW(pB1,14)};
    SBAR(); pv(o,vb0+2*sl_cur,PAF(0),PAF(1),PAF(2),PAF(3)); }
  #undef PKW
  #undef PAF
  #undef VFR
  #undef PIN
  #undef MX3
  #undef GAPA
  #undef GAPB
  #undef EX
  #undef VRD
  #undef VRD2
  #undef KRD
  #undef STEP
  #undef ENDW
  {auto rr=__builtin_amdgcn_permlane32_swap(__float_as_uint(l_reg),__float_as_uint(l_reg),false,false);l_reg=__uint_as_float(rr[0])+__uint_as_float(rr[1]);}
  if(hi==0)wsf[32+r32]=l_reg;asm volatile("s_waitcnt lgkmcnt(0)":::"memory");
  float rli[16];
  #pragma unroll
  for(int r=0;r<16;++r)rli[r]=__builtin_amdgcn_rcpf(wsf[32+crow(r,hi)]);
  bf16*Ow=O+(rowbase+q0+wid*QBLK)*DM+ocol;
  { bf16*stg=(bf16*)(shm+LDS_OST)+wid*4096;
    #pragma unroll
    for(int r=0;r<16;++r){const int orow=crow(r,hi);
      #pragma unroll
      for(int d0=0;d0<4;++d0)stg[orow*128+d0*32+r32]=__float2bfloat16(o[d0][r]*rli[r]);}
    asm volatile("s_waitcnt lgkmcnt(0)":::"memory");
    #pragma unroll
    for(int i=0;i<8;++i){const int row=i*4+(lane>>4),ch=lane&15; const u32x4 v=*(const u32x4*)(stg+row*128+ch*8); ATTN_STORE16(Ow+(long)row*DM+ch*8,v);} }
  asm volatile("s_waitcnt lgkmcnt(0)\n\ts_barrier":::"memory");
  #undef DMA_K
  #undef DMA_V
  #undef CMASK
  #undef START
  #undef RESC
  #undef ROT
}
constexpr int ATTN_LDS_BYTES=LDS_BYTES;
#undef SBAR
#undef WAIT_BAR
}

__device__ __forceinline__ void fstage_attn(const Params& p, int l, char* lds) {
    const int G = gridDim.x, bx = blockIdx.x;
    const int vcu = (G % 8 == 0) ? (bx % 8) * (G / 8) + bx / 8 : bx;
    const attn_body::bf16* Q = (const attn_body::bf16*)(p.ws + WS_QB); const attn_body::bf16* K = (const attn_body::bf16*)(p.ws + WS_KB); const attn_body::bf16* V = (const attn_body::bf16*)(p.ws + WS_VB);
    for (int k = vcu; k < 256; k += G) {
        const int s = k & 7, h = (k >> 3) & 3, b = k >> 5;
#pragma unroll 1
        for (int i = 0; i < 4; ++i) {
            const int qb = (i & 2) ? 15 - s : s, m = i & 1;
            attn_body::bf16* O = (attn_body::bf16*)(p.ws + (m == 0 ? WS_O1 : WS_O2));
            attn_body::attn_unit<8>(b, (2 * h + m) * 64, (2 * h + m) * 64, h * 128, h * 128, qb, Q, K, V, O, lds);
        }
    }
    asm volatile("s_waitcnt vmcnt(0)" ::: "memory");
    __syncthreads();
    int vc2 = vcu; asm volatile("" : "+s"(vc2));
    for (int k = vc2; k < 256; k += G) {
        const int s = k & 7, h = (k >> 3) & 3, b = k >> 5;
        const int tid = tid_fresh(), lane = tid & 63, wid = tid >> 6;
        const float* lq = (const float*)p.in[5] + l * 256;
        float d1 = lq[lane] * lq[64 + lane], d2 = lq[128 + lane] * lq[192 + lane];
        d1 = wave_sum(d1); d2 = wave_sum(d2);
        const float lam = expf(d1) - expf(d2) + lam_init_of(l);
#pragma unroll 2
        for (int it = 0; it < 16; ++it) {
            const int qb = (it & 8) ? 15 - s : s, r = (it & 7) * 32 + wid * 4 + (lane >> 4);
            const size_t o = ((size_t)b * S + qb * 256 + r) * 512 + h * 128 + (lane & 15) * 8;
            const u32x4 a = *(const u32x4*)((const bf16_t*)(p.ws + WS_O1) + o), c = *(const u32x4*)((const bf16_t*)(p.ws + WS_O2) + o);
            float x[8];
#pragma unroll
            for (int e = 0; e < 4; ++e) { x[2 * e] = __uint_as_float(a[e] << 16) - lam * __uint_as_float(c[e] << 16); x[2 * e + 1] = __uint_as_float(a[e] & 0xffff0000u) - lam * __uint_as_float(c[e] & 0xffff0000u); }
            float ss = 0.f;
#pragma unroll
            for (int e = 0; e < 8; ++e) ss += x[e] * x[e];
            ss = sum16(ss);
            const float rs = rsqrtf(ss * (1.f / 128.f) + EPS);
            u32x4 w;
#pragma unroll
            for (int e = 0; e < 4; ++e) w[e] = pk2(x[2 * e] * rs, x[2 * e + 1] * rs);
            *(u32x4*)((bf16_t*)(p.ws + WS_AO) + o) = w;
        }
    }
}


__device__ __forceinline__ void fstage_sgate(const Params& p, int l, lds_t lds) {
    unsigned char* ws = p.ws;
    const int tid = tid_fresh(), lane = tid & 63, wid = __builtin_amdgcn_readfirstlane(tid >> 6), fr = lane & 15, fq = lane >> 4;
    constexpr int VP = 132;
    PG8_LAS bf16_t* vnT = (PG8_LAS bf16_t*)lds;
    PG8_LAS float* st = (PG8_LAS float*)(lds + 512 * VP * 2);
    const bf16_t* vin = (const bf16_t*)(ws + WS_VIN); const bf16_t* uin = (const bf16_t*)(ws + WS_UIN); bf16_t* so = (bf16_t*)(ws + WS_SO);
    const float* lng = (const float*)p.in[9] + l * 512; const float* lnb = (const float*)p.in[10] + l * 512; const float* bsp = (const float*)p.in[12] + l * 512;
    const bf16_t* wsm = (const bf16_t*)(ws + WS_WSPT) + (size_t)l * 4 * 16384;
    for (int ch = blockIdx.x; ch < T / 128; ch += gridDim.x) {
        const int t0 = ch * 128;
        __syncthreads();
#pragma unroll 4
        for (int i = 0; i < 16; ++i) {
            const int row = wid * 16 + i;
            f32x4 a, b; up8(*(const u32x4*)(vin + (size_t)(t0 + row) * 512 + lane * 8), a, b);
            const float mu = wave_sum((a[0] + a[1]) + (a[2] + a[3]) + (b[0] + b[1]) + (b[2] + b[3])) * (1.f / 512.f);
            a = a - mu; b = b - mu;
            const float vr = wave_sum((a[0] * a[0] + a[1] * a[1]) + (a[2] * a[2] + a[3] * a[3]) + (b[0] * b[0] + b[1] * b[1]) + (b[2] * b[2] + b[3] * b[3])) * (1.f / 512.f);
            if (lane == 0) { st[2 * row] = mu; st[2 * row + 1] = rsqrtf(vr + EPS); }
        }
        __syncthreads();
        {
            const int cp = tid & 255, pb = tid >> 8;
            const float g0 = lng[2 * cp], g1 = lng[2 * cp + 1], b0 = lnb[2 * cp], b1 = lnb[2 * cp + 1];
#pragma unroll 2
            for (int blk = 0; blk < 8; ++blk) {
                const int s0 = (pb * 8 + blk) * 8;
                unsigned w[8];
#pragma unroll
                for (int e = 0; e < 8; ++e) w[e] = *(const unsigned*)(vin + (size_t)(t0 + s0 + e) * 512 + 2 * cp);
                float y0[8], y1[8];
#pragma unroll
                for (int e = 0; e < 8; ++e) { const float mu = st[2 * (s0 + e)], rs = st[2 * (s0 + e) + 1];
                    y0[e] = (__uint_as_float(w[e] << 16) - mu) * rs * g0 + b0; y1[e] = (__uint_as_float(w[e] & 0xffff0000u) - mu) * rs * g1 + b1; }
                PG8_LAS u32x2* d0 = (PG8_LAS u32x2*)(vnT + (2 * cp) * VP + s0); PG8_LAS u32x2* d1 = (PG8_LAS u32x2*)(vnT + (2 * cp + 1) * VP + s0);
                d0[0] = (u32x2){pk2(y0[0], y0[1]), pk2(y0[2], y0[3])}; d0[1] = (u32x2){pk2(y0[4], y0[5]), pk2(y0[6], y0[7])};
                d1[0] = (u32x2){pk2(y1[0], y1[1]), pk2(y1[2], y1[3])}; d1[1] = (u32x2){pk2(y1[4], y1[5]), pk2(y1[6], y1[7])};
            }
        }
        __syncthreads();
        const int nks = (16 * wid + 16 + 31) >> 5;
        const int trow = t0 + 16 * wid + fr;
#pragma unroll 1
        for (int g = 0; g < 4; ++g) {
            f32x4 acc[8];
#pragma unroll
            for (int nt = 0; nt < 8; ++nt) acc[nt] = (f32x4){0.f, 0.f, 0.f, 0.f};
            const bf16_t* wrow = wsm + ((size_t)g * 128 + 16 * wid + fr) * 128 + fq * 8;
#pragma unroll 1
            for (int ks = 0; ks < nks; ++ks) {
                const bf16x8 af = *(const bf16x8*)(wrow + ks * 32);
#pragma unroll
                for (int nt = 0; nt < 8; ++nt) {
                    const PG8_LAS u32x2* bp = (const PG8_LAS u32x2*)(vnT + (g * 128 + nt * 16 + fr) * VP + ks * 32 + fq * 8);
                    const u32x2 lo = bp[0], hi = bp[1];
                    const bf16x8 bf = __builtin_bit_cast(bf16x8, (u32x4){lo.x, lo.y, hi.x, hi.y});
                    acc[nt] = __builtin_amdgcn_mfma_f32_16x16x32_bf16(bf, af, acc[nt], 0, 0, 0);
                }
            }
            const float bs = bsp[g * 128 + 16 * wid + fr];
#pragma unroll
            for (int nt = 0; nt < 8; ++nt) { const size_t o = (size_t)trow * 512 + g * 128 + nt * 16 + fq * 4; st_bf4(so + o, ld_bf4(uin + o) * (acc[nt] + bs)); }
        }
    }
}

__device__ __forceinline__ void stage_pool_d(const Params& p, int bid, int nb) {
    const int tidx = tid_fresh();
    unsigned char* ws = p.ws;
    const unsigned char* pin = ws + WS_PIN; unsigned char* dp = ws + WS_DP;
    for (int i = bid * NT + tidx; i < (T / 8) * 64; i += nb * NT) {
        const int c8 = (i & 63) * 8, t0 = (i >> 6) * 8, s0 = t0 & (S - 1), g = c8 >> 7, w = 2 << g;
        const unsigned ob = (unsigned)(t0 * 512 + c8) * 2u;
        u32x4 pv[16], cv[8];
#pragma unroll
        for (int k = 1; k <= 16; ++k) pv[k - 1] = (k <= w && k <= s0) ? *(const u32x4*)(pin + (ob - (unsigned)k * 1024u)) : (u32x4){0u, 0u, 0u, 0u};
#pragma unroll
        for (int j = 0; j < 8; ++j) cv[j] = *(const u32x4*)(pin + (ob + (unsigned)j * 1024u));
        f32x4 s0v = (f32x4){0.f, 0.f, 0.f, 0.f}, s1v = s0v, a, b;
#pragma unroll
        for (int k = 0; k < 16; ++k) { up8(pv[k], a, b); s0v = s0v + a; s1v = s1v + b; }
#pragma unroll
        for (int j = 0; j < 8; ++j) {
            f32x4 ca, cb; up8(cv[j], ca, cb); s0v = s0v + ca; s1v = s1v + cb;
            u32x4 lv = pv[(15 - j) & 15];
            if (g == 2) lv = pv[7 - j];
            if (g == 1) lv = (j < 4) ? pv[3 - (j & 3)] : cv[(j - 4) & 7];
            if (g == 0) lv = (j < 2) ? pv[1 - (j & 1)] : cv[(j - 2) & 7];
            up8(lv, a, b); s0v = s0v - a; s1v = s1v - b;
            const int sj = s0 + j + 1; const float inv = 1.f / (float)(sj < w ? sj : w);
            *(u32x4*)(dp + (ob + (unsigned)j * 1024u)) = pk8(s0v * inv - ca, s1v * inv - cb);
        }
    }
}
__device__ __forceinline__ void stage_aout(const Params& p, int l, int bid, int nb) {
    const int tidx = tid_fresh();
    unsigned char* ws = p.ws;
    const int lane = tidx & 63, wid = tidx >> 6;
    const float* lq = (const float*)p.in[5] + l * 256;
    float d1 = lq[lane] * lq[64 + lane], d2 = lq[128 + lane] * lq[192 + lane];
    d1 = wave_sum(d1); d2 = wave_sum(d2);
    const float lam = expf(d1) - expf(d2) + lam_init_of(l);
    for (int t = bid * 8 + wid; t < T; t += nb * 8) {
        const u32x4 a = *(const u32x4*)((const bf16_t*)(ws + WS_O1) + (size_t)t * 512 + lane * 8), b = *(const u32x4*)((const bf16_t*)(ws + WS_O2) + (size_t)t * 512 + lane * 8);
        float x[8];
#pragma unroll
        for (int e = 0; e < 4; ++e) { x[2 * e] = __uint_as_float(a[e] << 16) - lam * __uint_as_float(b[e] << 16); x[2 * e + 1] = __uint_as_float(a[e] & 0xffff0000u) - lam * __uint_as_float(b[e] & 0xffff0000u); }
        float ss = 0.f;
#pragma unroll
        for (int e = 0; e < 8; ++e) ss += x[e] * x[e];
        ss = sum16(ss);
        const float rs = rsqrtf(ss * (1.f / 128.f) + EPS);
        u32x4 w;
#pragma unroll
        for (int e = 0; e < 4; ++e) w[e] = pk2(x[2 * e] * rs, x[2 * e + 1] * rs);
        *(u32x4*)((bf16_t*)(ws + WS_AO) + (size_t)t * 512 + lane * 8) = w;
    }
}
__device__ __forceinline__ unsigned key_of(float s, unsigned low) { const unsigned u = __float_as_uint(s); const unsigned k = (u & 0x80000000u) ? ~u : (u | 0x80000000u); return (k & ~255u) | low; }
__device__ __forceinline__ float val_of(unsigned key) { const unsigned k = key & ~255u; const unsigned u = (k & 0x80000000u) ? (k & 0x7fffffffu) : ~k; return __uint_as_float(u); }
__device__ __forceinline__ void sort16_desc(unsigned (&a)[16]) {
#pragma unroll
    for (int k = 2; k <= 16; k <<= 1)
#pragma unroll
        for (int j = k >> 1; j > 0; j >>= 1)
#pragma unroll
            for (int i = 0; i < 16; ++i) { const int l = i ^ j; if (l > i) { const unsigned hi = a[i] > a[l] ? a[i] : a[l], lo = a[i] > a[l] ? a[l] : a[i];
                if ((i & k) == 0) { a[i] = hi; a[l] = lo; } else { a[i] = lo; a[l] = hi; } } }
}
__device__ __forceinline__ void merge_top16(unsigned (&r)[16], const unsigned (&b)[16]) {
#pragma unroll
    for (int i = 0; i < 16; ++i) r[i] = r[i] > b[15 - i] ? r[i] : b[15 - i];
#pragma unroll
    for (int j = 8; j > 0; j >>= 1)
#pragma unroll
        for (int i = 0; i < 16; ++i) { const int l = i ^ j; if (l > i) { const unsigned hi = r[i] > r[l] ? r[i] : r[l], lo = r[i] > r[l] ? r[l] : r[i]; r[i] = hi; r[l] = lo; } }
}
__device__ __forceinline__ constexpr int cand_pair(int q) {
    int c = 0;
    for (int a = 0; a < 16; ++a) for (int b = 0; b < 16; ++b) if ((a + 1) * (b + 1) <= 16) { if (c == q) return a * 16 + b; ++c; }
    return -1;
}
template <class Sched>
__device__ __forceinline__ void topk_local(const Params& p, const Sched& O, lds_t lds) {
    const int tidx = tid_fresh(), lane = tidx & 63, wid = __builtin_amdgcn_readfirstlane(tidx >> 6);
    unsigned char* ws = p.ws;
    const _Float16* sc = (const _Float16*)(ws + WS_SC);
    constexpr int PITCH = 272;
    PG8_LAS unsigned char* st = lds + wid * (64 * PITCH);
#pragma unroll 1
    for (int bi = wid; ; bi += 8) {
        pg8::Unit u; if (!O.next(bi >> 2, u)) break;
        const int t0 = u.pm * 256 + (bi & 3) * 64, head = u.pn;
        unsigned la[16], lb[16], blk[16];
#pragma unroll
        for (int h = 0; h < 2; ++h) {
            unsigned (&top)[16] = h == 0 ? la : lb;
            u32x4 w[16];
#pragma unroll
            for (int q = 0; q < 16; ++q) w[q] = *(const u32x4*)(sc + (size_t)(t0 + 4 * q + (lane >> 4)) * 2048 + head * 256 + h * 128 + (lane & 15) * 8);
#pragma unroll
            for (int q = 0; q < 16; ++q) *(PG8_LAS u32x4*)(st + (4 * q + (lane >> 4)) * PITCH + (lane & 15) * 16) = w[q];
#pragma unroll
            for (int n0 = 0; n0 < 128; n0 += 16) {
                const f16x8 h0 = *(const PG8_LAS f16x8*)(st + lane * PITCH + n0 * 2), h1 = *(const PG8_LAS f16x8*)(st + lane * PITCH + n0 * 2 + 16);
#pragma unroll
                for (int e = 0; e < 8; ++e) { blk[e] = key_of((float)h0[e], 255u - (unsigned)(n0 + e)); blk[8 + e] = key_of((float)h1[e], 255u - (unsigned)(n0 + 8 + e)); }
                sort16_desc(blk);
                if (n0 == 0) {
#pragma unroll
                    for (int e = 0; e < 16; ++e) top[e] = blk[e];
                } else merge_top16(top, blk);
            }
        }
        const int i = (t0 + lane) * 8 + head;
        float sa[16], sb[16];
#pragma unroll
        for (int j = 0; j < 16; ++j) { sa[j] = val_of(la[j]); sb[j] = val_of(lb[j]); }
        unsigned lc[16];
#pragma unroll
        for (int q0 = 0; q0 < 64; q0 += 16) {
#pragma unroll
            for (int e = 0; e < 16; ++e) { const int ab = cand_pair(q0 + e); blk[e] = (ab >= 0) ? key_of(sa[ab >= 0 ? (ab >> 4) : 0] + sb[ab >= 0 ? (ab & 15) : 0], 255u - (unsigned)(ab >= 0 ? ab : 0)) : 0u; }
            sort16_desc(blk);
            if (q0 == 0) {
#pragma unroll
                for (int e = 0; e < 16; ++e) lc[e] = blk[e];
            } else merge_top16(lc, blk);
        }
        float g[16]; const float mx = val_of(lc[0]); float sum = 0.f;
#pragma unroll
        for (int j = 0; j < 16; ++j) { g[j] = __expf(val_of(lc[j]) - mx); sum += g[j]; }
        const float inv = 1.f / sum;
        int* ti = (int*)(ws + WS_TI) + (size_t)i * 16;
        int eo[16];
#pragma unroll
        for (int j = 0; j < 16; ++j) {
            const int c = 255 - (int)(lc[j] & 255u), a = c >> 4, b = c & 15;
            unsigned ka = la[0], kb = lb[0];
#pragma unroll
            for (int q = 1; q < 16; ++q) { ka = (a == q) ? la[q] : ka; kb = (b == q) ? lb[q] : kb; }
            const _Float16 gh = (_Float16)(g[j] * inv);
            eo[j] = ((255 - (int)(ka & 255u)) * 128 + (255 - (int)(kb & 255u))) | ((int)__builtin_bit_cast(unsigned short, gh) << 16);
        }
#pragma unroll
        for (int j = 0; j < 16; j += 4) *(int __attribute__((ext_vector_type(4)))*)(ti + j) = (int __attribute__((ext_vector_type(4)))){eo[j], eo[j + 1], eo[j + 2], eo[j + 3]};
    }
}
__device__ __forceinline__ void fstage_pscore(const Params& p, int l, lds_t lds, int bid, int nb) {
    pg8::Order O; O.init(T, 2048, nb, bid, p.ws + WS_XB, D, p.ws + WS_SKT + (size_t)l * 2048 * D * 2, D);
    pg8::gemm_phase<GEpiScaleF16, pg8::Order, true>(lds, D, D, D, O, GEpiScaleF16{p.ws, (_Float16*)(p.ws + WS_SC), 2048});
    topk_local(p, O, lds);
}
#define XB_TMO      128
#define XB_XCNT(j)  (256  + 64 * (j))
#define XB_XSUB(j)  (1280 + 64 * (j))
#define XB_XGEN(j)  (2304 + 64 * (j))
#define XB_TOP      3328
#define XB_TOPGEN   3392
#define XCD_BAR_WORDS 3456
#define XB_SPIN_CAP (1u << 18)
#define LAS __attribute__((address_space(3)))

__device__ __forceinline__ unsigned xb_ld(unsigned* p)              { return __hip_atomic_load(p, __ATOMIC_RELAXED, __HIP_MEMORY_SCOPE_AGENT); }
__device__ __forceinline__ unsigned xb_add(unsigned* p, unsigned v) { return __hip_atomic_fetch_add(p, v, __ATOMIC_RELAXED, __HIP_MEMORY_SCOPE_AGENT); }
__device__ __forceinline__ unsigned xb_xcc_id() { return (unsigned)__builtin_amdgcn_s_getreg((3 << 11) | 20) & 0xFu; }
#define XB_SPIN(cond, bar) do { unsigned _sp = 0; while (cond) { __builtin_amdgcn_s_sleep(1); \
    if ((++_sp & 255u) == 0u) { if (xb_ld(&(bar)[XB_TMO])) break; if (_sp > XB_SPIN_CAP) { atomicAdd(&(bar)[XB_TMO], 1u); break; } } } } while (0)

struct XcdBarrier {
    unsigned* bar; unsigned x;
    volatile LAS unsigned* st;
};

__device__ __forceinline__ XcdBarrier xcd_barrier_post(unsigned* bar, volatile LAS unsigned* st) {
    XcdBarrier b; b.bar = bar; b.x = xb_xcc_id(); b.st = st;
    if (tid_fresh() == 0) (void)xb_add(&bar[XB_XCNT(b.x)], 1u);
    return b;
}
__device__ __forceinline__ void xcd_barrier_complete(unsigned* bar, unsigned x, unsigned& nloc, unsigned& nx) {
    const unsigned G = gridDim.x * gridDim.y * gridDim.z;
    unsigned sum, cnt, mine, sp = 0u;
    for (;;) {
        sum = 0u; cnt = 0u; mine = 0u;
#pragma unroll
        for (unsigned j = 0; j < 16; ++j) { const unsigned c = xb_ld(&bar[XB_XCNT(j)]); sum += c; cnt += (c > 0u) ? 1u : 0u; mine = (j == x) ? c : mine; }
        if (sum == G) break;
        __builtin_amdgcn_s_sleep(1);
        if ((++sp & 255u) == 0u) { if (xb_ld(&bar[XB_TMO])) break; if (sp > XB_SPIN_CAP) { atomicAdd(&bar[XB_TMO], 1u); break; } }
    }
    nloc = mine > 0u ? mine : 1u; nx = cnt > 0u ? cnt : 1u;
}

__device__ __forceinline__ void xcd_barrier(const XcdBarrier& b) {
    asm volatile("s_waitcnt vmcnt(0)" ::: "memory");
    __syncthreads();
    if (tid_fresh() == 0) {
        unsigned* bar = b.bar;
        __builtin_amdgcn_s_waitcnt(0);
        unsigned nloc = b.st[0], nx = b.st[1];
        if (nloc == 0u) { xcd_barrier_complete(bar, b.x, nloc, nx); b.st[0] = nloc; b.st[1] = nx; }
        const unsigned old = xb_add(&bar[XB_XSUB(b.x)], 1u);
        const unsigned gen = old / nloc;
        if (old + 1u == (gen + 1u) * nloc) {
            __builtin_amdgcn_fence(__ATOMIC_RELEASE, "agent");
            asm volatile("s_waitcnt vmcnt(0)" ::: "memory");
            const unsigned og = xb_add(&bar[XB_TOP], 1u);
            const unsigned tg = og / nx;
            if (og + 1u == (tg + 1u) * nx) xb_add(&bar[XB_TOPGEN], 1u);
            else XB_SPIN(xb_ld(&bar[XB_TOPGEN]) == tg, bar);
            __builtin_amdgcn_fence(__ATOMIC_ACQUIRE, "agent");
            xb_add(&bar[XB_XGEN(b.x)], 1u);
            asm volatile("s_waitcnt vmcnt(0)" ::: "memory");
        } else {
            XB_SPIN(xb_ld(&bar[XB_XGEN(b.x)]) == gen, bar);
            __builtin_amdgcn_fence(__ATOMIC_ACQUIRE, "agent");
            asm volatile("s_waitcnt vmcnt(0)" ::: "memory");
        }
    }
    __syncthreads();
}


constexpr int PQ_CH = 16, PQ_NCH = T / PQ_CH;
constexpr int CW_PQ = 16384;
constexpr size_t CTL_ZERO_BYTES = 131072;
__device__ __forceinline__ unsigned pq_pull(unsigned* head, int lane) {
    unsigned c = 0; if (lane == 0) c = __hip_atomic_fetch_add(head, 1u, __ATOMIC_RELAXED, __HIP_MEMORY_SCOPE_AGENT);
    return (unsigned)__builtin_amdgcn_readfirstlane((int)c);
}
__device__ __forceinline__ f32x2 gelu_pk(f32x2 v) {
    const f32x2 av = __builtin_elementwise_abs(v), d = av * 0.2316418882f + 1.0f;
    f32x2 t; t.x = __builtin_amdgcn_rcpf(d.x); t.y = __builtin_amdgcn_rcpf(d.y);
    f32x2 q = t * 0.5307027145f + (-0.7265760135f); q = q * t + 0.7107068705f; q = q * t + (-0.142248368f); q = q * t + 0.127414796f; q = q * t;
    const f32x2 s = (v * v) * (-0.72134752044f);
    f32x2 e; e.x = __builtin_amdgcn_exp2f(s.x); e.y = __builtin_amdgcn_exp2f(s.y);
    const f32x2 m = v * (q * e), r = v - m;
    f32x2 o; o.x = v.x < 0.f ? m.x : r.x; o.y = v.y < 0.f ? m.y : r.y; return o;
}
__device__ __forceinline__ float gelu_erf(float d) { return 0.5f * d * (1.f + erff(d * 0.70710678118654752f)); }

constexpr unsigned ENT_INVALID = 0xffffffffu;
typedef long i64x2 __attribute__((ext_vector_type(2)));
__device__ __forceinline__ void fstage_peer_u(const Params& p, int l, int qsel, lds_t lds, unsigned imask = 16383u, size_t aoff = 0, bool skipg = false) {
    unsigned char* ws = p.ws;
    const int tid = tid_fresh(), lane = tid & 63, wid = __builtin_amdgcn_readfirstlane(tid >> 6), n = lane & 15, kq = lane >> 4;
    const unsigned char* u8 = ws + WS_U8 + (size_t)l * NEXP * D;
    unsigned* heads = (unsigned*)(ws + WS_CTL) + CW_PQ + ((qsel * 2 + 0) * 8) * 64;
    const int myx = (int)(xb_xcc_id() & 7u);
    float* Aout = (float*)(ws + WS_PA + aoff);
    constexpr int RB_BYTES = 16 * 1024, LIST_MAX = 400, WREG = RB_BYTES + (LIST_MAX + 16) * 8;
    PG8_LAS unsigned char* rbuf = lds + wid * WREG;
    PG8_LAS unsigned* ent = (PG8_LAS unsigned*)(rbuf + RB_BYTES);
    PG8_LAS float* gl = (PG8_LAS float*)(rbuf + RB_BYTES + (LIST_MAX + 16) * 4);
#pragma unroll 1
    for (int s8 = 0; s8 < 8; ++s8) {
        const int k = (myx + s8) & 7;
        unsigned c = pq_pull(heads + k * 64, lane);
#pragma unroll 1
        for (;;) {
            if (c >= (unsigned)PQ_NCH) break;
            const int t0 = (int)c * PQ_CH;
            unsigned c_next = c; bool pulled = false;
            int mxs = 0x7f7f7f7f; asm volatile("" : "+v"(mxs));
            pg8::i32x8_t xf8[8];
            { const unsigned char* xp = ws + WS_XQ8 + (size_t)(t0 + n) * D + kq * 16;
#pragma unroll
              for (int i = 0; i < 8; ++i) { const pg8::i32x4_t lo = *(const pg8::i32x4_t*)(xp + (2 * i) * 64), hi = *(const pg8::i32x4_t*)(xp + (2 * i + 1) * 64); xf8[i] = __builtin_shufflevector(lo, hi, 0, 1, 2, 3, 4, 5, 6, 7); } }
            const float rs = row_rstd((const float*)(ws + WS_SSP), t0 + n) * (1.f / (SU * XS));
            float* ao = Aout + (size_t)(t0 + n) * 128;
            int i_next = 0;
#pragma unroll 1
            while (i_next < 16) {
                int e0v[16], e1v[16];
                { const int* ti = (const int*)(ws + WS_TI) + (size_t)t0 * 128;
#pragma unroll
                  for (int i = 0; i < 16; ++i) { e0v[i] = ti[i * 128 + lane]; e1v[i] = ti[i * 128 + 64 + lane]; } }
                int cnt = 0; int i_end = 16;
#pragma unroll
                for (int i = 0; i < 16; ++i) {
                    if (i >= i_next && i < i_end) {
                        if (cnt > LIST_MAX - 128) { i_end = i; }
                        else {
                            const int e0 = e0v[i] & 16383, e1 = e1v[i] & 16383;
                            const bool s0 = (e0 >> 11) == k, s1 = (e1 >> 11) == k;
                            const unsigned long long m0 = __ballot(s0), m1 = __ballot(s1);
                            const int b0 = (int)__builtin_amdgcn_mbcnt_hi((unsigned)(m0 >> 32), __builtin_amdgcn_mbcnt_lo((unsigned)m0, 0u));
                            const int b1 = (int)__builtin_amdgcn_mbcnt_hi((unsigned)(m1 >> 32), __builtin_amdgcn_mbcnt_lo((unsigned)m1, 0u));
                            const int c0 = __builtin_popcountll(m0);
                            if (s0) { ent[cnt + b0] = ((unsigned)i << 21) | ((unsigned)lane << 14) | (unsigned)e0; gl[cnt + b0] = (float)__builtin_bit_cast(_Float16, (unsigned short)((unsigned)e0v[i] >> 16)); }
                            if (s1) { ent[cnt + c0 + b1] = ((unsigned)i << 21) | ((unsigned)(64 + lane) << 14) | (unsigned)e1; gl[cnt + c0 + b1] = (float)__builtin_bit_cast(_Float16, (unsigned short)((unsigned)e1v[i] >> 16)); }
                            cnt += c0 + __builtin_popcountll(m1);
                        }
                    }
                }
                i_next = i_end;
                if (cnt == 0) continue;
                if (lane < 16) ent[cnt + lane] = ENT_INVALID;
                const int ng = skipg ? 0 : ((cnt + 15) >> 4);
                u32x4 W[16];
#define PU_LOAD(g_) do { const PG8_LAS u32x4* ep_ = (const PG8_LAS u32x4*)(ent + (g_) * 16); const u32x4 q0_ = ep_[0], q1_ = ep_[1], q2_ = ep_[2], q3_ = ep_[3]; \
                    _Pragma("unroll") for (int q = 0; q < 16; ++q) { const unsigned e_ = (q < 4) ? q0_[q & 3] : (q < 8) ? q1_[q & 3] : (q < 12) ? q2_[q & 3] : q3_[q & 3]; \
                        const unsigned iq_ = (e_ == ENT_INVALID) ? 0u : (e_ & imask); W[q] = *(const u32x4*)(u8 + (size_t)iq_ * D + lane * 16); } } while (0)
                if (!pulled) { pulled = true; c_next = pq_pull(heads + k * 64, lane); }
                if (ng > 0) PU_LOAD(0);
#pragma unroll 1
                for (int g = 0; g < ng; ++g) {
#pragma unroll
                    for (int q = 0; q < 16; ++q) *(PG8_LAS u32x4*)(rbuf + q * 1024 + ((lane ^ q) * 16)) = W[q];
                    if (g + 1 < ng) PU_LOAD(g + 1);
                    f32x4 acc;
                    const PG8_LAS unsigned char* fp = rbuf + n * 1024;
#pragma unroll
                    for (int Lb = 0; Lb < 16; Lb += 4) {
                        pg8::i32x4_t fa[4];
#pragma unroll
                        for (int L = 0; L < 4; ++L) fa[L] = *(const PG8_LAS pg8::i32x4_t*)(fp + ((((Lb + L) * 4 + kq) ^ n) * 16));
                        __builtin_amdgcn_sched_barrier(0);
                        const pg8::i32x8_t a0 = __builtin_shufflevector(fa[0], fa[1], 0, 1, 2, 3, 4, 5, 6, 7), a1 = __builtin_shufflevector(fa[2], fa[3], 0, 1, 2, 3, 4, 5, 6, 7);
                        if (Lb == 0) asm volatile("v_mfma_scale_f32_16x16x128_f8f6f4 %0, %1, %2, 0, %3, %3 op_sel_hi:[0,0,0]" : "=v"(acc) : "v"(a0), "v"(xf8[0]), "v"(mxs));
                        else asm volatile("v_mfma_scale_f32_16x16x128_f8f6f4 %0, %1, %2, %0, %3, %3 op_sel_hi:[0,0,0]" : "+v"(acc) : "v"(a0), "v"(xf8[Lb >> 1]), "v"(mxs));
                        asm volatile("v_mfma_scale_f32_16x16x128_f8f6f4 %0, %1, %2, %0, %3, %3 op_sel_hi:[0,0,0]" : "+v"(acc) : "v"(a1), "v"(xf8[(Lb >> 1) + 1]), "v"(mxs));
                        __builtin_amdgcn_sched_barrier(0);
                    }
                    asm volatile("s_nop 15\n\ts_nop 7" : "+v"(acc) :: "memory");
                    {
                        const u32x4 e4 = *(const PG8_LAS u32x4*)(ent + g * 16 + 4 * kq); const f32x4 g4 = *(const PG8_LAS f32x4*)(gl + g * 16 + 4 * kq);
#pragma unroll
                        for (int r = 0; r < 4; r += 2) { const f32x2 ge = gelu_pk((f32x2){acc[r] * rs, acc[r + 1] * rs});
                            if (e4[r] != ENT_INVALID && (int)(e4[r] >> 21) == n) ao[(e4[r] >> 14) & 127u] = ge.x * g4[r];
                            if (e4[r + 1] != ENT_INVALID && (int)(e4[r + 1] >> 21) == n) ao[(e4[r + 1] >> 14) & 127u] = ge.y * g4[r + 1]; }
                    }
                }
#undef PU_LOAD
            }
            if (!pulled) c_next = pq_pull(heads + k * 64, lane);
            c = c_next;
        }
    }
}

constexpr float AS = 32.f;
__device__ __forceinline__ void tr4x4(unsigned a, unsigned b, unsigned c, unsigned d, unsigned& o0, unsigned& o1, unsigned& o2, unsigned& o3) {
    const unsigned p0 = __builtin_amdgcn_perm(b, a, 0x05010400u), p1 = __builtin_amdgcn_perm(b, a, 0x07030602u), p2 = __builtin_amdgcn_perm(d, c, 0x05010400u), p3 = __builtin_amdgcn_perm(d, c, 0x07030602u);
    o0 = __builtin_amdgcn_perm(p2, p0, 0x05040100u); o1 = __builtin_amdgcn_perm(p2, p0, 0x07060302u); o2 = __builtin_amdgcn_perm(p3, p1, 0x05040100u); o3 = __builtin_amdgcn_perm(p3, p1, 0x07060302u);
}
__device__ __forceinline__ void fstage_peer_v(const Params& p, int l, int qsel, bool dry, lds_t lds, int imask = 16383) {
    unsigned char* ws = p.ws;
    const int tid = tid_fresh(), lane = tid & 63, wid = __builtin_amdgcn_readfirstlane(tid >> 6), n = lane & 15, kq = lane >> 4, n8 = n & 7, h = n >> 3;
    const unsigned char* v8 = ws + WS_V8 + (size_t)l * NEXP * D;
    unsigned* heads = (unsigned*)(ws + WS_CTL) + CW_PQ + ((qsel * 2 + 1) * 8) * 64;
    const int myx = (int)(xb_xcc_id() & 7u);
    PG8_LAS int* til = (PG8_LAS int*)(lds + wid * 8192);
#pragma unroll 1
    for (int s8 = 0; s8 < 8; ++s8) {
        const int k = (myx + s8) & 7;
#pragma unroll 1
        for (;;) {
            const unsigned c = pq_pull(heads + k * 64, lane);
            if (c >= (unsigned)PQ_NCH) break;
            const int t0 = (int)c * PQ_CH;
            unsigned koff = (unsigned)n8 * 16u; asm volatile("" : "+v"(koff));
            const unsigned char* vb = v8 + (size_t)k * NEXP * 128;
            { const int* ti = (const int*)(ws + WS_TI) + (size_t)t0 * 128; int ev[32];
#pragma unroll
              for (int i = 0; i < 32; ++i) ev[i] = ti[i * 64 + lane];
#pragma unroll
              for (int i = 0; i < 32; ++i) til[i * 64 + lane] = ev[i] & (imask & 16383); }
            u32x4 R[4][8];
            typedef int i32x4 __attribute__((ext_vector_type(4)));
#define PV_ISSUE(b, slot) do { const PG8_LAS i32x4* ip_ = (const PG8_LAS i32x4*)(til + ((b) >> 1) * 128 + ((b) & 1) * 64 + h * 32 + kq * 8); const i32x4 i0_ = ip_[0], i1_ = ip_[1]; \
                _Pragma("unroll") for (int e_ = 0; e_ < 4; ++e_) { R[slot][e_] = *(const u32x4*)(vb + ((unsigned)i0_[e_] * 128u + koff)); R[slot][4 + e_] = *(const u32x4*)(vb + ((unsigned)i1_[e_] * 128u + koff)); } } while (0)
#define PV_COMPUTE(tok8, aq, slot) do { const long aop_ = ((n >> 1) == (tok8)) ? (aq) : 0l; \
                _Pragma("unroll") for (int c_ = 0; c_ < 4; ++c_) { unsigned lo_[4], hi_[4]; \
                    tr4x4(R[slot][0][c_], R[slot][1][c_], R[slot][2][c_], R[slot][3][c_], lo_[0], lo_[1], lo_[2], lo_[3]); \
                    tr4x4(R[slot][4][c_], R[slot][5][c_], R[slot][6][c_], R[slot][7][c_], hi_[0], hi_[1], hi_[2], hi_[3]); \
                    _Pragma("unroll") for (int j_ = 0; j_ < 4; ++j_) { const long b_ = (long)(((unsigned long)hi_[j_] << 32) | (unsigned long)lo_[j_]); \
                        acc[4 * c_ + j_] = __builtin_amdgcn_mfma_f32_16x16x32_fp8_fp8(aop_, b_, acc[4 * c_ + j_], 0, 0, 0); } } } while (0)
#pragma unroll
            for (int b = 0; b < 3; ++b) PV_ISSUE(b, b);
#pragma unroll 1
            for (int ps = 0; ps < 2; ++ps) {
                f32x4 acc[16];
#pragma unroll
                for (int j = 0; j < 16; ++j) acc[j] = (f32x4){0.f, 0.f, 0.f, 0.f};
                long aq0, aq1;
                { const float* ap = (const float*)(ws + WS_PA) + (size_t)(t0 + ps * 8 + (n >> 1)) * 128 + (n & 1) * 32 + kq * 8;
                  const f32x4 a0 = *(const f32x4*)ap, a1 = *(const f32x4*)(ap + 4), a2 = *(const f32x4*)(ap + 64), a3 = *(const f32x4*)(ap + 68);
                  int w0 = __builtin_amdgcn_cvt_pk_fp8_f32(a0[0] * AS, a0[1] * AS, 0, false); w0 = __builtin_amdgcn_cvt_pk_fp8_f32(a0[2] * AS, a0[3] * AS, w0, true);
                  int w1 = __builtin_amdgcn_cvt_pk_fp8_f32(a1[0] * AS, a1[1] * AS, 0, false); w1 = __builtin_amdgcn_cvt_pk_fp8_f32(a1[2] * AS, a1[3] * AS, w1, true);
                  int w2 = __builtin_amdgcn_cvt_pk_fp8_f32(a2[0] * AS, a2[1] * AS, 0, false); w2 = __builtin_amdgcn_cvt_pk_fp8_f32(a2[2] * AS, a2[3] * AS, w2, true);
                  int w3 = __builtin_amdgcn_cvt_pk_fp8_f32(a3[0] * AS, a3[1] * AS, 0, false); w3 = __builtin_amdgcn_cvt_pk_fp8_f32(a3[2] * AS, a3[3] * AS, w3, true);
                  aq0 = (long)(((unsigned long)(unsigned)w1 << 32) | (unsigned long)(unsigned)w0); aq1 = (long)(((unsigned long)(unsigned)w3 << 32) | (unsigned long)(unsigned)w2); }
#pragma unroll 1
                for (int b0 = 0; b0 < 16; b0 += 4) {
#pragma unroll
                    for (int s = 0; s < 4; ++s) {
                        const int bn = ps * 16 + b0 + s + 3;
                        if (bn < 32) PV_ISSUE(bn, (s + 3) & 3);
                        PV_COMPUTE((b0 + s) >> 1, (s & 1) ? aq1 : aq0, s);
                    }
                }
                int n8e = n8, kqe = kq; asm volatile("" : "+v"(n8e), "+v"(kqe));
                const int t = t0 + ps * 8 + 2 * kqe + h;
                float o[16];
#pragma unroll
                for (int j = 0; j < 16; ++j) { const float send = h ? acc[j][1] : acc[j][2]; const float recv = dppf<DPP_X8>(send); o[j] = (h ? acc[j][3] : acc[j][0]) + recv; }
                bf16_t* xr = (bf16_t*)(ws + WS_XB) + (size_t)t * D + k * 128 + n8e * 16;
                const float sc = 1.f / (SV * AS);
                float ss = 0.f;
#pragma unroll
                for (int g = 0; g < 2; ++g) {
                    f32x4 v0, v1; up8(*(const u32x4*)(xr + g * 8), v0, v1);
                    v0[0] += o[8 * g + 0] * sc; v0[1] += o[8 * g + 1] * sc; v0[2] += o[8 * g + 2] * sc; v0[3] += o[8 * g + 3] * sc;
                    v1[0] += o[8 * g + 4] * sc; v1[1] += o[8 * g + 5] * sc; v1[2] += o[8 * g + 6] * sc; v1[3] += o[8 * g + 7] * sc;
                    const u32x4 wq = pk8(v0, v1); up8(wq, v0, v1);
                    if (!dry) { *(u32x4*)(xr + g * 8) = wq; *(u32x2*)(ws + WS_XQ8 + (size_t)t * D + k * 128 + n8e * 16 + g * 8) = pk8_fp8(v0, v1, XS); }
                    ss += (v0[0] * v0[0] + v0[1] * v0[1]) + (v0[2] * v0[2] + v0[3] * v0[3]) + (v1[0] * v1[0] + v1[1] * v1[1]) + (v1[2] * v1[2] + v1[3] * v1[3]);
                }
                ss += dppf<DPP_X1>(ss); ss += dppf<DPP_X2>(ss); ss += dppf<DPP_HMIR>(ss);
                if (n8e < 2 && !dry) ((float*)(ws + WS_SSP))[(size_t)t * 16 + 2 * k + n8e] = (n8e == 0) ? ss : 0.f;
            }
#undef PV_ISSUE
#undef PV_COMPUTE
        }
    }
}
__device__ __forceinline__ void fstage_final_norm(const Params& p) {
    const int tid = tid_fresh(), lane = tid & 63, wid = tid >> 6;
    const float* gfin = (const float*)p.in[25];
    for (int t = blockIdx.x * 8 + wid; t < T; t += gridDim.x * 8) {
        const float r = row_rstd((const float*)(p.ws + WS_SSP), t);
        const bf16_t* xr = (const bf16_t*)(p.ws + WS_XB) + (size_t)t * D; float* o = p.out + (size_t)t * D;
#pragma unroll
        for (int i = 0; i < 2; ++i) { f32x4 a, b; up8(*(const u32x4*)(xr + (lane + 64 * i) * 8), a, b);
            const f32x4 g0 = *(const f32x4*)(gfin + (lane + 64 * i) * 8), g1 = *(const f32x4*)(gfin + (lane + 64 * i) * 8 + 4);
            *(f32x4*)(o + (lane + 64 * i) * 8) = a * r * g0; *(f32x4*)(o + (lane + 64 * i) * 8 + 4) = b * r * g1; }
    }
}

extern __shared__ __attribute__((aligned(16))) unsigned char dyn_lds[];
constexpr int LDS_BYTES = 163840;
constexpr int LDS_BARW = LDS_BYTES - 64;

__device__ __forceinline__ Params ldp() {
    Params r;
#if defined(__HIP_DEVICE_COMPILE__)
    const __attribute__((address_space(4))) unsigned long long* k = (const __attribute__((address_space(4))) unsigned long long*)__builtin_amdgcn_kernarg_segment_ptr();
    asm volatile("" : "+s"(k));
#pragma unroll
    for (int i = 0; i < 26; ++i) r.in[i] = (const void*)(const __attribute__((address_space(1))) void*)k[i];
    r.out = (float*)(__attribute__((address_space(1))) float*)k[26]; r.ws = (unsigned char*)(__attribute__((address_space(1))) unsigned char*)k[27];
#endif
    return r;
}
__device__ __forceinline__ int rep_of(int k) { int n = (PROBE == k) ? 2 : 1; asm volatile("" : "+s"(n)); return n; }
#if PROBE == 0
#define REP(k) for (int r_ = 0, n_ = 1; r_ < 1; ++r_)
#else
#define REP(k) for (int r_ = 0, n_ = rep_of(k); r_ < n_; ++r_)
#endif
#define PH(call) do { const Params q = ldp(); int bid = bid0, nb = nb0, l = l0; asm volatile("" : "+s"(bid), "+s"(nb), "+s"(l)); (void)l; call; } while (0)
__global__ void __launch_bounds__(NT, 2) mega(Params p_unused) {
    const int bid0 = blockIdx.x, nb0 = gridDim.x; int l0 = 0;
    float* lds = (float*)dyn_lds; const lds_t ldsp = (lds_t)dyn_lds;
    { const int w0_ = __builtin_amdgcn_readfirstlane((int)(threadIdx.x >> 6)); asm volatile("s_mov_b32 m0, %0" :: "s"(w0_)); }
    if (tid_fresh() == 0) *(uint4*)(dyn_lds + LDS_BARW) = make_uint4(0u, 0u, 0u, 0u);
    __syncthreads();
    { const Params q = ldp(); (void)xcd_barrier_post((unsigned*)(q.ws + WS_CTL), (volatile LAS unsigned*)(dyn_lds + LDS_BARW)); }
#define GRID_BAR() do { const Params q = ldp(); XcdBarrier b_; b_.bar = (unsigned*)(q.ws + WS_CTL); b_.x = xb_xcc_id(); b_.st = (volatile LAS unsigned*)(dyn_lds + LDS_BARW); xcd_barrier(b_); if (PROBE == 20) xcd_barrier(b_); } while (0)
    REP(1) { PH(stage_prologue0(q, bid, nb, lds)); GRID_BAR(); }
    REP(2) { PH(stage_prologue1(q, bid, nb)); PH(fstage_kv(q, ldsp, bid, nb)); GRID_BAR();
    PH(fstage_g(q, ldsp, bid, nb)); PH(fstage_y(q, ldsp, bid, nb));     GRID_BAR(); }

#pragma unroll 1
    for (l0 = 0; l0 < L; ++l0) {
        REP(9) { PH(fstage_win(q, l, ldsp, bid, nb)); GRID_BAR(); }
        REP(7) { PH(fstage_attn(q, l, (char*)dyn_lds)); } REP(4) { PH(stage_pool_d(q, bid, nb)); PH(fstage_sgate(q, l, ldsp)); } GRID_BAR();
#if PROBE == 21
        PH(fstage_branch<false>(q, l, ldsp, bid, nb)); GRID_BAR();
#endif
        REP(10) { PH(fstage_branch(q, l, ldsp, bid, nb)); GRID_BAR(); }
        PH(fstage_resid_out(q, l, ldsp, bid, nb)); GRID_BAR();
        REP(11) { PH(fstage_xscore(q, l, ldsp, bid, nb)); GRID_BAR(); }
        PH(fstage_resid_cross(q, l, ldsp, bid, nb)); GRID_BAR();
        REP(12) { PH(fstage_pscore(q, l, ldsp, bid, nb)); GRID_BAR(); }
        REP(13) { PH(fstage_peer_u(q, l, l + 4 * r_, ldsp)); GRID_BAR(); }
#if PROBE == 15
        PH(fstage_peer_u(q, l, l + 4, ldsp, 255u, 16 * MiB)); GRID_BAR();
#endif
#if PROBE == 17
        { int sk_ = 1; asm volatile("" : "+s"(sk_)); PH(fstage_peer_u(q, l, l + 4, ldsp, 16383u, 16 * MiB, sk_ != 0)); GRID_BAR(); }
#endif
        REP(14) { bool dry_ = (r_ == 0 && n_ == 2); PH(fstage_peer_v(q, l, l + 4 * r_, dry_, ldsp)); GRID_BAR(); }
#if PROBE == 16
        PH(fstage_peer_v(q, l, l + 4, true, ldsp, 255)); GRID_BAR();
#endif
    }
    PH(fstage_final_norm(q));
}

extern "C" void kernel_launch(void* const* d_in, const int* in_sizes, int n_in, void* d_out, int out_size, void* d_ws, size_t ws_size, hipStream_t stream) {
    Params p{};
    for (int i = 0; i < 26; ++i) p.in[i] = d_in[i];
    p.out = (float*)d_out; p.ws = (unsigned char*)d_ws;
    static int grid = 0;
    if (!grid) {
        int dev = 0, cus = 0, per_cu = 0;
        (void)hipGetDevice(&dev);
        (void)hipDeviceGetAttribute(&cus, hipDeviceAttributeMultiprocessorCount, dev);
        (void)hipFuncSetAttribute((const void*)mega, hipFuncAttributeMaxDynamicSharedMemorySize, LDS_BYTES);
        (void)hipOccupancyMaxActiveBlocksPerMultiprocessor(&per_cu, mega, NT, LDS_BYTES);
        grid = cus * (per_cu < 1 ? per_cu : 1);
    }
    (void)hipMemsetAsync(p.ws + WS_CTL, 0, CTL_ZERO_BYTES, stream);
    mega<<<grid, NT, LDS_BYTES, stream>>>(p);
}
```

```cpp
#include <hip/hip_runtime.h>
#ifndef PROBE
#define PROBE 0
#endif
#include <stdint.h>
#include <math.h>

typedef unsigned short bf16_t;
typedef short bf16x8 __attribute__((ext_vector_type(8)));
typedef float f32x4 __attribute__((ext_vector_type(4)));
typedef float f32x2 __attribute__((ext_vector_type(2)));
typedef unsigned u32x4 __attribute__((ext_vector_type(4)));
typedef unsigned u32x2 __attribute__((ext_vector_type(2)));

constexpr int D = 1024, NB = 8, S = 4096, T = NB * S, L = 4, MEM = 256, MROWS = NB * MEM;
constexpr int INW = 6144, NEXP = 16384;
constexpr float EPS = 1e-6f;
constexpr float C2 = 0.125f * 1.4426950408889634f;
constexpr float SU = 256.f, SV = 32.f;
constexpr float XS = 8.f;
constexpr float W8S = 256.f;
constexpr float GS = 16.f, YS = 16.f, PS = 256.f;
constexpr int NT = 512;

constexpr size_t MiB = 1u << 20;
constexpr size_t WS_CTL = 0, WS_ROPE = 1 * MiB, WS_SSP = 3 * MiB, WS_WSPT = 5 * MiB, WS_RSTDM = 6 * MiB, WS_WPOOLS = 7 * MiB, WS_KEYSB = 8 * MiB;
constexpr size_t WS_WIN = 10 * MiB, WS_WB0 = 58 * MiB, WS_WEFF = 62 * MiB, WS_WB2 = 66 * MiB, WS_WOUT = 70 * MiB, WS_GT = 78 * MiB, WS_YT = 142 * MiB;
constexpr size_t WS_SKT = 206 * MiB, WS_U8 = 222 * MiB, WS_V8 = 286 * MiB, WS_XB = 350 * MiB, WS_TI = 414 * MiB, WS_TG = 430 * MiB, WS_MX = 446 * MiB;
constexpr size_t WS_GTE = WS_MX, WS_QB = WS_MX + 192 * MiB, WS_KB = WS_MX + 224 * MiB, WS_VB = WS_MX + 256 * MiB, WS_PIN = WS_MX + 288 * MiB, WS_DP = WS_MX + 320 * MiB;
constexpr size_t WS_UIN = WS_MX + 352 * MiB, WS_VIN = WS_MX + 384 * MiB, WS_O1 = WS_MX + 416 * MiB, WS_O2 = WS_MX + 448 * MiB, WS_SO = WS_MX + 480 * MiB, WS_END = WS_MX + 512 * MiB;
constexpr size_t WS_PA = WS_END;
constexpr size_t WS_XQ8 = WS_PA + 32 * MiB;
constexpr size_t WS_AO = WS_QB, WS_MG = WS_KB, WS_SX = WS_MX, WS_PM = WS_O1, WS_SC = WS_MX;
constexpr size_t WS_MEMB = WS_MX, WS_WXQB = WS_MX + 4 * MiB, WS_WXOT = WS_MX + 12 * MiB, WS_WXKVT = WS_MX + 20 * MiB, WS_KV = WS_MX + 36 * MiB, WS_WB1T = WS_MX + 68 * MiB, WS_WPQB = WS_MX + 72 * MiB;
static_assert(WS_XQ8 + 32 * MiB <= 1024 * MiB, "workspace map");

struct Params { const void* in[26]; float* out; unsigned char* ws; };

__device__ __forceinline__ float bf2f(bf16_t v) { return __uint_as_float(((unsigned)v) << 16); }
__device__ __forceinline__ bf16_t f2bf(float f) { unsigned u = __float_as_uint(f); return (bf16_t)((u + 0x7fffu + ((u >> 16) & 1u)) >> 16); }
typedef __bf16 hwbf16x2 __attribute__((ext_vector_type(2)));
__device__ __forceinline__ unsigned pk2(float lo, float hi) { const f32x2 v = {lo, hi}; return __builtin_bit_cast(unsigned, __builtin_convertvector(v, hwbf16x2)); }
template <int CTRL> __device__ __forceinline__ float dppf(float v) { return __builtin_bit_cast(float, __builtin_amdgcn_update_dpp(0, __builtin_bit_cast(int, v), CTRL, 0xF, 0xF, true)); }
constexpr int DPP_X1 = 0xB1, DPP_X2 = 0x4E, DPP_HMIR = 0x141, DPP_MIR = 0x140, DPP_X8 = 0x128;
__device__ __forceinline__ float lx16(float v) { float r; asm volatile("ds_swizzle_b32 %0, %1 offset:swizzle(SWAP,16)\n\ts_waitcnt lgkmcnt(0)" : "=v"(r) : "v"(v)); return r; }
__device__ __forceinline__ float add_x32(float v) { const auto rr = __builtin_amdgcn_permlane32_swap(__float_as_uint(v), __float_as_uint(v), false, false); return __uint_as_float(rr[0]) + __uint_as_float(rr[1]); }
__device__ __forceinline__ float max_x32(float v) { const auto rr = __builtin_amdgcn_permlane32_swap(__float_as_uint(v), __float_as_uint(v), false, false); return fmaxf(__uint_as_float(rr[0]), __uint_as_float(rr[1])); }
__device__ __forceinline__ float sum16(float v) { v += dppf<DPP_X1>(v); v += dppf<DPP_X2>(v); v += dppf<DPP_HMIR>(v); v += dppf<DPP_MIR>(v); return v; }
__device__ __forceinline__ float max16(float v) { v = fmaxf(v, dppf<DPP_X1>(v)); v = fmaxf(v, dppf<DPP_X2>(v)); v = fmaxf(v, dppf<DPP_HMIR>(v)); v = fmaxf(v, dppf<DPP_MIR>(v)); return v; }
__device__ __forceinline__ float wave_sum(float v) { v = sum16(v); v += lx16(v); return add_x32(v); }
__device__ __forceinline__ float wave_max(float v) { v = max16(v); v = fmaxf(v, lx16(v)); return max_x32(v); }
__device__ __forceinline__ int tid_fresh() { unsigned w, ln; asm volatile("s_mov_b32 %0, m0\n\tv_mbcnt_lo_u32_b32 %1, -1, 0\n\tv_mbcnt_hi_u32_b32 %1, -1, %1" : "=s"(w), "=v"(ln)); return (int)((w << 6) | ln); }
__device__ __forceinline__ float row_rstd(const float* ssp, int row) {
    const f32x4* p = (const f32x4*)(ssp + (size_t)row * 16);
    f32x4 a = p[0], b = p[1], c = p[2], d = p[3];
    float s = (a[0] + a[1] + a[2] + a[3]) + (b[0] + b[1] + b[2] + b[3]) + (c[0] + c[1] + c[2] + c[3]) + (d[0] + d[1] + d[2] + d[3]);
    return rsqrtf(s * (1.f / D) + EPS);
}
__device__ __forceinline__ float lam_init_of(int l) { return 0.8f - 0.6f * expf(-0.3f * (float)l); }

__device__ __forceinline__ u32x2 pk8_fp8(f32x4 a, f32x4 b, float sc);
__device__ __forceinline__ u32x4 pk8(f32x4 a, f32x4 b);
__device__ __forceinline__ void tr_conv(const float* __restrict__ src, bf16_t* __restrict__ dst, int K, int N, const float* gain, int gmask, float gmul, int bid, int nb, float* tile, int ldd = 0, int lds_src = 0) {
    const int tidx = tid_fresh();
    const int tx = tidx & 63, ty = tidx >> 6;
    const int tn = N / 64, nt = (K / 64) * tn, sp = lds_src ? lds_src : N;
    float r[8], rn[8];
    int it = bid;
    if (it < nt) { const int k0 = (it / tn) * 64, n0 = (it % tn) * 64;
#pragma unroll
        for (int i = 0; i < 8; ++i) { const int k = ty + 8 * i; r[i] = src[(size_t)(k0 + k) * sp + n0 + tx]; if (gain) r[i] *= gain[(k0 + k) & gmask] * gmul; } }
    while (it < nt) {
        const int k0 = (it / tn) * 64, n0 = (it % tn) * 64, nx = it + nb;
        if (nx < nt) { const int k1 = (nx / tn) * 64, n1 = (nx % tn) * 64;
#pragma unroll
            for (int i = 0; i < 8; ++i) { const int k = ty + 8 * i; rn[i] = src[(size_t)(k1 + k) * sp + n1 + tx]; if (gain) rn[i] *= gain[(k1 + k) & gmask] * gmul; } }
        __syncthreads();
#pragma unroll
        for (int i = 0; i < 8; ++i) tile[(ty + 8 * i) * 65 + tx] = r[i];
        __syncthreads();
        { const int n = tidx >> 3, kq = (tidx & 7) * 8;
          f32x4 a, b;
#pragma unroll
          for (int e = 0; e < 4; ++e) { a[e] = tile[(kq + e) * 65 + n]; b[e] = tile[(kq + 4 + e) * 65 + n]; }
          *(u32x4*)(dst + (size_t)(n0 + n) * (ldd ? ldd : K) + k0 + kq) = pk8(a, b); }
#pragma unroll
        for (int i = 0; i < 8; ++i) r[i] = rn[i];
        it = nx;
    }
}
__device__ __forceinline__ void tr_conv8(const float* __restrict__ src, unsigned char* __restrict__ dst, int K, int N, const float* gain, float scale, int sp, int bid, int nb, float* tile) {
    const int tidx = tid_fresh();
    const int tx = tidx & 63, ty = tidx >> 6;
    const int tn = N / 64, nt = (K / 64) * tn;
    float r[8], rn[8];
    int it = bid;
    if (it < nt) { const int k0 = (it / tn) * 64, n0 = (it % tn) * 64;
#pragma unroll
        for (int i = 0; i < 8; ++i) { const int k = ty + 8 * i; r[i] = src[(size_t)(k0 + k) * sp + n0 + tx] * gain[k0 + k] * scale; } }
    while (it < nt) {
        const int k0 = (it / tn) * 64, n0 = (it % tn) * 64, nx = it + nb;
        if (nx < nt) { const int k1 = (nx / tn) * 64, n1 = (nx % tn) * 64;
#pragma unroll
            for (int i = 0; i < 8; ++i) { const int k = ty + 8 * i; rn[i] = src[(size_t)(k1 + k) * sp + n1 + tx] * gain[k1 + k] * scale; } }
        __syncthreads();
#pragma unroll
        for (int i = 0; i < 8; ++i) tile[(ty + 8 * i) * 65 + tx] = r[i];
        __syncthreads();
        { const int n = tidx >> 3, kq = (tidx & 7) * 8;
          f32x4 a, b;
#pragma unroll
          for (int e = 0; e < 4; ++e) { a[e] = tile[(kq + e) * 65 + n]; b[e] = tile[(kq + 4 + e) * 65 + n]; }
          *(u32x2*)(dst + (size_t)(n0 + n) * K + k0 + kq) = pk8_fp8(a, b, 1.f); }
#pragma unroll
        for (int i = 0; i < 8; ++i) r[i] = rn[i];
        it = nx;
    }
}
__device__ __forceinline__ void conv_plain(const float* __restrict__ src, bf16_t* __restrict__ dst, size_t n, int bid, int nb, const float* rowgain = nullptr) {
    const int tidx = tid_fresh();
    const size_t n4 = n / 4, st = (size_t)nb * NT;
    for (size_t i0 = (size_t)bid * NT + tidx; i0 < n4; i0 += 8 * st) {
        f32x4 v[8];
#pragma unroll
        for (int u = 0; u < 8; ++u) { const size_t i = i0 + u * st; v[u] = (i < n4) ? ((const f32x4*)src)[i] : (f32x4){0.f, 0.f, 0.f, 0.f}; }
#pragma unroll
        for (int u = 0; u < 8; ++u) { const size_t i = i0 + u * st; if (i < n4) { f32x4 x = v[u]; if (rowgain) x = x * rowgain[i >> 8];
            u32x2 w; w.x = pk2(x[0], x[1]); w.y = pk2(x[2], x[3]); ((u32x2*)dst)[i] = w; } }
    }
}
__device__ __forceinline__ void conv_fp8(const float* __restrict__ src, unsigned* __restrict__ dst, const float* gain, float scale, bool slice_major, int bid, int nb) {
    const int tidx = tid_fresh();
    const size_t n4 = (size_t)NEXP * D / 4, st = (size_t)nb * NT;
    for (size_t i0 = (size_t)bid * NT + tidx; i0 < n4; i0 += 8 * st) {
        f32x4 v[8];
#pragma unroll
        for (int u = 0; u < 8; ++u) { const size_t i = i0 + u * st; v[u] = (i < n4) ? ((const f32x4*)src)[i] : (f32x4){0.f, 0.f, 0.f, 0.f}; }
#pragma unroll
        for (int u = 0; u < 8; ++u) { const size_t i = i0 + u * st; if (i < n4) { f32x4 x = v[u];
            if (gain) { const f32x4 g = ((const f32x4*)gain)[i & (D / 4 - 1)]; x = x * g; }
            x = x * scale;
            int w = __builtin_amdgcn_cvt_pk_fp8_f32(x[0], x[1], 0, false);
            w = __builtin_amdgcn_cvt_pk_fp8_f32(x[2], x[3], w, true);
            size_t o = i;
            if (slice_major) { const size_t d = (i * 4) & (D - 1), e = (i * 4) >> 10; o = (((d >> 7) * NEXP + e) * 128 + (d & 127)) >> 2; }
            dst[o] = (unsigned)w; } }
    }
}

__device__ __forceinline__ void stage_prologue0(const Params& p, int bid, int nb, float* lds) {
    const int tidx = tid_fresh();
    unsigned char* ws = p.ws;
    const int tid = tidx, lane = tid & 63, wid = tid >> 6;
    for (int l = 0; l < L; ++l) {
        tr_conv((const float*)p.in[4] + (size_t)l * D * INW, (bf16_t*)(ws + WS_WIN) + (size_t)l * 3072 * D, D, 3072, (const float*)p.in[3] + l * D, D - 1, 1.f, bid, nb, lds, 0, INW);
        tr_conv8((const float*)p.in[4] + (size_t)l * D * INW + 3072, ws + WS_WIN + 24 * MiB + (size_t)l * 3072 * D, D, 3072, (const float*)p.in[3] + l * D, W8S, INW, bid, nb, lds);
        const float* wb = (const float*)p.in[13] + (size_t)l * 3 * 512 * D;
        bf16_t* wbr = (bf16_t*)(ws + WS_WB0) + (size_t)l * D * 1536;
        tr_conv(wb, wbr, 512, D, (const float*)p.in[6] + l * 128, 127, 1.f - lam_init_of(l), bid, nb, lds, 1536);
        tr_conv(wb + 512 * D, (bf16_t*)(ws + WS_WB1T) + (size_t)l * D * 512, 512, D, nullptr, 0, 1.f, bid, nb, lds);
        tr_conv(wb + 2 * 512 * D, wbr + 1024, 512, D, nullptr, 0, 1.f, bid, nb, lds, 1536);
        tr_conv((const float*)p.in[14] + (size_t)l * D * D, (bf16_t*)(ws + WS_WOUT) + (size_t)l * D * D, D, D, nullptr, 0, 1.f, bid, nb, lds);
        tr_conv((const float*)p.in[19] + (size_t)l * D * D, (bf16_t*)(ws + WS_WXOT) + (size_t)l * D * D, D, D, nullptr, 0, 1.f, bid, nb, lds);
        tr_conv((const float*)p.in[18] + (size_t)l * D * 2 * D, (bf16_t*)(ws + WS_WXKVT) + (size_t)l * 2 * D * D, D, 2 * D, (const float*)p.in[16] + l * D, D - 1, 1.f, bid, nb, lds);
        conv_fp8((const float*)p.in[23] + (size_t)l * NEXP * D, (unsigned*)(ws + WS_U8) + (size_t)l * NEXP * D / 4, (const float*)p.in[20] + l * D, SU, false, bid, nb);
        conv_fp8((const float*)p.in[24] + (size_t)l * NEXP * D, (unsigned*)(ws + WS_V8) + (size_t)l * NEXP * D / 4, nullptr, SV, true, bid, nb);
    }
    conv_plain((const float*)p.in[17], (bf16_t*)(ws + WS_WXQB), (size_t)L * D * D, bid, nb, (const float*)p.in[15]);
    conv_plain((const float*)p.in[21], (bf16_t*)(ws + WS_WPQB), (size_t)L * D * 2048, bid, nb);
    conv_plain((const float*)p.in[22], (bf16_t*)(ws + WS_KEYSB), (size_t)L * 8 * 2 * 128 * 128, bid, nb);
    for (int i = bid * NT + tid; i < L * 4 * 128 * 128; i += nb * NT) {
        const int e = i & 127, g = (i >> 14) & 3, l = i >> 16;
        ((bf16_t*)(ws + WS_WPOOLS))[i] = f2bf(((const float*)p.in[7])[i] * ((const float*)p.in[8])[l * 512 + g * 128 + e]);
        const int sx = i & 127, tx = (i >> 7) & 127;
        ((bf16_t*)(ws + WS_WSPT))[i] = f2bf((sx <= tx) ? ((const float*)p.in[11])[i] : 0.f);
    }
    for (int i = bid * NT + tid; i < T * 8; i += nb * NT) {
        const int j = i & 7, t = i >> 3;
        const double ang = (double)((const int*)p.in[2])[t] * pow(500000.0, -(double)j / 8.0);
        _Float16* r = (_Float16*)(ws + WS_ROPE) + (size_t)t * 16;
        r[j] = (_Float16)(float)cos(ang); r[8 + j] = (_Float16)(float)sin(ang);
    }
    for (int row = bid * 8 + wid; row < T + MROWS; row += nb * 8) {
        const bool ismem = row >= T; const int r = ismem ? row - T : row;
        const float* src = (ismem ? (const float*)p.in[1] : (const float*)p.in[0]) + (size_t)r * D;
        bf16_t* dstb = (bf16_t*)(ws + (ismem ? WS_MEMB : WS_XB)) + (size_t)r * D;
        float ss = 0.f;
#pragma unroll
        for (int i = 0; i < 4; ++i) {
            const f32x4 v = ((const f32x4*)src)[lane + 64 * i];
            ss += v[0] * v[0] + v[1] * v[1] + v[2] * v[2] + v[3] * v[3];
            u32x2 w; w.x = pk2(v[0], v[1]); w.y = pk2(v[2], v[3]); ((u32x2*)dstb)[lane + 64 * i] = w;
            if (!ismem) { int q = __builtin_amdgcn_cvt_pk_fp8_f32(v[0] * XS, v[1] * XS, 0, false); q = __builtin_amdgcn_cvt_pk_fp8_f32(v[2] * XS, v[3] * XS, q, true); ((unsigned*)(ws + WS_XQ8 + (size_t)r * D))[lane + 64 * i] = (unsigned)q; }
        }
        ss = wave_sum(ss);
        if (ismem) { if (lane == 0) ((float*)(ws + WS_RSTDM))[r] = rsqrtf(ss * (1.f / D) + EPS); }
        else if (lane < 16) ((float*)(ws + WS_SSP))[(size_t)r * 16 + lane] = (lane == 0) ? ss : 0.f;
    }
}

template <class Geom, class Epi>
__device__ __forceinline__ void gemm_simple(int nitems, int K, const Geom& geom, const Epi& epi, int bid, int nb) {
    const int tidx = tid_fresh();
    const int tid = tidx, lane = tid & 63, wid = tid >> 6, wm = wid >> 1, wn = wid & 1, fr = lane & 15, fq = lane >> 4;
    for (int it = bid; it < nitems; it += nb) {
        const bf16_t* A; const bf16_t* Bt; int lda, ldb, grp, row0, col0;
        geom(it, A, lda, Bt, ldb, grp, row0, col0);
        f32x4 acc[2][4];
#pragma unroll
        for (int i = 0; i < 2; ++i)
#pragma unroll
            for (int j = 0; j < 4; ++j) acc[i][j] = (f32x4){0.f, 0.f, 0.f, 0.f};
        const bf16_t* ap = A + (size_t)(wm * 32 + fr) * lda + fq * 8;
        const bf16_t* bp = Bt + (size_t)(wn * 64 + fr) * ldb + fq * 8;
#pragma unroll 2
        for (int k0 = 0; k0 < K; k0 += 32) {
            bf16x8 a[2], b[4];
#pragma unroll
            for (int i = 0; i < 2; ++i) a[i] = *(const bf16x8*)(ap + (size_t)(i * 16) * lda + k0);
#pragma unroll
            for (int j = 0; j < 4; ++j) b[j] = *(const bf16x8*)(bp + (size_t)(j * 16) * ldb + k0);
#pragma unroll
            for (int i = 0; i < 2; ++i)
#pragma unroll
                for (int j = 0; j < 4; ++j) acc[i][j] = __builtin_amdgcn_mfma_f32_16x16x32_bf16(b[j], a[i], acc[i][j], 0, 0, 0);
        }
#pragma unroll
        for (int i = 0; i < 2; ++i) {
            const int row = row0 + wm * 32 + i * 16 + fr;
            const float rs = epi.prep(grp, row);
            float part = 0.f;
#pragma unroll
            for (int j = 0; j < 4; ++j) part += epi.apply(grp, row, col0 + wn * 64 + j * 16 + fq * 4, acc[i][j], rs, lane);
            epi.rowdone(grp, row, col0 + wn * 64, part, lane);
        }
    }
}

__device__ __forceinline__ void st_bf4(bf16_t* p, f32x4 v) { u32x2 w; w.x = pk2(v[0], v[1]); w.y = pk2(v[2], v[3]); *(u32x2*)p = w; }
__device__ __forceinline__ f32x4 ld_bf4(const bf16_t* p) { const u32x2 w = *(const u32x2*)p; return (f32x4){__uint_as_float(w.x << 16), __uint_as_float(w.x & 0xffff0000u), __uint_as_float(w.y << 16), __uint_as_float(w.y & 0xffff0000u)}; }

struct EpiColGain {
    bf16_t* o; size_t gstride; int ld; const float* gain; int gdiv;
    __device__ __forceinline__ float prep(int, int) const { return 1.f; }
    __device__ __forceinline__ float apply(int grp, int row, int col, f32x4 v, float, int) const {
        if (gain) v = v * *(const f32x4*)(gain + (size_t)(grp / gdiv) * D + col);
        st_bf4(o + (size_t)grp * gstride + (size_t)row * ld + col, v);
        return 0.f;
    }
    __device__ __forceinline__ void rowdone(int, int, int, float, int) const {}
};

__device__ __forceinline__ void stage_prologue1(const Params& p, int bid, int nb) {
    unsigned char* ws = p.ws;
    {
        auto geom = [=](int it, const bf16_t*& A, int& lda, const bf16_t*& Bt, int& ldb, int& grp, int& row0, int& col0) {
            const int g = it >> 3, tn = it & 7, l = g >> 4, hp = g & 15; grp = g; row0 = 0; col0 = tn * 128; lda = 128; ldb = 2048;
            A = (const bf16_t*)(ws + WS_KEYSB) + (size_t)g * 16384; Bt = (const bf16_t*)(ws + WS_WPQB) + ((size_t)l * D + col0) * 2048 + hp * 128; };
        gemm_simple(L * 16 * 8, 128, geom, EpiColGain{(bf16_t*)(ws + WS_SKT), (size_t)128 * D, D, (const float*)p.in[20], 16}, bid, nb);
    }
    {
        auto geom = [=](int it, const bf16_t*& A, int& lda, const bf16_t*& Bt, int& ldb, int& grp, int& row0, int& col0) {
            const int lg = it >> 3, tm = it & 7, l = lg >> 2, g = lg & 3; grp = lg; row0 = tm * 128; col0 = 0; lda = 512; ldb = 128;
            A = (const bf16_t*)(ws + WS_WB1T) + ((size_t)l * D + row0) * 512 + g * 128; Bt = (const bf16_t*)(ws + WS_WPOOLS) + (size_t)lg * 16384; };
        struct EpiWeff { bf16_t* o; __device__ __forceinline__ float prep(int, int) const { return 1.f; }
            __device__ __forceinline__ float apply(int lg, int row, int col, f32x4 v, float, int) const { st_bf4(o + ((size_t)(lg >> 2) * D + row) * 1536 + 512 + (lg & 3) * 128 + col, v); return 0.f; }
            __device__ __forceinline__ void rowdone(int, int, int, float, int) const {} };
        gemm_simple(L * 4 * 8, 128, geom, EpiWeff{(bf16_t*)(ws + WS_WB0)}, bid, nb);
    }
}
namespace pg8 {
#define PG8_LAS __attribute__((address_space(3)))
constexpr int BM = 256, BK = 64, HALF = 128, HTB = HALF * BK * 2, STAGE_BYTES = 8 * HTB, NXCD = 8, WGM = 8;
__host__ __device__ __forceinline__ int lds_byte(int r, int c) { const int st = (r >> 4) * 2 + (c >> 5), rr = r & 15, cc = c & 31, ob = rr * 64 + cc * 2; return st * 1024 + (ob ^ (((ob >> 9) & 1) << 5)); }
__host__ __device__ __forceinline__ void stage_rc(int b, int& R, int& C) { const int st = b / 1024, sb = b % 1024, swz = sb ^ (((sb >> 9) & 1) << 5); R = (st >> 1) * 16 + swz / 64; C = (st & 1) * 32 + (swz % 64) / 2; }
__host__ __device__ __forceinline__ int perm32(int rho) { const int n = rho >> 4, i = rho & 15; return 8 * (i >> 2) + 4 * n + (i & 3); }
struct Unit { int pm, pn; };
struct Order {
    int nM, nN, nwg, G, c; const char* A; const char* Bt; size_t a_tile, b_tile, b_batch; int pm_per_batch;
    __device__ __forceinline__ void init(int M, int N, int G_, int c_, const void* A_, int lda, const void* Bt_, int ldb, size_t b_batch_bytes = 0, int pmpb = 1 << 30) {
        nM = M / BM; nN = N / BM; nwg = nM * nN; G = G_; c = c_; A = (const char*)A_; Bt = (const char*)Bt_; a_tile = (size_t)BM * lda * 2; b_tile = (size_t)BM * ldb * 2; b_batch = b_batch_bytes; pm_per_batch = pmpb; }
    __device__ __forceinline__ bool next(int i, Unit& u) const {
        const long Lx = (long)i * G + c; if (Lx >= nwg) return false;
        int wgid = (int)Lx; { const int q = nwg / NXCD, r = nwg % NXCD, xcd = wgid % NXCD, off = wgid / NXCD; wgid = (xcd < r ? xcd * (q + 1) : r * (q + 1) + (xcd - r) * q) + off; }
        const int nig = WGM * nN, gid = wgid / nig, fm = gid * WGM, gsz = (nM - fm) < WGM ? (nM - fm) : WGM;
        u.pm = fm + ((wgid % nig) % gsz); u.pn = (wgid % nig) / gsz; return true;
    }
    __device__ __forceinline__ const char* a_ptr(const Unit& u) const { return A + (size_t)u.pm * a_tile; }
    __device__ __forceinline__ const char* b_ptr(const Unit& u) const { return Bt + (size_t)u.pn * b_tile + (size_t)(u.pm / pm_per_batch) * b_batch; }
};
typedef int i32x8_t __attribute__((ext_vector_type(8))); typedef int i32x4_t __attribute__((ext_vector_type(4)));
__device__ __forceinline__ i32x8_t ld8_lds(const PG8_LAS unsigned char* p) { const i32x4_t lo = *(const PG8_LAS i32x4_t*)p, hi = *(const PG8_LAS i32x4_t*)(p + 1024); return __builtin_shufflevector(lo, hi, 0, 1, 2, 3, 4, 5, 6, 7); }
__device__ __forceinline__ void glds_s(const void* sbase, unsigned voff, unsigned lds_dst) { unsigned keep;
    asm volatile("s_mov_b32 %0, m0\n\ts_mov_b32 m0, %3\n\ts_nop 0\n\tglobal_load_lds_dwordx4 %1, %2\n\ts_mov_b32 m0, %0" : "=&s"(keep) : "v"(voff), "s"(sbase), "s"(lds_dst) : "memory"); }
struct NoHook { static constexpr bool ACTIVE = false; __device__ __forceinline__ void operator()(f32x4 (&)[2][2][4][2], const Unit&, int, int, int, int, int) const {} };
template <class Epi, class Sched, bool ALIGN_EPI, class Hook = NoHook, int SEG = 1 << 20, bool FP8 = false>
__device__ __forceinline__ void gemm_phase(PG8_LAS unsigned char* lds, const int K, const int lda, const int ldb, const Sched& S, const Epi& E, const long dA1 = 0, const long dA2 = 0, const Hook& H = Hook()) {
    const int tid = tid_fresh(), wid = __builtin_amdgcn_readfirstlane(tid >> 6), lane = tid & 63, wr = wid >> 2, wc = wid & 3, fr = lane & 15, fq = lane >> 4;
    const int nt = K / BK;
    int mxs = 0x7f7f7f7f; asm volatile("" : "+v"(mxs));
    (void)mxs;
    unsigned voffA, voffB;
    { int R, C; stage_rc(tid * 16, R, C); const int Rb = (R & ~31) + perm32(R & 31);
      voffA = (unsigned)(R * lda + C) * 2u; voffB = (unsigned)(Rb * ldb + C) * 2u; }
    const size_t p2A = (size_t)64 * lda * 2, p2B = (size_t)64 * ldb * 2;
    const size_t kstep = (size_t)(BK * 2);
    const size_t hstepA = (size_t)HALF * lda * 2, hstepB = (size_t)HALF * ldb * 2;
    const unsigned ldsw = (unsigned)wid * 1024u, ldsu = (unsigned)(unsigned long)lds;
    const int aoff = lds_byte(wr * 64 + fr, fq * 8), boff = lds_byte(wc * 32 + fr, fq * 8);
#define PG8_SA(b, h) (((b) * 2 + (h)) * HTB)
#define PG8_SB(b, h) ((4 + (b) * 2 + (h)) * HTB)
#define PG8_STAGE(bufoff, gbase, X) do { _Pragma("unroll") for (int _i = 0; _i < 2; ++_i) \
        pg8::glds_s((const void*)((const char*)(gbase) + _i * p2##X), voff##X, ldsu + (unsigned)(bufoff) + ldsw + (unsigned)(_i * 8192)); } while (0)
#define PG8_LD8(p_) pg8::ld8_lds((p_))
#define PG8_LDA(dst, b, h) do { _Pragma("unroll") for (int m = 0; m < 4; ++m) { if constexpr (FP8) dst##8[m] = PG8_LD8(lds + PG8_SA(b, h) + aoff + m * 2048); else { _Pragma("unroll") for (int k = 0; k < 2; ++k) dst[m][k] = *(const PG8_LAS bf16x8*)(lds + PG8_SA(b, h) + aoff + m * 2048 + k * 1024); } } } while (0)
#define PG8_LDB(dst, b, h) do { _Pragma("unroll") for (int n = 0; n < 2; ++n) { if constexpr (FP8) dst##8[n] = PG8_LD8(lds + PG8_SB(b, h) + boff + n * 2048); else { _Pragma("unroll") for (int k = 0; k < 2; ++k) dst[n][k] = *(const PG8_LAS bf16x8*)(lds + PG8_SB(b, h) + boff + n * 2048 + k * 1024); } } } while (0)
#define PG8_MMA(ai, bj, At, Bt) do { __builtin_amdgcn_s_setprio(1); _Pragma("unroll") for (int m = 0; m < 4; ++m) _Pragma("unroll") for (int n = 0; n < 2; ++n) { \
        if constexpr (FP8) asm volatile("v_mfma_scale_f32_16x16x128_f8f6f4 %0, %1, %2, %0, %3, %3 op_sel_hi:[0,0,0]" : "+v"(acc[ai][bj][m][n]) : "v"(Bt##8[n]), "v"(At##8[m]), "v"(mxs)); \
        else { _Pragma("unroll") for (int k = 0; k < 2; ++k) acc[ai][bj][m][n] = __builtin_amdgcn_mfma_f32_16x16x32_bf16(Bt[n][k], At[m][k], acc[ai][bj][m][n], 0, 0, 0); } } \
        __builtin_amdgcn_s_setprio(0); } while (0)
#define PG8_WAIT_V(n) asm volatile("s_waitcnt vmcnt(" #n ")" ::: "memory")
#define PG8_WAIT_L(n) asm volatile("s_waitcnt lgkmcnt(" #n ")" ::: "memory")
#define PG8_BAR __builtin_amdgcn_s_barrier()
#define PG8_SCHED __builtin_amdgcn_sched_barrier(0)
    Unit cur, nxt; int ui = 0;
    if (!S.next(0, cur)) return;
    f32x4 acc[2][2][4][2];
#pragma unroll
    for (int a = 0; a < 2; ++a)
#pragma unroll
        for (int b = 0; b < 2; ++b)
#pragma unroll
            for (int m = 0; m < 4; ++m)
#pragma unroll
                for (int n = 0; n < 2; ++n) acc[a][b][m][n] = (f32x4){0.f, 0.f, 0.f, 0.f};
    typedef int i32x8_ __attribute__((ext_vector_type(8))); typedef int i32x4_ __attribute__((ext_vector_type(4)));
    bf16x8 At[4][2], B0[2][2], B1[2][2]; i32x8_ At8[4], B08[2], B18[2];
    (void)At; (void)B0; (void)B1; (void)At8; (void)B08; (void)B18;
    const char* cA = S.a_ptr(cur); const char* cB = S.b_ptr(cur);
    PG8_STAGE(PG8_SB(0, 0), cB, B); PG8_STAGE(PG8_SB(0, 1), cB + hstepB, B); PG8_STAGE(PG8_SA(0, 0), cA, A); PG8_STAGE(PG8_SA(0, 1), cA + hstepA, A);
    if (wr == 1) PG8_BAR;
    PG8_WAIT_V(2); PG8_BAR;
    PG8_STAGE(PG8_SB(1, 0), cB + kstep, B); PG8_STAGE(PG8_SA(1, 0), cA + kstep, A); PG8_STAGE(PG8_SB(1, 1), cB + hstepB + kstep, B); PG8_STAGE(PG8_SA(1, 1), cA + kstep + hstepA, A);
    PG8_WAIT_V(8); PG8_BAR;
    bool stores = false;
    for (;;) {
        const bool has_next = S.next(ui + 1, nxt);
        const char* nA = has_next ? S.a_ptr(nxt) : cA; const char* nB = has_next ? S.b_ptr(nxt) : cB;
        for (int t = 0; t < nt; t += 2) {
            const bool last = (t == nt - 2);
#define PG8_AOFF(tile) ((long)(tile) * (long)kstep + ((tile) >= 2 * SEG ? dA2 : (tile) >= SEG ? dA1 : 0l))
            if (Hook::ACTIVE && (t == SEG || t == 2 * SEG)) { const int th = tid_fresh(); H(acc, cur, t, wr, wc, th & 15, (th >> 4) & 3); }
            const char* a1 = cA + PG8_AOFF(t + 1);
            const char* a2 = last ? nA : cA + PG8_AOFF(t + 2); const char* b2 = last ? nB : cB + (size_t)(t + 2) * kstep;
            const char* a3 = last ? nA + kstep : cA + PG8_AOFF(t + 3); const char* b3 = b2 + kstep;
            const bool head = (t == 0), drain = head && stores;
            PG8_LDB(B0, 0, 0); PG8_LDB(B1, 0, 1); PG8_SCHED; PG8_LDA(At, 0, 0); if (!head) PG8_STAGE(PG8_SA(1, 1), a1 + hstepA, A);
            if (drain) { if constexpr (Epi::NST >= 16) PG8_WAIT_V(16); else if constexpr (Epi::NST >= 8) PG8_WAIT_V(8); else PG8_WAIT_V(0); } else PG8_WAIT_V(8);
            PG8_WAIT_L(0); PG8_BAR; PG8_MMA(0, 0, At, B0); PG8_MMA(0, 1, At, B1); PG8_BAR; PG8_SCHED;
            PG8_LDA(At, 0, 1); PG8_STAGE(PG8_SB(0, 0), b2, B); PG8_STAGE(PG8_SB(0, 1), b2 + hstepB, B); PG8_STAGE(PG8_SA(0, 0), a2, A);
            if (!drain) PG8_WAIT_V(8);
            PG8_WAIT_L(0); PG8_BAR; PG8_MMA(1, 0, At, B0); PG8_MMA(1, 1, At, B1); PG8_BAR; PG8_SCHED;
            PG8_LDB(B0, 1, 0); PG8_LDB(B1, 1, 1); PG8_SCHED; PG8_LDA(At, 1, 0); PG8_STAGE(PG8_SA(0, 1), a2 + hstepA, A);
            if (!drain) PG8_WAIT_V(8);
            PG8_WAIT_L(0); PG8_BAR; PG8_MMA(0, 0, At, B0); PG8_MMA(0, 1, At, B1); PG8_BAR; PG8_SCHED;
            PG8_LDA(At, 1, 1); PG8_STAGE(PG8_SB(1, 0), b3, B); PG8_STAGE(PG8_SB(1, 1), b3 + hstepB, B); PG8_STAGE(PG8_SA(1, 0), a3, A);
            PG8_WAIT_V(8);
            PG8_WAIT_L(0); PG8_BAR; PG8_MMA(1, 0, At, B0); PG8_MMA(1, 1, At, B1); PG8_BAR; PG8_SCHED;
        }
        PG8_STAGE(PG8_SA(1, 1), nA + kstep + hstepA, A); PG8_SCHED;
        if constexpr (FP8) asm volatile("s_nop 15\n\ts_nop 7" ::: "memory");
        if constexpr (ALIGN_EPI) { if (wr == 0) PG8_BAR; }
        { const int te = tid_fresh(); E(acc, cur, wr, wc, te & 15, (te >> 4) & 3); }
        if (!has_next) break;
        stores = true;
#pragma unroll
        for (int a = 0; a < 2; ++a)
#pragma unroll
            for (int b = 0; b < 2; ++b)
#pragma unroll
                for (int m = 0; m < 4; ++m)
#pragma unroll
                    for (int n = 0; n < 2; ++n) acc[a][b][m][n] = (f32x4){0.f, 0.f, 0.f, 0.f};
        cur = nxt; cA = nA; cB = nB; ++ui;
        if constexpr (ALIGN_EPI) { if (wr == 1) PG8_BAR; }
    }
    PG8_WAIT_V(0);
    if constexpr (!ALIGN_EPI) { if (wr == 0) PG8_BAR; }
    PG8_BAR;
#undef PG8_AOFF
#undef PG8_SA
#undef PG8_SB
#undef PG8_STAGE
#undef PG8_LDA
#undef PG8_LD8
#undef PG8_LDB
#undef PG8_MMA
#undef PG8_WAIT_V
#undef PG8_WAIT_L
#undef PG8_BAR
#undef PG8_SCHED
}
}

__device__ __forceinline__ float rstd_q(const float* ssp, int row, int fq) {
    const f32x4 a = *(const f32x4*)(ssp + (size_t)row * 16 + 4 * fq);
    float s = (a[0] + a[1]) + (a[2] + a[3]); s += lx16(s); s = add_x32(s);
    return rsqrtf(s * (1.f / D) + EPS);
}
__device__ __forceinline__ void rstd8(const float* ssp, int row0, int fq, float mul, float (&rs)[2][4]) {
    f32x4 a[2][4];
#pragma unroll
    for (int ai = 0; ai < 2; ++ai)
#pragma unroll
        for (int m = 0; m < 4; ++m) a[ai][m] = *(const f32x4*)(ssp + (size_t)(row0 + ai * 128 + m * 16) * 16 + 4 * fq);
#pragma unroll
    for (int ai = 0; ai < 2; ++ai)
#pragma unroll
        for (int m = 0; m < 4; ++m) { float s = (a[ai][m][0] + a[ai][m][1]) + (a[ai][m][2] + a[ai][m][3]); s += lx16(s); s = add_x32(s); rs[ai][m] = rsqrtf(s * (1.f / D) + EPS) * mul; }
}
__device__ __forceinline__ u32x4 pk8(f32x4 a, f32x4 b) { u32x4 w; w.x = pk2(a[0], a[1]); w.y = pk2(a[2], a[3]); w.z = pk2(b[0], b[1]); w.w = pk2(b[2], b[3]); return w; }
__device__ __forceinline__ u32x2 pk8_fp8(f32x4 a, f32x4 b, float sc) {
    int q0 = __builtin_amdgcn_cvt_pk_fp8_f32(a[0] * sc, a[1] * sc, 0, false); q0 = __builtin_amdgcn_cvt_pk_fp8_f32(a[2] * sc, a[3] * sc, q0, true);
    int q1 = __builtin_amdgcn_cvt_pk_fp8_f32(b[0] * sc, b[1] * sc, 0, false); q1 = __builtin_amdgcn_cvt_pk_fp8_f32(b[2] * sc, b[3] * sc, q1, true);
    return (u32x2){(unsigned)q0, (unsigned)q1};
}
__device__ __forceinline__ void up8(u32x4 w, f32x4& a, f32x4& b) {
    a = (f32x4){__uint_as_float(w.x << 16), __uint_as_float(w.x & 0xffff0000u), __uint_as_float(w.y << 16), __uint_as_float(w.y & 0xffff0000u)};
    b = (f32x4){__uint_as_float(w.z << 16), __uint_as_float(w.z & 0xffff0000u), __uint_as_float(w.w << 16), __uint_as_float(w.w & 0xffff0000u)}; }
struct LaneTr {
    int addr, tr, tq;
    __device__ __forceinline__ LaneTr(int fr, int fq) { const int L = fq * 16 + fr; tr = L >> 2; tq = L & 3; addr = (tq * 16 + tr) * 4; }
    __device__ __forceinline__ u32x4 operator()(u32x4 w) const {
        return (u32x4){(unsigned)__builtin_amdgcn_ds_bpermute(addr, (int)w.x), (unsigned)__builtin_amdgcn_ds_bpermute(addr, (int)w.y), (unsigned)__builtin_amdgcn_ds_bpermute(addr, (int)w.z), (unsigned)__builtin_amdgcn_ds_bpermute(addr, (int)w.w)}; }
};
typedef _Float16 f16x2_t __attribute__((ext_vector_type(2)));
__device__ __forceinline__ u32x4 swz16x4(u32x4 a) { unsigned r0, r1, r2, r3;
    asm volatile("ds_swizzle_b32 %0, %4 offset:swizzle(SWAP,16)\n\tds_swizzle_b32 %1, %5 offset:swizzle(SWAP,16)\n\tds_swizzle_b32 %2, %6 offset:swizzle(SWAP,16)\n\tds_swizzle_b32 %3, %7 offset:swizzle(SWAP,16)\n\ts_waitcnt lgkmcnt(0)"
                 : "=&v"(r0), "=&v"(r1), "=&v"(r2), "=&v"(r3) : "v"(a.x), "v"(a.y), "v"(a.z), "v"(a.w));
    return (u32x4){r0, r1, r2, r3}; }
__device__ __forceinline__ f32x4 swz16f4(f32x4 a) { return __builtin_bit_cast(f32x4, swz16x4(__builtin_bit_cast(u32x4, a))); }
__device__ __forceinline__ float h2f_lo(unsigned w) { return (float)__builtin_bit_cast(f16x2_t, w)[0]; }
__device__ __forceinline__ float h2f_hi(unsigned w) { return (float)__builtin_bit_cast(f16x2_t, w)[1]; }
struct GEpiWin {
    unsigned char* ws;
    static constexpr int NST = 16;
    __device__ __forceinline__ void operator()(const f32x4 (&acc)[2][2][4][2], const pg8::Unit& u, int wr, int wc, int fr, int fq) const {
        const int pn = u.pn, row0 = u.pm * 256 + wr * 64 + fr;
        const LaneTr ltr(fr, fq); const int rowt = u.pm * 256 + wr * 64 + ltr.tr, ct = 32 * wc + 8 * ltr.tq;
        const float* ssp = (const float*)(ws + WS_SSP);
        if (pn < 4) {
            const bool rot = (wc & 1) == 0;
            bf16_t* dst = (bf16_t*)(ws + (pn < 2 ? WS_QB : WS_KB)) + (pn & 1) * 256 + ct;
            float rs8[2][4]; rstd8(ssp, row0, fq, pn < 2 ? C2 : 1.f, rs8);
            u32x4 tb[2][4];
#pragma unroll
            for (int ai = 0; ai < 2; ++ai)
#pragma unroll
                for (int m = 0; m < 4; ++m) tb[ai][m] = rot ? *(const u32x4*)(ws + WS_ROPE + (size_t)(row0 + ai * 128 + m * 16) * 32 + (fq & 1) * 16) : (u32x4){0u, 0u, 0u, 0u};
#pragma unroll
            for (int ai = 0; ai < 2; ++ai)
#pragma unroll
                for (int m = 0; m < 4; ++m) { const int row = rowt + ai * 128 + m * 16; const float rs = rs8[ai][m];
                    f32x4 c0 = (f32x4){1.f, 1.f, 1.f, 1.f}, c1 = c0, s0 = (f32x4){0.f, 0.f, 0.f, 0.f}, s1 = s0;
                    if (rot) { const u32x4 mine = tb[ai][m]; const u32x4 oth = swz16x4(mine);
                        const u32x4 cw = (fq & 1) ? oth : mine, sw = (fq & 1) ? mine : oth;
                        c0 = (f32x4){h2f_lo(cw.x), h2f_hi(cw.x), h2f_lo(cw.y), h2f_hi(cw.y)}; c1 = (f32x4){h2f_lo(cw.z), h2f_hi(cw.z), h2f_lo(cw.w), h2f_hi(cw.w)};
                        s0 = (f32x4){h2f_lo(sw.x), h2f_hi(sw.x), h2f_lo(sw.y), h2f_hi(sw.y)}; s1 = (f32x4){h2f_lo(sw.z), h2f_hi(sw.z), h2f_lo(sw.w), h2f_hi(sw.w)}; }
#pragma unroll
                    for (int bj = 0; bj < 2; ++bj) { f32x4 v0 = acc[ai][bj][m][0], v1 = acc[ai][bj][m][1];
                        if (rot) { const f32x4 o0 = swz16f4(v0), o1 = swz16f4(v1);
                            if (fq == 0) { v0 = v0 * c0 - o0 * s0; v1 = v1 * c1 - o1 * s1; } else if (fq == 1) { v0 = o0 * s0 + v0 * c0; v1 = o1 * s1 + v1 * c1; } }
                        *(u32x4*)(dst + (size_t)row * 512 + bj * 128) = ltr(pk8(v0 * rs, v1 * rs)); } }
        } else if (pn < 12) {
            const int seg = (pn - 4) >> 1; const size_t base = seg == 0 ? WS_VB : seg == 1 ? WS_PIN : seg == 2 ? WS_UIN : WS_VIN;
            bf16_t* dst = (bf16_t*)(ws + base) + (pn & 1) * 256 + ct;
            float rs[2][4]; rstd8(ssp, row0, fq, 1.f, rs);
#pragma unroll
            for (int ai = 0; ai < 2; ++ai)
#pragma unroll
                for (int m = 0; m < 4; ++m) { const int row = rowt + ai * 128 + m * 16;
#pragma unroll
                    for (int bj = 0; bj < 2; ++bj) *(u32x4*)(dst + (size_t)row * 512 + bj * 128) = ltr(pk8(acc[ai][bj][m][0] * rs[ai][m], acc[ai][bj][m][1] * rs[ai][m])); }
        }
    }
};
__device__ __forceinline__ size_t gate_off(int pm, int pn, int wid, int lane) { return (((size_t)(pm * 12 + pn) * 8 + wid) << 14) + (size_t)lane * 16; }
#define GATE_FRAG(ai, bj, m) ((((ai) * 2 + (bj)) * 4 + (m)) * 1024)
struct GEpiGate {
    unsigned char* ws;
    static constexpr int NST = 16;
    __device__ __forceinline__ void operator()(const f32x4 (&acc)[2][2][4][2], const pg8::Unit& u, int wr, int wc, int fr, int fq) const {
        const int row0 = u.pm * 256 + wr * 64 + fr;
        unsigned char* dst = ws + WS_GTE + gate_off(u.pm, u.pn, wr * 4 + wc, fq * 16 + fr);
        float rs8[2][4]; rstd8((const float*)(ws + WS_SSP), row0, fq, -1.4426950408889634f / (XS * W8S), rs8);
#pragma unroll
        for (int ai = 0; ai < 2; ++ai)
#pragma unroll
            for (int m = 0; m < 4; ++m) { const float rs = rs8[ai][m];
#pragma unroll
                for (int bj = 0; bj < 2; ++bj) { f32x4 v0 = acc[ai][bj][m][0] * rs, v1 = acc[ai][bj][m][1] * rs;
#pragma unroll
                    for (int e = 0; e < 4; ++e) { v0[e] = 1.f + __builtin_amdgcn_exp2f(fminf(v0[e], 60.f)); v1[e] = 1.f + __builtin_amdgcn_exp2f(fminf(v1[e], 60.f)); }
                    *(u32x4*)(dst + GATE_FRAG(ai, bj, m)) = pk8(v0, v1); } }
    }
};
__device__ __forceinline__ f32x4 rcp4(f32x4 v) { return (f32x4){__builtin_amdgcn_rcpf(fmaxf(v[0], 1e-30f)), __builtin_amdgcn_rcpf(fmaxf(v[1], 1e-30f)), __builtin_amdgcn_rcpf(fmaxf(v[2], 1e-30f)), __builtin_amdgcn_rcpf(fmaxf(v[3], 1e-30f))}; }
struct BranchHook {
    static constexpr bool ACTIVE = true; unsigned char* ws;
    __device__ __forceinline__ void operator()(f32x4 (&acc)[2][2][4][2], const pg8::Unit& u, int t, int wr, int wc, int fr, int fq) const {
        int lane = fq * 16 + fr;
        asm volatile("" : "+v"(lane));
        const unsigned char* gpa = ws + WS_GTE + gate_off(u.pm, u.pn + ((t == 8) ? 0 : 4), wr * 4 + wc, lane); const unsigned char* gpb = gpa + ((size_t)4 * 8 << 14);
#pragma unroll
        for (int ai = 0; ai < 2; ++ai) {
            u32x4 ga[4][2], gb[4][2];
#pragma unroll
            for (int m = 0; m < 4; ++m)
#pragma unroll
                for (int bj = 0; bj < 2; ++bj) { ga[m][bj] = *(const u32x4*)(gpa + GATE_FRAG(ai, bj, m)); gb[m][bj] = *(const u32x4*)(gpb + GATE_FRAG(ai, bj, m)); }
            __builtin_amdgcn_sched_barrier(0);
#pragma unroll
            for (int m = 0; m < 4; ++m)
#pragma unroll
                for (int bj = 0; bj < 2; ++bj) { f32x4 a0, a1, b0, b1; up8(ga[m][bj], a0, a1); up8(gb[m][bj], b0, b1);
                    acc[ai][bj][m][0] = acc[ai][bj][m][0] * (b0 * rcp4(a0)); acc[ai][bj][m][1] = acc[ai][bj][m][1] * (b1 * rcp4(a1)); }
            __builtin_amdgcn_sched_barrier(0);
        }
    }
};
struct GEpiBranch {
    unsigned char* ws;
    static constexpr int NST = 8;
    __device__ __forceinline__ void operator()(const f32x4 (&acc)[2][2][4][2], const pg8::Unit& u, int wr, int wc, int fr, int fq) const {
        const LaneTr ltr(fr, fq); const int row0 = u.pm * 256 + wr * 64 + ltr.tr, col0 = u.pn * 256 + 32 * wc + 8 * ltr.tq;
#pragma unroll
        for (int ai = 0; ai < 2; ++ai) {
            u32x4 g[4][2];
#pragma unroll
            for (int m = 0; m < 4; ++m)
#pragma unroll
                for (int bj = 0; bj < 2; ++bj) g[m][bj] = *(const u32x4*)(ws + WS_GTE + gate_off(u.pm, u.pn + 8, wr * 4 + wc, fq * 16 + fr) + GATE_FRAG(ai, bj, m));
#pragma unroll
            for (int m = 0; m < 4; ++m) { const int row = row0 + ai * 128 + m * 16;
#pragma unroll
                for (int bj = 0; bj < 2; ++bj) { const int col = col0 + bj * 128;
                    f32x4 g0, g1; up8(g[m][bj], g0, g1);
                    *(u32x4*)((bf16_t*)(ws + WS_MG) + (size_t)row * D + col) = ltr(pk8(acc[ai][bj][m][0] * rcp4(g0), acc[ai][bj][m][1] * rcp4(g1))); } }
        }
    }
};
struct GEpiResid {
    unsigned char* ws; bool q8; float ascale;
    static constexpr int NST = 16;
    __device__ __forceinline__ void operator()(const f32x4 (&acc)[2][2][4][2], const pg8::Unit& u, int wr, int wc, int fr, int fq) const {
        const int row0 = u.pm * 256 + wr * 64 + fr, col0 = u.pn * 256 + 32 * wc + 8 * fq;
#pragma unroll
        for (int ai = 0; ai < 2; ++ai) {
            u32x4 xin[4][2];
#pragma unroll
            for (int m = 0; m < 4; ++m)
#pragma unroll
                for (int bj = 0; bj < 2; ++bj) xin[m][bj] = *(const u32x4*)((const bf16_t*)(ws + WS_XB) + (size_t)(row0 + ai * 128 + m * 16) * D + col0 + bj * 128);
#pragma unroll
            for (int m = 0; m < 4; ++m) { const int row = row0 + ai * 128 + m * 16; float part = 0.f;
#pragma unroll
                for (int bj = 0; bj < 2; ++bj) { f32x4 x0, x1; up8(xin[m][bj], x0, x1);
                    const u32x4 w = pk8(acc[ai][bj][m][0] * ascale + x0, acc[ai][bj][m][1] * ascale + x1);
                    *(u32x4*)((bf16_t*)(ws + WS_XB) + (size_t)row * D + col0 + bj * 128) = w;
                    f32x4 v0, v1; up8(w, v0, v1);
                    if (q8) { int q0 = __builtin_amdgcn_cvt_pk_fp8_f32(v0[0] * XS, v0[1] * XS, 0, false); q0 = __builtin_amdgcn_cvt_pk_fp8_f32(v0[2] * XS, v0[3] * XS, q0, true);
                        int q1 = __builtin_amdgcn_cvt_pk_fp8_f32(v1[0] * XS, v1[1] * XS, 0, false); q1 = __builtin_amdgcn_cvt_pk_fp8_f32(v1[2] * XS, v1[3] * XS, q1, true);
                        *(u32x2*)(ws + WS_XQ8 + (size_t)row * D + col0 + bj * 128) = (u32x2){(unsigned)q0, (unsigned)q1}; }
                    part += (v0[0] * v0[0] + v0[1] * v0[1]) + (v0[2] * v0[2] + v0[3] * v0[3]) + (v1[0] * v1[0] + v1[1] * v1[1]) + (v1[2] * v1[2] + v1[3] * v1[3]); }
                part += lx16(part); part = add_x32(part);
                if (fq == 0) ((float*)(ws + WS_SSP))[(size_t)row * 16 + u.pn * 4 + wc] = part; }
        }
    }
};
typedef _Float16 f16x8 __attribute__((ext_vector_type(8)));
struct GEpiScaleF16 {
    unsigned char* ws; _Float16* o; int ld;
    static constexpr int NST = 16;
    __device__ __forceinline__ void operator()(const f32x4 (&acc)[2][2][4][2], const pg8::Unit& u, int wr, int wc, int fr, int fq) const {
        const int row0 = u.pm * 256 + wr * 64 + fr;
        const LaneTr ltr(fr, fq); const int rowt = u.pm * 256 + wr * 64 + ltr.tr, col0 = u.pn * 256 + 32 * wc + 8 * ltr.tq;
        float rs8[2][4]; rstd8((const float*)(ws + WS_SSP), row0, fq, 1.f, rs8);
#pragma unroll
        for (int ai = 0; ai < 2; ++ai)
#pragma unroll
            for (int m = 0; m < 4; ++m) { const int row = rowt + ai * 128 + m * 16; const float rs = rs8[ai][m];
#pragma unroll
                for (int bj = 0; bj < 2; ++bj) { const f32x4 a = acc[ai][bj][m][0] * rs, b = acc[ai][bj][m][1] * rs;
                    const f16x8 h = (f16x8){(_Float16)a[0], (_Float16)a[1], (_Float16)a[2], (_Float16)a[3], (_Float16)b[0], (_Float16)b[1], (_Float16)b[2], (_Float16)b[3]};
                    *(u32x4*)(o + (size_t)row * ld + col0 + bj * 128) = ltr(__builtin_bit_cast(u32x4, h)); } }
    }
};
typedef PG8_LAS unsigned char* lds_t;
struct GEpiXSoftmax {
    unsigned char* ws; lds_t part;
    static constexpr int NST = 16;
    __device__ __forceinline__ void operator()(const f32x4 (&acc)[2][2][4][2], const pg8::Unit& u, int wr, int wc, int fr, int fq) const {
        const int row0 = u.pm * 256 + wr * 64 + fr, col0 = u.pn * 256 + 32 * wc + 8 * fq;
        f32x4 (&ex)[2][2][4][2] = const_cast<f32x4 (&)[2][2][4][2]>(acc);
        PG8_LAS f32x2* pt = (PG8_LAS f32x2*)part;
        float rs[2][4], mw[2][4];
#pragma unroll
        for (int ai = 0; ai < 2; ++ai)
#pragma unroll
            for (int m = 0; m < 4; ++m) { const int row = row0 + ai * 128 + m * 16; rs[ai][m] = rstd_q((const float*)(ws + WS_SSP), row, fq) * (1.4426950408889634f / (16.f * XS * GS));
                float mx = -INFINITY;
#pragma unroll
                for (int bj = 0; bj < 2; ++bj)
#pragma unroll
                    for (int n = 0; n < 2; ++n)
#pragma unroll
                        for (int e = 0; e < 4; ++e) mx = fmaxf(mx, acc[ai][bj][m][n][e]);
                mx *= rs[ai][m];
                mx = fmaxf(mx, lx16(mx)); mx = max_x32(mx);
                float sm = 0.f;
#pragma unroll
                for (int bj = 0; bj < 2; ++bj)
#pragma unroll
                    for (int n = 0; n < 2; ++n)
#pragma unroll
                        for (int e = 0; e < 4; ++e) { const float x = __builtin_amdgcn_exp2f(acc[ai][bj][m][n][e] * rs[ai][m] - mx); ex[ai][bj][m][n][e] = x; sm += x; }
                sm += lx16(sm); sm = add_x32(sm);
                mw[ai][m] = mx;
                if (fq == 0) pt[(wr * 64 + fr + ai * 128 + m * 16) * 4 + wc] = (f32x2){mx, sm}; }
        asm volatile("s_waitcnt lgkmcnt(0)" ::: "memory");
        __builtin_amdgcn_s_barrier();
#pragma unroll
        for (int ai = 0; ai < 2; ++ai)
#pragma unroll
            for (int m = 0; m < 4; ++m) { const int row = row0 + ai * 128 + m * 16;
                const PG8_LAS f32x2* pr = pt + (wr * 64 + fr + ai * 128 + m * 16) * 4;
                const f32x2 p0 = pr[0], p1 = pr[1], p2 = pr[2], p3 = pr[3];
                const float M = fmaxf(fmaxf(p0.x, p1.x), fmaxf(p2.x, p3.x));
                const float tot = (p0.y * __builtin_amdgcn_exp2f(p0.x - M) + p1.y * __builtin_amdgcn_exp2f(p1.x - M)) + (p2.y * __builtin_amdgcn_exp2f(p2.x - M) + p3.y * __builtin_amdgcn_exp2f(p3.x - M));
                const float f = __builtin_amdgcn_exp2f(mw[ai][m] - M) * (PS / tot);
#pragma unroll
                for (int bj = 0; bj < 2; ++bj) *(u32x2*)(ws + WS_PM + (size_t)row * D + col0 + bj * 128) = pk8_fp8(ex[ai][bj][m][0], ex[ai][bj][m][1], f); }
    }
};
__device__ __forceinline__ void fstage_win(const Params& p, int l, lds_t lds, int bid, int nb) {
    { pg8::Order O; O.init(T, 3072, nb, bid, p.ws + WS_XB, D, p.ws + WS_WIN + (size_t)l * 3072 * D * 2, D);
      pg8::gemm_phase<GEpiWin, pg8::Order, true>(lds, D, D, D, O, GEpiWin{p.ws}); }
    { pg8::Order O; O.init(T, 3072, nb, bid, p.ws + WS_XQ8, D / 2, p.ws + WS_WIN + 24 * MiB + (size_t)l * 3072 * D, D / 2);
      pg8::gemm_phase<GEpiGate, pg8::Order, true, pg8::NoHook, 1 << 20, true>(lds, D / 2, D / 2, D / 2, O, GEpiGate{p.ws}); }
}
template <bool HOOKS = true>
__device__ __forceinline__ void fstage_branch(const Params& p, int l, lds_t lds, int bid, int nb) {
    pg8::Order O; O.init(T, D, nb, bid, p.ws + WS_AO, 512, p.ws + WS_WB0 + (size_t)l * D * 1536 * 2, 1536);
    const long d1 = (long)WS_DP - (long)WS_AO - 8 * 128, d2 = (long)WS_SO - (long)WS_AO - 16 * 128;
    if constexpr (HOOKS) pg8::gemm_phase<GEpiBranch, pg8::Order, true, BranchHook, 8>(lds, 1536, 512, 1536, O, GEpiBranch{p.ws}, d1, d2, BranchHook{p.ws});
    else pg8::gemm_phase<GEpiBranch, pg8::Order, true, pg8::NoHook, 8>(lds, 1536, 512, 1536, O, GEpiBranch{p.ws}, d1, d2);
}
__device__ __forceinline__ void fstage_resid_out(const Params& p, int l, lds_t lds, int bid, int nb) {
    pg8::Order O; O.init(T, D, nb, bid, p.ws + WS_MG, D, p.ws + WS_WOUT + (size_t)l * D * D * 2, D);
    pg8::gemm_phase<GEpiResid, pg8::Order, true>(lds, D, D, D, O, GEpiResid{p.ws, true, 1.f});
}
__device__ __forceinline__ void fstage_resid_cross(const Params& p, int l, lds_t lds, int bid, int nb) {
    pg8::Order O; O.init(T, D, nb, bid, p.ws + WS_PM, D / 2, p.ws + WS_YT + (size_t)l * NB * D * D, D / 2, (size_t)D * D, S / 256);
    pg8::gemm_phase<GEpiResid, pg8::Order, true, pg8::NoHook, 1 << 20, true>(lds, D / 2, D / 2, D / 2, O, GEpiResid{p.ws, true, 1.f / (PS * YS)});
}
__device__ __forceinline__ void fstage_xscore(const Params& p, int l, lds_t lds, int bid, int nb) {
    pg8::Order O; O.init(T, D, nb, bid, p.ws + WS_XQ8, D / 2, p.ws + WS_GT + (size_t)l * NB * D * D, D / 2, (size_t)D * D, S / 256);
    pg8::gemm_phase<GEpiXSoftmax, pg8::Order, true, pg8::NoHook, 1 << 20, true>(lds, D / 2, D / 2, D / 2, O, GEpiXSoftmax{p.ws, lds + 131072});
}


struct GEpiKV {
    unsigned char* ws;
    static constexpr int NST = 16;
    __device__ __forceinline__ void operator()(const f32x4 (&acc)[2][2][4][2], const pg8::Unit& u, int wr, int wc, int fr, int fq) const {
        asm volatile("" : "+v"(fr), "+v"(fq));
        const int row0 = u.pm * 256 + wr * 64 + fr, l = u.pn >> 3, col0 = (u.pn & 7) * 256 + 32 * wc + 8 * fq;
        float rs8[2][4];
#pragma unroll
        for (int ai = 0; ai < 2; ++ai)
#pragma unroll
            for (int m = 0; m < 4; ++m) rs8[ai][m] = ((const float*)(ws + WS_RSTDM))[row0 + ai * 128 + m * 16];
#pragma unroll
        for (int ai = 0; ai < 2; ++ai)
#pragma unroll
            for (int m = 0; m < 4; ++m) { const int row = row0 + ai * 128 + m * 16; const float rs = rs8[ai][m];
#pragma unroll
                for (int bj = 0; bj < 2; ++bj) *(u32x4*)((bf16_t*)(ws + WS_KV) + ((size_t)l * MROWS + row) * 2048 + col0 + bj * 128) = pk8(acc[ai][bj][m][0] * rs, acc[ai][bj][m][1] * rs); }
    }
};
struct OrderG : pg8::Order {
    unsigned char* ws;
    __device__ __forceinline__ const char* a_ptr(const pg8::Unit& u) const { const int l = u.pm >> 5, b = (u.pm >> 2) & 7, h = u.pm & 3; return (const char*)(ws + WS_KV) + (((size_t)l * MROWS + b * 256) * 2048 + h * 256) * 2; }
    __device__ __forceinline__ const char* b_ptr(const pg8::Unit& u) const { const int l = u.pm >> 5, h = u.pm & 3; return (const char*)(ws + WS_WXQB) + (((size_t)l * D + u.pn * 256) * D + h * 256) * 2; }
};
struct GEpiG {
    unsigned char* ws;
    static constexpr int NST = 16;
    __device__ __forceinline__ void operator()(const f32x4 (&acc)[2][2][4][2], const pg8::Unit& u, int wr, int wc, int fr, int fq) const {
        asm volatile("" : "+v"(fr), "+v"(fq));
        const int lb = u.pm >> 2, h = u.pm & 3, r0 = wr * 64 + fr, col0 = u.pn * 256 + 32 * wc + 8 * fq;
#pragma unroll
        for (int ai = 0; ai < 2; ++ai)
#pragma unroll
            for (int m = 0; m < 4; ++m)
#pragma unroll
                for (int bj = 0; bj < 2; ++bj) *(u32x2*)(ws + WS_GT + ((size_t)lb * D + h * 256 + r0 + ai * 128 + m * 16) * D + col0 + bj * 128) = pk8_fp8(acc[ai][bj][m][0], acc[ai][bj][m][1], GS);
    }
};
struct OrderY : pg8::Order {
    unsigned char* ws;
    __device__ __forceinline__ const char* a_ptr(const pg8::Unit& u) const { const int l = u.pn >> 5, h = u.pn & 3; return (const char*)(ws + WS_WXOT) + (((size_t)l * D + u.pm * 256) * D + h * 256) * 2; }
    __device__ __forceinline__ const char* b_ptr(const pg8::Unit& u) const { const int l = u.pn >> 5, b = (u.pn >> 2) & 7, h = u.pn & 3; return (const char*)(ws + WS_KV) + (((size_t)l * MROWS + b * 256) * 2048 + 1024 + h * 256) * 2; }
};
struct GEpiY {
    unsigned char* ws;
    static constexpr int NST = 16;
    __device__ __forceinline__ void operator()(const f32x4 (&acc)[2][2][4][2], const pg8::Unit& u, int wr, int wc, int fr, int fq) const {
        asm volatile("" : "+v"(fr), "+v"(fq));
        const int lb = u.pn >> 2, h = u.pn & 3, row0 = u.pm * 256 + wr * 64 + fr, col0 = h * 256 + 32 * wc + 8 * fq;
#pragma unroll
        for (int ai = 0; ai < 2; ++ai)
#pragma unroll
            for (int m = 0; m < 4; ++m)
#pragma unroll
                for (int bj = 0; bj < 2; ++bj) *(u32x2*)(ws + WS_YT + ((size_t)lb * D + row0 + ai * 128 + m * 16) * D + col0 + bj * 128) = pk8_fp8(acc[ai][bj][m][0], acc[ai][bj][m][1], YS);
    }
};
__device__ __forceinline__ void fstage_kv(const Params& p, lds_t lds, int bid, int nb) {
    pg8::Order O; O.init(MROWS, L * 2048, nb, bid, p.ws + WS_MEMB, D, p.ws + WS_WXKVT, D);
    pg8::gemm_phase<GEpiKV, pg8::Order, true>(lds, D, D, D, O, GEpiKV{p.ws});
}
__device__ __forceinline__ void fstage_g(const Params& p, lds_t lds, int bid, int nb) {
    OrderG O; O.init(128 * 256, D, nb, bid, nullptr, 2048, nullptr, D); O.ws = p.ws;
    pg8::gemm_phase<GEpiG, OrderG, true>(lds, 256, 2048, D, O, GEpiG{p.ws});
}
__device__ __forceinline__ void fstage_y(const Params& p, lds_t lds, int bid, int nb) {
    OrderY O; O.init(D, 128 * 256, nb, bid, nullptr, D, nullptr, 2048); O.ws = p.ws;
    pg8::gemm_phase<GEpiY, OrderY, true>(lds, 256, D, 2048, O, GEpiY{p.ws});
}

#include <hip/hip_bf16.h>
namespace attn_body {
using bf16=__hip_bfloat16;
using bf16x8=__attribute__((ext_vector_type(8)))short;
using s16x4=__attribute__((ext_vector_type(4)))short;
using f32x16=__attribute__((ext_vector_type(16)))float;
using u32x4=__attribute__((ext_vector_type(4)))unsigned;
constexpr int SEQ=4096,D=64,DM=512;
constexpr int NW=8,QBLK=32,QB=QBLK*NW,KVBLK=64,NQB=SEQ/QB;
constexpr int ATTN_PITCH=DM, ATTN_UNIT_ROWS=QB;
__device__ __forceinline__ int crow(int r,int hi){return (r&3)+8*(r>>2)+4*hi;}
#define SBAR() __builtin_amdgcn_sched_barrier(0)
__device__ __forceinline__ void cmask(f32x16&p0,f32x16&p1,int jb,int qrel,int hi){
  const float NEG=-INFINITY; int kb=64*jb+4*hi;
  #pragma unroll
  for(int r=0;r<16;++r){int kv=kb+(r&3)+8*(r>>2); if(kv>qrel)p0[r]=NEG; if(kv+32>qrel)p1[r]=NEG;}
}

constexpr int NSLOT=3, SLOTB=8192;
constexpr int LDS_K=0, LDS_V=NSLOT*SLOTB, LDS_WS=3*NSLOT*SLOTB, LDS_OST=LDS_WS+NW*64*4, LDS_BYTES=LDS_OST+NW*8192;
constexpr float C2=0.125f*1.4426950408889634f;
__device__ __forceinline__ void glds16(const void*gsrc,unsigned lds_dst){unsigned keep;
  asm volatile("s_mov_b32 %0, m0\n\ts_mov_b32 m0, %2\n\ts_nop 0\n\tglobal_load_lds_dwordx4 %1, off\n\ts_mov_b32 m0, %0":"=&s"(keep):"v"(gsrc),"s"(lds_dst):"memory");}
__device__ __forceinline__ float max3f(float a,float b,float c){float r;asm("v_max3_f32 %0, %1, %2, %3":"=v"(r):"v"(a),"v"(b),"v"(c));return r;}
__device__ __forceinline__ float max2f(float a,float b){float r;asm("v_max_f32_e32 %0, %1, %2":"=v"(r):"v"(a),"v"(b));return r;}
__device__ __forceinline__ float fadd_s(float a,float b){float r;asm("v_add_f32_e32 %0, %1, %2":"=v"(r):"v"(a),"v"(b));return r;}
__device__ __forceinline__ float fsub_s(float a,float b){float r;asm("v_sub_f32_e32 %0, %1, %2":"=v"(r):"v"(a),"v"(b));return r;}
typedef float f32x2_t __attribute__((ext_vector_type(2))); typedef __bf16 bf16x2_t __attribute__((ext_vector_type(2)));
__device__ __forceinline__ unsigned cvtpk_s(float lo,float hi){f32x2_t v={lo,hi};bf16x2_t b=__builtin_convertvector(v,bf16x2_t);return __builtin_bit_cast(unsigned,b);}
#define WAIT_BAR(N) asm volatile("s_waitcnt vmcnt(" #N ") lgkmcnt(0)\n\ts_barrier":::"memory")

__device__ __forceinline__ void qkt(f32x16&p0,f32x16&p1,const char*Kslot,const bf16x8*qr,const f32x16&negm,int r32,int hi){
  const char*kb=Kslot+hi*1024+r32*16;
  #pragma unroll
  for(int d0=0;d0<4;++d0){
    const bf16x8 b0=*reinterpret_cast<const bf16x8*>(kb+d0*2048);
    const bf16x8 b1=*reinterpret_cast<const bf16x8*>(kb+d0*2048+512);
    if(d0==0){p0=__builtin_amdgcn_mfma_f32_32x32x16_bf16(b0,qr[0],negm,0,0,0);p1=__builtin_amdgcn_mfma_f32_32x32x16_bf16(b1,qr[0],negm,0,0,0);}
    else{p0=__builtin_amdgcn_mfma_f32_32x32x16_bf16(b0,qr[d0],p0,0,0,0);p1=__builtin_amdgcn_mfma_f32_32x32x16_bf16(b1,qr[d0],p1,0,0,0);}}
}
typedef __attribute__((address_space(3))) const char* lds_cptr;
typedef short v4i16_t __attribute__((ext_vector_type(4)));
__device__ __forceinline__ void kload8(bf16x8*kf,lds_cptr kp){
  kf[0]=*(const __attribute__((address_space(3))) bf16x8*)(kp);      kf[1]=*(const __attribute__((address_space(3))) bf16x8*)(kp+512);
  kf[2]=*(const __attribute__((address_space(3))) bf16x8*)(kp+2048); kf[3]=*(const __attribute__((address_space(3))) bf16x8*)(kp+2560);
  kf[4]=*(const __attribute__((address_space(3))) bf16x8*)(kp+4096); kf[5]=*(const __attribute__((address_space(3))) bf16x8*)(kp+4608);
  kf[6]=*(const __attribute__((address_space(3))) bf16x8*)(kp+6144); kf[7]=*(const __attribute__((address_space(3))) bf16x8*)(kp+6656);
}
__device__ __forceinline__ void kload2(bf16x8*kf,lds_cptr kp,int j){ kf[2*j]=*(const __attribute__((address_space(3))) bf16x8*)(kp+j*2048); kf[2*j+1]=*(const __attribute__((address_space(3))) bf16x8*)(kp+j*2048+512); }
__device__ __forceinline__ s16x4 vtr(lds_cptr p){ return __builtin_bit_cast(s16x4,__builtin_amdgcn_ds_read_tr16_b64_v4i16((__attribute__((address_space(3))) v4i16_t*)p)); }
__device__ __forceinline__ float rowmax(const f32x16&p0,const f32x16&p1){
  float a=max3f(p0[0],p0[1],p1[0]),b=max3f(p0[2],p0[3],p1[1]);a=max3f(a,p1[2],p1[3]);
  #pragma unroll
  for(int r=4;r<16;r+=4){a=max3f(a,p0[r],p0[r+1]);b=max3f(b,p0[r+2],p0[r+3]);a=max3f(a,p1[r],p1[r+1]);b=max3f(b,p1[r+2],p1[r+3]);}
  const float m=max2f(a,b);
  auto rr=__builtin_amdgcn_permlane32_swap(__float_as_uint(m),__float_as_uint(m),false,false);
  return max2f(__uint_as_float(rr[0]),__uint_as_float(rr[1]));
}
__device__ __forceinline__ void pv(f32x16*o,int vb,bf16x8 pa0,bf16x8 pa1,bf16x8 pa2,bf16x8 pa3){
  #pragma unroll
  for(int d0=0;d0<4;++d0){s16x4 lo[4],hi[4];
    #pragma unroll
    for(int ks=0;ks<4;++ks){
      asm volatile("ds_read_b64_tr_b16 %0,%1 offset:%c2":"=&v"(lo[ks]):"v"(vb),"i"(d0*4096+ks*1024):"memory");
      asm volatile("ds_read_b64_tr_b16 %0,%1 offset:%c2":"=&v"(hi[ks]):"v"(vb),"i"(d0*4096+ks*1024+512):"memory");}
    asm volatile("s_waitcnt lgkmcnt(0)":::"memory");SBAR();
    #define PK(k) (bf16x8){lo[k][0],lo[k][1],lo[k][2],lo[k][3],hi[k][0],hi[k][1],hi[k][2],hi[k][3]}
    o[d0]=__builtin_amdgcn_mfma_f32_32x32x16_bf16(pa0,PK(0),o[d0],0,0,0);
    o[d0]=__builtin_amdgcn_mfma_f32_32x32x16_bf16(pa1,PK(1),o[d0],0,0,0);
    o[d0]=__builtin_amdgcn_mfma_f32_32x32x16_bf16(pa2,PK(2),o[d0],0,0,0);
    o[d0]=__builtin_amdgcn_mfma_f32_32x32x16_bf16(pa3,PK(3),o[d0],0,0,0);
    #undef PK
  }
}

#ifndef ATTN_STORE16
#define ATTN_STORE16(p,v) (*(u32x4*)(p)=(v))
#endif
template<int THRL> __device__ __forceinline__ void attn_unit(int b,int qcol,int kcol,int vcol,int ocol,int qb,const bf16*Q,const bf16*__restrict__ K,const bf16*__restrict__ V,bf16*O,char*shm){
  const int tid=tid_fresh(),lane=tid&63,r32=lane&31,hi=lane>>5; const int wid=__builtin_amdgcn_readfirstlane(tid>>6);
  const long rowbase=(long)b*SEQ; const int q0=qb*QB;
  const bf16*Qw=Q+(rowbase+q0+wid*QBLK)*DM+qcol;
  const bf16*Kh=K+rowbase*DM+kcol,*Vh=V+rowbase*DM+vcol;
  const unsigned lds0=(unsigned)(uintptr_t)shm;
  float*wsf=(float*)(shm+LDS_WS)+wid*64;
  const bf16*ksrc=Kh+(long)lane*DM+wid*8;
  const bf16*vsrc=Vh+(long)(16*(wid&3)+(lane>>2))*DM+(wid>>2)*32+(lane&3)*8;
  const unsigned kdst=lds0+LDS_K+wid*1024, vdst=lds0+LDS_V+wid*1024;
  #define DMA_K(t,slot) glds16(ksrc+(long)(t)*KVBLK*DM,(unsigned)__builtin_amdgcn_readfirstlane(kdst+(slot)))
  #define DMA_V(t,slot) do{ glds16(vsrc+(long)(t)*KVBLK*DM,(unsigned)__builtin_amdgcn_readfirstlane(vdst+2*(slot))); glds16(vsrc+64+(long)(t)*KVBLK*DM,(unsigned)__builtin_amdgcn_readfirstlane(vdst+2*(slot)+8192)); }while(0)
  const int vb0=(int)(lds0+LDS_V)+((lane>>4)&1)*32+(lane&3)*8+(4*hi+((lane&15)>>2))*64;
  const char*Kbase=shm+LDS_K; bf16x8 kf[8];
  const lds_cptr shm3=(lds_cptr)shm; const lds_cptr kp0=shm3+LDS_K+hi*1024+r32*16; const lds_cptr vp0=shm3+LDS_V+((lane>>4)&1)*32+(lane&3)*8+(4*hi+((lane&15)>>2))*64;
  const int NT=(q0+QB)/KVBLK;
  DMA_K(0,0);DMA_V(0,0);DMA_K(1,SLOTB);
  bf16x8 qr[4];
  #pragma unroll
  for(int d0=0;d0<4;++d0)qr[d0]=*reinterpret_cast<const bf16x8*>(&Qw[(long)r32*DM+d0*16+hi*8]);
  float mhat=0.f,l_reg=0.f;f32x16 o[4];f32x16 negm;{float z_=0.f;asm volatile("":"+v"(z_));o[0]=(f32x16)(z_);o[1]=(f32x16)(z_);o[2]=(f32x16)(z_);o[3]=(f32x16)(z_);negm=(f32x16)(z_);}asm volatile("":"+v"(negm));
  const int qrel=wid*QBLK+r32;
  #define CMASK(P0,P1,t) do{int jb_=(t)-(NT-4); if(jb_>=0)cmask(P0,P1,jb_,qrel,hi);}while(0)
  bool resc=false;
  #define START(P0,P1) do{ const float rm=rowmax(P0,P1); resc=false; \
    { const float dl=rm; mhat=fadd_s(mhat,dl); \
      _Pragma("unroll") for(int r=0;r<16;++r){P0[r]=fsub_s(P0[r],dl);P1[r]=fsub_s(P1[r],dl);} \
      _Pragma("unroll") for(int r=0;r<16;++r)negm[r]=-mhat; asm volatile("":"+v"(negm)); } \
    _Pragma("unroll") for(int r=0;r<16;++r)P0[r]=__builtin_amdgcn_exp2f(P0[r]); }while(0)
  #define RESC() do{ if(resc){ asm volatile("s_waitcnt lgkmcnt(0)":::"memory"); \
      _Pragma("unroll") for(int d_=0;d_<4;++d_) _Pragma("unroll") for(int r=0;r<16;++r)o[d_][r]*=wsf[crow(r,hi)]; } }while(0)
  f32x16 pA0,pA1,pB0,pB1;
  int sl_prev=0,sl_cur=0,sl_next=SLOTB;
  #define ROT() do{sl_prev=sl_cur;sl_cur=sl_next;sl_next=(sl_next==(NSLOT-1)*SLOTB)?0:sl_next+SLOTB;}while(0)
  DMA_K(2,2*SLOTB);
  WAIT_BAR(4);
  qkt(pA0,pA1,Kbase,qr,negm,r32,hi);asm volatile("s_nop 15\n\ts_nop 7":"+v"(pA0),"+v"(pA1));CMASK(pA0,pA1,0);
  START(pA0,pA1);
  _Pragma("unroll") for(int r=0;r<16;++r)pA1[r]=__builtin_amdgcn_exp2f(pA1[r]);
  WAIT_BAR(0);
  DMA_K(3,0);DMA_V(1,SLOTB);
  ROT();
  kload8(kf,kp0+sl_cur);
  WAIT_BAR(3);
  s16x4 vlo[8],vhi[8]; u32x4 pw0,pw1,pw2,pw3;
  #define PKW(P,B) cvtpk_s(P[B],P[B+1])
  #define PAF(k) __builtin_bit_cast(bf16x8,pw##k)
  #define VFR(i) (bf16x8){vlo[i][0],vlo[i][1],vlo[i][2],vlo[i][3],vhi[i][0],vhi[i][1],vhi[i][2],vhi[i][3]}
  #define PIN(x) asm volatile("":"+v"(x))
  #define MX3(a,b,c) __builtin_fmaxf(__builtin_fmaxf((a),(b)),(c))
  #define GAPA(MF,A0,A1,A2,A3,W0,W1,PW) do{ MF; sacc+=A0; sacc+=A1; sacc+=A2; sacc+=A3; PIN(sacc); W0; W1; PIN(PW); SBAR(); }while(0)
  #define EX(v) __builtin_amdgcn_exp2f(v)
  #define GAPB(MF,X,B) do{ MF; X[B]=EX(X[B]); X[B+1]=EX(X[B+1]); X[B+2]=EX(X[B+2]); X[B+3]=EX(X[B+3]); PIN(X); SBAR(); }while(0)
  #define VRD(i) do{ vlo[i]=vtr(vp_+(((i)>>2)*4096+((i)&3)*1024)); vhi[i]=vtr(vp_+(((i)>>2)*4096+((i)&3)*1024+512)); }while(0)
  #define VRD2(i) do{ vlo[i]=vtr(vp_+((((i)>>2)+2)*4096+((i)&3)*1024)); vhi[i]=vtr(vp_+((((i)>>2)+2)*4096+((i)&3)*1024+512)); SBAR(); }while(0)
  #define KRD(G,j) do{ if(G){ kload2(kf,kp0+sl_next,j); SBAR(); } }while(0)
  #define STEP(C0,C1,P0,P1,t,GK,GV,GL) do{ SBAR(); \
    const lds_cptr vp_=vp0+2*sl_prev; \
    VRD(0); SBAR(); float sacc=(P0[0]+P0[1]); \
    GAPA(C0=__builtin_amdgcn_mfma_f32_32x32x16_bf16(kf[0],qr[0],negm,0,0,0), P0[2],P0[3],P0[4],P0[5],     pw0[0]=PKW(P0,0), pw0[1]=PKW(P0,2), pw0); \
    VRD(4); SBAR(); GAPA(C1=__builtin_amdgcn_mfma_f32_32x32x16_bf16(kf[1],qr[0],negm,0,0,0), P0[6],P0[7],P0[8],P0[9],     pw0[2]=PKW(P0,4), pw0[3]=PKW(P0,6), pw0); \
    VRD(1); SBAR(); GAPA(C0=__builtin_amdgcn_mfma_f32_32x32x16_bf16(kf[2],qr[1],C0,0,0,0),   P0[10],P0[11],P0[12],P0[13], pw1[0]=PKW(P0,8), pw1[1]=PKW(P0,10), pw1); \
    VRD(5); SBAR(); GAPA(C1=__builtin_amdgcn_mfma_f32_32x32x16_bf16(kf[3],qr[1],C1,0,0,0),   P0[14],P0[15],P1[0],P1[1],   pw1[2]=PKW(P0,12),pw1[3]=PKW(P0,14), pw1); \
    VRD(2); SBAR(); GAPA(C0=__builtin_amdgcn_mfma_f32_32x32x16_bf16(kf[4],qr[2],C0,0,0,0),   P1[2],P1[3],P1[4],P1[5],     pw2[0]=PKW(P1,0), pw2[1]=PKW(P1,2), pw2); \
    VRD(6); SBAR(); GAPA(C1=__builtin_amdgcn_mfma_f32_32x32x16_bf16(kf[5],qr[2],C1,0,0,0),   P1[6],P1[7],P1[8],P1[9],     pw2[2]=PKW(P1,4), pw2[3]=PKW(P1,6), pw2); \
    VRD(3); SBAR(); GAPA(C0=__builtin_amdgcn_mfma_f32_32x32x16_bf16(kf[6],qr[3],C0,0,0,0),   P1[10],P1[11],P1[12],P1[13], pw3[0]=PKW(P1,8), pw3[1]=PKW(P1,10), pw3); \
    VRD(7); SBAR(); GAPA(C1=__builtin_amdgcn_mfma_f32_32x32x16_bf16(kf[7],qr[3],C1,0,0,0),   P1[14],P1[15],0.f,0.f,       pw3[2]=PKW(P1,12),pw3[3]=PKW(P1,14), pw3); \
    l_reg+=sacc; \
    if(GK){DMA_K((t)+3,sl_cur);} if(GV){DMA_V((t)+1,sl_next);} \
    CMASK(C0,C1,t); \
    { float a=MX3(C0[0],C0[1],C1[0]),b=MX3(C0[2],C0[3],C1[1]); a=MX3(a,C1[2],C1[3]); \
      _Pragma("unroll") for(int r=4;r<16;r+=4){a=MX3(a,C0[r],C0[r+1]);b=MX3(b,C0[r+2],C0[r+3]);a=MX3(a,C1[r],C1[r+1]);b=MX3(b,C1[r+2],C1[r+3]);} \
      float rm=__builtin_fmaxf(a,b); { auto rr=__builtin_amdgcn_permlane32_swap(__float_as_uint(rm),__float_as_uint(rm),false,false); rm=__builtin_fmaxf(__uint_as_float(rr[0]),__uint_as_float(rr[1])); } \
      resc=false; \
      if(__builtin_expect(__any(rm>(float)THRL),0)){ const float dl=__builtin_fmaxf(rm,0.f); mhat+=dl; \
        _Pragma("unroll") for(int r=0;r<16;++r){C0[r]-=dl;C1[r]-=dl;} \
        _Pragma("unroll") for(int r=0;r<16;++r)negm[r]=-mhat; asm volatile("":"+v"(negm)); \
        const float f=__builtin_amdgcn_exp2f(-dl); l_reg*=f; if(hi==0)wsf[r32]=f; resc=true; } } \
    SBAR(); \
    GAPB(o[0]=__builtin_amdgcn_mfma_f32_32x32x16_bf16(PAF(0),VFR(0),o[0],0,0,0), C0,0); VRD2(0); \
    GAPB(o[1]=__builtin_amdgcn_mfma_f32_32x32x16_bf16(PAF(0),VFR(4),o[1],0,0,0), C0,4); VRD2(4); \
    KRD(GL,0); GAPB(o[0]=__builtin_amdgcn_mfma_f32_32x32x16_bf16(PAF(1),VFR(1),o[0],0,0,0), C0,8); VRD2(1); \
    KRD(GL,1); GAPB(o[1]=__builtin_amdgcn_mfma_f32_32x32x16_bf16(PAF(1),VFR(5),o[1],0,0,0), C0,12); VRD2(5); \
    KRD(GL,2); GAPB(o[0]=__builtin_amdgcn_mfma_f32_32x32x16_bf16(PAF(2),VFR(2),o[0],0,0,0), C1,0); VRD2(2); \
    KRD(GL,3); GAPB(o[1]=__builtin_amdgcn_mfma_f32_32x32x16_bf16(PAF(2),VFR(6),o[1],0,0,0), C1,4); VRD2(6); \
    GAPB(o[0]=__builtin_amdgcn_mfma_f32_32x32x16_bf16(PAF(3),VFR(3),o[0],0,0,0), C1,8); VRD2(3); \
    GAPB(o[1]=__builtin_amdgcn_mfma_f32_32x32x16_bf16(PAF(3),VFR(7),o[1],0,0,0), C1,12); VRD2(7); \
    o[2]=__builtin_amdgcn_mfma_f32_32x32x16_bf16(PAF(0),VFR(0),o[2],0,0,0); o[3]=__builtin_amdgcn_mfma_f32_32x32x16_bf16(PAF(0),VFR(4),o[3],0,0,0); SBAR(); \
    o[2]=__builtin_amdgcn_mfma_f32_32x32x16_bf16(PAF(1),VFR(1),o[2],0,0,0); o[3]=__builtin_amdgcn_mfma_f32_32x32x16_bf16(PAF(1),VFR(5),o[3],0,0,0); SBAR(); \
    o[2]=__builtin_amdgcn_mfma_f32_32x32x16_bf16(PAF(2),VFR(2),o[2],0,0,0); o[3]=__builtin_amdgcn_mfma_f32_32x32x16_bf16(PAF(2),VFR(6),o[3],0,0,0); SBAR(); \
    o[2]=__builtin_amdgcn_mfma_f32_32x32x16_bf16(PAF(3),VFR(3),o[2],0,0,0); o[3]=__builtin_amdgcn_mfma_f32_32x32x16_bf16(PAF(3),VFR(7),o[3],0,0,0); SBAR(); \
    }while(0)
  int t=1;
  #undef CMASK
  #define CMASK(P0,P1,t) do{}while(0)
  for(;t+5<NT;t+=2){
    STEP(pB0,pB1,pA0,pA1,t,true,true,true);     WAIT_BAR(3); RESC(); ROT();
    STEP(pA0,pA1,pB0,pB1,t+1,true,true,true);   WAIT_BAR(3); RESC(); ROT();
  }
  #undef CMASK
  #define CMASK(P0,P1,t) do{int jb_=(t)-(NT-4); if(jb_>=0)cmask(P0,P1,jb_,qrel,hi);}while(0)
  #define ENDW(tt) do{ if((tt)+3<NT){WAIT_BAR(3);} else if((tt)+2<NT){WAIT_BAR(2);} else {WAIT_BAR(0);} }while(0)
  for(;t+1<NT;t+=2){
    STEP(pB0,pB1,pA0,pA1,t,(t+3<NT),(t+1<NT),(t+1<NT));       ENDW(t);   RESC(); ROT();
    STEP(pA0,pA1,pB0,pB1,t+1,(t+4<NT),(t+2<NT),(t+2<NT));     ENDW(t+1); RESC(); ROT();
  }
  STEP(pB0,pB1,pA0,pA1,NT-1,false,false,false); RESC();
  { float sacc=pB0[0]+pB0[1]; _Pragma("unroll") for(int r=2;r<16;++r)sacc+=pB0[r]; _Pragma("unroll") for(int r=0;r<16;++r)sacc+=pB1[r]; l_reg+=sacc;
    pw0=(u32x4){PKW(pB0,0),PKW(pB0,2),PKW(pB0,4),PKW(pB0,6)};pw1=(u32x4){PKW(pB0,8),PKW(pB0,10),PKW(pB0,12),PKW(pB0,14)};pw2=(u32x4){PKW(pB1,0),PKW(pB1,2),PKW(pB1,4),PKW(pB1,6)};pw3=(u32x4){PKW(pB1,8),PKW(pB1,10),PKW(pB1,12),PKW(pB1,14)};
    SBAR(); pv(o,vb0+2*sl_cur,PAF(0),PAF(1),PAF(2),PAF(3)); }
  #undef PKW
  #undef PAF
  #undef VFR
  #undef PIN
  #undef MX3
  #undef GAPA
  #undef GAPB
  #undef EX
  #undef VRD
  #undef VRD2
  #undef KRD
  #undef STEP
  #undef ENDW
  {auto rr=__builtin_amdgcn_permlane32_swap(__float_as_uint(l_reg),__float_as_uint(l_reg),false,false);l_reg=__uint_as_float(rr[0])+__uint_as_float(rr[1]);}
  if(hi==0)wsf[32+r32]=l_reg;asm volatile("s_waitcnt lgkmcnt(0)":::"memory");
  float rli[16];
  #pragma unroll
  for(int r=0;r<16;++r)rli[r]=__builtin_amdgcn_rcpf(wsf[32+crow(r,hi)]);
  bf16*Ow=O+(rowbase+q0+wid*QBLK)*DM+ocol;
  { bf16*stg=(bf16*)(shm+LDS_OST)+wid*4096;
    #pragma unroll
    for(int r=0;r<16;++r){const int orow=crow(r,hi);
      #pragma unroll
      for(int d0=0;d0<4;++d0)stg[orow*128+d0*32+r32]=__float2bfloat16(o[d0][r]*rli[r]);}
    asm volatile("s_waitcnt lgkmcnt(0)":::"memory");
    #pragma unroll
    for(int i=0;i<8;++i){const int row=i*4+(lane>>4),ch=lane&15; const u32x4 v=*(const u32x4*)(stg+row*128+ch*8); ATTN_STORE16(Ow+(long)row*DM+ch*8,v);} }
  asm volatile("s_waitcnt lgkmcnt(0)\n\ts_barrier":::"memory");
  #undef DMA_K
  #undef DMA_V
  #undef CMASK
  #undef START
  #undef RESC
  #undef ROT
}
constexpr int ATTN_LDS_BYTES=LDS_BYTES;
#undef SBAR
#undef WAIT_BAR
}

__device__ __forceinline__ void fstage_attn(const Params& p, int l, char* lds) {
    const int G = gridDim.x, bx = blockIdx.x;
    const int vcu = (G % 8 == 0) ? (bx % 8) * (G / 8) + bx / 8 : bx;
    const attn_body::bf16* Q = (const attn_body::bf16*)(p.ws + WS_QB); const attn_body::bf16* K = (const attn_body::bf16*)(p.ws + WS_KB); const attn_body::bf16* V = (const attn_body::bf16*)(p.ws + WS_VB);
    for (int k = vcu; k < 256; k += G) {
        const int s = k & 7, h = (k >> 3) & 3, b = k >> 5;
#pragma unroll 1
        for (int i = 0; i < 4; ++i) {
            const int qb = (i & 2) ? 15 - s : s, m = i & 1;
            attn_body::bf16* O = (attn_body::bf16*)(p.ws + (m == 0 ? WS_O1 : WS_O2));
            attn_body::attn_unit<8>(b, (2 * h + m) * 64, (2 * h + m) * 64, h * 128, h * 128, qb, Q, K, V, O, lds);
        }
    }
    asm volatile("s_waitcnt vmcnt(0)" ::: "memory");
    __syncthreads();
    int vc2 = vcu; asm volatile("" : "+s"(vc2));
    for (int k = vc2; k < 256; k += G) {
        const int s = k & 7, h = (k >> 3) & 3, b = k >> 5;
        const int tid = tid_fresh(), lane = tid & 63, wid = tid >> 6;
        const float* lq = (const float*)p.in[5] + l * 256;
        float d1 = lq[lane] * lq[64 + lane], d2 = lq[128 + lane] * lq[192 + lane];
        d1 = wave_sum(d1); d2 = wave_sum(d2);
        const float lam = expf(d1) - expf(d2) + lam_init_of(l);
#pragma unroll 2
        for (int it = 0; it < 16; ++it) {
            const int qb = (it & 8) ? 15 - s : s, r = (it & 7) * 32 + wid * 4 + (lane >> 4);
            const size_t o = ((size_t)b * S + qb * 256 + r) * 512 + h * 128 + (lane & 15) * 8;
            const u32x4 a = *(const u32x4*)((const bf16_t*)(p.ws + WS_O1) + o), c = *(const u32x4*)((const bf16_t*)(p.ws + WS_O2) + o);
            float x[8];
#pragma unroll
            for (int e = 0; e < 4; ++e) { x[2 * e] = __uint_as_float(a[e] << 16) - lam * __uint_as_float(c[e] << 16); x[2 * e + 1] = __uint_as_float(a[e] & 0xffff0000u) - lam * __uint_as_float(c[e] & 0xffff0000u); }
            float ss = 0.f;
#pragma unroll
            for (int e = 0; e < 8; ++e) ss += x[e] * x[e];
            ss = sum16(ss);
            const float rs = rsqrtf(ss * (1.f / 128.f) + EPS);
            u32x4 w;
#pragma unroll
            for (int e = 0; e < 4; ++e) w[e] = pk2(x[2 * e] * rs, x[2 * e + 1] * rs);
            *(u32x4*)((bf16_t*)(p.ws + WS_AO) + o) = w;
        }
    }
}


__device__ __forceinline__ void fstage_sgate(const Params& p, int l, lds_t lds) {
    unsigned char* ws = p.ws;
    const int tid = tid_fresh(), lane = tid & 63, wid = __builtin_amdgcn_readfirstlane(tid >> 6), fr = lane & 15, fq = lane >> 4;
    constexpr int VP = 132;
    PG8_LAS bf16_t* vnT = (PG8_LAS bf16_t*)lds;
    PG8_LAS float* st = (PG8_LAS float*)(lds + 512 * VP * 2);
    const bf16_t* vin = (const bf16_t*)(ws + WS_VIN); const bf16_t* uin = (const bf16_t*)(ws + WS_UIN); bf16_t* so = (bf16_t*)(ws + WS_SO);
    const float* lng = (const float*)p.in[9] + l * 512; const float* lnb = (const float*)p.in[10] + l * 512; const float* bsp = (const float*)p.in[12] + l * 512;
    const bf16_t* wsm = (const bf16_t*)(ws + WS_WSPT) + (size_t)l * 4 * 16384;
    for (int ch = blockIdx.x; ch < T / 128; ch += gridDim.x) {
        const int t0 = ch * 128;
        __syncthreads();
#pragma unroll 4
        for (int i = 0; i < 16; ++i) {
            const int row = wid * 16 + i;
            f32x4 a, b; up8(*(const u32x4*)(vin + (size_t)(t0 + row) * 512 + lane * 8), a, b);
            const float mu = wave_sum((a[0] + a[1]) + (a[2] + a[3]) + (b[0] + b[1]) + (b[2] + b[3])) * (1.f / 512.f);
            a = a - mu; b = b - mu;
            const float vr = wave_sum((a[0] * a[0] + a[1] * a[1]) + (a[2] * a[2] + a[3] * a[3]) + (b[0] * b[0] + b[1] * b[1]) + (b[2] * b[2] + b[3] * b[3])) * (1.f / 512.f);
            if (lane == 0) { st[2 * row] = mu; st[2 * row + 1] = rsqrtf(vr + EPS); }
        }
        __syncthreads();
        {
            const int cp = tid & 255, pb = tid >> 8;
            const float g0 = lng[2 * cp], g1 = lng[2 * cp + 1], b0 = lnb[2 * cp], b1 = lnb[2 * cp + 1];
#pragma unroll 2
            for (int blk = 0; blk < 8; ++blk) {
                const int s0 = (pb * 8 + blk) * 8;
                unsigned w[8];
#pragma unroll
                for (int e = 0; e < 8; ++e) w[e] = *(const unsigned*)(vin + (size_t)(t0 + s0 + e) * 512 + 2 * cp);
                float y0[8], y1[8];
#pragma unroll
                for (int e = 0; e < 8; ++e) { const float mu = st[2 * (s0 + e)], rs = st[2 * (s0 + e) + 1];
                    y0[e] = (__uint_as_float(w[e] << 16) - mu) * rs * g0 + b0; y1[e] = (__uint_as_float(w[e] & 0xffff0000u) - mu) * rs * g1 + b1; }
                PG8_LAS u32x2* d0 = (PG8_LAS u32x2*)(vnT + (2 * cp) * VP + s0); PG8_LAS u32x2* d1 = (PG8_LAS u32x2*)(vnT + (2 * cp + 1) * VP + s0);
                d0[0] = (u32x2){pk2(y0[0], y0[1]), pk2(y0[2], y0[3])}; d0[1] = (u32x2){pk2(y0[4], y0[5]), pk2(y0[6], y0[7])};
                d1[0] = (u32x2){pk2(y1[0], y1[1]), pk2(y1[2], y1[3])}; d1[1] = (u32x2){pk2(y1[4], y1[5]), pk2(y1[6], y1[7])};
            }
        }
        __syncthreads();
        const int nks = (16 * wid + 16 + 31) >> 5;
        const int trow = t0 + 16 * wid + fr;
#pragma unroll 1
        for (int g = 0; g < 4; ++g) {
            f32x4 acc[8];
#pragma unroll
            for (int nt = 0; nt < 8; ++nt) acc[nt] = (f32x4){0.f, 0.f, 0.f, 0.f};
            const bf16_t* wrow = wsm + ((size_t)g * 128 + 16 * wid + fr) * 128 + fq * 8;
#pragma unroll 1
            for (int ks = 0; ks < nks; ++ks) {
                const bf16x8 af = *(const bf16x8*)(wrow + ks * 32);
#pragma unroll
                for (int nt = 0; nt < 8; ++nt) {
                    const PG8_LAS u32x2* bp = (const PG8_LAS u32x2*)(vnT + (g * 128 + nt * 16 + fr) * VP + ks * 32 + fq * 8);
                    const u32x2 lo = bp[0], hi = bp[1];
                    const bf16x8 bf = __builtin_bit_cast(bf16x8, (u32x4){lo.x, lo.y, hi.x, hi.y});
                    acc[nt] = __builtin_amdgcn_mfma_f32_16x16x32_bf16(bf, af, acc[nt], 0, 0, 0);
                }
            }
            const float bs = bsp[g * 128 + 16 * wid + fr];
#pragma unroll
            for (int nt = 0; nt < 8; ++nt) { const size_t o = (size_t)trow * 512 + g * 128 + nt * 16 + fq * 4; st_bf4(so + o, ld_bf4(uin + o) * (acc[nt] + bs)); }
        }
    }
}

__device__ __forceinline__ void stage_pool_d(const Params& p, int bid, int nb) {
    const int tidx = tid_fresh();
    unsigned char* ws = p.ws;
    const unsigned char* pin = ws + WS_PIN; unsigned char* dp = ws + WS_DP;
    for (int i = bid * NT + tidx; i < (T / 8) * 64; i += nb * NT) {
        const int c8 = (i & 63) * 8, t0 = (i >> 6) * 8, s0 = t0 & (S - 1), g = c8 >> 7, w = 2 << g;
        const unsigned ob = (unsigned)(t0 * 512 + c8) * 2u;
        u32x4 pv[16], cv[8];
#pragma unroll
        for (int k = 1; k <= 16; ++k) pv[k - 1] = (k <= w && k <= s0) ? *(const u32x4*)(pin + (ob - (unsigned)k * 1024u)) : (u32x4){0u, 0u, 0u, 0u};
#pragma unroll
        for (int j = 0; j < 8; ++j) cv[j] = *(const u32x4*)(pin + (ob + (unsigned)j * 1024u));
        f32x4 s0v = (f32x4){0.f, 0.f, 0.f, 0.f}, s1v = s0v, a, b;
#pragma unroll
        for (int k = 0; k < 16; ++k) { up8(pv[k], a, b); s0v = s0v + a; s1v = s1v + b; }
#pragma unroll
        for (int j = 0; j < 8; ++j) {
            f32x4 ca, cb; up8(cv[j], ca, cb); s0v = s0v + ca; s1v = s1v + cb;
            u32x4 lv = pv[(15 - j) & 15];
            if (g == 2) lv = pv[7 - j];
            if (g == 1) lv = (j < 4) ? pv[3 - (j & 3)] : cv[(j - 4) & 7];
            if (g == 0) lv = (j < 2) ? pv[1 - (j & 1)] : cv[(j - 2) & 7];
            up8(lv, a, b); s0v = s0v - a; s1v = s1v - b;
            const int sj = s0 + j + 1; const float inv = 1.f / (float)(sj < w ? sj : w);
            *(u32x4*)(dp + (ob + (unsigned)j * 1024u)) = pk8(s0v * inv - ca, s1v * inv - cb);
        }
    }
}
__device__ __forceinline__ void stage_aout(const Params& p, int l, int bid, int nb) {
    const int tidx = tid_fresh();
    unsigned char* ws = p.ws;
    const int lane = tidx & 63, wid = tidx >> 6;
    const float* lq = (const float*)p.in[5] + l * 256;
    float d1 = lq[lane] * lq[64 + lane], d2 = lq[128 + lane] * lq[192 + lane];
    d1 = wave_sum(d1); d2 = wave_sum(d2);
    const float lam = expf(d1) - expf(d2) + lam_init_of(l);
    for (int t = bid * 8 + wid; t < T; t += nb * 8) {
        const u32x4 a = *(const u32x4*)((const bf16_t*)(ws + WS_O1) + (size_t)t * 512 + lane * 8), b = *(const u32x4*)((const bf16_t*)(ws + WS_O2) + (size_t)t * 512 + lane * 8);
        float x[8];
#pragma unroll
        for (int e = 0; e < 4; ++e) { x[2 * e] = __uint_as_float(a[e] << 16) - lam * __uint_as_float(b[e] << 16); x[2 * e + 1] = __uint_as_float(a[e] & 0xffff0000u) - lam * __uint_as_float(b[e] & 0xffff0000u); }
        float ss = 0.f;
#pragma unroll
        for (int e = 0; e < 8; ++e) ss += x[e] * x[e];
        ss = sum16(ss);
        const float rs = rsqrtf(ss * (1.f / 128.f) + EPS);
        u32x4 w;
#pragma unroll
        for (int e = 0; e < 4; ++e) w[e] = pk2(x[2 * e] * rs, x[2 * e + 1] * rs);
        *(u32x4*)((bf16_t*)(ws + WS_AO) + (size_t)t * 512 + lane * 8) = w;
    }
}
__device__ __forceinline__ unsigned key_of(float s, unsigned low) { const unsigned u = __float_as_uint(s); const unsigned k = (u & 0x80000000u) ? ~u : (u | 0x80000000u); return (k & ~255u) | low; }
__device__ __forceinline__ float val_of(unsigned key) { const unsigned k = key & ~255u; const unsigned u = (k & 0x80000000u) ? (k & 0x7fffffffu) : ~k; return __uint_as_float(u); }
__device__ __forceinline__ void sort16_desc(unsigned (&a)[16]) {
#pragma unroll
    for (int k = 2; k <= 16; k <<= 1)
#pragma unroll
        for (int j = k >> 1; j > 0; j >>= 1)
#pragma unroll
            for (int i = 0; i < 16; ++i) { const int l = i ^ j; if (l > i) { const unsigned hi = a[i] > a[l] ? a[i] : a[l], lo = a[i] > a[l] ? a[l] : a[i];
                if ((i & k) == 0) { a[i] = hi; a[l] = lo; } else { a[i] = lo; a[l] = hi; } } }
}
__device__ __forceinline__ void merge_top16(unsigned (&r)[16], const unsigned (&b)[16]) {
#pragma unroll
    for (int i = 0; i < 16; ++i) r[i] = r[i] > b[15 - i] ? r[i] : b[15 - i];
#pragma unroll
    for (int j = 8; j > 0; j >>= 1)
#pragma unroll
        for (int i = 0; i < 16; ++i) { const int l = i ^ j; if (l > i) { const unsigned hi = r[i] > r[l] ? r[i] : r[l], lo = r[i] > r[l] ? r[l] : r[i]; r[i] = hi; r[l] = lo; } }
}
__device__ __forceinline__ constexpr int cand_pair(int q) {
    int c = 0;
    for (int a = 0; a < 16; ++a) for (int b = 0; b < 16; ++b) if ((a + 1) * (b + 1) <= 16) { if (c == q) return a * 16 + b; ++c; }
    return -1;
}
template <class Sched>
__device__ __forceinline__ void topk_local(const Params& p, const Sched& O, lds_t lds) {
    const int tidx = tid_fresh(), lane = tidx & 63, wid = __builtin_amdgcn_readfirstlane(tidx >> 6);
    unsigned char* ws = p.ws;
    const _Float16* sc = (const _Float16*)(ws + WS_SC);
    constexpr int PITCH = 272;
    PG8_LAS unsigned char* st = lds + wid * (64 * PITCH);
#pragma unroll 1
    for (int bi = wid; ; bi += 8) {
        pg8::Unit u; if (!O.next(bi >> 2, u)) break;
        const int t0 = u.pm * 256 + (bi & 3) * 64, head = u.pn;
        unsigned la[16], lb[16], blk[16];
#pragma unroll
        for (int h = 0; h < 2; ++h) {
            unsigned (&top)[16] = h == 0 ? la : lb;
            u32x4 w[16];
#pragma unroll
            for (int q = 0; q < 16; ++q) w[q] = *(const u32x4*)(sc + (size_t)(t0 + 4 * q + (lane >> 4)) * 2048 + head * 256 + h * 128 + (lane & 15) * 8);
#pragma unroll
            for (int q = 0; q < 16; ++q) *(PG8_LAS u32x4*)(st + (4 * q + (lane >> 4)) * PITCH + (lane & 15) * 16) = w[q];
#pragma unroll
            for (int n0 = 0; n0 < 128; n0 += 16) {
                const f16x8 h0 = *(const PG8_LAS f16x8*)(st + lane * PITCH + n0 * 2), h1 = *(const PG8_LAS f16x8*)(st + lane * PITCH + n0 * 2 + 16);
#pragma unroll
                for (int e = 0; e < 8; ++e) { blk[e] = key_of((float)h0[e], 255u - (unsigned)(n0 + e)); blk[8 + e] = key_of((float)h1[e], 255u - (unsigned)(n0 + 8 + e)); }
                sort16_desc(blk);
                if (n0 == 0) {
#pragma unroll
                    for (int e = 0; e < 16; ++e) top[e] = blk[e];
                } else merge_top16(top, blk);
            }
        }
        const int i = (t0 + lane) * 8 + head;
        float sa[16], sb[16];
#pragma unroll
        for (int j = 0; j < 16; ++j) { sa[j] = val_of(la[j]); sb[j] = val_of(lb[j]); }
        unsigned lc[16];
#pragma unroll
        for (int q0 = 0; q0 < 64; q0 += 16) {
#pragma unroll
            for (int e = 0; e < 16; ++e) { const int ab = cand_pair(q0 + e); blk[e] = (ab >= 0) ? key_of(sa[ab >= 0 ? (ab >> 4) : 0] + sb[ab >= 0 ? (ab & 15) : 0], 255u - (unsigned)(ab >= 0 ? ab : 0)) : 0u; }
            sort16_desc(blk);
            if (q0 == 0) {
#pragma unroll
                for (int e = 0; e < 16; ++e) lc[e] = blk[e];
            } else merge_top16(lc, blk);
        }
        float g[16]; const float mx = val_of(lc[0]); float sum = 0.f;
#pragma unroll
        for (int j = 0; j < 16; ++j) { g[j] = __expf(val_of(lc[j]) - mx); sum += g[j]; }
        const float inv = 1.f / sum;
        int* ti = (int*)(ws + WS_TI) + (size_t)i * 16;
        int eo[16];
#pragma unroll
        for (int j = 0; j < 16; ++j) {
            const int c = 255 - (int)(lc[j] & 255u), a = c >> 4, b = c & 15;
            unsigned ka = la[0], kb = lb[0];
#pragma unroll
            for (int q = 1; q < 16; ++q) { ka = (a == q) ? la[q] : ka; kb = (b == q) ? lb[q] : kb; }
            const _Float16 gh = (_Float16)(g[j] * inv);
            eo[j] = ((255 - (int)(ka & 255u)) * 128 + (255 - (int)(kb & 255u))) | ((int)__builtin_bit_cast(unsigned short, gh) << 16);
        }
#pragma unroll
        for (int j = 0; j < 16; j += 4) *(int __attribute__((ext_vector_type(4)))*)(ti + j) = (int __attribute__((ext_vector_type(4)))){eo[j], eo[j + 1], eo[j + 2], eo[j + 3]};
    }
}
__device__ __forceinline__ void fstage_pscore(const Params& p, int l, lds_t lds, int bid, int nb) {
    pg8::Order O; O.init(T, 2048, nb, bid, p.ws + WS_XB, D, p.ws + WS_SKT + (size_t)l * 2048 * D * 2, D);
    pg8::gemm_phase<GEpiScaleF16, pg8::Order, true>(lds, D, D, D, O, GEpiScaleF16{p.ws, (_Float16*)(p.ws + WS_SC), 2048});
    topk_local(p, O, lds);
}
#define XB_TMO      128
#define XB_XCNT(j)  (256  + 64 * (j))
#define XB_XSUB(j)  (1280 + 64 * (j))
#define XB_XGEN(j)  (2304 + 64 * (j))
#define XB_TOP      3328
#define XB_TOPGEN   3392
#define XCD_BAR_WORDS 3456
#define XB_SPIN_CAP (1u << 18)
#define LAS __attribute__((address_space(3)))

__device__ __forceinline__ unsigned xb_ld(unsigned* p)              { return __hip_atomic_load(p, __ATOMIC_RELAXED, __HIP_MEMORY_SCOPE_AGENT); }
__device__ __forceinline__ unsigned xb_add(unsigned* p, unsigned v) { return __hip_atomic_fetch_add(p, v, __ATOMIC_RELAXED, __HIP_MEMORY_SCOPE_AGENT); }
__device__ __forceinline__ unsigned xb_xcc_id() { return (unsigned)__builtin_amdgcn_s_getreg((3 << 11) | 20) & 0xFu; }
#define XB_SPIN(cond, bar) do { unsigned _sp = 0; while (cond) { __builtin_amdgcn_s_sleep(1); \
    if ((++_sp & 255u) == 0u) { if (xb_ld(&(bar)[XB_TMO])) break; if (_sp > XB_SPIN_CAP) { atomicAdd(&(bar)[XB_TMO], 1u); break; } } } } while (0)

struct XcdBarrier {
    unsigned* bar; unsigned x;
    volatile LAS unsigned* st;
};

__device__ __forceinline__ XcdBarrier xcd_barrier_post(unsigned* bar, volatile LAS unsigned* st) {
    XcdBarrier b; b.bar = bar; b.x = xb_xcc_id(); b.st = st;
    if (tid_fresh() == 0) (void)xb_add(&bar[XB_XCNT(b.x)], 1u);
    return b;
}
__device__ __forceinline__ void xcd_barrier_complete(unsigned* bar, unsigned x, unsigned& nloc, unsigned& nx) {
    const unsigned G = gridDim.x * gridDim.y * gridDim.z;
    unsigned sum, cnt, mine, sp = 0u;
    for (;;) {
        sum = 0u; cnt = 0u; mine = 0u;
#pragma unroll
        for (unsigned j = 0; j < 16; ++j) { const unsigned c = xb_ld(&bar[XB_XCNT(j)]); sum += c; cnt += (c > 0u) ? 1u : 0u; mine = (j == x) ? c : mine; }
        if (sum == G) break;
        __builtin_amdgcn_s_sleep(1);
        if ((++sp & 255u) == 0u) { if (xb_ld(&bar[XB_TMO])) break; if (sp > XB_SPIN_CAP) { atomicAdd(&bar[XB_TMO], 1u); break; } }
    }
    nloc = mine > 0u ? mine : 1u; nx = cnt > 0u ? cnt : 1u;
}

__device__ __forceinline__ void xcd_barrier(const XcdBarrier& b) {
    asm volatile("s_waitcnt vmcnt(0)" ::: "memory");
    __syncthreads();
    if (tid_fresh() == 0) {
        unsigned* bar = b.bar;
        __builtin_amdgcn_s_waitcnt(0);
        unsigned nloc = b.st[0], nx = b.st[1];
        if (nloc == 0u) { xcd_barrier_complete(bar, b.x, nloc, nx); b.st[0] = nloc; b.st[1] = nx; }
        const unsigned old = xb_add(&bar[XB_XSUB(b.x)], 1u);
        const unsigned gen = old / nloc;
        if (old + 1u == (gen + 1u) * nloc) {
            __builtin_amdgcn_fence(__ATOMIC_RELEASE, "agent");
            asm volatile("s_waitcnt vmcnt(0)" ::: "memory");
            const unsigned og = xb_add(&bar[XB_TOP], 1u);
            const unsigned tg = og / nx;
            if (og + 1u == (tg + 1u) * nx) xb_add(&bar[XB_TOPGEN], 1u);
            else XB_SPIN(xb_ld(&bar[XB_TOPGEN]) == tg, bar);
            __builtin_amdgcn_fence(__ATOMIC_ACQUIRE, "agent");
            xb_add(&bar[XB_XGEN(b.x)], 1u);
            asm volatile("s_waitcnt vmcnt(0)" ::: "memory");
        } else {
            XB_SPIN(xb_ld(&bar[XB_XGEN(b.x)]) == gen, bar);
            __builtin_amdgcn_fence(__ATOMIC_ACQUIRE, "agent");
            asm volatile("s_waitcnt vmcnt(0)" ::: "memory");
        }
    }
    __syncthreads();
}


constexpr int PQ_CH = 16, PQ_NCH = T / PQ_CH;
constexpr int CW_PQ = 16384;
constexpr size_t CTL_ZERO_BYTES = 131072;
__device__ __forceinline__ unsigned pq_pull(unsigned* head, int lane) {
    unsigned c = 0; if (lane == 0) c = __hip_atomic_fetch_add(head, 1u, __ATOMIC_RELAXED, __HIP_MEMORY_SCOPE_AGENT);
    return (unsigned)__builtin_amdgcn_readfirstlane((int)c);
}
__device__ __forceinline__ f32x2 gelu_pk(f32x2 v) {
    const f32x2 av = __builtin_elementwise_abs(v), d = av * 0.2316418882f + 1.0f;
    f32x2 t; t.x = __builtin_amdgcn_rcpf(d.x); t.y = __builtin_amdgcn_rcpf(d.y);
    f32x2 q = t * 0.5307027145f + (-0.7265760135f); q = q * t + 0.7107068705f; q = q * t + (-0.142248368f); q = q * t + 0.127414796f; q = q * t;
    const f32x2 s = (v * v) * (-0.72134752044f);
    f32x2 e; e.x = __builtin_amdgcn_exp2f(s.x); e.y = __builtin_amdgcn_exp2f(s.y);
    const f32x2 m = v * (q * e), r = v - m;
    f32x2 o; o.x = v.x < 0.f ? m.x : r.x; o.y = v.y < 0.f ? m.y : r.y; return o;
}
__device__ __forceinline__ float gelu_erf(float d) { return 0.5f * d * (1.f + erff(d * 0.70710678118654752f)); }

constexpr unsigned ENT_INVALID = 0xffffffffu;
typedef long i64x2 __attribute__((ext_vector_type(2)));
__device__ __forceinline__ void fstage_peer_u(const Params& p, int l, int qsel, lds_t lds, unsigned imask = 16383u, size_t aoff = 0, bool skipg = false) {
    unsigned char* ws = p.ws;
    const int tid = tid_fresh(), lane = tid & 63, wid = __builtin_amdgcn_readfirstlane(tid >> 6), n = lane & 15, kq = lane >> 4;
    const unsigned char* u8 = ws + WS_U8 + (size_t)l * NEXP * D;
    unsigned* heads = (unsigned*)(ws + WS_CTL) + CW_PQ + ((qsel * 2 + 0) * 8) * 64;
    const int myx = (int)(xb_xcc_id() & 7u);
    float* Aout = (float*)(ws + WS_PA + aoff);
    constexpr int RB_BYTES = 16 * 1024, LIST_MAX = 400, WREG = RB_BYTES + (LIST_MAX + 16) * 8;
    PG8_LAS unsigned char* rbuf = lds + wid * WREG;
    PG8_LAS unsigned* ent = (PG8_LAS unsigned*)(rbuf + RB_BYTES);
    PG8_LAS float* gl = (PG8_LAS float*)(rbuf + RB_BYTES + (LIST_MAX + 16) * 4);
#pragma unroll 1
    for (int s8 = 0; s8 < 8; ++s8) {
        const int k = (myx + s8) & 7;
        unsigned c = pq_pull(heads + k * 64, lane);
#pragma unroll 1
        for (;;) {
            if (c >= (unsigned)PQ_NCH) break;
            const int t0 = (int)c * PQ_CH;
            unsigned c_next = c; bool pulled = false;
            int mxs = 0x7f7f7f7f; asm volatile("" : "+v"(mxs));
            pg8::i32x8_t xf8[8];
            { const unsigned char* xp = ws + WS_XQ8 + (size_t)(t0 + n) * D + kq * 16;
#pragma unroll
              for (int i = 0; i < 8; ++i) { const pg8::i32x4_t lo = *(const pg8::i32x4_t*)(xp + (2 * i) * 64), hi = *(const pg8::i32x4_t*)(xp + (2 * i + 1) * 64); xf8[i] = __builtin_shufflevector(lo, hi, 0, 1, 2, 3, 4, 5, 6, 7); } }
            const float rs = row_rstd((const float*)(ws + WS_SSP), t0 + n) * (1.f / (SU * XS));
            float* ao = Aout + (size_t)(t0 + n) * 128;
            int i_next = 0;
#pragma unroll 1
            while (i_next < 16) {
                int e0v[16], e1v[16];
                { const int* ti = (const int*)(ws + WS_TI) + (size_t)t0 * 128;
#pragma unroll
                  for (int i = 0; i < 16; ++i) { e0v[i] = ti[i * 128 + lane]; e1v[i] = ti[i * 128 + 64 + lane]; } }
                int cnt = 0; int i_end = 16;
#pragma unroll
                for (int i = 0; i < 16; ++i) {
                    if (i >= i_next && i < i_end) {
                        if (cnt > LIST_MAX - 128) { i_end = i; }
                        else {
                            const int e0 = e0v[i] & 16383, e1 = e1v[i] & 16383;
                            const bool s0 = (e0 >> 11) == k, s1 = (e1 >> 11) == k;
                            const unsigned long long m0 = __ballot(s0), m1 = __ballot(s1);
                            const int b0 = (int)__builtin_amdgcn_mbcnt_hi((unsigned)(m0 >> 32), __builtin_amdgcn_mbcnt_lo((unsigned)m0, 0u));
                            const int b1 = (int)__builtin_amdgcn_mbcnt_hi((unsigned)(m1 >> 32), __builtin_amdgcn_mbcnt_lo((unsigned)m1, 0u));
                            const int c0 = __builtin_popcountll(m0);
                            if (s0) { ent[cnt + b0] = ((unsigned)i << 21) | ((unsigned)lane << 14) | (unsigned)e0; gl[cnt + b0] = (float)__builtin_bit_cast(_Float16, (unsigned short)((unsigned)e0v[i] >> 16)); }
                            if (s1) { ent[cnt + c0 + b1] = ((unsigned)i << 21) | ((unsigned)(64 + lane) << 14) | (unsigned)e1; gl[cnt + c0 + b1] = (float)__builtin_bit_cast(_Float16, (unsigned short)((unsigned)e1v[i] >> 16)); }
                            cnt += c0 + __builtin_popcountll(m1);
                        }
                    }
                }
                i_next = i_end;
                if (cnt == 0) continue;
                if (lane < 16) ent[cnt + lane] = ENT_INVALID;
                const int ng = skipg ? 0 : ((cnt + 15) >> 4);
                u32x4 W[16];
#define PU_LOAD(g_) do { const PG8_LAS u32x4* ep_ = (const PG8_LAS u32x4*)(ent + (g_) * 16); const u32x4 q0_ = ep_[0], q1_ = ep_[1], q2_ = ep_[2], q3_ = ep_[3]; \
                    _Pragma("unroll") for (int q = 0; q < 16; ++q) { const unsigned e_ = (q < 4) ? q0_[q & 3] : (q < 8) ? q1_[q & 3] : (q < 12) ? q2_[q & 3] : q3_[q & 3]; \
                        const unsigned iq_ = (e_ == ENT_INVALID) ? 0u : (e_ & imask); W[q] = *(const u32x4*)(u8 + (size_t)iq_ * D + lane * 16); } } while (0)
                if (!pulled) { pulled = true; c_next = pq_pull(heads + k * 64, lane); }
                if (ng > 0) PU_LOAD(0);
#pragma unroll 1
                for (int g = 0; g < ng; ++g) {
#pragma unroll
                    for (int q = 0; q < 16; ++q) *(PG8_LAS u32x4*)(rbuf + q * 1024 + ((lane ^ q) * 16)) = W[q];
                    if (g + 1 < ng) PU_LOAD(g + 1);
                    f32x4 acc;
                    const PG8_LAS unsigned char* fp = rbuf + n * 1024;
#pragma unroll
                    for (int Lb = 0; Lb < 16; Lb += 4) {
                        pg8::i32x4_t fa[4];
#pragma unroll
                        for (int L = 0; L < 4; ++L) fa[L] = *(const PG8_LAS pg8::i32x4_t*)(fp + ((((Lb + L) * 4 + kq) ^ n) * 16));
                        __builtin_amdgcn_sched_barrier(0);
                        const pg8::i32x8_t a0 = __builtin_shufflevector(fa[0], fa[1], 0, 1, 2, 3, 4, 5, 6, 7), a1 = __builtin_shufflevector(fa[2], fa[3], 0, 1, 2, 3, 4, 5, 6, 7);
                        if (Lb == 0) asm volatile("v_mfma_scale_f32_16x16x128_f8f6f4 %0, %1, %2, 0, %3, %3 op_sel_hi:[0,0,0]" : "=v"(acc) : "v"(a0), "v"(xf8[0]), "v"(mxs));
                        else asm volatile("v_mfma_scale_f32_16x16x128_f8f6f4 %0, %1, %2, %0, %3, %3 op_sel_hi:[0,0,0]" : "+v"(acc) : "v"(a0), "v"(xf8[Lb >> 1]), "v"(mxs));
                        asm volatile("v_mfma_scale_f32_16x16x128_f8f6f4 %0, %1, %2, %0, %3, %3 op_sel_hi:[0,0,0]" : "+v"(acc) : "v"(a1), "v"(xf8[(Lb >> 1) + 1]), "v"(mxs));
                        __builtin_amdgcn_sched_barrier(0);
                    }
                    asm volatile("s_nop 15\n\ts_nop 7" : "+v"(acc) :: "memory");
                    {
                        const u32x4 e4 = *(const PG8_LAS u32x4*)(ent + g * 16 + 4 * kq); const f32x4 g4 = *(const PG8_LAS f32x4*)(gl + g * 16 + 4 * kq);
#pragma unroll
                        for (int r = 0; r < 4; r += 2) { const f32x2 ge = gelu_pk((f32x2){acc[r] * rs, acc[r + 1] * rs});
                            if (e4[r] != ENT_INVALID && (int)(e4[r] >> 21) == n) ao[(e4[r] >> 14) & 127u] = ge.x * g4[r];
                            if (e4[r + 1] != ENT_INVALID && (int)(e4[r + 1] >> 21) == n) ao[(e4[r + 1] >> 14) & 127u] = ge.y * g4[r + 1]; }
                    }
                }
#undef PU_LOAD
            }
            if (!pulled) c_next = pq_pull(heads + k * 64, lane);
            c = c_next;
        }
    }
}

constexpr float AS = 32.f;
__device__ __forceinline__ void tr4x4(unsigned a, unsigned b, unsigned c, unsigned d, unsigned& o0, unsigned& o1, unsigned& o2, unsigned& o3) {
    const unsigned p0 = __builtin_amdgcn_perm(b, a, 0x05010400u), p1 = __builtin_amdgcn_perm(b, a, 0x07030602u), p2 = __builtin_amdgcn_perm(d, c, 0x05010400u), p3 = __builtin_amdgcn_perm(d, c, 0x07030602u);
    o0 = __builtin_amdgcn_perm(p2, p0, 0x05040100u); o1 = __builtin_amdgcn_perm(p2, p0, 0x07060302u); o2 = __builtin_amdgcn_perm(p3, p1, 0x05040100u); o3 = __builtin_amdgcn_perm(p3, p1, 0x07060302u);
}
__device__ __forceinline__ void fstage_peer_v(const Params& p, int l, int qsel, bool dry, lds_t lds, int imask = 16383) {
    unsigned char* ws = p.ws;
    const int tid = tid_fresh(), lane = tid & 63, wid = __builtin_amdgcn_readfirstlane(tid >> 6), n = lane & 15, kq = lane >> 4, n8 = n & 7, h = n >> 3;
    const unsigned char* v8 = ws + WS_V8 + (size_t)l * NEXP * D;
    unsigned* heads = (unsigned*)(ws + WS_CTL) + CW_PQ + ((qsel * 2 + 1) * 8) * 64;
    const int myx = (int)(xb_xcc_id() & 7u);
    PG8_LAS int* til = (PG8_LAS int*)(lds + wid * 8192);
#pragma unroll 1
    for (int s8 = 0; s8 < 8; ++s8) {
        const int k = (myx + s8) & 7;
#pragma unroll 1
        for (;;) {
            const unsigned c = pq_pull(heads + k * 64, lane);
            if (c >= (unsigned)PQ_NCH) break;
            const int t0 = (int)c * PQ_CH;
            unsigned koff = (unsigned)n8 * 16u; asm volatile("" : "+v"(koff));
            const unsigned char* vb = v8 + (size_t)k * NEXP * 128;
            { const int* ti = (const int*)(ws + WS_TI) + (size_t)t0 * 128; int ev[32];
#pragma unroll
              for (int i = 0; i < 32; ++i) ev[i] = ti[i * 64 + lane];
#pragma unroll
              for (int i = 0; i < 32; ++i) til[i * 64 + lane] = ev[i] & (imask & 16383); }
            u32x4 R[4][8];
            typedef int i32x4 __attribute__((ext_vector_type(4)));
#define PV_ISSUE(b, slot) do { const PG8_LAS i32x4* ip_ = (const PG8_LAS i32x4*)(til + ((b) >> 1) * 128 + ((b) & 1) * 64 + h * 32 + kq * 8); const i32x4 i0_ = ip_[0], i1_ = ip_[1]; \
                _Pragma("unroll") for (int e_ = 0; e_ < 4; ++e_) { R[slot][e_] = *(const u32x4*)(vb + ((unsigned)i0_[e_] * 128u + koff)); R[slot][4 + e_] = *(const u32x4*)(vb + ((unsigned)i1_[e_] * 128u + koff)); } } while (0)
#define PV_COMPUTE(tok8, aq, slot) do { const long aop_ = ((n >> 1) == (tok8)) ? (aq) : 0l; \
                _Pragma("unroll") for (int c_ = 0; c_ < 4; ++c_) { unsigned lo_[4], hi_[4]; \
                    tr4x4(R[slot][0][c_], R[slot][1][c_], R[slot][2][c_], R[slot][3][c_], lo_[0], lo_[1], lo_[2], lo_[3]); \
                    tr4x4(R[slot][4][c_], R[slot][5][c_], R[slot][6][c_], R[slot][7][c_], hi_[0], hi_[1], hi_[2], hi_[3]); \
                    _Pragma("unroll") for (int j_ = 0; j_ < 4; ++j_) { const long b_ = (long)(((unsigned long)hi_[j_] << 32) | (unsigned long)lo_[j_]); \
                        acc[4 * c_ + j_] = __builtin_amdgcn_mfma_f32_16x16x32_fp8_fp8(aop_, b_, acc[4 * c_ + j_], 0, 0, 0); } } } while (0)
#pragma unroll
            for (int b = 0; b < 3; ++b) PV_ISSUE(b, b);
#pragma unroll 1
            for (int ps = 0; ps < 2; ++ps) {
                f32x4 acc[16];
#pragma unroll
                for (int j = 0; j < 16; ++j) acc[j] = (f32x4){0.f, 0.f, 0.f, 0.f};
                long aq0, aq1;
                { const float* ap = (const float*)(ws + WS_PA) + (size_t)(t0 + ps * 8 + (n >> 1)) * 128 + (n & 1) * 32 + kq * 8;
                  const f32x4 a0 = *(const f32x4*)ap, a1 = *(const f32x4*)(ap + 4), a2 = *(const f32x4*)(ap + 64), a3 = *(const f32x4*)(ap + 68);
                  int w0 = __builtin_amdgcn_cvt_pk_fp8_f32(a0[0] * AS, a0[1] * AS, 0, false); w0 = __builtin_amdgcn_cvt_pk_fp8_f32(a0[2] * AS, a0[3] * AS, w0, true);
                  int w1 = __builtin_amdgcn_cvt_pk_fp8_f32(a1[0] * AS, a1[1] * AS, 0, false); w1 = __builtin_amdgcn_cvt_pk_fp8_f32(a1[2] * AS, a1[3] * AS, w1, true);
                  int w2 = __builtin_amdgcn_cvt_pk_fp8_f32(a2[0] * AS, a2[1] * AS, 0, false); w2 = __builtin_amdgcn_cvt_pk_fp8_f32(a2[2] * AS, a2[3] * AS, w2, true);
                  int w3 = __builtin_amdgcn_cvt_pk_fp8_f32(a3[0] * AS, a3[1] * AS, 0, false); w3 = __builtin_amdgcn_cvt_pk_fp8_f32(a3[2] * AS, a3[3] * AS, w3, true);
                  aq0 = (long)(((unsigned long)(unsigned)w1 << 32) | (unsigned long)(unsigned)w0); aq1 = (long)(((unsigned long)(unsigned)w3 << 32) | (unsigned long)(unsigned)w2); }
#pragma unroll 1
                for (int b0 = 0; b0 < 16; b0 += 4) {
#pragma unroll
                    for (int s = 0; s < 4; ++s) {
                        const int bn = ps * 16 + b0 + s + 3;
                        if (bn < 32) PV_ISSUE(bn, (s + 3) & 3);
                        PV_COMPUTE((b0 + s) >> 1, (s & 1) ? aq1 : aq0, s);
                    }
                }
                int n8e = n8, kqe = kq; asm volatile("" : "+v"(n8e), "+v"(kqe));
                const int t = t0 + ps * 8 + 2 * kqe + h;
                float o[16];
#pragma unroll
                for (int j = 0; j < 16; ++j) { const float send = h ? acc[j][1] : acc[j][2]; const float recv = dppf<DPP_X8>(send); o[j] = (h ? acc[j][3] : acc[j][0]) + recv; }
                bf16_t* xr = (bf16_t*)(ws + WS_XB) + (size_t)t * D + k * 128 + n8e * 16;
                const float sc = 1.f / (SV * AS);
                float ss = 0.f;
#pragma unroll
                for (int g = 0; g < 2; ++g) {
                    f32x4 v0, v1; up8(*(const u32x4*)(xr + g * 8), v0, v1);
                    v0[0] += o[8 * g + 0] * sc; v0[1] += o[8 * g + 1] * sc; v0[2] += o[8 * g + 2] * sc; v0[3] += o[8 * g + 3] * sc;
                    v1[0] += o[8 * g + 4] * sc; v1[1] += o[8 * g + 5] * sc; v1[2] += o[8 * g + 6] * sc; v1[3] += o[8 * g + 7] * sc;
                    const u32x4 wq = pk8(v0, v1); up8(wq, v0, v1);
                    if (!dry) { *(u32x4*)(xr + g * 8) = wq; *(u32x2*)(ws + WS_XQ8 + (size_t)t * D + k * 128 + n8e * 16 + g * 8) = pk8_fp8(v0, v1, XS); }
                    ss += (v0[0] * v0[0] + v0[1] * v0[1]) + (v0[2] * v0[2] + v0[3] * v0[3]) + (v1[0] * v1[0] + v1[1] * v1[1]) + (v1[2] * v1[2] + v1[3] * v1[3]);
                }
                ss += dppf<DPP_X1>(ss); ss += dppf<DPP_X2>(ss); ss += dppf<DPP_HMIR>(ss);
                if (n8e < 2 && !dry) ((float*)(ws + WS_SSP))[(size_t)t * 16 + 2 * k + n8e] = (n8e == 0) ? ss : 0.f;
            }
#undef PV_ISSUE
#undef PV_COMPUTE
        }
    }
}
__device__ __forceinline__ void fstage_final_norm(const Params& p) {
    const int tid = tid_fresh(), lane = tid & 63, wid = tid >> 6;
    const float* gfin = (const float*)p.in[25];
    for (int t = blockIdx.x * 8 + wid; t < T; t += gridDim.x * 8) {
        const float r = row_rstd((const float*)(p.ws + WS_SSP), t);
        const bf16_t* xr = (const bf16_t*)(p.ws + WS_XB) + (size_t)t * D; float* o = p.out + (size_t)t * D;
#pragma unroll
        for (int i = 0; i < 2; ++i) { f32x4 a, b; up8(*(const u32x4*)(xr + (lane + 64 * i) * 8), a, b);
            const f32x4 g0 = *(const f32x4*)(gfin + (lane + 64 * i) * 8), g1 = *(const f32x4*)(gfin + (lane + 64 * i) * 8 + 4);
            *(f32x4*)(o + (lane + 64 * i) * 8) = a * r * g0; *(f32x4*)(o + (lane + 64 * i) * 8 + 4) = b * r * g1; }
    }
}

extern __shared__ __attribute__((aligned(16))) unsigned char dyn_lds[];
constexpr int LDS_BYTES = 163840;
constexpr int LDS_BARW = LDS_BYTES - 64;

__device__ __forceinline__ Params ldp() {
    Params r;
#if defined(__HIP_DEVICE_COMPILE__)
    const __attribute__((address_space(4))) unsigned long long* k = (const __attribute__((address_space(4))) unsigned long long*)__builtin_amdgcn_kernarg_segment_ptr();
    asm volatile("" : "+s"(k));
#pragma unroll
    for (int i = 0; i < 26; ++i) r.in[i] = (const void*)(const __attribute__((address_space(1))) void*)k[i];
    r.out = (float*)(__attribute__((address_space(1))) float*)k[26]; r.ws = (unsigned char*)(__attribute__((address_space(1))) unsigned char*)k[27];
#endif
    return r;
}
__device__ __forceinline__ int rep_of(int k) { int n = (PROBE == k) ? 2 : 1; asm volatile("" : "+s"(n)); return n; }
#if PROBE == 0
#define REP(k) for (int r_ = 0, n_ = 1; r_ < 1; ++r_)
#else
#define REP(k) for (int r_ = 0, n_ = rep_of(k); r_ < n_; ++r_)
#endif
#define PH(call) do { const Params q = ldp(); int bid = bid0, nb = nb0, l = l0; asm volatile("" : "+s"(bid), "+s"(nb), "+s"(l)); (void)l; call; } while (0)
__global__ void __launch_bounds__(NT, 2) mega(Params p_unused) {
    const int bid0 = blockIdx.x, nb0 = gridDim.x; int l0 = 0;
    float* lds = (float*)dyn_lds; const lds_t ldsp = (lds_t)dyn_lds;
    { const int w0_ = __builtin_amdgcn_readfirstlane((int)(threadIdx.x >> 6)); asm volatile("s_mov_b32 m0, %0" :: "s"(w0_)); }
    if (tid_fresh() == 0) *(uint4*)(dyn_lds + LDS_BARW) = make_uint4(0u, 0u, 0u, 0u);
    __syncthreads();
    { const Params q = ldp(); (void)xcd_barrier_post((unsigned*)(q.ws + WS_CTL), (volatile LAS unsigned*)(dyn_lds + LDS_BARW)); }
#define GRID_BAR() do { const Params q = ldp(); XcdBarrier b_; b_.bar = (unsigned*)(q.ws + WS_CTL); b_.x = xb_xcc_id(); b_.st = (volatile LAS unsigned*)(dyn_lds + LDS_BARW); xcd_barrier(b_); if (PROBE == 20) xcd_barrier(b_); } while (0)
    REP(1) { PH(stage_prologue0(q, bid, nb, lds)); GRID_BAR(); }
    REP(2) { PH(stage_prologue1(q, bid, nb)); PH(fstage_kv(q, ldsp, bid, nb)); GRID_BAR();
    PH(fstage_g(q, ldsp, bid, nb)); PH(fstage_y(q, ldsp, bid, nb));     GRID_BAR(); }

#pragma unroll 1
    for (l0 = 0; l0 < L; ++l0) {
        REP(9) { PH(fstage_win(q, l, ldsp, bid, nb)); GRID_BAR(); }
        REP(7) { PH(fstage_attn(q, l, (char*)dyn_lds)); } REP(4) { PH(stage_pool_d(q, bid, nb)); PH(fstage_sgate(q, l, ldsp)); } GRID_BAR();
#if PROBE == 21
        PH(fstage_branch<false>(q, l, ldsp, bid, nb)); GRID_BAR();
#endif
        REP(10) { PH(fstage_branch(q, l, ldsp, bid, nb)); GRID_BAR(); }
        PH(fstage_resid_out(q, l, ldsp, bid, nb)); GRID_BAR();
        REP(11) { PH(fstage_xscore(q, l, ldsp, bid, nb)); GRID_BAR(); }
        PH(fstage_resid_cross(q, l, ldsp, bid, nb)); GRID_BAR();
        REP(12) { PH(fstage_pscore(q, l, ldsp, bid, nb)); GRID_BAR(); }
        REP(13) { PH(fstage_peer_u(q, l, l + 4 * r_, ldsp)); GRID_BAR(); }
#if PROBE == 15
        PH(fstage_peer_u(q, l, l + 4, ldsp, 255u, 16 * MiB)); GRID_BAR();
#endif
#if PROBE == 17
        { int sk_ = 1; asm volatile("" : "+s"(sk_)); PH(fstage_peer_u(q, l, l + 4, ldsp, 16383u, 16 * MiB, sk_ != 0)); GRID_BAR(); }
#endif
        REP(14) { bool dry_ = (r_ == 0 && n_ == 2); PH(fstage_peer_v(q, l, l + 4 * r_, dry_, ldsp)); GRID_BAR(); }
#if PROBE == 16
        PH(fstage_peer_v(q, l, l + 4, true, ldsp, 255)); GRID_BAR();
#endif
    }
    PH(fstage_final_norm(q));
}

extern "C" void kernel_launch(void* const* d_in, const int* in_sizes, int n_in, void* d_out, int out_size, void* d_ws, size_t ws_size, hipStream_t stream) {
    Params p{};
    for (int i = 0; i < 26; ++i) p.in[i] = d_in[i];
    p.out = (float*)d_out; p.ws = (unsigned char*)d_ws;
    static int grid = 0;
    if (!grid) {
        int dev = 0, cus = 0, per_cu = 0;
        (void)hipGetDevice(&dev);
        (void)hipDeviceGetAttribute(&cus, hipDeviceAttributeMultiprocessorCount, dev);
        (void)hipFuncSetAttribute((const void*)mega, hipFuncAttributeMaxDynamicSharedMemorySize, LDS_BYTES);
        (void)hipOccupancyMaxActiveBlocksPerMultiprocessor(&per_cu, mega, NT, LDS_BYTES);
        grid = cus * (per_cu < 1 ? per_cu : 1);
    }
    (void)hipMemsetAsync(p.ws + WS_CTL, 0, CTL_ZERO_BYTES, stream);
    mega<<<grid, NT, LDS_BYTES, stream>>>(p);
}
```

```cpp
#include <hip/hip_runtime.h>
#ifndef PROBE
#define PROBE 0
#endif
#include <stdint.h>
#include <math.h>

typedef unsigned short bf16_t;
typedef short bf16x8 __attribute__((ext_vector_type(8)));
typedef float f32x4 __attribute__((ext_vector_type(4)));
typedef float f32x2 __attribute__((ext_vector_type(2)));
typedef unsigned u32x4 __attribute__((ext_vector_type(4)));
typedef unsigned u32x2 __attribute__((ext_vector_type(2)));

constexpr int D = 1024, NB = 8, S = 4096, T = NB * S, L = 4, MEM = 256, MROWS = NB * MEM;
constexpr int INW = 6144, NEXP = 16384;
constexpr float EPS = 1e-6f;
constexpr float C2 = 0.125f * 1.4426950408889634f;
constexpr float SU = 256.f, SV = 32.f;
constexpr float XS = 8.f;
constexpr float W8S = 256.f;
constexpr float GS = 16.f, YS = 16.f, PS = 256.f;
constexpr int NT = 512;

constexpr size_t MiB = 1u << 20;
constexpr size_t WS_CTL = 0, WS_ROPE = 1 * MiB, WS_SSP = 3 * MiB, WS_WSPT = 5 * MiB, WS_RSTDM = 6 * MiB, WS_WPOOLS = 7 * MiB, WS_KEYSB = 8 * MiB;
constexpr size_t WS_WIN = 10 * MiB, WS_WB0 = 58 * MiB, WS_WEFF = 62 * MiB, WS_WB2 = 66 * MiB, WS_WOUT = 70 * MiB, WS_GT = 78 * MiB, WS_YT = 142 * MiB;
constexpr size_t WS_SKT = 206 * MiB, WS_U8 = 222 * MiB, WS_V8 = 286 * MiB, WS_XB = 350 * MiB, WS_TI = 414 * MiB, WS_TG = 430 * MiB, WS_MX = 446 * MiB;
constexpr size_t WS_GTE = WS_MX, WS_QB = WS_MX + 192 * MiB, WS_KB = WS_MX + 224 * MiB, WS_VB = WS_MX + 256 * MiB, WS_PIN = WS_MX + 288 * MiB, WS_DP = WS_MX + 320 * MiB;
constexpr size_t WS_UIN = WS_MX + 352 * MiB, WS_VIN = WS_MX + 384 * MiB, WS_O1 = WS_MX + 416 * MiB, WS_O2 = WS_MX + 448 * MiB, WS_SO = WS_MX + 480 * MiB, WS_END = WS_MX + 512 * MiB;
constexpr size_t WS_PA = WS_END;
constexpr size_t WS_XQ8 = WS_PA + 32 * MiB;
constexpr size_t WS_AO = WS_QB, WS_MG = WS_KB, WS_SX = WS_MX, WS_PM = WS_O1, WS_SC = WS_MX;
constexpr size_t WS_MEMB = WS_MX, WS_WXQB = WS_MX + 4 * MiB, WS_WXOT = WS_MX + 12 * MiB, WS_WXKVT = WS_MX + 20 * MiB, WS_KV = WS_MX + 36 * MiB, WS_WB1T = WS_MX + 68 * MiB, WS_WPQB = WS_MX + 72 * MiB;
static_assert(WS_XQ8 + 32 * MiB <= 1024 * MiB, "workspace map");

struct Params { const void* in[26]; float* out; unsigned char* ws; };

__device__ __forceinline__ float bf2f(bf16_t v) { return __uint_as_float(((unsigned)v) << 16); }
__device__ __forceinline__ bf16_t f2bf(float f) { unsigned u = __float_as_uint(f); return (bf16_t)((u + 0x7fffu + ((u >> 16) & 1u)) >> 16); }
typedef __bf16 hwbf16x2 __attribute__((ext_vector_type(2)));
__device__ __forceinline__ unsigned pk2(float lo, float hi) { const f32x2 v = {lo, hi}; return __builtin_bit_cast(unsigned, __builtin_convertvector(v, hwbf16x2)); }
template <int CTRL> __device__ __forceinline__ float dppf(float v) { return __builtin_bit_cast(float, __builtin_amdgcn_update_dpp(0, __builtin_bit_cast(int, v), CTRL, 0xF, 0xF, true)); }
constexpr int DPP_X1 = 0xB1, DPP_X2 = 0x4E, DPP_HMIR = 0x141, DPP_MIR = 0x140, DPP_X8 = 0x128;
__device__ __forceinline__ float lx16(float v) { float r; asm volatile("ds_swizzle_b32 %0, %1 offset:swizzle(SWAP,16)\n\ts_waitcnt lgkmcnt(0)" : "=v"(r) : "v"(v)); return r; }
__device__ __forceinline__ float add_x32(float v) { const auto rr = __builtin_amdgcn_permlane32_swap(__float_as_uint(v), __float_as_uint(v), false, false); return __uint_as_float(rr[0]) + __uint_as_float(rr[1]); }
__device__ __forceinline__ float max_x32(float v) { const auto rr = __builtin_amdgcn_permlane32_swap(__float_as_uint(v), __float_as_uint(v), false, false); return fmaxf(__uint_as_float(rr[0]), __uint_as_float(rr[1])); }
__device__ __forceinline__ float sum16(float v) { v += dppf<DPP_X1>(v); v += dppf<DPP_X2>(v); v += dppf<DPP_HMIR>(v); v += dppf<DPP_MIR>(v); return v; }
__device__ __forceinline__ float max16(float v) { v = fmaxf(v, dppf<DPP_X1>(v)); v = fmaxf(v, dppf<DPP_X2>(v)); v = fmaxf(v, dppf<DPP_HMIR>(v)); v = fmaxf(v, dppf<DPP_MIR>(v)); return v; }
__device__ __forceinline__ float wave_sum(float v) { v = sum16(v); v += lx16(v); return add_x32(v); }
__device__ __forceinline__ float wave_max(float v) { v = max16(v); v = fmaxf(v, lx16(v)); return max_x32(v); }
__device__ __forceinline__ int tid_fresh() { unsigned w, ln; asm volatile("s_mov_b32 %0, m0\n\tv_mbcnt_lo_u32_b32 %1, -1, 0\n\tv_mbcnt_hi_u32_b32 %1, -1, %1" : "=s"(w), "=v"(ln)); return (int)((w << 6) | ln); }
__device__ __forceinline__ float row_rstd(const float* ssp, int row) {
    const f32x4* p = (const f32x4*)(ssp + (size_t)row * 16);
    f32x4 a = p[0], b = p[1], c = p[2], d = p[3];
    float s = (a[0] + a[1] + a[2] + a[3]) + (b[0] + b[1] + b[2] + b[3]) + (c[0] + c[1] + c[2] + c[3]) + (d[0] + d[1] + d[2] + d[3]);
    return rsqrtf(s * (1.f / D) + EPS);
}
__device__ __forceinline__ float lam_init_of(int l) { return 0.8f - 0.6f * expf(-0.3f * (float)l); }

__device__ __forceinline__ u32x2 pk8_fp8(f32x4 a, f32x4 b, float sc);
__device__ __forceinline__ u32x4 pk8(f32x4 a, f32x4 b);
__device__ __forceinline__ void tr_conv(const float* __restrict__ src, bf16_t* __restrict__ dst, int K, int N, const float* gain, int gmask, float gmul, int bid, int nb, float* tile, int ldd = 0, int lds_src = 0) {
    const int tidx = tid_fresh();
    const int tx = tidx & 63, ty = tidx >> 6;
    const int tn = N / 64, nt = (K / 64) * tn, sp = lds_src ? lds_src : N;
    float r[8], rn[8];
    int it = bid;
    if (it < nt) { const int k0 = (it / tn) * 64, n0 = (it % tn) * 64;
#pragma unroll
        for (int i = 0; i < 8; ++i) { const int k = ty + 8 * i; r[i] = src[(size_t)(k0 + k) * sp + n0 + tx]; if (gain) r[i] *= gain[(k0 + k) & gmask] * gmul; } }
    while (it < nt) {
        const int k0 = (it / tn) * 64, n0 = (it % tn) * 64, nx = it + nb;
        if (nx < nt) { const int k1 = (nx / tn) * 64, n1 = (nx % tn) * 64;
#pragma unroll
            for (int i = 0; i < 8; ++i) { const int k = ty + 8 * i; rn[i] = src[(size_t)(k1 + k) * sp + n1 + tx]; if (gain) rn[i] *= gain[(k1 + k) & gmask] * gmul; } }
        __syncthreads();
#pragma unroll
        for (int i = 0; i < 8; ++i) tile[(ty + 8 * i) * 65 + tx] = r[i];
        __syncthreads();
        { const int n = tidx >> 3, kq = (tidx & 7) * 8;
          f32x4 a, b;
#pragma unroll
          for (int e = 0; e < 4; ++e) { a[e] = tile[(kq + e) * 65 + n]; b[e] = tile[(kq + 4 + e) * 65 + n]; }
          *(u32x4*)(dst + (size_t)(n0 + n) * (ldd ? ldd : K) + k0 + kq) = pk8(a, b); }
#pragma unroll
        for (int i = 0; i < 8; ++i) r[i] = rn[i];
        it = nx;
    }
}
__device__ __forceinline__ void tr_conv8(const float* __restrict__ src, unsigned char* __restrict__ dst, int K, int N, const float* gain, float scale, int sp, int bid, int nb, float* tile) {
    const int tidx = tid_fresh();
    const int tx = tidx & 63, ty = tidx >> 6;
    const int tn = N / 64, nt = (K / 64) * tn;
    float r[8], rn[8];
    int it = bid;
    if (it < nt) { const int k0 = (it / tn) * 64, n0 = (it % tn) * 64;
#pragma unroll
        for (int i = 0; i < 8; ++i) { const int k = ty + 8 * i; r[i] = src[(size_t)(k0 + k) * sp + n0 + tx] * gain[k0 + k] * scale; } }
    while (it < nt) {
        const int k0 = (it / tn) * 64, n0 = (it % tn) * 64, nx = it + nb;
        if (nx < nt) { const int k1 = (nx / tn) * 64, n1 = (nx % tn) * 64;
#pragma unroll
            for (int i = 0; i < 8; ++i) { const int k = ty + 8 * i; rn[i] = src[(size_t)(k1 + k) * sp + n1 + tx] * gain[k1 + k] * scale; } }
        __syncthreads();
#pragma unroll
        for (int i = 0; i < 8; ++i) tile[(ty + 8 * i) * 65 + tx] = r[i];
        __syncthreads();
        { const int n = tidx >> 3, kq = (tidx & 7) * 8;
          f32x4 a, b;
#pragma unroll
          for (int e = 0; e < 4; ++e) { a[e] = tile[(kq + e) * 65 + n]; b[e] = tile[(kq + 4 + e) * 65 + n]; }
          *(u32x2*)(dst + (size_t)(n0 + n) * K + k0 + kq) = pk8_fp8(a, b, 1.f); }
#pragma unroll
        for (int i = 0; i < 8; ++i) r[i] = rn[i];
        it = nx;
    }
}
__device__ __forceinline__ void conv_plain(const float* __restrict__ src, bf16_t* __restrict__ dst, size_t n, int bid, int nb, const float* rowgain = nullptr) {
    const int tidx = tid_fresh();
    const size_t n4 = n / 4, st = (size_t)nb * NT;
    for (size_t i0 = (size_t)bid * NT + tidx; i0 < n4; i0 += 8 * st) {
        f32x4 v[8];
#pragma unroll
        for (int u = 0; u < 8; ++u) { const size_t i = i0 + u * st; v[u] = (i < n4) ? ((const f32x4*)src)[i] : (f32x4){0.f, 0.f, 0.f, 0.f}; }
#pragma unroll
        for (int u = 0; u < 8; ++u) { const size_t i = i0 + u * st; if (i < n4) { f32x4 x = v[u]; if (rowgain) x = x * rowgain[i >> 8];
            u32x2 w; w.x = pk2(x[0], x[1]); w.y = pk2(x[2], x[3]); ((u32x2*)dst)[i] = w; } }
    }
}
__device__ __forceinline__ void conv_fp8(const float* __restrict__ src, unsigned* __restrict__ dst, const float* gain, float scale, bool slice_major, int bid, int nb) {
    const int tidx = tid_fresh();
    const size_t n4 = (size_t)NEXP * D / 4, st = (size_t)nb * NT;
    for (size_t i0 = (size_t)bid * NT + tidx; i0 < n4; i0 += 8 * st) {
        f32x4 v[8];
#pragma unroll
        for (int u = 0; u < 8; ++u) { const size_t i = i0 + u * st; v[u] = (i < n4) ? ((const f32x4*)src)[i] : (f32x4){0.f, 0.f, 0.f, 0.f}; }
#pragma unroll
        for (int u = 0; u < 8; ++u) { const size_t i = i0 + u * st; if (i < n4) { f32x4 x = v[u];
            if (gain) { const f32x4 g = ((const f32x4*)gain)[i & (D / 4 - 1)]; x = x * g; }
            x = x * scale;
            int w = __builtin_amdgcn_cvt_pk_fp8_f32(x[0], x[1], 0, false);
            w = __builtin_amdgcn_cvt_pk_fp8_f32(x[2], x[3], w, true);
            size_t o = i;
            if (slice_major) { const size_t d = (i * 4) & (D - 1), e = (i * 4) >> 10; o = (((d >> 7) * NEXP + e) * 128 + (d & 127)) >> 2; }
            dst[o] = (unsigned)w; } }
    }
}

__device__ __forceinline__ void stage_prologue0(const Params& p, int bid, int nb, float* lds) {
    const int tidx = tid_fresh();
    unsigned char* ws = p.ws;
    const int tid = tidx, lane = tid & 63, wid = tid >> 6;
    for (int l = 0; l < L; ++l) {
        tr_conv((const float*)p.in[4] + (size_t)l * D * INW, (bf16_t*)(ws + WS_WIN) + (size_t)l * 3072 * D, D, 3072, (const float*)p.in[3] + l * D, D - 1, 1.f, bid, nb, lds, 0, INW);
        tr_conv8((const float*)p.in[4] + (size_t)l * D * INW + 3072, ws + WS_WIN + 24 * MiB + (size_t)l * 3072 * D, D, 3072, (const float*)p.in[3] + l * D, W8S, INW, bid, nb, lds);
        const float* wb = (const float*)p.in[13] + (size_t)l * 3 * 512 * D;
        bf16_t* wbr = (bf16_t*)(ws + WS_WB0) + (size_t)l * D * 1536;
        tr_conv(wb, wbr, 512, D, (const float*)p.in[6] + l * 128, 127, 1.f - lam_init_of(l), bid, nb, lds, 1536);
        tr_conv(wb + 512 * D, (bf16_t*)(ws + WS_WB1T) + (size_t)l * D * 512, 512, D, nullptr, 0, 1.f, bid, nb, lds);
        tr_conv(wb + 2 * 512 * D, wbr + 1024, 512, D, nullptr, 0, 1.f, bid, nb, lds, 1536);
        tr_conv((const float*)p.in[14] + (size_t)l * D * D, (bf16_t*)(ws + WS_WOUT) + (size_t)l * D * D, D, D, nullptr, 0, 1.f, bid, nb, lds);
        tr_conv((const float*)p.in[19] + (size_t)l * D * D, (bf16_t*)(ws + WS_WXOT) + (size_t)l * D * D, D, D, nullptr, 0, 1.f, bid, nb, lds);
        tr_conv((const float*)p.in[18] + (size_t)l * D * 2 * D, (bf16_t*)(ws + WS_WXKVT) + (size_t)l * 2 * D * D, D, 2 * D, (const float*)p.in[16] + l * D, D - 1, 1.f, bid, nb, lds);
        conv_fp8((const float*)p.in[23] + (size_t)l * NEXP * D, (unsigned*)(ws + WS_U8) + (size_t)l * NEXP * D / 4, (const float*)p.in[20] + l * D, SU, false, bid, nb);
        conv_fp8((const float*)p.in[24] + (size_t)l * NEXP * D, (unsigned*)(ws + WS_V8) + (size_t)l * NEXP * D / 4, nullptr, SV, true, bid, nb);
    }
    conv_plain((const float*)p.in[17], (bf16_t*)(ws + WS_WXQB), (size_t)L * D * D, bid, nb, (const float*)p.in[15]);
    conv_plain((const float*)p.in[21], (bf16_t*)(ws + WS_WPQB), (size_t)L * D * 2048, bid, nb);
    conv_plain((const float*)p.in[22], (bf16_t*)(ws + WS_KEYSB), (size_t)L * 8 * 2 * 128 * 128, bid, nb);
    for (int i = bid * NT + tid; i < L * 4 * 128 * 128; i += nb * NT) {
        const int e = i & 127, g = (i >> 14) & 3, l = i >> 16;
        ((bf16_t*)(ws + WS_WPOOLS))[i] = f2bf(((const float*)p.in[7])[i] * ((const float*)p.in[8])[l * 512 + g * 128 + e]);
        const int sx = i & 127, tx = (i >> 7) & 127;
        ((bf16_t*)(ws + WS_WSPT))[i] = f2bf((sx <= tx) ? ((const float*)p.in[11])[i] : 0.f);
    }
    for (int i = bid * NT + tid; i < T * 8; i += nb * NT) {
        const int j = i & 7, t = i >> 3;
        const double ang = (double)((const int*)p.in[2])[t] * pow(500000.0, -(double)j / 8.0);
        _Float16* r = (_Float16*)(ws + WS_ROPE) + (size_t)t * 16;
        r[j] = (_Float16)(float)cos(ang); r[8 + j] = (_Float16)(float)sin(ang);
    }
    for (int row = bid * 8 + wid; row < T + MROWS; row += nb * 8) {
        const bool ismem = row >= T; const int r = ismem ? row - T : row;
        const float* src = (ismem ? (const float*)p.in[1] : (const float*)p.in[0]) + (size_t)r * D;
        bf16_t* dstb = (bf16_t*)(ws + (ismem ? WS_MEMB : WS_XB)) + (size_t)r * D;
        float ss = 0.f;
#pragma unroll
        for (int i = 0; i < 4; ++i) {
            const f32x4 v = ((const f32x4*)src)[lane + 64 * i];
            ss += v[0] * v[0] + v[1] * v[1] + v[2] * v[2] + v[3] * v[3];
            u32x2 w; w.x = pk2(v[0], v[1]); w.y = pk2(v[2], v[3]); ((u32x2*)dstb)[lane + 64 * i] = w;
            if (!ismem) { int q = __builtin_amdgcn_cvt_pk_fp8_f32(v[0] * XS, v[1] * XS, 0, false); q = __builtin_amdgcn_cvt_pk_fp8_f32(v[2] * XS, v[3] * XS, q, true); ((unsigned*)(ws + WS_XQ8 + (size_t)r * D))[lane + 64 * i] = (unsigned)q; }
        }
        ss = wave_sum(ss);
        if (ismem) { if (lane == 0) ((float*)(ws + WS_RSTDM))[r] = rsqrtf(ss * (1.f / D) + EPS); }
        else if (lane < 16) ((float*)(ws + WS_SSP))[(size_t)r * 16 + lane] = (lane == 0) ? ss : 0.f;
    }
}

template <class Geom, class Epi>
__device__ __forceinline__ void gemm_simple(int nitems, int K, const Geom& geom, const Epi& epi, int bid, int nb) {
    const int tidx = tid_fresh();
    const int tid = tidx, lane = tid & 63, wid = tid >> 6, wm = wid >> 1, wn = wid & 1, fr = lane & 15, fq = lane >> 4;
    for (int it = bid; it < nitems; it += nb) {
        const bf16_t* A; const bf16_t* Bt; int lda, ldb, grp, row0, col0;
        geom(it, A, lda, Bt, ldb, grp, row0, col0);
        f32x4 acc[2][4];
#pragma unroll
        for (int i = 0; i < 2; ++i)
#pragma unroll
            for (int j = 0; j < 4; ++j) acc[i][j] = (f32x4){0.f, 0.f, 0.f, 0.f};
        const bf16_t* ap = A + (size_t)(wm * 32 + fr) * lda + fq * 8;
        const bf16_t* bp = Bt + (size_t)(wn * 64 + fr) * ldb + fq * 8;
#pragma unroll 2
        for (int k0 = 0; k0 < K; k0 += 32) {
            bf16x8 a[2], b[4];
#pragma unroll
            for (int i = 0; i < 2; ++i) a[i] = *(const bf16x8*)(ap + (size_t)(i * 16) * lda + k0);
#pragma unroll
            for (int j = 0; j < 4; ++j) b[j] = *(const bf16x8*)(bp + (size_t)(j * 16) * ldb + k0);
#pragma unroll
            for (int i = 0; i < 2; ++i)
#pragma unroll
                for (int j = 0; j < 4; ++j) acc[i][j] = __builtin_amdgcn_mfma_f32_16x16x32_bf16(b[j], a[i], acc[i][j], 0, 0, 0);
        }
#pragma unroll
        for (int i = 0; i < 2; ++i) {
            const int row = row0 + wm * 32 + i * 16 + fr;
            const float rs = epi.prep(grp, row);
            float part = 0.f;
#pragma unroll
            for (int j = 0; j < 4; ++j) part += epi.apply(grp, row, col0 + wn * 64 + j * 16 + fq * 4, acc[i][j], rs, lane);
            epi.rowdone(grp, row, col0 + wn * 64, part, lane);
        }
    }
}

__device__ __forceinline__ void st_bf4(bf16_t* p, f32x4 v) { u32x2 w; w.x = pk2(v[0], v[1]); w.y = pk2(v[2], v[3]); *(u32x2*)p = w; }
__device__ __forceinline__ f32x4 ld_bf4(const bf16_t* p) { const u32x2 w = *(const u32x2*)p; return (f32x4){__uint_as_float(w.x << 16), __uint_as_float(w.x & 0xffff0000u), __uint_as_float(w.y << 16), __uint_as_float(w.y & 0xffff0000u)}; }

struct EpiColGain {
    bf16_t* o; size_t gstride; int ld; const float* gain; int gdiv;
    __device__ __forceinline__ float prep(int, int) const { return 1.f; }
    __device__ __forceinline__ float apply(int grp, int row, int col, f32x4 v, float, int) const {
        if (gain) v = v * *(const f32x4*)(gain + (size_t)(grp / gdiv) * D + col);
        st_bf4(o + (size_t)grp * gstride + (size_t)row * ld + col, v);
        return 0.f;
    }
    __device__ __forceinline__ void rowdone(int, int, int, float, int) const {}
};

__device__ __forceinline__ void stage_prologue1(const Params& p, int bid, int nb) {
    unsigned char* ws = p.ws;
    {
        auto geom = [=](int it, const bf16_t*& A, int& lda, const bf16_t*& Bt, int& ldb, int& grp, int& row0, int& col0) {
            const int g = it >> 3, tn = it & 7, l = g >> 4, hp = g & 15; grp = g; row0 = 0; col0 = tn * 128; lda = 128; ldb = 2048;
            A = (const bf16_t*)(ws + WS_KEYSB) + (size_t)g * 16384; Bt = (const bf16_t*)(ws + WS_WPQB) + ((size_t)l * D + col0) * 2048 + hp * 128; };
        gemm_simple(L * 16 * 8, 128, geom, EpiColGain{(bf16_t*)(ws + WS_SKT), (size_t)128 * D, D, (const float*)p.in[20], 16}, bid, nb);
    }
    {
        auto geom = [=](int it, const bf16_t*& A, int& lda, const bf16_t*& Bt, int& ldb, int& grp, int& row0, int& col0) {
            const int lg = it >> 3, tm = it & 7, l = lg >> 2, g = lg & 3; grp = lg; row0 = tm * 128; col0 = 0; lda = 512; ldb = 128;
            A = (const bf16_t*)(ws + WS_WB1T) + ((size_t)l * D + row0) * 512 + g * 128; Bt = (const bf16_t*)(ws + WS_WPOOLS) + (size_t)lg * 16384; };
        struct EpiWeff { bf16_t* o; __device__ __forceinline__ float prep(int, int) const { return 1.f; }
            __device__ __forceinline__ float apply(int lg, int row, int col, f32x4 v, float, int) const { st_bf4(o + ((size_t)(lg >> 2) * D + row) * 1536 + 512 + (lg & 3) * 128 + col, v); return 0.f; }
            __device__ __forceinline__ void rowdone(int, int, int, float, int) const {} };
        gemm_simple(L * 4 * 8, 128, geom, EpiWeff{(bf16_t*)(ws + WS_WB0)}, bid, nb);
    }
}
namespace pg8 {
#define PG8_LAS __attribute__((address_space(3)))
constexpr int BM = 256, BK = 64, HALF = 128, HTB = HALF * BK * 2, STAGE_BYTES = 8 * HTB, NXCD = 8, WGM = 8;
__host__ __device__ __forceinline__ int lds_byte(int r, int c) { const int st = (r >> 4) * 2 + (c >> 5), rr = r & 15, cc = c & 31, ob = rr * 64 + cc * 2; return st * 1024 + (ob ^ (((ob >> 9) & 1) << 5)); }
__host__ __device__ __forceinline__ void stage_rc(int b, int& R, int& C) { const int st = b / 1024, sb = b % 1024, swz = sb ^ (((sb >> 9) & 1) << 5); R = (st >> 1) * 16 + swz / 64; C = (st & 1) * 32 + (swz % 64) / 2; }
__host__ __device__ __forceinline__ int perm32(int rho) { const int n = rho >> 4, i = rho & 15; return 8 * (i >> 2) + 4 * n + (i & 3); }
struct Unit { int pm, pn; };
struct Order {
    int nM, nN, nwg, G, c; const char* A; const char* Bt; size_t a_tile, b_tile, b_batch; int pm_per_batch;
    __device__ __forceinline__ void init(int M, int N, int G_, int c_, const void* A_, int lda, const void* Bt_, int ldb, size_t b_batch_bytes = 0, int pmpb = 1 << 30) {
        nM = M / BM; nN = N / BM; nwg = nM * nN; G = G_; c = c_; A = (const char*)A_; Bt = (const char*)Bt_; a_tile = (size_t)BM * lda * 2; b_tile = (size_t)BM * ldb * 2; b_batch = b_batch_bytes; pm_per_batch = pmpb; }
    __device__ __forceinline__ bool next(int i, Unit& u) const {
        const long Lx = (long)i * G + c; if (Lx >= nwg) return false;
        int wgid = (int)Lx; { const int q = nwg / NXCD, r = nwg % NXCD, xcd = wgid % NXCD, off = wgid / NXCD; wgid = (xcd < r ? xcd * (q + 1) : r * (q + 1) + (xcd - r) * q) + off; }
        const int nig = WGM * nN, gid = wgid / nig, fm = gid * WGM, gsz = (nM - fm) < WGM ? (nM - fm) : WGM;
        u.pm = fm + ((wgid % nig) % gsz); u.pn = (wgid % nig) / gsz; return true;
    }
    __device__ __forceinline__ const char* a_ptr(const Unit& u) const { return A + (size_t)u.pm * a_tile; }
    __device__ __forceinline__ const char* b_ptr(const Unit& u) const { return Bt + (size_t)u.pn * b_tile + (size_t)(u.pm / pm_per_batch) * b_batch; }
};
typedef int i32x8_t __attribute__((ext_vector_type(8))); typedef int i32x4_t __attribute__((ext_vector_type(4)));
__device__ __forceinline__ i32x8_t ld8_lds(const PG8_LAS unsigned char* p) { const i32x4_t lo = *(const PG8_LAS i32x4_t*)p, hi = *(const PG8_LAS i32x4_t*)(p + 1024); return __builtin_shufflevector(lo, hi, 0, 1, 2, 3, 4, 5, 6, 7); }
__device__ __forceinline__ void glds_s(const void* sbase, unsigned voff, unsigned lds_dst) { unsigned keep;
    asm volatile("s_mov_b32 %0, m0\n\ts_mov_b32 m0, %3\n\ts_nop 0\n\tglobal_load_lds_dwordx4 %1, %2\n\ts_mov_b32 m0, %0" : "=&s"(keep) : "v"(voff), "s"(sbase), "s"(lds_dst) : "memory"); }
struct NoHook { static constexpr bool ACTIVE = false; __device__ __forceinline__ void operator()(f32x4 (&)[2][2][4][2], const Unit&, int, int, int, int, int) const {} };
template <class Epi, class Sched, bool ALIGN_EPI, class Hook = NoHook, int SEG = 1 << 20, bool FP8 = false>
__device__ __forceinline__ void gemm_phase(PG8_LAS unsigned char* lds, const int K, const int lda, const int ldb, const Sched& S, const Epi& E, const long dA1 = 0, const long dA2 = 0, const Hook& H = Hook()) {
    const int tid = tid_fresh(), wid = __builtin_amdgcn_readfirstlane(tid >> 6), lane = tid & 63, wr = wid >> 2, wc = wid & 3, fr = lane & 15, fq = lane >> 4;
    const int nt = K / BK;
    int mxs = 0x7f7f7f7f; asm volatile("" : "+v"(mxs));
    (void)mxs;
    unsigned voffA, voffB;
    { int R, C; stage_rc(tid * 16, R, C); const int Rb = (R & ~31) + perm32(R & 31);
      voffA = (unsigned)(R * lda + C) * 2u; voffB = (unsigned)(Rb * ldb + C) * 2u; }
    const size_t p2A = (size_t)64 * lda * 2, p2B = (size_t)64 * ldb * 2;
    const size_t kstep = (size_t)(BK * 2);
    const size_t hstepA = (size_t)HALF * lda * 2, hstepB = (size_t)HALF * ldb * 2;
    const unsigned ldsw = (unsigned)wid * 1024u, ldsu = (unsigned)(unsigned long)lds;
    const int aoff = lds_byte(wr * 64 + fr, fq * 8), boff = lds_byte(wc * 32 + fr, fq * 8);
#define PG8_SA(b, h) (((b) * 2 + (h)) * HTB)
#define PG8_SB(b, h) ((4 + (b) * 2 + (h)) * HTB)
#define PG8_STAGE(bufoff, gbase, X) do { _Pragma("unroll") for (int _i = 0; _i < 2; ++_i) \
        pg8::glds_s((const void*)((const char*)(gbase) + _i * p2##X), voff##X, ldsu + (unsigned)(bufoff) + ldsw + (unsigned)(_i * 8192)); } while (0)
#define PG8_LD8(p_) pg8::ld8_lds((p_))
#define PG8_LDA(dst, b, h) do { _Pragma("unroll") for (int m = 0; m < 4; ++m) { if constexpr (FP8) dst##8[m] = PG8_LD8(lds + PG8_SA(b, h) + aoff + m * 2048); else { _Pragma("unroll") for (int k = 0; k < 2; ++k) dst[m][k] = *(const PG8_LAS bf16x8*)(lds + PG8_SA(b, h) + aoff + m * 2048 + k * 1024); } } } while (0)
#define PG8_LDB(dst, b, h) do { _Pragma("unroll") for (int n = 0; n < 2; ++n) { if constexpr (FP8) dst##8[n] = PG8_LD8(lds + PG8_SB(b, h) + boff + n * 2048); else { _Pragma("unroll") for (int k = 0; k < 2; ++k) dst[n][k] = *(const PG8_LAS bf16x8*)(lds + PG8_SB(b, h) + boff + n * 2048 + k * 1024); } } } while (0)
#define PG8_MMA(ai, bj, At, Bt) do { __builtin_amdgcn_s_setprio(1); _Pragma("unroll") for (int m = 0; m < 4; ++m) _Pragma("unroll") for (int n = 0; n < 2; ++n) { \
        if constexpr (FP8) asm volatile("v_mfma_scale_f32_16x16x128_f8f6f4 %0, %1, %2, %0, %3, %3 op_sel_hi:[0,0,0]" : "+v"(acc[ai][bj][m][n]) : "v"(Bt##8[n]), "v"(At##8[m]), "v"(mxs)); \
        else { _Pragma("unroll") for (int k = 0; k < 2; ++k) acc[ai][bj][m][n] = __builtin_amdgcn_mfma_f32_16x16x32_bf16(Bt[n][k], At[m][k], acc[ai][bj][m][n], 0, 0, 0); } } \
        __builtin_amdgcn_s_setprio(0); } while (0)
#define PG8_WAIT_V(n) asm volatile("s_waitcnt vmcnt(" #n ")" ::: "memory")
#define PG8_WAIT_L(n) asm volatile("s_waitcnt lgkmcnt(" #n ")" ::: "memory")
#define PG8_BAR __builtin_amdgcn_s_barrier()
#define PG8_SCHED __builtin_amdgcn_sched_barrier(0)
    Unit cur, nxt; int ui = 0;
    if (!S.next(0, cur)) return;
    f32x4 acc[2][2][4][2];
#pragma unroll
    for (int a = 0; a < 2; ++a)
#pragma unroll
        for (int b = 0; b < 2; ++b)
#pragma unroll
            for (int m = 0; m < 4; ++m)
#pragma unroll
                for (int n = 0; n < 2; ++n) acc[a][b][m][n] = (f32x4){0.f, 0.f, 0.f, 0.f};
    typedef int i32x8_ __attribute__((ext_vector_type(8))); typedef int i32x4_ __attribute__((ext_vector_type(4)));
    bf16x8 At[4][2], B0[2][2], B1[2][2]; i32x8_ At8[4], B08[2], B18[2];
    (void)At; (void)B0; (void)B1; (void)At8; (void)B08; (void)B18;
    const char* cA = S.a_ptr(cur); const char* cB = S.b_ptr(cur);
    PG8_STAGE(PG8_SB(0, 0), cB, B); PG8_STAGE(PG8_SB(0, 1), cB + hstepB, B); PG8_STAGE(PG8_SA(0, 0), cA, A); PG8_STAGE(PG8_SA(0, 1), cA + hstepA, A);
    if (wr == 1) PG8_BAR;
    PG8_WAIT_V(2); PG8_BAR;
    PG8_STAGE(PG8_SB(1, 0), cB + kstep, B); PG8_STAGE(PG8_SA(1, 0), cA + kstep, A); PG8_STAGE(PG8_SB(1, 1), cB + hstepB + kstep, B); PG8_STAGE(PG8_SA(1, 1), cA + kstep + hstepA, A);
    PG8_WAIT_V(8); PG8_BAR;
    bool stores = false;
    for (;;) {
        const bool has_next = S.next(ui + 1, nxt);
        const char* nA = has_next ? S.a_ptr(nxt) : cA; const char* nB = has_next ? S.b_ptr(nxt) : cB;
        for (int t = 0; t < nt; t += 2) {
            const bool last = (t == nt - 2);
#define PG8_AOFF(tile) ((long)(tile) * (long)kstep + ((tile) >= 2 * SEG ? dA2 : (tile) >= SEG ? dA1 : 0l))
            if (Hook::ACTIVE && (t == SEG || t == 2 * SEG)) { const int th = tid_fresh(); H(acc, cur, t, wr, wc, th & 15, (th >> 4) & 3); }
            const char* a1 = cA + PG8_AOFF(t + 1);
            const char* a2 = last ? nA : cA + PG8_AOFF(t + 2); const char* b2 = last ? nB : cB + (size_t)(t + 2) * kstep;
            const char* a3 = last ? nA + kstep : cA + PG8_AOFF(t + 3); const char* b3 = b2 + kstep;
            const bool head = (t == 0), drain = head && stores;
            PG8_LDB(B0, 0, 0); PG8_LDB(B1, 0, 1); PG8_SCHED; PG8_LDA(At, 0, 0); if (!head) PG8_STAGE(PG8_SA(1, 1), a1 + hstepA, A);
            if (drain) { if constexpr (Epi::NST >= 16) PG8_WAIT_V(16); else if constexpr (Epi::NST >= 8) PG8_WAIT_V(8); else PG8_WAIT_V(0); } else PG8_WAIT_V(8);
            PG8_WAIT_L(0); PG8_BAR; PG8_MMA(0, 0, At, B0); PG8_MMA(0, 1, At, B1); PG8_BAR; PG8_SCHED;
            PG8_LDA(At, 0, 1); PG8_STAGE(PG8_SB(0, 0), b2, B); PG8_STAGE(PG8_SB(0, 1), b2 + hstepB, B); PG8_STAGE(PG8_SA(0, 0), a2, A);
            if (!drain) PG8_WAIT_V(8);
            PG8_WAIT_L(0); PG8_BAR; PG8_MMA(1, 0, At, B0); PG8_MMA(1, 1, At, B1); PG8_BAR; PG8_SCHED;
            PG8_LDB(B0, 1, 0); PG8_LDB(B1, 1, 1); PG8_SCHED; PG8_LDA(At, 1, 0); PG8_STAGE(PG8_SA(0, 1), a2 + hstepA, A);
            if (!drain) PG8_WAIT_V(8);
            PG8_WAIT_L(0); PG8_BAR; PG8_MMA(0, 0, At, B0); PG8_MMA(0, 1, At, B1); PG8_BAR; PG8_SCHED;
            PG8_LDA(At, 1, 1); PG8_STAGE(PG8_SB(1, 0), b3, B); PG8_STAGE(PG8_SB(1, 1), b3 + hstepB, B); PG8_STAGE(PG8_SA(1, 0), a3, A);
            PG8_WAIT_V(8);
            PG8_WAIT_L(0); PG8_BAR; PG8_MMA(1, 0, At, B0); PG8_MMA(1, 1, At, B1); PG8_BAR; PG8_SCHED;
        }
        PG8_STAGE(PG8_SA(1, 1), nA + kstep + hstepA, A); PG8_SCHED;
        if constexpr (FP8) asm volatile("s_nop 15\n\ts_nop 7" ::: "memory");
        if constexpr (ALIGN_EPI) { if (wr == 0) PG8_BAR; }
        { const int te = tid_fresh(); E(acc, cur, wr, wc, te & 15, (te >> 4) & 3); }
        if (!has_next) break;
        stores = true;
#pragma unroll
        for (int a = 0; a < 2; ++a)
#pragma unroll
            for (int b = 0; b < 2; ++b)
#pragma unroll
                for (int m = 0; m < 4; ++m)
#pragma unroll
                    for (int n = 0; n < 2; ++n) acc[a][b][m][n] = (f32x4){0.f, 0.f, 0.f, 0.f};
        cur = nxt; cA = nA; cB = nB; ++ui;
        if constexpr (ALIGN_EPI) { if (wr == 1) PG8_BAR; }
    }
    PG8_WAIT_V(0);
    if constexpr (!ALIGN_EPI) { if (wr == 0) PG8_BAR; }
    PG8_BAR;
#undef PG8_AOFF
#undef PG8_SA
#undef PG8_SB
#undef PG8_STAGE
#undef PG8_LDA
#undef PG8_LD8
#undef PG8_LDB
#undef PG8_MMA
#undef PG8_WAIT_V
#undef PG8_WAIT_L
#undef PG8_BAR
#undef PG8_SCHED
}
}

__device__ __forceinline__ float rstd_q(const float* ssp, int row, int fq) {
    const f32x4 a = *(const f32x4*)(ssp + (size_t)row * 16 + 4 * fq);
    float s = (a[0] + a[1]) + (a[2] + a[3]); s += lx16(s); s = add_x32(s);
    return rsqrtf(s * (1.f / D) + EPS);
}
__device__ __forceinline__ void rstd8(const float* ssp, int row0, int fq, float mul, float (&rs)[2][4]) {
    f32x4 a[2][4];
#pragma unroll
    for (int ai = 0; ai < 2; ++ai)
#pragma unroll
        for (int m = 0; m < 4; ++m) a[ai][m] = *(const f32x4*)(ssp + (size_t)(row0 + ai * 128 + m * 16) * 16 + 4 * fq);
#pragma unroll
    for (int ai = 0; ai < 2; ++ai)
#pragma unroll
        for (int m = 0; m < 4; ++m) { float s = (a[ai][m][0] + a[ai][m][1]) + (a[ai][m][2] + a[ai][m][3]); s += lx16(s); s = add_x32(s); rs[ai][m] = rsqrtf(s * (1.f / D) + EPS) * mul; }
}
__device__ __forceinline__ u32x4 pk8(f32x4 a, f32x4 b) { u32x4 w; w.x = pk2(a[0], a[1]); w.y = pk2(a[2], a[3]); w.z = pk2(b[0], b[1]); w.w = pk2(b[2], b[3]); return w; }
__device__ __forceinline__ u32x2 pk8_fp8(f32x4 a, f32x4 b, float sc) {
    int q0 = __builtin_amdgcn_cvt_pk_fp8_f32(a[0] * sc, a[1] * sc, 0, false); q0 = __builtin_amdgcn_cvt_pk_fp8_f32(a[2] * sc, a[3] * sc, q0, true);
    int q1 = __builtin_amdgcn_cvt_pk_fp8_f32(b[0] * sc, b[1] * sc, 0, false); q1 = __builtin_amdgcn_cvt_pk_fp8_f32(b[2] * sc, b[3] * sc, q1, true);
    return (u32x2){(unsigned)q0, (unsigned)q1};
}
__device__ __forceinline__ void up8(u32x4 w, f32x4& a, f32x4& b) {
    a = (f32x4){__uint_as_float(w.x << 16), __uint_as_float(w.x & 0xffff0000u), __uint_as_float(w.y << 16), __uint_as_float(w.y & 0xffff0000u)};
    b = (f32x4){__uint_as_float(w.z << 16), __uint_as_float(w.z & 0xffff0000u), __uint_as_float(w.w << 16), __uint_as_float(w.w & 0xffff0000u)}; }
struct LaneTr {
    int addr, tr, tq;
    __device__ __forceinline__ LaneTr(int fr, int fq) { const int L = fq * 16 + fr; tr = L >> 2; tq = L & 3; addr = (tq * 16 + tr) * 4; }
    __device__ __forceinline__ u32x4 operator()(u32x4 w) const {
        return (u32x4){(unsigned)__builtin_amdgcn_ds_bpermute(addr, (int)w.x), (unsigned)__builtin_amdgcn_ds_bpermute(addr, (int)w.y), (unsigned)__builtin_amdgcn_ds_bpermute(addr, (int)w.z), (unsigned)__builtin_amdgcn_ds_bpermute(addr, (int)w.w)}; }
};
typedef _Float16 f16x2_t __attribute__((ext_vector_type(2)));
__device__ __forceinline__ u32x4 swz16x4(u32x4 a) { unsigned r0, r1, r2, r3;
    asm volatile("ds_swizzle_b32 %0, %4 offset:swizzle(SWAP,16)\n\tds_swizzle_b32 %1, %5 offset:swizzle(SWAP,16)\n\tds_swizzle_b32 %2, %6 offset:swizzle(SWAP,16)\n\tds_swizzle_b32 %3, %7 offset:swizzle(SWAP,16)\n\ts_waitcnt lgkmcnt(0)"
                 : "=&v"(r0), "=&v"(r1), "=&v"(r2), "=&v"(r3) : "v"(a.x), "v"(a.y), "v"(a.z), "v"(a.w));
    return (u32x4){r0, r1, r2, r3}; }
__device__ __forceinline__ f32x4 swz16f4(f32x4 a) { return __builtin_bit_cast(f32x4, swz16x4(__builtin_bit_cast(u32x4, a))); }
__device__ __forceinline__ float h2f_lo(unsigned w) { return (float)__builtin_bit_cast(f16x2_t, w)[0]; }
__device__ __forceinline__ float h2f_hi(unsigned w) { return (float)__builtin_bit_cast(f16x2_t, w)[1]; }
struct GEpiWin {
    unsigned char* ws;
    static constexpr int NST = 16;
    __device__ __forceinline__ void operator()(const f32x4 (&acc)[2][2][4][2], const pg8::Unit& u, int wr, int wc, int fr, int fq) const {
        const int pn = u.pn, row0 = u.pm * 256 + wr * 64 + fr;
        const LaneTr ltr(fr, fq); const int rowt = u.pm * 256 + wr * 64 + ltr.tr, ct = 32 * wc + 8 * ltr.tq;
        const float* ssp = (const float*)(ws + WS_SSP);
        if (pn < 4) {
            const bool rot = (wc & 1) == 0;
            bf16_t* dst = (bf16_t*)(ws + (pn < 2 ? WS_QB : WS_KB)) + (pn & 1) * 256 + ct;
            float rs8[2][4]; rstd8(ssp, row0, fq, pn < 2 ? C2 : 1.f, rs8);
            u32x4 tb[2][4];
#pragma unroll
            for (int ai = 0; ai < 2; ++ai)
#pragma unroll
                for (int m = 0; m < 4; ++m) tb[ai][m] = rot ? *(const u32x4*)(ws + WS_ROPE + (size_t)(row0 + ai * 128 + m * 16) * 32 + (fq & 1) * 16) : (u32x4){0u, 0u, 0u, 0u};
#pragma unroll
            for (int ai = 0; ai < 2; ++ai)
#pragma unroll
                for (int m = 0; m < 4; ++m) { const int row = rowt + ai * 128 + m * 16; const float rs = rs8[ai][m];
                    f32x4 c0 = (f32x4){1.f, 1.f, 1.f, 1.f}, c1 = c0, s0 = (f32x4){0.f, 0.f, 0.f, 0.f}, s1 = s0;
                    if (rot) { const u32x4 mine = tb[ai][m]; const u32x4 oth = swz16x4(mine);
                        const u32x4 cw = (fq & 1) ? oth : mine, sw = (fq & 1) ? mine : oth;
                        c0 = (f32x4){h2f_lo(cw.x), h2f_hi(cw.x), h2f_lo(cw.y), h2f_hi(cw.y)}; c1 = (f32x4){h2f_lo(cw.z), h2f_hi(cw.z), h2f_lo(cw.w), h2f_hi(cw.w)};
                        s0 = (f32x4){h2f_lo(sw.x), h2f_hi(sw.x), h2f_lo(sw.y), h2f_hi(sw.y)}; s1 = (f32x4){h2f_lo(sw.z), h2f_hi(sw.z), h2f_lo(sw.w), h2f_hi(sw.w)}; }
#pragma unroll
                    for (int bj = 0; bj < 2; ++bj) { f32x4 v0 = acc[ai][bj][m][0], v1 = acc[ai][bj][m][1];
                        if (rot) { const f32x4 o0 = swz16f4(v0), o1 = swz16f4(v1);
                            if (fq == 0) { v0 = v0 * c0 - o0 * s0; v1 = v1 * c1 - o1 * s1; } else if (fq == 1) { v0 = o0 * s0 + v0 * c0; v1 = o1 * s1 + v1 * c1; } }
                        *(u32x4*)(dst + (size_t)row * 512 + bj * 128) = ltr(pk8(v0 * rs, v1 * rs)); } }
        } else if (pn < 12) {
            const int seg = (pn - 4) >> 1; const size_t base = seg == 0 ? WS_VB : seg == 1 ? WS_PIN : seg == 2 ? WS_UIN : WS_VIN;
            bf16_t* dst = (bf16_t*)(ws + base) + (pn & 1) * 256 + ct;
            float rs[2][4]; rstd8(ssp, row0, fq, 1.f, rs);
#pragma unroll
            for (int ai = 0; ai < 2; ++ai)
#pragma unroll
                for (int m = 0; m < 4; ++m) { const int row = rowt + ai * 128 + m * 16;
#pragma unroll
                    for (int bj = 0; bj < 2; ++bj) *(u32x4*)(dst + (size_t)row * 512 + bj * 128) = ltr(pk8(acc[ai][bj][m][0] * rs[ai][m], acc[ai][bj][m][1] * rs[ai][m])); }
        }
    }
};
__device__ __forceinline__ size_t gate_off(int pm, int pn, int wid, int lane) { return (((size_t)(pm * 12 + pn) * 8 + wid) << 14) + (size_t)lane * 16; }
#define GATE_FRAG(ai, bj, m) ((((ai) * 2 + (bj)) * 4 + (m)) * 1024)
struct GEpiGate {
    unsigned char* ws;
    static constexpr int NST = 16;
    __device__ __forceinline__ void operator()(const f32x4 (&acc)[2][2][4][2], const pg8::Unit& u, int wr, int wc, int fr, int fq) const {
        const int row0 = u.pm * 256 + wr * 64 + fr;
        unsigned char* dst = ws + WS_GTE + gate_off(u.pm, u.pn, wr * 4 + wc, fq * 16 + fr);
        float rs8[2][4]; rstd8((const float*)(ws + WS_SSP), row0, fq, -1.4426950408889634f / (XS * W8S), rs8);
#pragma unroll
        for (int ai = 0; ai < 2; ++ai)
#pragma unroll
            for (int m = 0; m < 4; ++m) { const float rs = rs8[ai][m];
#pragma unroll
                for (int bj = 0; bj < 2; ++bj) { f32x4 v0 = acc[ai][bj][m][0] * rs, v1 = acc[ai][bj][m][1] * rs;
#pragma unroll
                    for (int e = 0; e < 4; ++e) { v0[e] = 1.f + __builtin_amdgcn_exp2f(fminf(v0[e], 60.f)); v1[e] = 1.f + __builtin_amdgcn_exp2f(fminf(v1[e], 60.f)); }
                    *(u32x4*)(dst + GATE_FRAG(ai, bj, m)) = pk8(v0, v1); } }
    }
};
__device__ __forceinline__ f32x4 rcp4(f32x4 v) { return (f32x4){__builtin_amdgcn_rcpf(fmaxf(v[0], 1e-30f)), __builtin_amdgcn_rcpf(fmaxf(v[1], 1e-30f)), __builtin_amdgcn_rcpf(fmaxf(v[2], 1e-30f)), __builtin_amdgcn_rcpf(fmaxf(v[3], 1e-30f))}; }
struct BranchHook {
    static constexpr bool ACTIVE = true; unsigned char* ws;
    __device__ __forceinline__ void operator()(f32x4 (&acc)[2][2][4][2], const pg8::Unit& u, int t, int wr, int wc, int fr, int fq) const {
        int lane = fq * 16 + fr;
        asm volatile("" : "+v"(lane));
        const unsigned char* gpa = ws + WS_GTE + gate_off(u.pm, u.pn + ((t == 8) ? 0 : 4), wr * 4 + wc, lane); const unsigned char* gpb = gpa + ((size_t)4 * 8 << 14);
#pragma unroll
        for (int ai = 0; ai < 2; ++ai) {
            u32x4 ga[4][2], gb[4][2];
#pragma unroll
            for (int m = 0; m < 4; ++m)
#pragma unroll
                for (int bj = 0; bj < 2; ++bj) { ga[m][bj] = *(const u32x4*)(gpa + GATE_FRAG(ai, bj, m)); gb[m][bj] = *(const u32x4*)(gpb + GATE_FRAG(ai, bj, m)); }
            __builtin_amdgcn_sched_barrier(0);
#pragma unroll
            for (int m = 0; m < 4; ++m)
#pragma unroll
                for (int bj = 0; bj < 2; ++bj) { f32x4 a0, a1, b0, b1; up8(ga[m][bj], a0, a1); up8(gb[m][bj], b0, b1);
                    acc[ai][bj][m][0] = acc[ai][bj][m][0] * (b0 * rcp4(a0)); acc[ai][bj][m][1] = acc[ai][bj][m][1] * (b1 * rcp4(a1)); }
            __builtin_amdgcn_sched_barrier(0);
        }
    }
};
struct GEpiBranch {
    unsigned char* ws;
    static constexpr int NST = 8;
    __device__ __forceinline__ void operator()(const f32x4 (&acc)[2][2][4][2], const pg8::Unit& u, int wr, int wc, int fr, int fq) const {
        const LaneTr ltr(fr, fq); const int row0 = u.pm * 256 + wr * 64 + ltr.tr, col0 = u.pn * 256 + 32 * wc + 8 * ltr.tq;
#pragma unroll
        for (int ai = 0; ai < 2; ++ai) {
            u32x4 g[4][2];
#pragma unroll
            for (int m = 0; m < 4; ++m)
#pragma unroll
                for (int bj = 0; bj < 2; ++bj) g[m][bj] = *(const u32x4*)(ws + WS_GTE + gate_off(u.pm, u.pn + 8, wr * 4 + wc, fq * 16 + fr) + GATE_FRAG(ai, bj, m));
#pragma unroll
            for (int m = 0; m < 4; ++m) { const int row = row0 + ai * 128 + m * 16;
#pragma unroll
                for (int bj = 0; bj < 2; ++bj) { const int col = col0 + bj * 128;
                    f32x4 g0, g1; up8(g[m][bj], g0, g1);
                    *(u32x4*)((bf16_t*)(ws + WS_MG) + (size_t)row * D + col) = ltr(pk8(acc[ai][bj][m][0] * rcp4(g0), acc[ai][bj][m][1] * rcp4(g1))); } }
        }
    }
};
struct GEpiResid {
    unsigned char* ws; bool q8; float ascale;
    static constexpr int NST = 16;
    __device__ __forceinline__ void operator()(const f32x4 (&acc)[2][2][4][2], const pg8::Unit& u, int wr, int wc, int fr, int fq) const {
        const int row0 = u.pm * 256 + wr * 64 + fr, col0 = u.pn * 256 + 32 * wc + 8 * fq;
#pragma unroll
        for (int ai = 0; ai < 2; ++ai) {
            u32x4 xin[4][2];
#pragma unroll
            for (int m = 0; m < 4; ++m)
#pragma unroll
                for (int bj = 0; bj < 2; ++bj) xin[m][bj] = *(const u32x4*)((const bf16_t*)(ws + WS_XB) + (size_t)(row0 + ai * 128 + m * 16) * D + col0 + bj * 128);
#pragma unroll
            for (int m = 0; m < 4; ++m) { const int row = row0 + ai * 128 + m * 16; float part = 0.f;
#pragma unroll
                for (int bj = 0; bj < 2; ++bj) { f32x4 x0, x1; up8(xin[m][bj], x0, x1);
                    const u32x4 w = pk8(acc[ai][bj][m][0] * ascale + x0, acc[ai][bj][m][1] * ascale + x1);
                    *(u32x4*)((bf16_t*)(ws + WS_XB) + (size_t)row * D + col0 + bj * 128) = w;
                    f32x4 v0, v1; up8(w, v0, v1);
                    if (q8) { int q0 = __builtin_amdgcn_cvt_pk_fp8_f32(v0[0] * XS, v0[1] * XS, 0, false); q0 = __builtin_amdgcn_cvt_pk_fp8_f32(v0[2] * XS, v0[3] * XS, q0, true);
                        int q1 = __builtin_amdgcn_cvt_pk_fp8_f32(v1[0] * XS, v1[1] * XS, 0, false); q1 = __builtin_amdgcn_cvt_pk_fp8_f32(v1[2] * XS, v1[3] * XS, q1, true);
                        *(u32x2*)(ws + WS_XQ8 + (size_t)row * D + col0 + bj * 128) = (u32x2){(unsigned)q0, (unsigned)q1}; }
                    part += (v0[0] * v0[0] + v0[1] * v0[1]) + (v0[2] * v0[2] + v0[3] * v0[3]) + (v1[0] * v1[0] + v1[1] * v1[1]) + (v1[2] * v1[2] + v1[3] * v1[3]); }
                part += lx16(part); part = add_x32(part);
                if (fq == 0) ((float*)(ws + WS_SSP))[(size_t)row * 16 + u.pn * 4 + wc] = part; }
        }
    }
};
typedef _Float16 f16x8 __attribute__((ext_vector_type(8)));
struct GEpiScaleF16 {
    unsigned char* ws; _Float16* o; int ld;
    static constexpr int NST = 16;
    __device__ __forceinline__ void operator()(const f32x4 (&acc)[2][2][4][2], const pg8::Unit& u, int wr, int wc, int fr, int fq) const {
        const int row0 = u.pm * 256 + wr * 64 + fr;
        const LaneTr ltr(fr, fq); const int rowt = u.pm * 256 + wr * 64 + ltr.tr, col0 = u.pn * 256 + 32 * wc + 8 * ltr.tq;
        float rs8[2][4]; rstd8((const float*)(ws + WS_SSP), row0, fq, 1.f, rs8);
#pragma unroll
        for (int ai = 0; ai < 2; ++ai)
#pragma unroll
            for (int m = 0; m < 4; ++m) { const int row = rowt + ai * 128 + m * 16; const float rs = rs8[ai][m];
#pragma unroll
                for (int bj = 0; bj < 2; ++bj) { const f32x4 a = acc[ai][bj][m][0] * rs, b = acc[ai][bj][m][1] * rs;
                    const f16x8 h = (f16x8){(_Float16)a[0], (_Float16)a[1], (_Float16)a[2], (_Float16)a[3], (_Float16)b[0], (_Float16)b[1], (_Float16)b[2], (_Float16)b[3]};
                    *(u32x4*)(o + (size_t)row * ld + col0 + bj * 128) = ltr(__builtin_bit_cast(u32x4, h)); } }
    }
};
typedef PG8_LAS unsigned char* lds_t;
struct GEpiXSoftmax {
    unsigned char* ws; lds_t part;
    static constexpr int NST = 16;
    __device__ __forceinline__ void operator()(const f32x4 (&acc)[2][2][4][2], const pg8::Unit& u, int wr, int wc, int fr, int fq) const {
        const int row0 = u.pm * 256 + wr * 64 + fr, col0 = u.pn * 256 + 32 * wc + 8 * fq;
        f32x4 (&ex)[2][2][4][2] = const_cast<f32x4 (&)[2][2][4][2]>(acc);
        PG8_LAS f32x2* pt = (PG8_LAS f32x2*)part;
        float rs[2][4], mw[2][4];
#pragma unroll
        for (int ai = 0; ai < 2; ++ai)
#pragma unroll
            for (int m = 0; m < 4; ++m) { const int row = row0 + ai * 128 + m * 16; rs[ai][m] = rstd_q((const float*)(ws + WS_SSP), row, fq) * (1.4426950408889634f / (16.f * XS * GS));
                float mx = -INFINITY;
#pragma unroll
                for (int bj = 0; bj < 2; ++bj)
#pragma unroll
                    for (int n = 0; n < 2; ++n)
#pragma unroll
                        for (int e = 0; e < 4; ++e) mx = fmaxf(mx, acc[ai][bj][m][n][e]);
                mx *= rs[ai][m];
                mx = fmaxf(mx, lx16(mx)); mx = max_x32(mx);
                float sm = 0.f;
#pragma unroll
                for (int bj = 0; bj < 2; ++bj)
#pragma unroll
                    for (int n = 0; n < 2; ++n)
#pragma unroll
                        for (int e = 0; e < 4; ++e) { const float x = __builtin_amdgcn_exp2f(acc[ai][bj][m][n][e] * rs[ai][m] - mx); ex[ai][bj][m][n][e] = x; sm += x; }
                sm += lx16(sm); sm = add_x32(sm);
                mw[ai][m] = mx;
                if (fq == 0) pt[(wr * 64 + fr + ai * 128 + m * 16) * 4 + wc] = (f32x2){mx, sm}; }
        asm volatile("s_waitcnt lgkmcnt(0)" ::: "memory");
        __builtin_amdgcn_s_barrier();
#pragma unroll
        for (int ai = 0; ai < 2; ++ai)
#pragma unroll
            for (int m = 0; m < 4; ++m) { const int row = row0 + ai * 128 + m * 16;
                const PG8_LAS f32x2* pr = pt + (wr * 64 + fr + ai * 128 + m * 16) * 4;
                const f32x2 p0 = pr[0], p1 = pr[1], p2 = pr[2], p3 = pr[3];
                const float M = fmaxf(fmaxf(p0.x, p1.x), fmaxf(p2.x, p3.x));
                const float tot = (p0.y * __builtin_amdgcn_exp2f(p0.x - M) + p1.y * __builtin_amdgcn_exp2f(p1.x - M)) + (p2.y * __builtin_amdgcn_exp2f(p2.x - M) + p3.y * __builtin_amdgcn_exp2f(p3.x - M));
                const float f = __builtin_amdgcn_exp2f(mw[ai][m] - M) * (PS / tot);
#pragma unroll
                for (int bj = 0; bj < 2; ++bj) *(u32x2*)(ws + WS_PM + (size_t)row * D + col0 + bj * 128) = pk8_fp8(ex[ai][bj][m][0], ex[ai][bj][m][1], f); }
    }
};
__device__ __forceinline__ void fstage_win(const Params& p, int l, lds_t lds, int bid, int nb) {
    { pg8::Order O; O.init(T, 3072, nb, bid, p.ws + WS_XB, D, p.ws + WS_WIN + (size_t)l * 3072 * D * 2, D);
      pg8::gemm_phase<GEpiWin, pg8::Order, true>(lds, D, D, D, O, GEpiWin{p.ws}); }
    { pg8::Order O; O.init(T, 3072, nb, bid, p.ws + WS_XQ8, D / 2, p.ws + WS_WIN + 24 * MiB + (size_t)l * 3072 * D, D / 2);
      pg8::gemm_phase<GEpiGate, pg8::Order, true, pg8::NoHook, 1 << 20, true>(lds, D / 2, D / 2, D / 2, O, GEpiGate{p.ws}); }
}
template <bool HOOKS = true>
__device__ __forceinline__ void fstage_branch(const Params& p, int l, lds_t lds, int bid, int nb) {
    pg8::Order O; O.init(T, D, nb, bid, p.ws + WS_AO, 512, p.ws + WS_WB0 + (size_t)l * D * 1536 * 2, 1536);
    const long d1 = (long)WS_DP - (long)WS_AO - 8 * 128, d2 = (long)WS_SO - (long)WS_AO - 16 * 128;
    if constexpr (HOOKS) pg8::gemm_phase<GEpiBranch, pg8::Order, true, BranchHook, 8>(lds, 1536, 512, 1536, O, GEpiBranch{p.ws}, d1, d2, BranchHook{p.ws});
    else pg8::gemm_phase<GEpiBranch, pg8::Order, true, pg8::NoHook, 8>(lds, 1536, 512, 1536, O, GEpiBranch{p.ws}, d1, d2);
}
__device__ __forceinline__ void fstage_resid_out(const Params& p, int l, lds_t lds, int bid, int nb) {
    pg8::Order O; O.init(T, D, nb, bid, p.ws + WS_MG, D, p.ws + WS_WOUT + (size_t)l * D * D * 2, D);
    pg8::gemm_phase<GEpiResid, pg8::Order, true>(lds, D, D, D, O, GEpiResid{p.ws, true, 1.f});
}
__device__ __forceinline__ void fstage_resid_cross(const Params& p, int l, lds_t lds, int bid, int nb) {
    pg8::Order O; O.init(T, D, nb, bid, p.ws + WS_PM, D / 2, p.ws + WS_YT + (size_t)l * NB * D * D, D / 2, (size_t)D * D, S / 256);
    pg8::gemm_phase<GEpiResid, pg8::Order, true, pg8::NoHook, 1 << 20, true>(lds, D / 2, D / 2, D / 2, O, GEpiResid{p.ws, true, 1.f / (PS * YS)});
}
__device__ __forceinline__ void fstage_xscore(const Params& p, int l, lds_t lds, int bid, int nb) {
    pg8::Order O; O.init(T, D, nb, bid, p.ws + WS_XQ8, D / 2, p.ws + WS_GT + (size_t)l * NB * D * D, D / 2, (size_t)D * D, S / 256);
    pg8::gemm_phase<GEpiXSoftmax, pg8::Order, true, pg8::NoHook, 1 << 20, true>(lds, D / 2, D / 2, D / 2, O, GEpiXSoftmax{p.ws, lds + 131072});
}


struct GEpiKV {
    unsigned char* ws;
    static constexpr int NST = 16;
    __device__ __forceinline__ void operator()(const f32x4 (&acc)[2][2][4][2], const pg8::Unit& u, int wr, int wc, int fr, int fq) const {
        asm volatile("" : "+v"(fr), "+v"(fq));
        const int row0 = u.pm * 256 + wr * 64 + fr, l = u.pn >> 3, col0 = (u.pn & 7) * 256 + 32 * wc + 8 * fq;
        float rs8[2][4];
#pragma unroll
        for (int ai = 0; ai < 2; ++ai)
#pragma unroll
            for (int m = 0; m < 4; ++m) rs8[ai][m] = ((const float*)(ws + WS_RSTDM))[row0 + ai * 128 + m * 16];
#pragma unroll
        for (int ai = 0; ai < 2; ++ai)
#pragma unroll
            for (int m = 0; m < 4; ++m) { const int row = row0 + ai * 128 + m * 16; const float rs = rs8[ai][m];
#pragma unroll
                for (int bj = 0; bj < 2; ++bj) *(u32x4*)((bf16_t*)(ws + WS_KV) + ((size_t)l * MROWS + row) * 2048 + col0 + bj * 128) = pk8(acc[ai][bj][m][0] * rs, acc[ai][bj][m][1] * rs); }
    }
};
struct OrderG : pg8::Order {
    unsigned char* ws;
    __device__ __forceinline__ const char* a_ptr(const pg8::Unit& u) const { const int l = u.pm >> 5, b = (u.pm >> 2) & 7, h = u.pm & 3; return (const char*)(ws + WS_KV) + (((size_t)l * MROWS + b * 256) * 2048 + h * 256) * 2; }
    __device__ __forceinline__ const char* b_ptr(const pg8::Unit& u) const { const int l = u.pm >> 5, h = u.pm & 3; return (const char*)(ws + WS_WXQB) + (((size_t)l * D + u.pn * 256) * D + h * 256) * 2; }
};
struct GEpiG {
    unsigned char* ws;
    static constexpr int NST = 16;
    __device__ __forceinline__ void operator()(const f32x4 (&acc)[2][2][4][2], const pg8::Unit& u, int wr, int wc, int fr, int fq) const {
        asm volatile("" : "+v"(fr), "+v"(fq));
        const int lb = u.pm >> 2, h = u.pm & 3, r0 = wr * 64 + fr, col0 = u.pn * 256 + 32 * wc + 8 * fq;
#pragma unroll
        for (int ai = 0; ai < 2; ++ai)
#pragma unroll
            for (int m = 0; m < 4; ++m)
#pragma unroll
                for (int bj = 0; bj < 2; ++bj) *(u32x2*)(ws + WS_GT + ((size_t)lb * D + h * 256 + r0 + ai * 128 + m * 16) * D + col0 + bj * 128) = pk8_fp8(acc[ai][bj][m][0], acc[ai][bj][m][1], GS);
    }
};
struct OrderY : pg8::Order {
    unsigned char* ws;
    __device__ __forceinline__ const char* a_ptr(const pg8::Unit& u) const { const int l = u.pn >> 5, h = u.pn & 3; return (const char*)(ws + WS_WXOT) + (((size_t)l * D + u.pm * 256) * D + h * 256) * 2; }
    __device__ __forceinline__ const char* b_ptr(const pg8::Unit& u) const { const int l = u.pn >> 5, b = (u.pn >> 2) & 7, h = u.pn & 3; return (const char*)(ws + WS_KV) + (((size_t)l * MROWS + b * 256) * 2048 + 1024 + h * 256) * 2; }
};
struct GEpiY {
    unsigned char* ws;
    static constexpr int NST = 16;
    __device__ __forceinline__ void operator()(const f32x4 (&acc)[2][2][4][2], const pg8::Unit& u, int wr, int wc, int fr, int fq) const {
        asm volatile("" : "+v"(fr), "+v"(fq));
        const int lb = u.pn >> 2, h = u.pn & 3, row0 = u.pm * 256 + wr * 64 + fr, col0 = h * 256 + 32 * wc + 8 * fq;
#pragma unroll
        for (int ai = 0; ai < 2; ++ai)
#pragma unroll
            for (int m = 0; m < 4; ++m)
#pragma unroll
                for (int bj = 0; bj < 2; ++bj) *(u32x2*)(ws + WS_YT + ((size_t)lb * D + row0 + ai * 128 + m * 16) * D + col0 + bj * 128) = pk8_fp8(acc[ai][bj][m][0], acc[ai][bj][m][1], YS);
    }
};
__device__ __forceinline__ void fstage_kv(const Params& p, lds_t lds, int bid, int nb) {
    pg8::Order O; O.init(MROWS, L * 2048, nb, bid, p.ws + WS_MEMB, D, p.ws + WS_WXKVT, D);
    pg8::gemm_phase<GEpiKV, pg8::Order, true>(lds, D, D, D, O, GEpiKV{p.ws});
}
__device__ __forceinline__ void fstage_g(const Params& p, lds_t lds, int bid, int nb) {
    OrderG O; O.init(128 * 256, D, nb, bid, nullptr, 2048, nullptr, D); O.ws = p.ws;
    pg8::gemm_phase<GEpiG, OrderG, true>(lds, 256, 2048, D, O, GEpiG{p.ws});
}
__device__ __forceinline__ void fstage_y(const Params& p, lds_t lds, int bid, int nb) {
    OrderY O; O.init(D, 128 * 256, nb, bid, nullptr, D, nullptr, 2048); O.ws = p.ws;
    pg8::gemm_phase<GEpiY, OrderY, true>(lds, 256, D, 2048, O, GEpiY{p.ws});
}

#include <hip/hip_bf16.h>
namespace attn_body {
using bf16=__hip_bfloat16;
using bf16x8=__attribute__((ext_vector_type(8)))short;
using s16x4=__attribute__((ext_vector_type(4)))short;
using f32x16=__attribute__((ext_vector_type(16)))float;
using u32x4=__attribute__((ext_vector_type(4)))unsigned;
constexpr int SEQ=4096,D=64,DM=512;
constexpr int NW=8,QBLK=32,QB=QBLK*NW,KVBLK=64,NQB=SEQ/QB;
constexpr int ATTN_PITCH=DM, ATTN_UNIT_ROWS=QB;
__device__ __forceinline__ int crow(int r,int hi){return (r&3)+8*(r>>2)+4*hi;}
#define SBAR() __builtin_amdgcn_sched_barrier(0)
__device__ __forceinline__ void cmask(f32x16&p0,f32x16&p1,int jb,int qrel,int hi){
  const float NEG=-INFINITY; int kb=64*jb+4*hi;
  #pragma unroll
  for(int r=0;r<16;++r){int kv=kb+(r&3)+8*(r>>2); if(kv>qrel)p0[r]=NEG; if(kv+32>qrel)p1[r]=NEG;}
}

constexpr int NSLOT=3, SLOTB=8192;
constexpr int LDS_K=0, LDS_V=NSLOT*SLOTB, LDS_WS=3*NSLOT*SLOTB, LDS_OST=LDS_WS+NW*64*4, LDS_BYTES=LDS_OST+NW*8192;
constexpr float C2=0.125f*1.4426950408889634f;
__device__ __forceinline__ void glds16(const void*gsrc,unsigned lds_dst){unsigned keep;
  asm volatile("s_mov_b32 %0, m0\n\ts_mov_b32 m0, %2\n\ts_nop 0\n\tglobal_load_lds_dwordx4 %1, off\n\ts_mov_b32 m0, %0":"=&s"(keep):"v"(gsrc),"s"(lds_dst):"memory");}
__device__ __forceinline__ float max3f(float a,float b,float c){float r;asm("v_max3_f32 %0, %1, %2, %3":"=v"(r):"v"(a),"v"(b),"v"(c));return r;}
__device__ __forceinline__ float max2f(float a,float b){float r;asm("v_max_f32_e32 %0, %1, %2":"=v"(r):"v"(a),"v"(b));return r;}
__device__ __forceinline__ float fadd_s(float a,float b){float r;asm("v_add_f32_e32 %0, %1, %2":"=v"(r):"v"(a),"v"(b));return r;}
__device__ __forceinline__ float fsub_s(float a,float b){float r;asm("v_sub_f32_e32 %0, %1, %2":"=v"(r):"v"(a),"v"(b));return r;}
typedef float f32x2_t __attribute__((ext_vector_type(2))); typedef __bf16 bf16x2_t __attribute__((ext_vector_type(2)));
__device__ __forceinline__ unsigned cvtpk_s(float lo,float hi){f32x2_t v={lo,hi};bf16x2_t b=__builtin_convertvector(v,bf16x2_t);return __builtin_bit_cast(unsigned,b);}
#define WAIT_BAR(N) asm volatile("s_waitcnt vmcnt(" #N ") lgkmcnt(0)\n\ts_barrier":::"memory")

__device__ __forceinline__ void qkt(f32x16&p0,f32x16&p1,const char*Kslot,const bf16x8*qr,const f32x16&negm,int r32,int hi){
  const char*kb=Kslot+hi*1024+r32*16;
  #pragma unroll
  for(int d0=0;d0<4;++d0){
    const bf16x8 b0=*reinterpret_cast<const bf16x8*>(kb+d0*2048);
    const bf16x8 b1=*reinterpret_cast<const bf16x8*>(kb+d0*2048+512);
    if(d0==0){p0=__builtin_amdgcn_mfma_f32_32x32x16_bf16(b0,qr[0],negm,0,0,0);p1=__builtin_amdgcn_mfma_f32_32x32x16_bf16(b1,qr[0],negm,0,0,0);}
    else{p0=__builtin_amdgcn_mfma_f32_32x32x16_bf16(b0,qr[d0],p0,0,0,0);p1=__builtin_amdgcn_mfma_f32_32x32x16_bf16(b1,qr[d0],p1,0,0,0);}}
}
typedef __attribute__((address_space(3))) const char* lds_cptr;
typedef short v4i16_t __attribute__((ext_vector_type(4)));
__device__ __forceinline__ void kload8(bf16x8*kf,lds_cptr kp){
  kf[0]=*(const __attribute__((address_space(3))) bf16x8*)(kp);      kf[1]=*(const __attribute__((address_space(3))) bf16x8*)(kp+512);
  kf[2]=*(const __attribute__((address_space(3))) bf16x8*)(kp+2048); kf[3]=*(const __attribute__((address_space(3))) bf16x8*)(kp+2560);
  kf[4]=*(const __attribute__((address_space(3))) bf16x8*)(kp+4096); kf[5]=*(const __attribute__((address_space(3))) bf16x8*)(kp+4608);
  kf[6]=*(const __attribute__((address_space(3))) bf16x8*)(kp+6144); kf[7]=*(const __attribute__((address_space(3))) bf16x8*)(kp+6656);
}
__device__ __forceinline__ void kload2(bf16x8*kf,lds_cptr kp,int j){ kf[2*j]=*(const __attribute__((address_space(3))) bf16x8*)(kp+j*2048); kf[2*j+1]=*(const __attribute__((address_space(3))) bf16x8*)(kp+j*2048+512); }
__device__ __forceinline__ s16x4 vtr(lds_cptr p){ return __builtin_bit_cast(s16x4,__builtin_amdgcn_ds_read_tr16_b64_v4i16((__attribute__((address_space(3))) v4i16_t*)p)); }
__device__ __forceinline__ float rowmax(const f32x16&p0,const f32x16&p1){
  float a=max3f(p0[0],p0[1],p1[0]),b=max3f(p0[2],p0[3],p1[1]);a=max3f(a,p1[2],p1[3]);
  #pragma unroll
  for(int r=4;r<16;r+=4){a=max3f(a,p0[r],p0[r+1]);b=max3f(b,p0[r+2],p0[r+3]);a=max3f(a,p1[r],p1[r+1]);b=max3f(b,p1[r+2],p1[r+3]);}
  const float m=max2f(a,b);
  auto rr=__builtin_amdgcn_permlane32_swap(__float_as_uint(m),__float_as_uint(m),false,false);
  return max2f(__uint_as_float(rr[0]),__uint_as_float(rr[1]));
}
__device__ __forceinline__ void pv(f32x16*o,int vb,bf16x8 pa0,bf16x8 pa1,bf16x8 pa2,bf16x8 pa3){
  #pragma unroll
  for(int d0=0;d0<4;++d0){s16x4 lo[4],hi[4];
    #pragma unroll
    for(int ks=0;ks<4;++ks){
      asm volatile("ds_read_b64_tr_b16 %0,%1 offset:%c2":"=&v"(lo[ks]):"v"(vb),"i"(d0*4096+ks*1024):"memory");
      asm volatile("ds_read_b64_tr_b16 %0,%1 offset:%c2":"=&v"(hi[ks]):"v"(vb),"i"(d0*4096+ks*1024+512):"memory");}
    asm volatile("s_waitcnt lgkmcnt(0)":::"memory");SBAR();
    #define PK(k) (bf16x8){lo[k][0],lo[k][1],lo[k][2],lo[k][3],hi[k][0],hi[k][1],hi[k][2],hi[k][3]}
    o[d0]=__builtin_amdgcn_mfma_f32_32x32x16_bf16(pa0,PK(0),o[d0],0,0,0);
    o[d0]=__builtin_amdgcn_mfma_f32_32x32x16_bf16(pa1,PK(1),o[d0],0,0,0);
    o[d0]=__builtin_amdgcn_mfma_f32_32x32x16_bf16(pa2,PK(2),o[d0],0,0,0);
    o[d0]=__builtin_amdgcn_mfma_f32_32x32x16_bf16(pa3,PK(3),o[d0],0,0,0);
    #undef PK
  }
}

#ifndef ATTN_STORE16
#define ATTN_STORE16(p,v) (*(u32x4*)(p)=(v))
#endif
template<int THRL> __device__ __forceinline__ void attn_unit(int b,int qcol,int kcol,int vcol,int ocol,int qb,const bf16*Q,const bf16*__restrict__ K,const bf16*__restrict__ V,bf16*O,char*shm){
  const int tid=tid_fresh(),lane=tid&63,r32=lane&31,hi=lane>>5; const int wid=__builtin_amdgcn_readfirstlane(tid>>6);
  const long rowbase=(long)b*SEQ; const int q0=qb*QB;
  const bf16*Qw=Q+(rowbase+q0+wid*QBLK)*DM+qcol;
  const bf16*Kh=K+rowbase*DM+kcol,*Vh=V+rowbase*DM+vcol;
  const unsigned lds0=(unsigned)(uintptr_t)shm;
  float*wsf=(float*)(shm+LDS_WS)+wid*64;
  const bf16*ksrc=Kh+(long)lane*DM+wid*8;
  const bf16*vsrc=Vh+(long)(16*(wid&3)+(lane>>2))*DM+(wid>>2)*32+(lane&3)*8;
  const unsigned kdst=lds0+LDS_K+wid*1024, vdst=lds0+LDS_V+wid*1024;
  #define DMA_K(t,slot) glds16(ksrc+(long)(t)*KVBLK*DM,(unsigned)__builtin_amdgcn_readfirstlane(kdst+(slot)))
  #define DMA_V(t,slot) do{ glds16(vsrc+(long)(t)*KVBLK*DM,(unsigned)__builtin_amdgcn_readfirstlane(vdst+2*(slot))); glds16(vsrc+64+(long)(t)*KVBLK*DM,(unsigned)__builtin_amdgcn_readfirstlane(vdst+2*(slot)+8192)); }while(0)
  const int vb0=(int)(lds0+LDS_V)+((lane>>4)&1)*32+(lane&3)*8+(4*hi+((lane&15)>>2))*64;
  const char*Kbase=shm+LDS_K; bf16x8 kf[8];
  const lds_cptr shm3=(lds_cptr)shm; const lds_cptr kp0=shm3+LDS_K+hi*1024+r32*16; const lds_cptr vp0=shm3+LDS_V+((lane>>4)&1)*32+(lane&3)*8+(4*hi+((lane&15)>>2))*64;
  const int NT=(q0+QB)/KVBLK;
  DMA_K(0,0);DMA_V(0,0);DMA_K(1,SLOTB);
  bf16x8 qr[4];
  #pragma unroll
  for(int d0=0;d0<4;++d0)qr[d0]=*reinterpret_cast<const bf16x8*>(&Qw[(long)r32*DM+d0*16+hi*8]);
  float mhat=0.f,l_reg=0.f;f32x16 o[4];f32x16 negm;{float z_=0.f;asm volatile("":"+v"(z_));o[0]=(f32x16)(z_);o[1]=(f32x16)(z_);o[2]=(f32x16)(z_);o[3]=(f32x16)(z_);negm=(f32x16)(z_);}asm volatile("":"+v"(negm));
  const int qrel=wid*QBLK+r32;
  #define CMASK(P0,P1,t) do{int jb_=(t)-(NT-4); if(jb_>=0)cmask(P0,P1,jb_,qrel,hi);}while(0)
  bool resc=false;
  #define START(P0,P1) do{ const float rm=rowmax(P0,P1); resc=false; \
    { const float dl=rm; mhat=fadd_s(mhat,dl); \
      _Pragma("unroll") for(int r=0;r<16;++r){P0[r]=fsub_s(P0[r],dl);P1[r]=fsub_s(P1[r],dl);} \
      _Pragma("unroll") for(int r=0;r<16;++r)negm[r]=-mhat; asm volatile("":"+v"(negm)); } \
    _Pragma("unroll") for(int r=0;r<16;++r)P0[r]=__builtin_amdgcn_exp2f(P0[r]); }while(0)
  #define RESC() do{ if(resc){ asm volatile("s_waitcnt lgkmcnt(0)":::"memory"); \
      _Pragma("unroll") for(int d_=0;d_<4;++d_) _Pragma("unroll") for(int r=0;r<16;++r)o[d_][r]*=wsf[crow(r,hi)]; } }while(0)
  f32x16 pA0,pA1,pB0,pB1;
  int sl_prev=0,sl_cur=0,sl_next=SLOTB;
  #define ROT() do{sl_prev=sl_cur;sl_cur=sl_next;sl_next=(sl_next==(NSLOT-1)*SLOTB)?0:sl_next+SLOTB;}while(0)
  DMA_K(2,2*SLOTB);
  WAIT_BAR(4);
  qkt(pA0,pA1,Kbase,qr,negm,r32,hi);asm volatile("s_nop 15\n\ts_nop 7":"+v"(pA0),"+v"(pA1));CMASK(pA0,pA1,0);
  START(pA0,pA1);
  _Pragma("unroll") for(int r=0;r<16;++r)pA1[r]=__builtin_amdgcn_exp2f(pA1[r]);
  WAIT_BAR(0);
  DMA_K(3,0);DMA_V(1,SLOTB);
  ROT();
  kload8(kf,kp0+sl_cur);
  WAIT_BAR(3);
  s16x4 vlo[8],vhi[8]; u32x4 pw0,pw1,pw2,pw3;
  #define PKW(P,B) cvtpk_s(P[B],P[B+1])
  #define PAF(k) __builtin_bit_cast(bf16x8,pw##k)
  #define VFR(i) (bf16x8){vlo[i][0],vlo[i][1],vlo[i][2],vlo[i][3],vhi[i][0],vhi[i][1],vhi[i][2],vhi[i][3]}
  #define PIN(x) asm volatile("":"+v"(x))
  #define MX3(a,b,c) __builtin_fmaxf(__builtin_fmaxf((a),(b)),(c))
  #define GAPA(MF,A0,A1,A2,A3,W0,W1,PW) do{ MF; sacc+=A0; sacc+=A1; sacc+=A2; sacc+=A3; PIN(sacc); W0; W1; PIN(PW); SBAR(); }while(0)
  #define EX(v) __builtin_amdgcn_exp2f(v)
  #define GAPB(MF,X,B) do{ MF; X[B]=EX(X[B]); X[B+1]=EX(X[B+1]); X[B+2]=EX(X[B+2]); X[B+3]=EX(X[B+3]); PIN(X); SBAR(); }while(0)
  #define VRD(i) do{ vlo[i]=vtr(vp_+(((i)>>2)*4096+((i)&3)*1024)); vhi[i]=vtr(vp_+(((i)>>2)*4096+((i)&3)*1024+512)); }while(0)
  #define VRD2(i) do{ vlo[i]=vtr(vp_+((((i)>>2)+2)*4096+((i)&3)*1024)); vhi[i]=vtr(vp_+((((i)>>2)+2)*4096+((i)&3)*1024+512)); SBAR(); }while(0)
  #define KRD(G,j) do{ if(G){ kload2(kf,kp0+sl_next,j); SBAR(); } }while(0)
  #define STEP(C0,C1,P0,P1,t,GK,GV,GL) do{ SBAR(); \
    const lds_cptr vp_=vp0+2*sl_prev; \
    VRD(0); SBAR(); float sacc=(P0[0]+P0[1]); \
    GAPA(C0=__builtin_amdgcn_mfma_f32_32x32x16_bf16(kf[0],qr[0],negm,0,0,0), P0[2],P0[3],P0[4],P0[5],     pw0[0]=PKW(P0,0), pw0[1]=PKW(P0,2), pw0); \
    VRD(4); SBAR(); GAPA(C1=__builtin_amdgcn_mfma_f32_32x32x16_bf16(kf[1],qr[0],negm,0,0,0), P0[6],P0[7],P0[8],P0[9],     pw0[2]=PKW(P0,4), pw0[3]=PKW(P0,6), pw0); \
    VRD(1); SBAR(); GAPA(C0=__builtin_amdgcn_mfma_f32_32x32x16_bf16(kf[2],qr[1],C0,0,0,0),   P0[10],P0[11],P0[12],P0[13], pw1[0]=PKW(P0,8), pw1[1]=PKW(P0,10), pw1); \
    VRD(5); SBAR(); GAPA(C1=__builtin_amdgcn_mfma_f32_32x32x16_bf16(kf[3],qr[1],C1,0,0,0),   P0[14],P0[15],P1[0],P1[1],   pw1[2]=PKW(P0,12),pw1[3]=PKW(P0,14), pw1); \
    VRD(2); SBAR(); GAPA(C0=__builtin_amdgcn_mfma_f32_32x32x16_bf16(kf[4],qr[2],C0,0,0,0),   P1[2],P1[3],P1[4],P1[5],     pw2[0]=PKW(P1,0), pw2[1]=PKW(P1,2), pw2); \
    VRD(6); SBAR(); GAPA(C1=__builtin_amdgcn_mfma_f32_32x32x16_bf16(kf[5],qr[2],C1,0,0,0),   P1[6],P1[7],P1[8],P1[9],     pw2[2]=PKW(P1,4), pw2[3]=PKW(P1,6), pw2); \
    VRD(3); SBAR(); GAPA(C0=__builtin_amdgcn_mfma_f32_32x32x16_bf16(kf[6],qr[3],C0,0,0,0),   P1[10],P1[11],P1[12],P1[13], pw3[0]=PKW(P1,8), pw3[1]=PKW(P1,10), pw3); \
    VRD(7); SBAR(); GAPA(C1=__builtin_amdgcn_mfma_f32_32x32x16_bf16(kf[7],qr[3],C1,0,0,0),   P1[14],P1[15],0.f,0.f,       pw3[2]=PKW(P1,12),pw3[3]=PKW(P1,14), pw3); \
    l_reg+=sacc; \
    if(GK){DMA_K((t)+3,sl_cur);} if(GV){DMA_V((t)+1,sl_next);} \
    CMASK(C0,C1,t); \
    { float a=MX3(C0[0],C0[1],C1[0]),b=MX3(C0[2],C0[3],C1[1]); a=MX3(a,C1[2],C1[3]); \
      _Pragma("unroll") for(int r=4;r<16;r+=4){a=MX3(a,C0[r],C0[r+1]);b=MX3(b,C0[r+2],C0[r+3]);a=MX3(a,C1[r],C1[r+1]);b=MX3(b,C1[r+2],C1[r+3]);} \
      float rm=__builtin_fmaxf(a,b); { auto rr=__builtin_amdgcn_permlane32_swap(__float_as_uint(rm),__float_as_uint(rm),false,false); rm=__builtin_fmaxf(__uint_as_float(rr[0]),__uint_as_float(rr[1])); } \
      resc=false; \
      if(__builtin_expect(__any(rm>(float)THRL),0)){ const float dl=__builtin_fmaxf(rm,0.f); mhat+=dl; \
        _Pragma("unroll") for(int r=0;r<16;++r){C0[r]-=dl;C1[r]-=dl;} \
        _Pragma("unroll") for(int r=0;r<16;++r)negm[r]=-mhat; asm volatile("":"+v"(negm)); \
        const float f=__builtin_amdgcn_exp2f(-dl); l_reg*=f; if(hi==0)wsf[r32]=f; resc=true; } } \
    SBAR(); \
    GAPB(o[0]=__builtin_amdgcn_mfma_f32_32x32x16_bf16(PAF(0),VFR(0),o[0],0,0,0), C0,0); VRD2(0); \
    GAPB(o[1]=__builtin_amdgcn_mfma_f32_32x32x16_bf16(PAF(0),VFR(4),o[1],0,0,0), C0,4); VRD2(4); \
    KRD(GL,0); GAPB(o[0]=__builtin_amdgcn_mfma_f32_32x32x16_bf16(PAF(1),VFR(1),o[0],0,0,0), C0,8); VRD2(1); \
    KRD(GL,1); GAPB(o[1]=__builtin_amdgcn_mfma_f32_32x32x16_bf16(PAF(1),VFR(5),o[1],0,0,0), C0,12); VRD2(5); \
    KRD(GL,2); GAPB(o[0]=__builtin_amdgcn_mfma_f32_32x32x16_bf16(PAF(2),VFR(2),o[0],0,0,0), C1,0); VRD2(2); \
    KRD(GL,3); GAPB(o[1]=__builtin_amdgcn_mfma_f32_32x32x16_bf16(PAF(2),VFR(6),o[1],0,0,0), C1,4); VRD2(6); \
    GAPB(o[0]=__builtin_amdgcn_mfma_f32_32x32x16_bf16(PAF(3),VFR(3),o[0],0,0,0), C1,8); VRD2(3); \
    GAPB(o[1]=__builtin_amdgcn_mfma_f32_32x32x16_bf16(PAF(3),VFR(7),o[1],0,0,0), C1,12); VRD2(7); \
    o[2]=__builtin_amdgcn_mfma_f32_32x32x16_bf16(PAF(0),VFR(0),o[2],0,0,0); o[3]=__builtin_amdgcn_mfma_f32_32x32x16_bf16(PAF(0),VFR(4),o[3],0,0,0); SBAR(); \
    o[2]=__builtin_amdgcn_mfma_f32_32x32x16_bf16(PAF(1),VFR(1),o[2],0,0,0); o[3]=__builtin_amdgcn_mfma_f32_32x32x16_bf16(PAF(1),VFR(5),o[3],0,0,0); SBAR(); \
    o[2]=__builtin_amdgcn_mfma_f32_32x32x16_bf16(PAF(2),VFR(2),o[2],0,0,0); o[3]=__builtin_amdgcn_mfma_f32_32x32x16_bf16(PAF(2),VFR(6),o[3],0,0,0); SBAR(); \
    o[2]=__builtin_amdgcn_mfma_f32_32x32x16_bf16(PAF(3),VFR(3),o[2],0,0,0); o[3]=__builtin_amdgcn_mfma_f32_32x32x16_bf16(PAF(3),VFR(7),o[3],0,0,0); SBAR(); \
    }while(0)
  int t=1;
  #undef CMASK
  #define CMASK(P0,P1,t) do{}while(0)
  for(;t+5<NT;t+=2){
    STEP(pB0,pB1,pA0,pA1,t,true,true,true);     WAIT_BAR(3); RESC(); ROT();
    STEP(pA0,pA1,pB0,pB1,t+1,true,true,true);   WAIT_BAR(3); RESC(); ROT();
  }
  #undef CMASK
  #define CMASK(P0,P1,t) do{int jb_=(t)-(NT-4); if(jb_>=0)cmask(P0,P1,jb_,qrel,hi);}while(0)
  #define ENDW(tt) do{ if((tt)+3<NT){WAIT_BAR(3);} else if((tt)+2<NT){WAIT_BAR(2);} else {WAIT_BAR(0);} }while(0)
  for(;t+1<NT;t+=2){
    STEP(pB0,pB1,pA0,pA1,t,(t+3<NT),(t+1<NT),(t+1<NT));       ENDW(t);   RESC(); ROT();
    STEP(pA0,pA1,pB0,pB1,t+1,(t+4<NT),(t+2<NT),(t+2<NT));     ENDW(t+1); RESC(); ROT();
  }
  STEP(pB0,pB1,pA0,pA1,NT-1,false,false,false); RESC();
  { float sacc=pB0[0]+pB0[1]; _Pragma("unroll") for(int r=2;r<16;++r)sacc+=pB0[r]; _Pragma("unroll") for(int r=0;r<16;++r)sacc+=pB1[r]; l_reg+=sacc;
    pw0=(u32x4){PKW(pB0,0),PKW(pB0,2),PKW(pB0,4),PKW(pB0,6)};pw1=(u32x4){PKW(pB0,8),PKW(pB0,10),PKW(pB0,12),PKW(pB0,14)};pw2=(u32x4){PKW(pB1,0),PKW(pB1,2),PKW(pB1,4),PKW(pB1,6)};pw3=(u32x4){PKW(pB1,8),PKW(pB1,10),PKW(pB1,12),PKW(pB1,14)};
    SBAR(); pv(o,vb0+2*sl_cur,PAF(0),PAF(1),PAF(2),PAF(3)); }
  #undef PKW
  #undef PAF
  #undef VFR
  #undef PIN
  #undef MX3
  #undef GAPA
  #undef GAPB
  #undef EX
  #undef VRD
  #undef VRD2
  #undef KRD
  #undef STEP
  #undef ENDW
  {auto rr=__builtin_amdgcn_permlane32_swap(__float_as_uint(l_reg),__float_as_uint(l_reg),false,false);l_reg=__uint_as_float(rr[0])+__uint_as_float(rr[1]);}
  if(hi==0)wsf[32+r32]=l_reg;asm volatile("s_waitcnt lgkmcnt(0)":::"memory");
  float rli[16];
  #pragma unroll
  for(int r=0;r<16;++r)rli[r]=__builtin_amdgcn_rcpf(wsf[32+crow(r,hi)]);
  bf16*Ow=O+(rowbase+q0+wid*QBLK)*DM+ocol;
  { bf16*stg=(bf16*)(shm+LDS_OST)+wid*4096;
    #pragma unroll
    for(int r=0;r<16;++r){const int orow=crow(r,hi);
      #pragma unroll
      for(int d0=0;d0<4;++d0)stg[orow*128+d0*32+r32]=__float2bfloat16(o[d0][r]*rli[r]);}
    asm volatile("s_waitcnt lgkmcnt(0)":::"memory");
    #pragma unroll
    for(int i=0;i<8;++i){const int row=i*4+(lane>>4),ch=lane&15; const u32x4 v=*(const u32x4*)(stg+row*128+ch*8); ATTN_STORE16(Ow+(long)row*DM+ch*8,v);} }
  asm volatile("s_waitcnt lgkmcnt(0)\n\ts_barrier":::"memory");
  #undef DMA_K
  #undef DMA_V
  #undef CMASK
  #undef START
  #undef RESC
  #undef ROT
}
constexpr int ATTN_LDS_BYTES=LDS_BYTES;
#undef SBAR
#undef WAIT_BAR
}

__device__ __forceinline__ void fstage_attn(const Params& p, int l, char* lds) {
    const int G = gridDim.x, bx = blockIdx.x;
    const int vcu = (G % 8 == 0) ? (bx % 8) * (G / 8) + bx / 8 : bx;
    const attn_body::bf16* Q = (const attn_body::bf16*)(p.ws + WS_QB); const attn_body::bf16* K = (const attn_body::bf16*)(p.ws + WS_KB); const attn_body::bf16* V = (const attn_body::bf16*)(p.ws + WS_VB);
    for (int k = vcu; k < 256; k += G) {
        const int s = k & 7, h = (k >> 3) & 3, b = k >> 5;
#pragma unroll 1
        for (int i = 0; i < 4; ++i) {
            const int qb = (i & 2) ? 15 - s : s, m = i & 1;
            attn_body::bf16* O = (attn_body::bf16*)(p.ws + (m == 0 ? WS_O1 : WS_O2));
            attn_body::attn_unit<8>(b, (2 * h + m) * 64, (2 * h + m) * 64, h * 128, h * 128, qb, Q, K, V, O, lds);
        }
    }
    asm volatile("s_waitcnt vmcnt(0)" ::: "memory");
    __syncthreads();
    int vc2 = vcu; asm volatile("" : "+s"(vc2));
    for (int k = vc2; k < 256; k += G) {
        const int s = k & 7, h = (k >> 3) & 3, b = k >> 5;
        const int tid = tid_fresh(), lane = tid & 63, wid = tid >> 6;
        const float* lq = (const float*)p.in[5] + l * 256;
        float d1 = lq[lane] * lq[64 + lane], d2 = lq[128 + lane] * lq[192 + lane];
        d1 = wave_sum(d1); d2 = wave_sum(d2);
        const float lam = expf(d1) - expf(d2) + lam_init_of(l);
#pragma unroll 2
        for (int it = 0; it < 16; ++it) {
            const int qb = (it & 8) ? 15 - s : s, r = (it & 7) * 32 + wid * 4 + (lane >> 4);
            const size_t o = ((size_t)b * S + qb * 256 + r) * 512 + h * 128 + (lane & 15) * 8;
            const u32x4 a = *(const u32x4*)((const bf16_t*)(p.ws + WS_O1) + o), c = *(const u32x4*)((const bf16_t*)(p.ws + WS_O2) + o);
            float x[8];
#pragma unroll
            for (int e = 0; e < 4; ++e) { x[2 * e] = __uint_as_float(a[e] << 16) - lam * __uint_as_float(c[e] << 16); x[2 * e + 1] = __uint_as_float(a[e] & 0xffff0000u) - lam * __uint_as_float(c[e] & 0xffff0000u); }
            float ss = 0.f;
#pragma unroll
            for (int e = 0; e < 8; ++e) ss += x[e] * x[e];
            ss = sum16(ss);
            const float rs = rsqrtf(ss * (1.f / 128.f) + EPS);
            u32x4 w;
#pragma unroll
            for (int e = 0; e < 4; ++e) w[e] = pk2(x[2 * e] * rs, x[2 * e + 1] * rs);
            *(u32x4*)((bf16_t*)(p.ws + WS_AO) + o) = w;
        }
    }
}


__device__ __forceinline__ void fstage_sgate(const Params& p, int l, lds_t lds) {
    unsigned char* ws = p.ws;
    const int tid = tid_fresh(), lane = tid & 63, wid = __builtin_amdgcn_readfirstlane(tid >> 6), fr = lane & 15, fq = lane >> 4;
    constexpr int PV = 1056;
    PG8_LAS unsigned char* vn = lds;
    const bf16_t* vin = (const bf16_t*)(ws + WS_VIN); const bf16_t* uin = (const bf16_t*)(ws + WS_UIN); bf16_t* so = (bf16_t*)(ws + WS_SO);
    const float* lng = (const float*)p.in[9] + l * 512; const float* lnb = (const float*)p.in[10] + l * 512; const float* bsp = (const float*)p.in[12] + l * 512;
    const bf16_t* wsm = (const bf16_t*)(ws + WS_WSPT) + (size_t)l * 4 * 16384;
    for (int ch = blockIdx.x; ch < T / 128; ch += gridDim.x) {
        const int t0 = ch * 128;
        __syncthreads();
        {
            u32x4 rw[16];
#pragma unroll
            for (int i = 0; i < 16; ++i) rw[i] = *(const u32x4*)(vin + (size_t)(t0 + wid * 16 + i) * 512 + lane * 8);
            const f32x4 g0 = *(const f32x4*)(lng + lane * 8), g1 = *(const f32x4*)(lng + lane * 8 + 4), b0 = *(const f32x4*)(lnb + lane * 8), b1 = *(const f32x4*)(lnb + lane * 8 + 4);
#pragma unroll
            for (int i = 0; i < 16; ++i) {
                f32x4 a, b; up8(rw[i], a, b);
                const float mu = wave_sum((a[0] + a[1]) + (a[2] + a[3]) + (b[0] + b[1]) + (b[2] + b[3])) * (1.f / 512.f);
                a = a - mu; b = b - mu;
                const float vr = wave_sum((a[0] * a[0] + a[1] * a[1]) + (a[2] * a[2] + a[3] * a[3]) + (b[0] * b[0] + b[1] * b[1]) + (b[2] * b[2] + b[3] * b[3])) * (1.f / 512.f);
                const float rs = rsqrtf(vr + EPS);
                *(PG8_LAS u32x4*)(vn + (wid * 16 + i) * PV + lane * 16) = pk8(a * rs * g0 + b0, b * rs * g1 + b1);
            }
        }
        __syncthreads();
        const int nks = (16 * wid + 16 + 31) >> 5;
        const int trow = t0 + 16 * wid + fr;
#pragma unroll 1
        for (int g = 0; g < 4; ++g) {
            f32x4 acc[8];
#pragma unroll
            for (int nt = 0; nt < 8; ++nt) acc[nt] = (f32x4){0.f, 0.f, 0.f, 0.f};
            const bf16_t* wrow = wsm + ((size_t)g * 128 + 16 * wid + fr) * 128 + fq * 8;
#pragma unroll 1
            for (int ks = 0; ks < nks; ++ks) {
                const bf16x8 af = *(const bf16x8*)(wrow + ks * 32);
                const PG8_LAS unsigned char* vb = vn + (ks * 32 + fq * 8 + (fr >> 2)) * PV + (fr & 3) * 8 + g * 256;
#pragma unroll
                for (int nt = 0; nt < 8; ++nt) {
                    typedef short v4i16s __attribute__((ext_vector_type(4)));
                    const v4i16s lo = __builtin_amdgcn_ds_read_tr16_b64_v4i16((PG8_LAS v4i16s*)(vb + nt * 32)), hi = __builtin_amdgcn_ds_read_tr16_b64_v4i16((PG8_LAS v4i16s*)(vb + nt * 32 + 4 * PV));
                    const bf16x8 bf = (bf16x8){lo[0], lo[1], lo[2], lo[3], hi[0], hi[1], hi[2], hi[3]};
                    acc[nt] = __builtin_amdgcn_mfma_f32_16x16x32_bf16(bf, af, acc[nt], 0, 0, 0);
                }
            }
            const float bs = bsp[g * 128 + 16 * wid + fr];
#pragma unroll
            for (int nt = 0; nt < 8; ++nt) { const size_t o = (size_t)trow * 512 + g * 128 + nt * 16 + fq * 4; st_bf4(so + o, ld_bf4(uin + o) * (acc[nt] + bs)); }
        }
    }
}

__device__ __forceinline__ void stage_pool_d(const Params& p, int bid, int nb) {
    const int tidx = tid_fresh();
    unsigned char* ws = p.ws;
    const unsigned char* pin = ws + WS_PIN; unsigned char* dp = ws + WS_DP;
    for (int i = bid * NT + tidx; i < (T / 8) * 64; i += nb * NT) {
        const int c8 = (i & 63) * 8, t0 = (i >> 6) * 8, s0 = t0 & (S - 1), g = c8 >> 7, w = 2 << g;
        const unsigned ob = (unsigned)(t0 * 512 + c8) * 2u;
        u32x4 pv[16], cv[8];
#pragma unroll
        for (int k = 1; k <= 16; ++k) pv[k - 1] = (k <= w && k <= s0) ? *(const u32x4*)(pin + (ob - (unsigned)k * 1024u)) : (u32x4){0u, 0u, 0u, 0u};
#pragma unroll
        for (int j = 0; j < 8; ++j) cv[j] = *(const u32x4*)(pin + (ob + (unsigned)j * 1024u));
        f32x4 s0v = (f32x4){0.f, 0.f, 0.f, 0.f}, s1v = s0v, a, b;
#pragma unroll
        for (int k = 0; k < 16; ++k) { up8(pv[k], a, b); s0v = s0v + a; s1v = s1v + b; }
#pragma unroll
        for (int j = 0; j < 8; ++j) {
            f32x4 ca, cb; up8(cv[j], ca, cb); s0v = s0v + ca; s1v = s1v + cb;
            u32x4 lv = pv[(15 - j) & 15];
            if (g == 2) lv = pv[7 - j];
            if (g == 1) lv = (j < 4) ? pv[3 - (j & 3)] : cv[(j - 4) & 7];
            if (g == 0) lv = (j < 2) ? pv[1 - (j & 1)] : cv[(j - 2) & 7];
            up8(lv, a, b); s0v = s0v - a; s1v = s1v - b;
            const int sj = s0 + j + 1; const float inv = 1.f / (float)(sj < w ? sj : w);
            *(u32x4*)(dp + (ob + (unsigned)j * 1024u)) = pk8(s0v * inv - ca, s1v * inv - cb);
        }
    }
}
__device__ __forceinline__ void stage_aout(const Params& p, int l, int bid, int nb) {
    const int tidx = tid_fresh();
    unsigned char* ws = p.ws;
    const int lane = tidx & 63, wid = tidx >> 6;
    const float* lq = (const float*)p.in[5] + l * 256;
    float d1 = lq[lane] * lq[64 + lane], d2 = lq[128 + lane] * lq[192 + lane];
    d1 = wave_sum(d1); d2 = wave_sum(d2);
    const float lam = expf(d1) - expf(d2) + lam_init_of(l);
    for (int t = bid * 8 + wid; t < T; t += nb * 8) {
        const u32x4 a = *(const u32x4*)((const bf16_t*)(ws + WS_O1) + (size_t)t * 512 + lane * 8), b = *(const u32x4*)((const bf16_t*)(ws + WS_O2) + (size_t)t * 512 + lane * 8);
        float x[8];
#pragma unroll
        for (int e = 0; e < 4; ++e) { x[2 * e] = __uint_as_float(a[e] << 16) - lam * __uint_as_float(b[e] << 16); x[2 * e + 1] = __uint_as_float(a[e] & 0xffff0000u) - lam * __uint_as_float(b[e] & 0xffff0000u); }
        float ss = 0.f;
#pragma unroll
        for (int e = 0; e < 8; ++e) ss += x[e] * x[e];
        ss = sum16(ss);
        const float rs = rsqrtf(ss * (1.f / 128.f) + EPS);
        u32x4 w;
#pragma unroll
        for (int e = 0; e < 4; ++e) w[e] = pk2(x[2 * e] * rs, x[2 * e + 1] * rs);
        *(u32x4*)((bf16_t*)(ws + WS_AO) + (size_t)t * 512 + lane * 8) = w;
    }
}
__device__ __forceinline__ unsigned key_of(float s, unsigned low) { const unsigned u = __float_as_uint(s); const unsigned k = (u & 0x80000000u) ? ~u : (u | 0x80000000u); return (k & ~255u) | low; }
__device__ __forceinline__ float val_of(unsigned key) { const unsigned k = key & ~255u; const unsigned u = (k & 0x80000000u) ? (k & 0x7fffffffu) : ~k; return __uint_as_float(u); }
__device__ __forceinline__ void sort16_desc(unsigned (&a)[16]) {
#pragma unroll
    for (int k = 2; k <= 16; k <<= 1)
#pragma unroll
        for (int j = k >> 1; j > 0; j >>= 1)
#pragma unroll
            for (int i = 0; i < 16; ++i) { const int l = i ^ j; if (l > i) { const unsigned hi = a[i] > a[l] ? a[i] : a[l], lo = a[i] > a[l] ? a[l] : a[i];
                if ((i & k) == 0) { a[i] = hi; a[l] = lo; } else { a[i] = lo; a[l] = hi; } } }
}
__device__ __forceinline__ void merge_top16(unsigned (&r)[16], const unsigned (&b)[16]) {
#pragma unroll
    for (int i = 0; i < 16; ++i) r[i] = r[i] > b[15 - i] ? r[i] : b[15 - i];
#pragma unroll
    for (int j = 8; j > 0; j >>= 1)
#pragma unroll
        for (int i = 0; i < 16; ++i) { const int l = i ^ j; if (l > i) { const unsigned hi = r[i] > r[l] ? r[i] : r[l], lo = r[i] > r[l] ? r[l] : r[i]; r[i] = hi; r[l] = lo; } }
}
__device__ __forceinline__ constexpr int cand_pair(int q) {
    int c = 0;
    for (int a = 0; a < 16; ++a) for (int b = 0; b < 16; ++b) if ((a + 1) * (b + 1) <= 16) { if (c == q) return a * 16 + b; ++c; }
    return -1;
}
template <class Sched>
__device__ __forceinline__ void topk_local(const Params& p, const Sched& O, lds_t lds) {
    const int tidx = tid_fresh(), lane = tidx & 63, wid = __builtin_amdgcn_readfirstlane(tidx >> 6);
    unsigned char* ws = p.ws;
    const _Float16* sc = (const _Float16*)(ws + WS_SC);
    constexpr int PITCH = 272;
    PG8_LAS unsigned char* st = lds + wid * (64 * PITCH);
#pragma unroll 1
    for (int bi = wid; ; bi += 8) {
        pg8::Unit u; if (!O.next(bi >> 2, u)) break;
        const int t0 = u.pm * 256 + (bi & 3) * 64, head = u.pn;
        unsigned la[16], lb[16], blk[16];
#pragma unroll
        for (int h = 0; h < 2; ++h) {
            unsigned (&top)[16] = h == 0 ? la : lb;
            u32x4 w[16];
#pragma unroll
            for (int q = 0; q < 16; ++q) w[q] = *(const u32x4*)(sc + (size_t)(t0 + 4 * q + (lane >> 4)) * 2048 + head * 256 + h * 128 + (lane & 15) * 8);
#pragma unroll
            for (int q = 0; q < 16; ++q) *(PG8_LAS u32x4*)(st + (4 * q + (lane >> 4)) * PITCH + (lane & 15) * 16) = w[q];
#pragma unroll
            for (int n0 = 0; n0 < 128; n0 += 16) {
                const f16x8 h0 = *(const PG8_LAS f16x8*)(st + lane * PITCH + n0 * 2), h1 = *(const PG8_LAS f16x8*)(st + lane * PITCH + n0 * 2 + 16);
#pragma unroll
                for (int e = 0; e < 8; ++e) { blk[e] = key_of((float)h0[e], 255u - (unsigned)(n0 + e)); blk[8 + e] = key_of((float)h1[e], 255u - (unsigned)(n0 + 8 + e)); }
                sort16_desc(blk);
                if (n0 == 0) {
#pragma unroll
                    for (int e = 0; e < 16; ++e) top[e] = blk[e];
                } else merge_top16(top, blk);
            }
        }
        const int i = (t0 + lane) * 8 + head;
        float sa[16], sb[16];
#pragma unroll
        for (int j = 0; j < 16; ++j) { sa[j] = val_of(la[j]); sb[j] = val_of(lb[j]); }
        unsigned lc[16];
#pragma unroll
        for (int q0 = 0; q0 < 64; q0 += 16) {
#pragma unroll
            for (int e = 0; e < 16; ++e) { const int ab = cand_pair(q0 + e); blk[e] = (ab >= 0) ? key_of(sa[ab >= 0 ? (ab >> 4) : 0] + sb[ab >= 0 ? (ab & 15) : 0], 255u - (unsigned)(ab >= 0 ? ab : 0)) : 0u; }
            sort16_desc(blk);
            if (q0 == 0) {
#pragma unroll
                for (int e = 0; e < 16; ++e) lc[e] = blk[e];
            } else merge_top16(lc, blk);
        }
        float g[16]; const float mx = val_of(lc[0]); float sum = 0.f;
#pragma unroll
        for (int j = 0; j < 16; ++j) { g[j] = __expf(val_of(lc[j]) - mx); sum += g[j]; }
        const float inv = 1.f / sum;
        int* ti = (int*)(ws + WS_TI) + (size_t)i * 16;
        int eo[16];
#pragma unroll
        for (int j = 0; j < 16; ++j) {
            const int c = 255 - (int)(lc[j] & 255u), a = c >> 4, b = c & 15;
            unsigned ka = la[0], kb = lb[0];
#pragma unroll
            for (int q = 1; q < 16; ++q) { ka = (a == q) ? la[q] : ka; kb = (b == q) ? lb[q] : kb; }
            const _Float16 gh = (_Float16)(g[j] * inv);
            eo[j] = ((255 - (int)(ka & 255u)) * 128 + (255 - (int)(kb & 255u))) | ((int)__builtin_bit_cast(unsigned short, gh) << 16);
        }
#pragma unroll
        for (int j = 0; j < 16; j += 4) *(int __attribute__((ext_vector_type(4)))*)(ti + j) = (int __attribute__((ext_vector_type(4)))){eo[j], eo[j + 1], eo[j + 2], eo[j + 3]};
    }
}
__device__ __forceinline__ void fstage_pscore(const Params& p, int l, lds_t lds, int bid, int nb) {
    pg8::Order O; O.init(T, 2048, nb, bid, p.ws + WS_XB, D, p.ws + WS_SKT + (size_t)l * 2048 * D * 2, D);
    pg8::gemm_phase<GEpiScaleF16, pg8::Order, true>(lds, D, D, D, O, GEpiScaleF16{p.ws, (_Float16*)(p.ws + WS_SC), 2048});
    topk_local(p, O, lds);
}
#define XB_TMO      128
#define XB_XCNT(j)  (256  + 64 * (j))
#define XB_XSUB(j)  (1280 + 64 * (j))
#define XB_XGEN(j)  (2304 + 64 * (j))
#define XB_TOP      3328
#define XB_TOPGEN   3392
#define XCD_BAR_WORDS 3456
#define XB_SPIN_CAP (1u << 18)
#define LAS __attribute__((address_space(3)))

__device__ __forceinline__ unsigned xb_ld(unsigned* p)              { return __hip_atomic_load(p, __ATOMIC_RELAXED, __HIP_MEMORY_SCOPE_AGENT); }
__device__ __forceinline__ unsigned xb_add(unsigned* p, unsigned v) { return __hip_atomic_fetch_add(p, v, __ATOMIC_RELAXED, __HIP_MEMORY_SCOPE_AGENT); }
__device__ __forceinline__ unsigned xb_xcc_id() { return (unsigned)__builtin_amdgcn_s_getreg((3 << 11) | 20) & 0xFu; }
#define XB_SPIN(cond, bar) do { unsigned _sp = 0; while (cond) { __builtin_amdgcn_s_sleep(1); \
    if ((++_sp & 255u) == 0u) { if (xb_ld(&(bar)[XB_TMO])) break; if (_sp > XB_SPIN_CAP) { atomicAdd(&(bar)[XB_TMO], 1u); break; } } } } while (0)

struct XcdBarrier {
    unsigned* bar; unsigned x;
    volatile LAS unsigned* st;
};

__device__ __forceinline__ XcdBarrier xcd_barrier_post(unsigned* bar, volatile LAS unsigned* st) {
    XcdBarrier b; b.bar = bar; b.x = xb_xcc_id(); b.st = st;
    if (tid_fresh() == 0) (void)xb_add(&bar[XB_XCNT(b.x)], 1u);
    return b;
}
__device__ __forceinline__ void xcd_barrier_complete(unsigned* bar, unsigned x, unsigned& nloc, unsigned& nx) {
    const unsigned G = gridDim.x * gridDim.y * gridDim.z;
    unsigned sum, cnt, mine, sp = 0u;
    for (;;) {
        sum = 0u; cnt = 0u; mine = 0u;
#pragma unroll
        for (unsigned j = 0; j < 16; ++j) { const unsigned c = xb_ld(&bar[XB_XCNT(j)]); sum += c; cnt += (c > 0u) ? 1u : 0u; mine = (j == x) ? c : mine; }
        if (sum == G) break;
        __builtin_amdgcn_s_sleep(1);
        if ((++sp & 255u) == 0u) { if (xb_ld(&bar[XB_TMO])) break; if (sp > XB_SPIN_CAP) { atomicAdd(&bar[XB_TMO], 1u); break; } }
    }
    nloc = mine > 0u ? mine : 1u; nx = cnt > 0u ? cnt : 1u;
}

__device__ __forceinline__ void xcd_barrier(const XcdBarrier& b) {
    asm volatile("s_waitcnt vmcnt(0)" ::: "memory");
    __syncthreads();
    if (tid_fresh() == 0) {
        unsigned* bar = b.bar;
        __builtin_amdgcn_s_waitcnt(0);
        unsigned nloc = b.st[0], nx = b.st[1];
        if (nloc == 0u) { xcd_barrier_complete(bar, b.x, nloc, nx); b.st[0] = nloc; b.st[1] = nx; }
        const unsigned old = xb_add(&bar[XB_XSUB(b.x)], 1u);
        const unsigned gen = old / nloc;
        if (old + 1u == (gen + 1u) * nloc) {
            __builtin_amdgcn_fence(__ATOMIC_RELEASE, "agent");
            asm volatile("s_waitcnt vmcnt(0)" ::: "memory");
            const unsigned og = xb_add(&bar[XB_TOP], 1u);
            const unsigned tg = og / nx;
            if (og + 1u == (tg + 1u) * nx) xb_add(&bar[XB_TOPGEN], 1u);
            else XB_SPIN(xb_ld(&bar[XB_TOPGEN]) == tg, bar);
            __builtin_amdgcn_fence(__ATOMIC_ACQUIRE, "agent");
            xb_add(&bar[XB_XGEN(b.x)], 1u);
            asm volatile("s_waitcnt vmcnt(0)" ::: "memory");
        } else {
            XB_SPIN(xb_ld(&bar[XB_XGEN(b.x)]) == gen, bar);
            __builtin_amdgcn_fence(__ATOMIC_ACQUIRE, "agent");
            asm volatile("s_waitcnt vmcnt(0)" ::: "memory");
        }
    }
    __syncthreads();
}


constexpr int PQ_CH = 16, PQ_NCH = T / PQ_CH;
constexpr int CW_PQ = 16384;
constexpr size_t CTL_ZERO_BYTES = 131072;
__device__ __forceinline__ unsigned pq_pull(unsigned* head, int lane) {
    unsigned c = 0; if (lane == 0) c = __hip_atomic_fetch_add(head, 1u, __ATOMIC_RELAXED, __HIP_MEMORY_SCOPE_AGENT);
    return (unsigned)__builtin_amdgcn_readfirstlane((int)c);
}
__device__ __forceinline__ f32x2 gelu_pk(f32x2 v) {
    const f32x2 av = __builtin_elementwise_abs(v), d = av * 0.2316418882f + 1.0f;
    f32x2 t; t.x = __builtin_amdgcn_rcpf(d.x); t.y = __builtin_amdgcn_rcpf(d.y);
    f32x2 q = t * 0.5307027145f + (-0.7265760135f); q = q * t + 0.7107068705f; q = q * t + (-0.142248368f); q = q * t + 0.127414796f; q = q * t;
    const f32x2 s = (v * v) * (-0.72134752044f);
    f32x2 e; e.x = __builtin_amdgcn_exp2f(s.x); e.y = __builtin_amdgcn_exp2f(s.y);
    const f32x2 m = v * (q * e), r = v - m;
    f32x2 o; o.x = v.x < 0.f ? m.x : r.x; o.y = v.y < 0.f ? m.y : r.y; return o;
}
__device__ __forceinline__ float gelu_erf(float d) { return 0.5f * d * (1.f + erff(d * 0.70710678118654752f)); }

constexpr unsigned ENT_INVALID = 0xffffffffu;
typedef long i64x2 __attribute__((ext_vector_type(2)));
__device__ __forceinline__ void fstage_peer_u(const Params& p, int l, int qsel, lds_t lds, unsigned imask = 16383u, size_t aoff = 0, bool skipg = false) {
    unsigned char* ws = p.ws;
    const int tid = tid_fresh(), lane = tid & 63, wid = __builtin_amdgcn_readfirstlane(tid >> 6), n = lane & 15, kq = lane >> 4;
    const unsigned char* u8 = ws + WS_U8 + (size_t)l * NEXP * D;
    unsigned* heads = (unsigned*)(ws + WS_CTL) + CW_PQ + ((qsel * 2 + 0) * 8) * 64;
    const int myx = (int)(xb_xcc_id() & 7u);
    float* Aout = (float*)(ws + WS_PA + aoff);
    constexpr int RB_BYTES = 16 * 1024, LIST_MAX = 400, WREG = RB_BYTES + (LIST_MAX + 16) * 8;
    PG8_LAS unsigned char* rbuf = lds + wid * WREG;
    PG8_LAS unsigned* ent = (PG8_LAS unsigned*)(rbuf + RB_BYTES);
    PG8_LAS float* gl = (PG8_LAS float*)(rbuf + RB_BYTES + (LIST_MAX + 16) * 4);
#pragma unroll 1
    for (int s8 = 0; s8 < 8; ++s8) {
        const int k = (myx + s8) & 7;
        unsigned c = pq_pull(heads + k * 64, lane);
#pragma unroll 1
        for (;;) {
            if (c >= (unsigned)PQ_NCH) break;
            const int t0 = (int)c * PQ_CH;
            unsigned c_next = c; bool pulled = false;
            int mxs = 0x7f7f7f7f; asm volatile("" : "+v"(mxs));
            pg8::i32x8_t xf8[8];
            { const unsigned char* xp = ws + WS_XQ8 + (size_t)(t0 + n) * D + kq * 16;
#pragma unroll
              for (int i = 0; i < 8; ++i) { const pg8::i32x4_t lo = *(const pg8::i32x4_t*)(xp + (2 * i) * 64), hi = *(const pg8::i32x4_t*)(xp + (2 * i + 1) * 64); xf8[i] = __builtin_shufflevector(lo, hi, 0, 1, 2, 3, 4, 5, 6, 7); } }
            const float rs = row_rstd((const float*)(ws + WS_SSP), t0 + n) * (1.f / (SU * XS));
            float* ao = Aout + (size_t)(t0 + n) * 128;
            int i_next = 0;
#pragma unroll 1
            while (i_next < 16) {
                int e0v[16], e1v[16];
                { const int* ti = (const int*)(ws + WS_TI) + (size_t)t0 * 128;
#pragma unroll
                  for (int i = 0; i < 16; ++i) { e0v[i] = ti[i * 128 + lane]; e1v[i] = ti[i * 128 + 64 + lane]; } }
                int cnt = 0; int i_end = 16;
#pragma unroll
                for (int i = 0; i < 16; ++i) {
                    if (i >= i_next && i < i_end) {
                        if (cnt > LIST_MAX - 128) { i_end = i; }
                        else {
                            const int e0 = e0v[i] & 16383, e1 = e1v[i] & 16383;
                            const bool s0 = (e0 >> 11) == k, s1 = (e1 >> 11) == k;
                            const unsigned long long m0 = __ballot(s0), m1 = __ballot(s1);
                            const int b0 = (int)__builtin_amdgcn_mbcnt_hi((unsigned)(m0 >> 32), __builtin_amdgcn_mbcnt_lo((unsigned)m0, 0u));
                            const int b1 = (int)__builtin_amdgcn_mbcnt_hi((unsigned)(m1 >> 32), __builtin_amdgcn_mbcnt_lo((unsigned)m1, 0u));
                            const int c0 = __builtin_popcountll(m0);
                            if (s0) { ent[cnt + b0] = ((unsigned)i << 21) | ((unsigned)lane << 14) | (unsigned)e0; gl[cnt + b0] = (float)__builtin_bit_cast(_Float16, (unsigned short)((unsigned)e0v[i] >> 16)); }
                            if (s1) { ent[cnt + c0 + b1] = ((unsigned)i << 21) | ((unsigned)(64 + lane) << 14) | (unsigned)e1; gl[cnt + c0 + b1] = (float)__builtin_bit_cast(_Float16, (unsigned short)((unsigned)e1v[i] >> 16)); }
                            cnt += c0 + __builtin_popcountll(m1);
                        }
                    }
                }
                i_next = i_end;
                if (cnt == 0) continue;
                if (lane < 16) ent[cnt + lane] = ENT_INVALID;
                const int ng = skipg ? 0 : ((cnt + 15) >> 4);
                u32x4 W[16];
#define PU_LOAD(g_) do { const PG8_LAS u32x4* ep_ = (const PG8_LAS u32x4*)(ent + (g_) * 16); const u32x4 q0_ = ep_[0], q1_ = ep_[1], q2_ = ep_[2], q3_ = ep_[3]; \
                    _Pragma("unroll") for (int q = 0; q < 16; ++q) { const unsigned e_ = (q < 4) ? q0_[q & 3] : (q < 8) ? q1_[q & 3] : (q < 12) ? q2_[q & 3] : q3_[q & 3]; \
                        const unsigned iq_ = (e_ == ENT_INVALID) ? 0u : (e_ & imask); W[q] = *(const u32x4*)(u8 + (size_t)iq_ * D + lane * 16); } } while (0)
                if (!pulled) { pulled = true; c_next = pq_pull(heads + k * 64, lane); }
                if (ng > 0) PU_LOAD(0);
#pragma unroll 1
                for (int g = 0; g < ng; ++g) {
#pragma unroll
                    for (int q = 0; q < 16; ++q) *(PG8_LAS u32x4*)(rbuf + q * 1024 + ((lane ^ q) * 16)) = W[q];
                    if (g + 1 < ng) PU_LOAD(g + 1);
                    f32x4 acc;
                    const PG8_LAS unsigned char* fp = rbuf + n * 1024;
#pragma unroll
                    for (int Lb = 0; Lb < 16; Lb += 4) {
                        pg8::i32x4_t fa[4];
#pragma unroll
                        for (int L = 0; L < 4; ++L) fa[L] = *(const PG8_LAS pg8::i32x4_t*)(fp + ((((Lb + L) * 4 + kq) ^ n) * 16));
                        __builtin_amdgcn_sched_barrier(0);
                        const pg8::i32x8_t a0 = __builtin_shufflevector(fa[0], fa[1], 0, 1, 2, 3, 4, 5, 6, 7), a1 = __builtin_shufflevector(fa[2], fa[3], 0, 1, 2, 3, 4, 5, 6, 7);
                        if (Lb == 0) asm volatile("v_mfma_scale_f32_16x16x128_f8f6f4 %0, %1, %2, 0, %3, %3 op_sel_hi:[0,0,0]" : "=v"(acc) : "v"(a0), "v"(xf8[0]), "v"(mxs));
                        else asm volatile("v_mfma_scale_f32_16x16x128_f8f6f4 %0, %1, %2, %0, %3, %3 op_sel_hi:[0,0,0]" : "+v"(acc) : "v"(a0), "v"(xf8[Lb >> 1]), "v"(mxs));
                        asm volatile("v_mfma_scale_f32_16x16x128_f8f6f4 %0, %1, %2, %0, %3, %3 op_sel_hi:[0,0,0]" : "+v"(acc) : "v"(a1), "v"(xf8[(Lb >> 1) + 1]), "v"(mxs));
                        __builtin_amdgcn_sched_barrier(0);
                    }
                    asm volatile("s_nop 15\n\ts_nop 7" : "+v"(acc) :: "memory");
                    {
                        const u32x4 e4 = *(const PG8_LAS u32x4*)(ent + g * 16 + 4 * kq); const f32x4 g4 = *(const PG8_LAS f32x4*)(gl + g * 16 + 4 * kq);
#pragma unroll
                        for (int r = 0; r < 4; r += 2) { const f32x2 ge = gelu_pk((f32x2){acc[r] * rs, acc[r + 1] * rs});
                            if (e4[r] != ENT_INVALID && (int)(e4[r] >> 21) == n) ao[(e4[r] >> 14) & 127u] = ge.x * g4[r];
                            if (e4[r + 1] != ENT_INVALID && (int)(e4[r + 1] >> 21) == n) ao[(e4[r + 1] >> 14) & 127u] = ge.y * g4[r + 1]; }
                    }
                }
#undef PU_LOAD
            }
            if (!pulled) c_next = pq_pull(heads + k * 64, lane);
            c = c_next;
        }
    }
}

constexpr float AS = 32.f;
__device__ __forceinline__ void tr4x4(unsigned a, unsigned b, unsigned c, unsigned d, unsigned& o0, unsigned& o1, unsigned& o2, unsigned& o3) {
    const unsigned p0 = __builtin_amdgcn_perm(b, a, 0x05010400u), p1 = __builtin_amdgcn_perm(b, a, 0x07030602u), p2 = __builtin_amdgcn_perm(d, c, 0x05010400u), p3 = __builtin_amdgcn_perm(d, c, 0x07030602u);
    o0 = __builtin_amdgcn_perm(p2, p0, 0x05040100u); o1 = __builtin_amdgcn_perm(p2, p0, 0x07060302u); o2 = __builtin_amdgcn_perm(p3, p1, 0x05040100u); o3 = __builtin_amdgcn_perm(p3, p1, 0x07060302u);
}
__device__ __forceinline__ void fstage_peer_v(const Params& p, int l, int qsel, bool dry, lds_t lds, int imask = 16383) {
    unsigned char* ws = p.ws;
    const int tid = tid_fresh(), lane = tid & 63, wid = __builtin_amdgcn_readfirstlane(tid >> 6), n = lane & 15, kq = lane >> 4, n8 = n & 7, h = n >> 3;
    const unsigned char* v8 = ws + WS_V8 + (size_t)l * NEXP * D;
    unsigned* heads = (unsigned*)(ws + WS_CTL) + CW_PQ + ((qsel * 2 + 1) * 8) * 64;
    const int myx = (int)(xb_xcc_id() & 7u);
    PG8_LAS int* til = (PG8_LAS int*)(lds + wid * 8192);
#pragma unroll 1
    for (int s8 = 0; s8 < 8; ++s8) {
        const int k = (myx + s8) & 7;
#pragma unroll 1
        for (;;) {
            const unsigned c = pq_pull(heads + k * 64, lane);
            if (c >= (unsigned)PQ_NCH) break;
            const int t0 = (int)c * PQ_CH;
            unsigned koff = (unsigned)n8 * 16u; asm volatile("" : "+v"(koff));
            const unsigned char* vb = v8 + (size_t)k * NEXP * 128;
            { const int* ti = (const int*)(ws + WS_TI) + (size_t)t0 * 128; int ev[32];
#pragma unroll
              for (int i = 0; i < 32; ++i) ev[i] = ti[i * 64 + lane];
#pragma unroll
              for (int i = 0; i < 32; ++i) til[i * 64 + lane] = ev[i] & (imask & 16383); }
            u32x4 R[4][8];
            typedef int i32x4 __attribute__((ext_vector_type(4)));
#define PV_ISSUE(b, slot) do { const PG8_LAS i32x4* ip_ = (const PG8_LAS i32x4*)(til + ((b) >> 1) * 128 + ((b) & 1) * 64 + h * 32 + kq * 8); const i32x4 i0_ = ip_[0], i1_ = ip_[1]; \
                _Pragma("unroll") for (int e_ = 0; e_ < 4; ++e_) { R[slot][e_] = *(const u32x4*)(vb + ((unsigned)i0_[e_] * 128u + koff)); R[slot][4 + e_] = *(const u32x4*)(vb + ((unsigned)i1_[e_] * 128u + koff)); } } while (0)
#define PV_COMPUTE(tok8, aq, slot) do { const long aop_ = ((n >> 1) == (tok8)) ? (aq) : 0l; \
                _Pragma("unroll") for (int c_ = 0; c_ < 4; ++c_) { unsigned lo_[4], hi_[4]; \
                    tr4x4(R[slot][0][c_], R[slot][1][c_], R[slot][2][c_], R[slot][3][c_], lo_[0], lo_[1], lo_[2], lo_[3]); \
                    tr4x4(R[slot][4][c_], R[slot][5][c_], R[slot][6][c_], R[slot][7][c_], hi_[0], hi_[1], hi_[2], hi_[3]); \
                    _Pragma("unroll") for (int j_ = 0; j_ < 4; ++j_) { const long b_ = (long)(((unsigned long)hi_[j_] << 32) | (unsigned long)lo_[j_]); \
                        acc[4 * c_ + j_] = __builtin_amdgcn_mfma_f32_16x16x32_fp8_fp8(aop_, b_, acc[4 * c_ + j_], 0, 0, 0); } } } while (0)
#pragma unroll
            for (int b = 0; b < 3; ++b) PV_ISSUE(b, b);
#pragma unroll 1
            for (int ps = 0; ps < 2; ++ps) {
                f32x4 acc[16];
#pragma unroll
                for (int j = 0; j < 16; ++j) acc[j] = (f32x4){0.f, 0.f, 0.f, 0.f};
                long aq0, aq1;
                { const float* ap = (const float*)(ws + WS_PA) + (size_t)(t0 + ps * 8 + (n >> 1)) * 128 + (n & 1) * 32 + kq * 8;
                  const f32x4 a0 = *(const f32x4*)ap, a1 = *(const f32x4*)(ap + 4), a2 = *(const f32x4*)(ap + 64), a3 = *(const f32x4*)(ap + 68);
                  int w0 = __builtin_amdgcn_cvt_pk_fp8_f32(a0[0] * AS, a0[1] * AS, 0, false); w0 = __builtin_amdgcn_cvt_pk_fp8_f32(a0[2] * AS, a0[3] * AS, w0, true);
                  int w1 = __builtin_amdgcn_cvt_pk_fp8_f32(a1[0] * AS, a1[1] * AS, 0, false); w1 = __builtin_amdgcn_cvt_pk_fp8_f32(a1[2] * AS, a1[3] * AS, w1, true);
                  int w2 = __builtin_amdgcn_cvt_pk_fp8_f32(a2[0] * AS, a2[1] * AS, 0, false); w2 = __builtin_amdgcn_cvt_pk_fp8_f32(a2[2] * AS, a2[3] * AS, w2, true);
                  int w3 = __builtin_amdgcn_cvt_pk_fp8_f32(a3[0] * AS, a3[1] * AS, 0, false); w3 = __builtin_amdgcn_cvt_pk_fp8_f32(a3[2] * AS, a3[3] * AS, w3, true);
                  aq0 = (long)(((unsigned long)(unsigned)w1 << 32) | (unsigned long)(unsigned)w0); aq1 = (long)(((unsigned long)(unsigned)w3 << 32) | (unsigned long)(unsigned)w2); }
#pragma unroll 1
                for (int b0 = 0; b0 < 16; b0 += 4) {
#pragma unroll
                    for (int s = 0; s < 4; ++s) {
                        const int bn = ps * 16 + b0 + s + 3;
                        if (bn < 32) PV_ISSUE(bn, (s + 3) & 3);
                        PV_COMPUTE((b0 + s) >> 1, (s & 1) ? aq1 : aq0, s);
                    }
                }
                int n8e = n8, kqe = kq; asm volatile("" : "+v"(n8e), "+v"(kqe));
                const int t = t0 + ps * 8 + 2 * kqe + h;
                float o[16];
#pragma unroll
                for (int j = 0; j < 16; ++j) { const float send = h ? acc[j][1] : acc[j][2]; const float recv = dppf<DPP_X8>(send); o[j] = (h ? acc[j][3] : acc[j][0]) + recv; }
                bf16_t* xr = (bf16_t*)(ws + WS_XB) + (size_t)t * D + k * 128 + n8e * 16;
                const float sc = 1.f / (SV * AS);
                float ss = 0.f;
#pragma unroll
                for (int g = 0; g < 2; ++g) {
                    f32x4 v0, v1; up8(*(const u32x4*)(xr + g * 8), v0, v1);
                    v0[0] += o[8 * g + 0] * sc; v0[1] += o[8 * g + 1] * sc; v0[2] += o[8 * g + 2] * sc; v0[3] += o[8 * g + 3] * sc;
                    v1[0] += o[8 * g + 4] * sc; v1[1] += o[8 * g + 5] * sc; v1[2] += o[8 * g + 6] * sc; v1[3] += o[8 * g + 7] * sc;
                    const u32x4 wq = pk8(v0, v1); up8(wq, v0, v1);
                    if (!dry) { *(u32x4*)(xr + g * 8) = wq; *(u32x2*)(ws + WS_XQ8 + (size_t)t * D + k * 128 + n8e * 16 + g * 8) = pk8_fp8(v0, v1, XS); }
                    ss += (v0[0] * v0[0] + v0[1] * v0[1]) + (v0[2] * v0[2] + v0[3] * v0[3]) + (v1[0] * v1[0] + v1[1] * v1[1]) + (v1[2] * v1[2] + v1[3] * v1[3]);
                }
                ss += dppf<DPP_X1>(ss); ss += dppf<DPP_X2>(ss); ss += dppf<DPP_HMIR>(ss);
                if (n8e < 2 && !dry) ((float*)(ws + WS_SSP))[(size_t)t * 16 + 2 * k + n8e] = (n8e == 0) ? ss : 0.f;
            }
#undef PV_ISSUE
#undef PV_COMPUTE
        }
    }
}
__device__ __forceinline__ void fstage_final_norm(const Params& p) {
    const int tid = tid_fresh(), lane = tid & 63, wid = tid >> 6;
    const float* gfin = (const float*)p.in[25];
    for (int t = blockIdx.x * 8 + wid; t < T; t += gridDim.x * 8) {
        const float r = row_rstd((const float*)(p.ws + WS_SSP), t);
        const bf16_t* xr = (const bf16_t*)(p.ws + WS_XB) + (size_t)t * D; float* o = p.out + (size_t)t * D;
#pragma unroll
        for (int i = 0; i < 2; ++i) { f32x4 a, b; up8(*(const u32x4*)(xr + (lane + 64 * i) * 8), a, b);
            const f32x4 g0 = *(const f32x4*)(gfin + (lane + 64 * i) * 8), g1 = *(const f32x4*)(gfin + (lane + 64 * i) * 8 + 4);
            *(f32x4*)(o + (lane + 64 * i) * 8) = a * r * g0; *(f32x4*)(o + (lane + 64 * i) * 8 + 4) = b * r * g1; }
    }
}

extern __shared__ __attribute__((aligned(16))) unsigned char dyn_lds[];
constexpr int LDS_BYTES = 163840;
constexpr int LDS_BARW = LDS_BYTES - 64;

__device__ __forceinline__ Params ldp() {
    Params r;
#if defined(__HIP_DEVICE_COMPILE__)
    const __attribute__((address_space(4))) unsigned long long* k = (const __attribute__((address_space(4))) unsigned long long*)__builtin_amdgcn_kernarg_segment_ptr();
    asm volatile("" : "+s"(k));
#pragma unroll
    for (int i = 0; i < 26; ++i) r.in[i] = (const void*)(const __attribute__((address_space(1))) void*)k[i];
    r.out = (float*)(__attribute__((address_space(1))) float*)k[26]; r.ws = (unsigned char*)(__attribute__((address_space(1))) unsigned char*)k[27];
#endif
    return r;
}
__device__ __forceinline__ int rep_of(int k) { int n = (PROBE == k) ? 2 : 1; asm volatile("" : "+s"(n)); return n; }
#if PROBE == 0
#define REP(k) for (int r_ = 0, n_ = 1; r_ < 1; ++r_)
#else
#define REP(k) for (int r_ = 0, n_ = rep_of(k); r_ < n_; ++r_)
#endif
#define PH(call) do { const Params q = ldp(); int bid = bid0, nb = nb0, l = l0; asm volatile("" : "+s"(bid), "+s"(nb), "+s"(l)); (void)l; call; } while (0)
__global__ void __launch_bounds__(NT, 2) mega(Params p_unused) {
    const int bid0 = blockIdx.x, nb0 = gridDim.x; int l0 = 0;
    float* lds = (float*)dyn_lds; const lds_t ldsp = (lds_t)dyn_lds;
    { const int w0_ = __builtin_amdgcn_readfirstlane((int)(threadIdx.x >> 6)); asm volatile("s_mov_b32 m0, %0" :: "s"(w0_)); }
    if (tid_fresh() == 0) *(uint4*)(dyn_lds + LDS_BARW) = make_uint4(0u, 0u, 0u, 0u);
    __syncthreads();
    { const Params q = ldp(); (void)xcd_barrier_post((unsigned*)(q.ws + WS_CTL), (volatile LAS unsigned*)(dyn_lds + LDS_BARW)); }
#define GRID_BAR() do { const Params q = ldp(); XcdBarrier b_; b_.bar = (unsigned*)(q.ws + WS_CTL); b_.x = xb_xcc_id(); b_.st = (volatile LAS unsigned*)(dyn_lds + LDS_BARW); xcd_barrier(b_); if (PROBE == 20) xcd_barrier(b_); } while (0)
    REP(1) { PH(stage_prologue0(q, bid, nb, lds)); GRID_BAR(); }
    REP(2) { PH(stage_prologue1(q, bid, nb)); PH(fstage_kv(q, ldsp, bid, nb)); GRID_BAR();
    PH(fstage_g(q, ldsp, bid, nb)); PH(fstage_y(q, ldsp, bid, nb));     GRID_BAR(); }

#pragma unroll 1
    for (l0 = 0; l0 < L; ++l0) {
        REP(9) { PH(fstage_win(q, l, ldsp, bid, nb)); GRID_BAR(); }
        REP(7) { PH(fstage_attn(q, l, (char*)dyn_lds)); } REP(4) { PH(stage_pool_d(q, bid, nb)); PH(fstage_sgate(q, l, ldsp)); } GRID_BAR();
#if PROBE == 21
        PH(fstage_branch<false>(q, l, ldsp, bid, nb)); GRID_BAR();
#endif
        REP(10) { PH(fstage_branch(q, l, ldsp, bid, nb)); GRID_BAR(); }
        PH(fstage_resid_out(q, l, ldsp, bid, nb)); GRID_BAR();
        REP(11) { PH(fstage_xscore(q, l, ldsp, bid, nb)); GRID_BAR(); }
        PH(fstage_resid_cross(q, l, ldsp, bid, nb)); GRID_BAR();
        REP(12) { PH(fstage_pscore(q, l, ldsp, bid, nb)); GRID_BAR(); }
        REP(13) { PH(fstage_peer_u(q, l, l + 4 * r_, ldsp)); GRID_BAR(); }
#if PROBE == 15
        PH(fstage_peer_u(q, l, l + 4, ldsp, 255u, 16 * MiB)); GRID_BAR();
#endif
#if PROBE == 17
        { int sk_ = 1; asm volatile("" : "+s"(sk_)); PH(fstage_peer_u(q, l, l + 4, ldsp, 16383u, 16 * MiB, sk_ != 0)); GRID_BAR(); }
#endif
        REP(14) { bool dry_ = (r_ == 0 && n_ == 2); PH(fstage_peer_v(q, l, l + 4 * r_, dry_, ldsp)); GRID_BAR(); }
#if PROBE == 16
        PH(fstage_peer_v(q, l, l + 4, true, ldsp, 255)); GRID_BAR();
#endif
    }
    PH(fstage_final_norm(q));
}

extern "C" void kernel_launch(void* const* d_in, const int* in_sizes, int n_in, void* d_out, int out_size, void* d_ws, size_t ws_size, hipStream_t stream) {
    Params p{};
    for (int i = 0; i < 26; ++i) p.in[i] = d_in[i];
    p.out = (float*)d_out; p.ws = (unsigned char*)d_ws;
    static int grid = 0;
    if (!grid) {
        int dev = 0, cus = 0, per_cu = 0;
        (void)hipGetDevice(&dev);
        (void)hipDeviceGetAttribute(&cus, hipDeviceAttributeMultiprocessorCount, dev);
        (void)hipFuncSetAttribute((const void*)mega, hipFuncAttributeMaxDynamicSharedMemorySize, LDS_BYTES);
        (void)hipOccupancyMaxActiveBlocksPerMultiprocessor(&per_cu, mega, NT, LDS_BYTES);
        grid = cus * (per_cu < 1 ? per_cu : 1);
    }
    (void)hipMemsetAsync(p.ws + WS_CTL, 0, CTL_ZERO_BYTES, stream);
    mega<<<grid, NT, LDS_BYTES, stream>>>(p);
}
```

```cpp
#include <hip/hip_runtime.h>
#ifndef PROBE
#define PROBE 0
#endif
#include <stdint.h>
#include <math.h>

typedef unsigned short bf16_t;
typedef short bf16x8 __attribute__((ext_vector_type(8)));
typedef float f32x4 __attribute__((ext_vector_type(4)));
typedef float f32x2 __attribute__((ext_vector_type(2)));
typedef unsigned u32x4 __attribute__((ext_vector_type(4)));
typedef unsigned u32x2 __attribute__((ext_vector_type(2)));

constexpr int D = 1024, NB = 8, S = 4096, T = NB * S, L = 4, MEM = 256, MROWS = NB * MEM;
constexpr int INW = 6144, NEXP = 16384;
constexpr float EPS = 1e-6f;
constexpr float C2 = 0.125f * 1.4426950408889634f;
constexpr float SU = 256.f, SV = 32.f;
constexpr float XS = 8.f;
constexpr float W8S = 256.f;
constexpr float GS = 16.f, YS = 16.f, PS = 256.f;
constexpr int NT = 512;

constexpr size_t MiB = 1u << 20;
constexpr size_t WS_CTL = 0, WS_ROPE = 1 * MiB, WS_SSP = 3 * MiB, WS_WSPT = 5 * MiB, WS_RSTDM = 6 * MiB, WS_WPOOLS = 7 * MiB, WS_KEYSB = 8 * MiB;
constexpr size_t WS_WIN = 10 * MiB, WS_WB0 = 58 * MiB, WS_WEFF = 62 * MiB, WS_WB2 = 66 * MiB, WS_WOUT = 70 * MiB, WS_GT = 78 * MiB, WS_YT = 142 * MiB;
constexpr size_t WS_SKT = 206 * MiB, WS_U8 = 222 * MiB, WS_V8 = 286 * MiB, WS_XB = 350 * MiB, WS_TI = 414 * MiB, WS_TG = 430 * MiB, WS_MX = 446 * MiB;
constexpr size_t WS_GTE = WS_MX, WS_QB = WS_MX + 192 * MiB, WS_KB = WS_MX + 224 * MiB, WS_VB = WS_MX + 256 * MiB, WS_PIN = WS_MX + 288 * MiB, WS_DP = WS_MX + 320 * MiB;
constexpr size_t WS_UIN = WS_MX + 352 * MiB, WS_VIN = WS_MX + 384 * MiB, WS_O1 = WS_MX + 416 * MiB, WS_O2 = WS_MX + 448 * MiB, WS_SO = WS_MX + 480 * MiB, WS_END = WS_MX + 512 * MiB;
constexpr size_t WS_PA = WS_END;
constexpr size_t WS_XQ8 = WS_PA + 32 * MiB;
constexpr size_t WS_AO = WS_QB, WS_MG = WS_KB, WS_SX = WS_MX, WS_PM = WS_O1, WS_SC = WS_MX;
constexpr size_t WS_MEMB = WS_MX, WS_WXQB = WS_MX + 4 * MiB, WS_WXOT = WS_MX + 12 * MiB, WS_WXKVT = WS_MX + 20 * MiB, WS_KV = WS_MX + 36 * MiB, WS_WB1T = WS_MX + 68 * MiB, WS_WPQB = WS_MX + 72 * MiB;
static_assert(WS_XQ8 + 32 * MiB <= 1024 * MiB, "workspace map");

struct Params { const void* in[26]; float* out; unsigned char* ws; };

__device__ __forceinline__ float bf2f(bf16_t v) { return __uint_as_float(((unsigned)v) << 16); }
__device__ __forceinline__ bf16_t f2bf(float f) { unsigned u = __float_as_uint(f); return (bf16_t)((u + 0x7fffu + ((u >> 16) & 1u)) >> 16); }
typedef __bf16 hwbf16x2 __attribute__((ext_vector_type(2)));
__device__ __forceinline__ unsigned pk2(float lo, float hi) { const f32x2 v = {lo, hi}; return __builtin_bit_cast(unsigned, __builtin_convertvector(v, hwbf16x2)); }
template <int CTRL> __device__ __forceinline__ float dppf(float v) { return __builtin_bit_cast(float, __builtin_amdgcn_update_dpp(0, __builtin_bit_cast(int, v), CTRL, 0xF, 0xF, true)); }
constexpr int DPP_X1 = 0xB1, DPP_X2 = 0x4E, DPP_HMIR = 0x141, DPP_MIR = 0x140, DPP_X8 = 0x128;
__device__ __forceinline__ float lx16(float v) { float r; asm volatile("ds_swizzle_b32 %0, %1 offset:swizzle(SWAP,16)\n\ts_waitcnt lgkmcnt(0)" : "=v"(r) : "v"(v)); return r; }
__device__ __forceinline__ float add_x32(float v) { const auto rr = __builtin_amdgcn_permlane32_swap(__float_as_uint(v), __float_as_uint(v), false, false); return __uint_as_float(rr[0]) + __uint_as_float(rr[1]); }
__device__ __forceinline__ float max_x32(float v) { const auto rr = __builtin_amdgcn_permlane32_swap(__float_as_uint(v), __float_as_uint(v), false, false); return fmaxf(__uint_as_float(rr[0]), __uint_as_float(rr[1])); }
__device__ __forceinline__ float sum16(float v) { v += dppf<DPP_X1>(v); v += dppf<DPP_X2>(v); v += dppf<DPP_HMIR>(v); v += dppf<DPP_MIR>(v); return v; }
__device__ __forceinline__ float max16(float v) { v = fmaxf(v, dppf<DPP_X1>(v)); v = fmaxf(v, dppf<DPP_X2>(v)); v = fmaxf(v, dppf<DPP_HMIR>(v)); v = fmaxf(v, dppf<DPP_MIR>(v)); return v; }
__device__ __forceinline__ float wave_sum(float v) { v = sum16(v); v += lx16(v); return add_x32(v); }
__device__ __forceinline__ float wave_max(float v) { v = max16(v); v = fmaxf(v, lx16(v)); return max_x32(v); }
__device__ __forceinline__ int tid_fresh() { unsigned w, ln; asm volatile("s_mov_b32 %0, m0\n\tv_mbcnt_lo_u32_b32 %1, -1, 0\n\tv_mbcnt_hi_u32_b32 %1, -1, %1" : "=s"(w), "=v"(ln)); return (int)((w << 6) | ln); }
__device__ __forceinline__ float row_rstd(const float* ssp, int row) {
    const f32x4* p = (const f32x4*)(ssp + (size_t)row * 16);
    f32x4 a = p[0], b = p[1], c = p[2], d = p[3];
    float s = (a[0] + a[1] + a[2] + a[3]) + (b[0] + b[1] + b[2] + b[3]) + (c[0] + c[1] + c[2] + c[3]) + (d[0] + d[1] + d[2] + d[3]);
    return rsqrtf(s * (1.f / D) + EPS);
}
__device__ __forceinline__ float lam_init_of(int l) { return 0.8f - 0.6f * expf(-0.3f * (float)l); }

__device__ __forceinline__ u32x2 pk8_fp8(f32x4 a, f32x4 b, float sc);
__device__ __forceinline__ u32x4 pk8(f32x4 a, f32x4 b);
__device__ __forceinline__ void tr_conv(const float* __restrict__ src, bf16_t* __restrict__ dst, int K, int N, const float* gain, int gmask, float gmul, int bid, int nb, float* tile, int ldd = 0, int lds_src = 0) {
    const int tidx = tid_fresh();
    const int tx = tidx & 63, ty = tidx >> 6;
    const int tn = N / 64, nt = (K / 64) * tn, sp = lds_src ? lds_src : N;
    float r[8], rn[8];
    int it = bid;
    if (it < nt) { const int k0 = (it / tn) * 64, n0 = (it % tn) * 64;
#pragma unroll
        for (int i = 0; i < 8; ++i) { const int k = ty + 8 * i; r[i] = src[(size_t)(k0 + k) * sp + n0 + tx]; if (gain) r[i] *= gain[(k0 + k) & gmask] * gmul; } }
    while (it < nt) {
        const int k0 = (it / tn) * 64, n0 = (it % tn) * 64, nx = it + nb;
        if (nx < nt) { const int k1 = (nx / tn) * 64, n1 = (nx % tn) * 64;
#pragma unroll
            for (int i = 0; i < 8; ++i) { const int k = ty + 8 * i; rn[i] = src[(size_t)(k1 + k) * sp + n1 + tx]; if (gain) rn[i] *= gain[(k1 + k) & gmask] * gmul; } }
        __syncthreads();
#pragma unroll
        for (int i = 0; i < 8; ++i) tile[(ty + 8 * i) * 65 + tx] = r[i];
        __syncthreads();
        { const int n = tidx >> 3, kq = (tidx & 7) * 8;
          f32x4 a, b;
#pragma unroll
          for (int e = 0; e < 4; ++e) { a[e] = tile[(kq + e) * 65 + n]; b[e] = tile[(kq + 4 + e) * 65 + n]; }
          *(u32x4*)(dst + (size_t)(n0 + n) * (ldd ? ldd : K) + k0 + kq) = pk8(a, b); }
#pragma unroll
        for (int i = 0; i < 8; ++i) r[i] = rn[i];
        it = nx;
    }
}
__device__ __forceinline__ void tr_conv8(const float* __restrict__ src, unsigned char* __restrict__ dst, int K, int N, const float* gain, float scale, int sp, int bid, int nb, float* tile) {
    const int tidx = tid_fresh();
    const int tx = tidx & 63, ty = tidx >> 6;
    const int tn = N / 64, nt = (K / 64) * tn;
    float r[8], rn[8];
    int it = bid;
    if (it < nt) { const int k0 = (it / tn) * 64, n0 = (it % tn) * 64;
#pragma unroll
        for (int i = 0; i < 8; ++i) { const int k = ty + 8 * i; r[i] = src[(size_t)(k0 + k) * sp + n0 + tx] * gain[k0 + k] * scale; } }
    while (it < nt) {
        const int k0 = (it / tn) * 64, n0 = (it % tn) * 64, nx = it + nb;
        if (nx < nt) { const int k1 = (nx / tn) * 64, n1 = (nx % tn) * 64;
#pragma unroll
            for (int i = 0; i < 8; ++i) { const int k = ty + 8 * i; rn[i] = src[(size_t)(k1 + k) * sp + n1 + tx] * gain[k1 + k] * scale; } }
        __syncthreads();
#pragma unroll
        for (int i = 0; i < 8; ++i) tile[(ty + 8 * i) * 65 + tx] = r[i];
        __syncthreads();
        { const int n = tidx >> 3, kq = (tidx & 7) * 8;
          f32x4 a, b;
#pragma unroll
          for (int e = 0; e < 4; ++e) { a[e] = tile[(kq + e) * 65 + n]; b[e] = tile[(kq + 4 + e) * 65 + n]; }
          *(u32x2*)(dst + (size_t)(n0 + n) * K + k0 + kq) = pk8_fp8(a, b, 1.f); }
#pragma unroll
        for (int i = 0; i < 8; ++i) r[i] = rn[i];
        it = nx;
    }
}
__device__ __forceinline__ void conv_plain(const float* __restrict__ src, bf16_t* __restrict__ dst, size_t n, int bid, int nb, const float* rowgain = nullptr) {
    const int tidx = tid_fresh();
    const size_t n4 = n / 4, st = (size_t)nb * NT;
    for (size_t i0 = (size_t)bid * NT + tidx; i0 < n4; i0 += 8 * st) {
        f32x4 v[8];
#pragma unroll
        for (int u = 0; u < 8; ++u) { const size_t i = i0 + u * st; v[u] = (i < n4) ? ((const f32x4*)src)[i] : (f32x4){0.f, 0.f, 0.f, 0.f}; }
#pragma unroll
        for (int u = 0; u < 8; ++u) { const size_t i = i0 + u * st; if (i < n4) { f32x4 x = v[u]; if (rowgain) x = x * rowgain[i >> 8];
            u32x2 w; w.x = pk2(x[0], x[1]); w.y = pk2(x[2], x[3]); ((u32x2*)dst)[i] = w; } }
    }
}
__device__ __forceinline__ void conv_fp8(const float* __restrict__ src, unsigned* __restrict__ dst, const float* gain, float scale, bool slice_major, int bid, int nb) {
    const int tidx = tid_fresh();
    const size_t n4 = (size_t)NEXP * D / 4, st = (size_t)nb * NT;
    for (size_t i0 = (size_t)bid * NT + tidx; i0 < n4; i0 += 8 * st) {
        f32x4 v[8];
#pragma unroll
        for (int u = 0; u < 8; ++u) { const size_t i = i0 + u * st; v[u] = (i < n4) ? ((const f32x4*)src)[i] : (f32x4){0.f, 0.f, 0.f, 0.f}; }
#pragma unroll
        for (int u = 0; u < 8; ++u) { const size_t i = i0 + u * st; if (i < n4) { f32x4 x = v[u];
            if (gain) { const f32x4 g = ((const f32x4*)gain)[i & (D / 4 - 1)]; x = x * g; }
            x = x * scale;
            int w = __builtin_amdgcn_cvt_pk_fp8_f32(x[0], x[1], 0, false);
            w = __builtin_amdgcn_cvt_pk_fp8_f32(x[2], x[3], w, true);
            size_t o = i;
            if (slice_major) { const size_t d = (i * 4) & (D - 1), e = (i * 4) >> 10; o = (((d >> 7) * NEXP + e) * 128 + (d & 127)) >> 2; }
            dst[o] = (unsigned)w; } }
    }
}

__device__ __forceinline__ void stage_prologue0(const Params& p, int bid, int nb, float* lds) {
    const int tidx = tid_fresh();
    unsigned char* ws = p.ws;
    const int tid = tidx, lane = tid & 63, wid = tid >> 6;
    for (int l = 0; l < L; ++l) {
        tr_conv((const float*)p.in[4] + (size_t)l * D * INW, (bf16_t*)(ws + WS_WIN) + (size_t)l * 3072 * D, D, 3072, (const float*)p.in[3] + l * D, D - 1, 1.f, bid, nb, lds, 0, INW);
        tr_conv8((const float*)p.in[4] + (size_t)l * D * INW + 3072, ws + WS_WIN + 24 * MiB + (size_t)l * 3072 * D, D, 3072, (const float*)p.in[3] + l * D, W8S, INW, bid, nb, lds);
        const float* wb = (const float*)p.in[13] + (size_t)l * 3 * 512 * D;
        bf16_t* wbr = (bf16_t*)(ws + WS_WB0) + (size_t)l * D * 1536;
        tr_conv(wb, wbr, 512, D, (const float*)p.in[6] + l * 128, 127, 1.f - lam_init_of(l), bid, nb, lds, 1536);
        tr_conv(wb + 512 * D, (bf16_t*)(ws + WS_WB1T) + (size_t)l * D * 512, 512, D, nullptr, 0, 1.f, bid, nb, lds);
        tr_conv(wb + 2 * 512 * D, wbr + 1024, 512, D, nullptr, 0, 1.f, bid, nb, lds, 1536);
        tr_conv((const float*)p.in[14] + (size_t)l * D * D, (bf16_t*)(ws + WS_WOUT) + (size_t)l * D * D, D, D, nullptr, 0, 1.f, bid, nb, lds);
        tr_conv((const float*)p.in[19] + (size_t)l * D * D, (bf16_t*)(ws + WS_WXOT) + (size_t)l * D * D, D, D, nullptr, 0, 1.f, bid, nb, lds);
        tr_conv((const float*)p.in[18] + (size_t)l * D * 2 * D, (bf16_t*)(ws + WS_WXKVT) + (size_t)l * 2 * D * D, D, 2 * D, (const float*)p.in[16] + l * D, D - 1, 1.f, bid, nb, lds);
        conv_fp8((const float*)p.in[23] + (size_t)l * NEXP * D, (unsigned*)(ws + WS_U8) + (size_t)l * NEXP * D / 4, (const float*)p.in[20] + l * D, SU, false, bid, nb);
        conv_fp8((const float*)p.in[24] + (size_t)l * NEXP * D, (unsigned*)(ws + WS_V8) + (size_t)l * NEXP * D / 4, nullptr, SV, true, bid, nb);
    }
    conv_plain((const float*)p.in[17], (bf16_t*)(ws + WS_WXQB), (size_t)L * D * D, bid, nb, (const float*)p.in[15]);
    conv_plain((const float*)p.in[21], (bf16_t*)(ws + WS_WPQB), (size_t)L * D * 2048, bid, nb);
    conv_plain((const float*)p.in[22], (bf16_t*)(ws + WS_KEYSB), (size_t)L * 8 * 2 * 128 * 128, bid, nb);
    for (int i = bid * NT + tid; i < L * 4 * 128 * 128; i += nb * NT) {
        const int e = i & 127, g = (i >> 14) & 3, l = i >> 16;
        ((bf16_t*)(ws + WS_WPOOLS))[i] = f2bf(((const float*)p.in[7])[i] * ((const float*)p.in[8])[l * 512 + g * 128 + e]);
        const int sx = i & 127, tx = (i >> 7) & 127;
        ((bf16_t*)(ws + WS_WSPT))[i] = f2bf((sx <= tx) ? ((const float*)p.in[11])[i] : 0.f);
    }
    for (int i = bid * NT + tid; i < T * 8; i += nb * NT) {
        const int j = i & 7, t = i >> 3;
        const double ang = (double)((const int*)p.in[2])[t] * pow(500000.0, -(double)j / 8.0);
        _Float16* r = (_Float16*)(ws + WS_ROPE) + (size_t)t * 16;
        r[j] = (_Float16)(float)cos(ang); r[8 + j] = (_Float16)(float)sin(ang);
    }
    for (int row = bid * 8 + wid; row < T + MROWS; row += nb * 8) {
        const bool ismem = row >= T; const int r = ismem ? row - T : row;
        const float* src = (ismem ? (const float*)p.in[1] : (const float*)p.in[0]) + (size_t)r * D;
        bf16_t* dstb = (bf16_t*)(ws + (ismem ? WS_MEMB : WS_XB)) + (size_t)r * D;
        float ss = 0.f;
#pragma unroll
        for (int i = 0; i < 4; ++i) {
            const f32x4 v = ((const f32x4*)src)[lane + 64 * i];
            ss += v[0] * v[0] + v[1] * v[1] + v[2] * v[2] + v[3] * v[3];
            u32x2 w; w.x = pk2(v[0], v[1]); w.y = pk2(v[2], v[3]); ((u32x2*)dstb)[lane + 64 * i] = w;
            if (!ismem) { int q = __builtin_amdgcn_cvt_pk_fp8_f32(v[0] * XS, v[1] * XS, 0, false); q = __builtin_amdgcn_cvt_pk_fp8_f32(v[2] * XS, v[3] * XS, q, true); ((unsigned*)(ws + WS_XQ8 + (size_t)r * D))[lane + 64 * i] = (unsigned)q; }
        }
        ss = wave_sum(ss);
        if (ismem) { if (lane == 0) ((float*)(ws + WS_RSTDM))[r] = rsqrtf(ss * (1.f / D) + EPS); }
        else if (lane < 16) ((float*)(ws + WS_SSP))[(size_t)r * 16 + lane] = (lane == 0) ? ss : 0.f;
    }
}

template <class Geom, class Epi>
__device__ __forceinline__ void gemm_simple(int nitems, int K, const Geom& geom, const Epi& epi, int bid, int nb) {
    const int tidx = tid_fresh();
    const int tid = tidx, lane = tid & 63, wid = tid >> 6, wm = wid >> 1, wn = wid & 1, fr = lane & 15, fq = lane >> 4;
    for (int it = bid; it < nitems; it += nb) {
        const bf16_t* A; const bf16_t* Bt; int lda, ldb, grp, row0, col0;
        geom(it, A, lda, Bt, ldb, grp, row0, col0);
        f32x4 acc[2][4];
#pragma unroll
        for (int i = 0; i < 2; ++i)
#pragma unroll
            for (int j = 0; j < 4; ++j) acc[i][j] = (f32x4){0.f, 0.f, 0.f, 0.f};
        const bf16_t* ap = A + (size_t)(wm * 32 + fr) * lda + fq * 8;
        const bf16_t* bp = Bt + (size_t)(wn * 64 + fr) * ldb + fq * 8;
#pragma unroll 2
        for (int k0 = 0; k0 < K; k0 += 32) {
            bf16x8 a[2], b[4];
#pragma unroll
            for (int i = 0; i < 2; ++i) a[i] = *(const bf16x8*)(ap + (size_t)(i * 16) * lda + k0);
#pragma unroll
            for (int j = 0; j < 4; ++j) b[j] = *(const bf16x8*)(bp + (size_t)(j * 16) * ldb + k0);
#pragma unroll
            for (int i = 0; i < 2; ++i)
#pragma unroll
                for (int j = 0; j < 4; ++j) acc[i][j] = __builtin_amdgcn_mfma_f32_16x16x32_bf16(b[j], a[i], acc[i][j], 0, 0, 0);
        }
#pragma unroll
        for (int i = 0; i < 2; ++i) {
            const int row = row0 + wm * 32 + i * 16 + fr;
            const float rs = epi.prep(grp, row);
            float part = 0.f;
#pragma unroll
            for (int j = 0; j < 4; ++j) part += epi.apply(grp, row, col0 + wn * 64 + j * 16 + fq * 4, acc[i][j], rs, lane);
            epi.rowdone(grp, row, col0 + wn * 64, part, lane);
        }
    }
}

__device__ __forceinline__ void st_bf4(bf16_t* p, f32x4 v) { u32x2 w; w.x = pk2(v[0], v[1]); w.y = pk2(v[2], v[3]); *(u32x2*)p = w; }
__device__ __forceinline__ f32x4 ld_bf4(const bf16_t* p) { const u32x2 w = *(const u32x2*)p; return (f32x4){__uint_as_float(w.x << 16), __uint_as_float(w.x & 0xffff0000u), __uint_as_float(w.y << 16), __uint_as_float(w.y & 0xffff0000u)}; }

struct EpiColGain {
    bf16_t* o; size_t gstride; int ld; const float* gain; int gdiv;
    __device__ __forceinline__ float prep(int, int) const { return 1.f; }
    __device__ __forceinline__ float apply(int grp, int row, int col, f32x4 v, float, int) const {
        if (gain) v = v * *(const f32x4*)(gain + (size_t)(grp / gdiv) * D + col);
        st_bf4(o + (size_t)grp * gstride + (size_t)row * ld + col, v);
        return 0.f;
    }
    __device__ __forceinline__ void rowdone(int, int, int, float, int) const {}
};

__device__ __forceinline__ void stage_prologue1(const Params& p, int bid, int nb) {
    unsigned char* ws = p.ws;
    {
        auto geom = [=](int it, const bf16_t*& A, int& lda, const bf16_t*& Bt, int& ldb, int& grp, int& row0, int& col0) {
            const int g = it >> 3, tn = it & 7, l = g >> 4, hp = g & 15; grp = g; row0 = 0; col0 = tn * 128; lda = 128; ldb = 2048;
            A = (const bf16_t*)(ws + WS_KEYSB) + (size_t)g * 16384; Bt = (const bf16_t*)(ws + WS_WPQB) + ((size_t)l * D + col0) * 2048 + hp * 128; };
        gemm_simple(L * 16 * 8, 128, geom, EpiColGain{(bf16_t*)(ws + WS_SKT), (size_t)128 * D, D, (const float*)p.in[20], 16}, bid, nb);
    }
    {
        auto geom = [=](int it, const bf16_t*& A, int& lda, const bf16_t*& Bt, int& ldb, int& grp, int& row0, int& col0) {
            const int lg = it >> 3, tm = it & 7, l = lg >> 2, g = lg & 3; grp = lg; row0 = tm * 128; col0 = 0; lda = 512; ldb = 128;
            A = (const bf16_t*)(ws + WS_WB1T) + ((size_t)l * D + row0) * 512 + g * 128; Bt = (const bf16_t*)(ws + WS_WPOOLS) + (size_t)lg * 16384; };
        struct EpiWeff { bf16_t* o; __device__ __forceinline__ float prep(int, int) const { return 1.f; }
            __device__ __forceinline__ float apply(int lg, int row, int col, f32x4 v, float, int) const { st_bf4(o + ((size_t)(lg >> 2) * D + row) * 1536 + 512 + (lg & 3) * 128 + col, v); return 0.f; }
            __device__ __forceinline__ void rowdone(int, int, int, float, int) const {} };
        gemm_simple(L * 4 * 8, 128, geom, EpiWeff{(bf16_t*)(ws + WS_WB0)}, bid, nb);
    }
}
namespace pg8 {
#define PG8_LAS __attribute__((address_space(3)))
constexpr int BM = 256, BK = 64, HALF = 128, HTB = HALF * BK * 2, STAGE_BYTES = 8 * HTB, NXCD = 8, WGM = 8;
__host__ __device__ __forceinline__ int lds_byte(int r, int c) { const int st = (r >> 4) * 2 + (c >> 5), rr = r & 15, cc = c & 31, ob = rr * 64 + cc * 2; return st * 1024 + (ob ^ (((ob >> 9) & 1) << 5)); }
__host__ __device__ __forceinline__ void stage_rc(int b, int& R, int& C) { const int st = b / 1024, sb = b % 1024, swz = sb ^ (((sb >> 9) & 1) << 5); R = (st >> 1) * 16 + swz / 64; C = (st & 1) * 32 + (swz % 64) / 2; }
__host__ __device__ __forceinline__ int perm32(int rho) { const int n = rho >> 4, i = rho & 15; return 8 * (i >> 2) + 4 * n + (i & 3); }
struct Unit { int pm, pn; };
struct Order {
    int nM, nN, nwg, G, c; const char* A; const char* Bt; size_t a_tile, b_tile, b_batch; int pm_per_batch;
    __device__ __forceinline__ void init(int M, int N, int G_, int c_, const void* A_, int lda, const void* Bt_, int ldb, size_t b_batch_bytes = 0, int pmpb = 1 << 30) {
        nM = M / BM; nN = N / BM; nwg = nM * nN; G = G_; c = c_; A = (const char*)A_; Bt = (const char*)Bt_; a_tile = (size_t)BM * lda * 2; b_tile = (size_t)BM * ldb * 2; b_batch = b_batch_bytes; pm_per_batch = pmpb; }
    __device__ __forceinline__ bool next(int i, Unit& u) const {
        const long Lx = (long)i * G + c; if (Lx >= nwg) return false;
        int wgid = (int)Lx; { const int q = nwg / NXCD, r = nwg % NXCD, xcd = wgid % NXCD, off = wgid / NXCD; wgid = (xcd < r ? xcd * (q + 1) : r * (q + 1) + (xcd - r) * q) + off; }
        const int nig = WGM * nN, gid = wgid / nig, fm = gid * WGM, gsz = (nM - fm) < WGM ? (nM - fm) : WGM;
        u.pm = fm + ((wgid % nig) % gsz); u.pn = (wgid % nig) / gsz; return true;
    }
    __device__ __forceinline__ const char* a_ptr(const Unit& u) const { return A + (size_t)u.pm * a_tile; }
    __device__ __forceinline__ const char* b_ptr(const Unit& u) const { return Bt + (size_t)u.pn * b_tile + (size_t)(u.pm / pm_per_batch) * b_batch; }
};
typedef int i32x8_t __attribute__((ext_vector_type(8))); typedef int i32x4_t __attribute__((ext_vector_type(4)));
__device__ __forceinline__ i32x8_t ld8_lds(const PG8_LAS unsigned char* p) { const i32x4_t lo = *(const PG8_LAS i32x4_t*)p, hi = *(const PG8_LAS i32x4_t*)(p + 1024); return __builtin_shufflevector(lo, hi, 0, 1, 2, 3, 4, 5, 6, 7); }
__device__ __forceinline__ void glds_s(const void* sbase, unsigned voff, unsigned lds_dst) { unsigned keep;
    asm volatile("s_mov_b32 %0, m0\n\ts_mov_b32 m0, %3\n\ts_nop 0\n\tglobal_load_lds_dwordx4 %1, %2\n\ts_mov_b32 m0, %0" : "=&s"(keep) : "v"(voff), "s"(sbase), "s"(lds_dst) : "memory"); }
struct NoHook { static constexpr bool ACTIVE = false; __device__ __forceinline__ void operator()(f32x4 (&)[2][2][4][2], const Unit&, int, int, int, int, int) const {} };
template <class Epi, class Sched, bool ALIGN_EPI, class Hook = NoHook, int SEG = 1 << 20, bool FP8 = false>
__device__ __forceinline__ void gemm_phase(PG8_LAS unsigned char* lds, const int K, const int lda, const int ldb, const Sched& S, const Epi& E, const long dA1 = 0, const long dA2 = 0, const Hook& H = Hook()) {
    const int tid = tid_fresh(), wid = __builtin_amdgcn_readfirstlane(tid >> 6), lane = tid & 63, wr = wid >> 2, wc = wid & 3, fr = lane & 15, fq = lane >> 4;
    const int nt = K / BK;
    int mxs = 0x7f7f7f7f; asm volatile("" : "+v"(mxs));
    (void)mxs;
    unsigned voffA, voffB;
    { int R, C; stage_rc(tid * 16, R, C); const int Rb = (R & ~31) + perm32(R & 31);
      voffA = (unsigned)(R * lda + C) * 2u; voffB = (unsigned)(Rb * ldb + C) * 2u; }
    const size_t p2A = (size_t)64 * lda * 2, p2B = (size_t)64 * ldb * 2;
    const size_t kstep = (size_t)(BK * 2);
    const size_t hstepA = (size_t)HALF * lda * 2, hstepB = (size_t)HALF * ldb * 2;
    const unsigned ldsw = (unsigned)wid * 1024u, ldsu = (unsigned)(unsigned long)lds;
    const int aoff = lds_byte(wr * 64 + fr, fq * 8), boff = lds_byte(wc * 32 + fr, fq * 8);
#define PG8_SA(b, h) (((b) * 2 + (h)) * HTB)
#define PG8_SB(b, h) ((4 + (b) * 2 + (h)) * HTB)
#define PG8_STAGE(bufoff, gbase, X) do { _Pragma("unroll") for (int _i = 0; _i < 2; ++_i) \
        pg8::glds_s((const void*)((const char*)(gbase) + _i * p2##X), voff##X, ldsu + (unsigned)(bufoff) + ldsw + (unsigned)(_i * 8192)); } while (0)
#define PG8_LD8(p_) pg8::ld8_lds((p_))
#define PG8_LDA(dst, b, h) do { _Pragma("unroll") for (int m = 0; m < 4; ++m) { if constexpr (FP8) dst##8[m] = PG8_LD8(lds + PG8_SA(b, h) + aoff + m * 2048); else { _Pragma("unroll") for (int k = 0; k < 2; ++k) dst[m][k] = *(const PG8_LAS bf16x8*)(lds + PG8_SA(b, h) + aoff + m * 2048 + k * 1024); } } } while (0)
#define PG8_LDB(dst, b, h) do { _Pragma("unroll") for (int n = 0; n < 2; ++n) { if constexpr (FP8) dst##8[n] = PG8_LD8(lds + PG8_SB(b, h) + boff + n * 2048); else { _Pragma("unroll") for (int k = 0; k < 2; ++k) dst[n][k] = *(const PG8_LAS bf16x8*)(lds + PG8_SB(b, h) + boff + n * 2048 + k * 1024); } } } while (0)
#define PG8_MMA(ai, bj, At, Bt) do { __builtin_amdgcn_s_setprio(1); _Pragma("unroll") for (int m = 0; m < 4; ++m) _Pragma("unroll") for (int n = 0; n < 2; ++n) { \
        if constexpr (FP8) asm volatile("v_mfma_scale_f32_16x16x128_f8f6f4 %0, %1, %2, %0, %3, %3 op_sel_hi:[0,0,0]" : "+v"(acc[ai][bj][m][n]) : "v"(Bt##8[n]), "v"(At##8[m]), "v"(mxs)); \
        else { _Pragma("unroll") for (int k = 0; k < 2; ++k) acc[ai][bj][m][n] = __builtin_amdgcn_mfma_f32_16x16x32_bf16(Bt[n][k], At[m][k], acc[ai][bj][m][n], 0, 0, 0); } } \
        __builtin_amdgcn_s_setprio(0); } while (0)
#define PG8_WAIT_V(n) asm volatile("s_waitcnt vmcnt(" #n ")" ::: "memory")
#define PG8_WAIT_L(n) asm volatile("s_waitcnt lgkmcnt(" #n ")" ::: "memory")
#define PG8_BAR __builtin_amdgcn_s_barrier()
#define PG8_SCHED __builtin_amdgcn_sched_barrier(0)
    Unit cur, nxt; int ui = 0;
    if (!S.next(0, cur)) return;
    f32x4 acc[2][2][4][2];
#pragma unroll
    for (int a = 0; a < 2; ++a)
#pragma unroll
        for (int b = 0; b < 2; ++b)
#pragma unroll
            for (int m = 0; m < 4; ++m)
#pragma unroll
                for (int n = 0; n < 2; ++n) acc[a][b][m][n] = (f32x4){0.f, 0.f, 0.f, 0.f};
    typedef int i32x8_ __attribute__((ext_vector_type(8))); typedef int i32x4_ __attribute__((ext_vector_type(4)));
    bf16x8 At[4][2], B0[2][2], B1[2][2]; i32x8_ At8[4], B08[2], B18[2];
    (void)At; (void)B0; (void)B1; (void)At8; (void)B08; (void)B18;
    const char* cA = S.a_ptr(cur); const char* cB = S.b_ptr(cur);
    PG8_STAGE(PG8_SB(0, 0), cB, B); PG8_STAGE(PG8_SB(0, 1), cB + hstepB, B); PG8_STAGE(PG8_SA(0, 0), cA, A); PG8_STAGE(PG8_SA(0, 1), cA + hstepA, A);
    if (wr == 1) PG8_BAR;
    PG8_WAIT_V(2); PG8_BAR;
    PG8_STAGE(PG8_SB(1, 0), cB + kstep, B); PG8_STAGE(PG8_SA(1, 0), cA + kstep, A); PG8_STAGE(PG8_SB(1, 1), cB + hstepB + kstep, B); PG8_STAGE(PG8_SA(1, 1), cA + kstep + hstepA, A);
    PG8_WAIT_V(8); PG8_BAR;
    bool stores = false;
    for (;;) {
        const bool has_next = S.next(ui + 1, nxt);
        const char* nA = has_next ? S.a_ptr(nxt) : cA; const char* nB = has_next ? S.b_ptr(nxt) : cB;
        for (int t = 0; t < nt; t += 2) {
            const bool last = (t == nt - 2);
#define PG8_AOFF(tile) ((long)(tile) * (long)kstep + ((tile) >= 2 * SEG ? dA2 : (tile) >= SEG ? dA1 : 0l))
            if (Hook::ACTIVE && (t == SEG || t == 2 * SEG)) { const int th = tid_fresh(); H(acc, cur, t, wr, wc, th & 15, (th >> 4) & 3); }
            const char* a1 = cA + PG8_AOFF(t + 1);
            const char* a2 = last ? nA : cA + PG8_AOFF(t + 2); const char* b2 = last ? nB : cB + (size_t)(t + 2) * kstep;
            const char* a3 = last ? nA + kstep : cA + PG8_AOFF(t + 3); const char* b3 = b2 + kstep;
            const bool head = (t == 0), drain = head && stores;
            PG8_LDB(B0, 0, 0); PG8_LDB(B1, 0, 1); PG8_SCHED; PG8_LDA(At, 0, 0); if (!head) PG8_STAGE(PG8_SA(1, 1), a1 + hstepA, A);
            if (drain) { if constexpr (Epi::NST >= 16) PG8_WAIT_V(16); else if constexpr (Epi::NST >= 8) PG8_WAIT_V(8); else PG8_WAIT_V(0); } else PG8_WAIT_V(8);
            PG8_WAIT_L(0); PG8_BAR; PG8_MMA(0, 0, At, B0); PG8_MMA(0, 1, At, B1); PG8_BAR; PG8_SCHED;
            PG8_LDA(At, 0, 1); PG8_STAGE(PG8_SB(0, 0), b2, B); PG8_STAGE(PG8_SB(0, 1), b2 + hstepB, B); PG8_STAGE(PG8_SA(0, 0), a2, A);
            if (!drain) PG8_WAIT_V(8);
            PG8_WAIT_L(0); PG8_BAR; PG8_MMA(1, 0, At, B0); PG8_MMA(1, 1, At, B1); PG8_BAR; PG8_SCHED;
            PG8_LDB(B0, 1, 0); PG8_LDB(B1, 1, 1); PG8_SCHED; PG8_LDA(At, 1, 0); PG8_STAGE(PG8_SA(0, 1), a2 + hstepA, A);
            if (!drain) PG8_WAIT_V(8);
            PG8_WAIT_L(0); PG8_BAR; PG8_MMA(0, 0, At, B0); PG8_MMA(0, 1, At, B1); PG8_BAR; PG8_SCHED;
            PG8_LDA(At, 1, 1); PG8_STAGE(PG8_SB(1, 0), b3, B); PG8_STAGE(PG8_SB(1, 1), b3 + hstepB, B); PG8_STAGE(PG8_SA(1, 0), a3, A);
            PG8_WAIT_V(8);
            PG8_WAIT_L(0); PG8_BAR; PG8_MMA(1, 0, At, B0); PG8_MMA(1, 1, At, B1); PG8_BAR; PG8_SCHED;
        }
        PG8_STAGE(PG8_SA(1, 1), nA + kstep + hstepA, A); PG8_SCHED;
        if constexpr (FP8) asm volatile("s_nop 15\n\ts_nop 7" ::: "memory");
        if constexpr (ALIGN_EPI) { if (wr == 0) PG8_BAR; }
        { const int te = tid_fresh(); E(acc, cur, wr, wc, te & 15, (te >> 4) & 3); }
        if (!has_next) break;
        stores = true;
#pragma unroll
        for (int a = 0; a < 2; ++a)
#pragma unroll
            for (int b = 0; b < 2; ++b)
#pragma unroll
                for (int m = 0; m < 4; ++m)
#pragma unroll
                    for (int n = 0; n < 2; ++n) acc[a][b][m][n] = (f32x4){0.f, 0.f, 0.f, 0.f};
        cur = nxt; cA = nA; cB = nB; ++ui;
        if constexpr (ALIGN_EPI) { if (wr == 1) PG8_BAR; }
    }
    PG8_WAIT_V(0);
    if constexpr (!ALIGN_EPI) { if (wr == 0) PG8_BAR; }
    PG8_BAR;
#undef PG8_AOFF
#undef PG8_SA
#undef PG8_SB
#undef PG8_STAGE
#undef PG8_LDA
#undef PG8_LD8
#undef PG8_LDB
#undef PG8_MMA
#undef PG8_WAIT_V
#undef PG8_WAIT_L
#undef PG8_BAR
#undef PG8_SCHED
}
}

__device__ __forceinline__ float rstd_q(const float* ssp, int row, int fq) {
    const f32x4 a = *(const f32x4*)(ssp + (size_t)row * 16 + 4 * fq);
    float s = (a[0] + a[1]) + (a[2] + a[3]); s += lx16(s); s = add_x32(s);
    return rsqrtf(s * (1.f / D) + EPS);
}
__device__ __forceinline__ void rstd8(const float* ssp, int row0, int fq, float mul, float (&rs)[2][4]) {
    f32x4 a[2][4];
#pragma unroll
    for (int ai = 0; ai < 2; ++ai)
#pragma unroll
        for (int m = 0; m < 4; ++m) a[ai][m] = *(const f32x4*)(ssp + (size_t)(row0 + ai * 128 + m * 16) * 16 + 4 * fq);
#pragma unroll
    for (int ai = 0; ai < 2; ++ai)
#pragma unroll
        for (int m = 0; m < 4; ++m) { float s = (a[ai][m][0] + a[ai][m][1]) + (a[ai][m][2] + a[ai][m][3]); s += lx16(s); s = add_x32(s); rs[ai][m] = rsqrtf(s * (1.f / D) + EPS) * mul; }
}
__device__ __forceinline__ u32x4 pk8(f32x4 a, f32x4 b) { u32x4 w; w.x = pk2(a[0], a[1]); w.y = pk2(a[2], a[3]); w.z = pk2(b[0], b[1]); w.w = pk2(b[2], b[3]); return w; }
__device__ __forceinline__ u32x2 pk8_fp8(f32x4 a, f32x4 b, float sc) {
    int q0 = __builtin_amdgcn_cvt_pk_fp8_f32(a[0] * sc, a[1] * sc, 0, false); q0 = __builtin_amdgcn_cvt_pk_fp8_f32(a[2] * sc, a[3] * sc, q0, true);
    int q1 = __builtin_amdgcn_cvt_pk_fp8_f32(b[0] * sc, b[1] * sc, 0, false); q1 = __builtin_amdgcn_cvt_pk_fp8_f32(b[2] * sc, b[3] * sc, q1, true);
    return (u32x2){(unsigned)q0, (unsigned)q1};
}
__device__ __forceinline__ void up8(u32x4 w, f32x4& a, f32x4& b) {
    a = (f32x4){__uint_as_float(w.x << 16), __uint_as_float(w.x & 0xffff0000u), __uint_as_float(w.y << 16), __uint_as_float(w.y & 0xffff0000u)};
    b = (f32x4){__uint_as_float(w.z << 16), __uint_as_float(w.z & 0xffff0000u), __uint_as_float(w.w << 16), __uint_as_float(w.w & 0xffff0000u)}; }
struct LaneTr {
    int addr, tr, tq;
    __device__ __forceinline__ LaneTr(int fr, int fq) { const int L = fq * 16 + fr; tr = L >> 2; tq = L & 3; addr = (tq * 16 + tr) * 4; }
    __device__ __forceinline__ u32x4 operator()(u32x4 w) const {
        return (u32x4){(unsigned)__builtin_amdgcn_ds_bpermute(addr, (int)w.x), (unsigned)__builtin_amdgcn_ds_bpermute(addr, (int)w.y), (unsigned)__builtin_amdgcn_ds_bpermute(addr, (int)w.z), (unsigned)__builtin_amdgcn_ds_bpermute(addr, (int)w.w)}; }
};
typedef _Float16 f16x2_t __attribute__((ext_vector_type(2)));
__device__ __forceinline__ u32x4 swz16x4(u32x4 a) { unsigned r0, r1, r2, r3;
    asm volatile("ds_swizzle_b32 %0, %4 offset:swizzle(SWAP,16)\n\tds_swizzle_b32 %1, %5 offset:swizzle(SWAP,16)\n\tds_swizzle_b32 %2, %6 offset:swizzle(SWAP,16)\n\tds_swizzle_b32 %3, %7 offset:swizzle(SWAP,16)\n\ts_waitcnt lgkmcnt(0)"
                 : "=&v"(r0), "=&v"(r1), "=&v"(r2), "=&v"(r3) : "v"(a.x), "v"(a.y), "v"(a.z), "v"(a.w));
    return (u32x4){r0, r1, r2, r3}; }
__device__ __forceinline__ f32x4 swz16f4(f32x4 a) { return __builtin_bit_cast(f32x4, swz16x4(__builtin_bit_cast(u32x4, a))); }
__device__ __forceinline__ float h2f_lo(unsigned w) { return (float)__builtin_bit_cast(f16x2_t, w)[0]; }
__device__ __forceinline__ float h2f_hi(unsigned w) { return (float)__builtin_bit_cast(f16x2_t, w)[1]; }
struct GEpiWin {
    unsigned char* ws;
    static constexpr int NST = 16;
    __device__ __forceinline__ void operator()(const f32x4 (&acc)[2][2][4][2], const pg8::Unit& u, int wr, int wc, int fr, int fq) const {
        const int pn = u.pn, row0 = u.pm * 256 + wr * 64 + fr;
        const LaneTr ltr(fr, fq); const int rowt = u.pm * 256 + wr * 64 + ltr.tr, ct = 32 * wc + 8 * ltr.tq;
        const float* ssp = (const float*)(ws + WS_SSP);
        if (pn < 4) {
            const bool rot = (wc & 1) == 0;
            bf16_t* dst = (bf16_t*)(ws + (pn < 2 ? WS_QB : WS_KB)) + (pn & 1) * 256 + ct;
            float rs8[2][4]; rstd8(ssp, row0, fq, pn < 2 ? C2 : 1.f, rs8);
            u32x4 tb[2][4];
#pragma unroll
            for (int ai = 0; ai < 2; ++ai)
#pragma unroll
                for (int m = 0; m < 4; ++m) tb[ai][m] = rot ? *(const u32x4*)(ws + WS_ROPE + (size_t)(row0 + ai * 128 + m * 16) * 32 + (fq & 1) * 16) : (u32x4){0u, 0u, 0u, 0u};
#pragma unroll
            for (int ai = 0; ai < 2; ++ai)
#pragma unroll
                for (int m = 0; m < 4; ++m) { const int row = rowt + ai * 128 + m * 16; const float rs = rs8[ai][m];
                    f32x4 c0 = (f32x4){1.f, 1.f, 1.f, 1.f}, c1 = c0, s0 = (f32x4){0.f, 0.f, 0.f, 0.f}, s1 = s0;
                    if (rot) { const u32x4 mine = tb[ai][m]; const u32x4 oth = swz16x4(mine);
                        const u32x4 cw = (fq & 1) ? oth : mine, sw = (fq & 1) ? mine : oth;
                        c0 = (f32x4){h2f_lo(cw.x), h2f_hi(cw.x), h2f_lo(cw.y), h2f_hi(cw.y)}; c1 = (f32x4){h2f_lo(cw.z), h2f_hi(cw.z), h2f_lo(cw.w), h2f_hi(cw.w)};
                        s0 = (f32x4){h2f_lo(sw.x), h2f_hi(sw.x), h2f_lo(sw.y), h2f_hi(sw.y)}; s1 = (f32x4){h2f_lo(sw.z), h2f_hi(sw.z), h2f_lo(sw.w), h2f_hi(sw.w)}; }
#pragma unroll
                    for (int bj = 0; bj < 2; ++bj) { f32x4 v0 = acc[ai][bj][m][0], v1 = acc[ai][bj][m][1];
                        if (rot) { const f32x4 o0 = swz16f4(v0), o1 = swz16f4(v1);
                            if (fq == 0) { v0 = v0 * c0 - o0 * s0; v1 = v1 * c1 - o1 * s1; } else if (fq == 1) { v0 = o0 * s0 + v0 * c0; v1 = o1 * s1 + v1 * c1; } }
                        *(u32x4*)(dst + (size_t)row * 512 + bj * 128) = ltr(pk8(v0 * rs, v1 * rs)); } }
        } else if (pn < 12) {
            const int seg = (pn - 4) >> 1; const size_t base = seg == 0 ? WS_VB : seg == 1 ? WS_PIN : seg == 2 ? WS_UIN : WS_VIN;
            bf16_t* dst = (bf16_t*)(ws + base) + (pn & 1) * 256 + ct;
            float rs[2][4]; rstd8(ssp, row0, fq, 1.f, rs);
#pragma unroll
            for (int ai = 0; ai < 2; ++ai)
#pragma unroll
                for (int m = 0; m < 4; ++m) { const int row = rowt + ai * 128 + m * 16;
#pragma unroll
                    for (int bj = 0; bj < 2; ++bj) *(u32x4*)(dst + (size_t)row * 512 + bj * 128) = ltr(pk8(acc[ai][bj][m][0] * rs[ai][m], acc[ai][bj][m][1] * rs[ai][m])); }
        }
    }
};
__device__ __forceinline__ size_t gate_off(int pm, int pn, int wid, int lane) { return (((size_t)(pm * 12 + pn) * 8 + wid) << 14) + (size_t)lane * 16; }
#define GATE_FRAG(ai, bj, m) ((((ai) * 2 + (bj)) * 4 + (m)) * 1024)
struct GEpiGate {
    unsigned char* ws;
    static constexpr int NST = 16;
    __device__ __forceinline__ void operator()(const f32x4 (&acc)[2][2][4][2], const pg8::Unit& u, int wr, int wc, int fr, int fq) const {
        const int row0 = u.pm * 256 + wr * 64 + fr;
        unsigned char* dst = ws + WS_GTE + gate_off(u.pm, u.pn, wr * 4 + wc, fq * 16 + fr);
        float rs8[2][4]; rstd8((const float*)(ws + WS_SSP), row0, fq, -1.4426950408889634f / (XS * W8S), rs8);
#pragma unroll
        for (int ai = 0; ai < 2; ++ai)
#pragma unroll
            for (int m = 0; m < 4; ++m) { const float rs = rs8[ai][m];
#pragma unroll
                for (int bj = 0; bj < 2; ++bj) { f32x4 v0 = acc[ai][bj][m][0] * rs, v1 = acc[ai][bj][m][1] * rs;
#pragma unroll
                    for (int e = 0; e < 4; ++e) { v0[e] = 1.f + __builtin_amdgcn_exp2f(fminf(v0[e], 60.f)); v1[e] = 1.f + __builtin_amdgcn_exp2f(fminf(v1[e], 60.f)); }
                    *(u32x4*)(dst + GATE_FRAG(ai, bj, m)) = pk8(v0, v1); } }
    }
};
__device__ __forceinline__ f32x4 rcp4(f32x4 v) { return (f32x4){__builtin_amdgcn_rcpf(fmaxf(v[0], 1e-30f)), __builtin_amdgcn_rcpf(fmaxf(v[1], 1e-30f)), __builtin_amdgcn_rcpf(fmaxf(v[2], 1e-30f)), __builtin_amdgcn_rcpf(fmaxf(v[3], 1e-30f))}; }
struct BranchHook {
    static constexpr bool ACTIVE = true; unsigned char* ws;
    __device__ __forceinline__ void operator()(f32x4 (&acc)[2][2][4][2], const pg8::Unit& u, int t, int wr, int wc, int fr, int fq) const {
        int lane = fq * 16 + fr;
        asm volatile("" : "+v"(lane));
        const unsigned char* gpa = ws + WS_GTE + gate_off(u.pm, u.pn + ((t == 8) ? 0 : 4), wr * 4 + wc, lane); const unsigned char* gpb = gpa + ((size_t)4 * 8 << 14);
#pragma unroll
        for (int ai = 0; ai < 2; ++ai) {
            u32x4 ga[4][2], gb[4][2];
#pragma unroll
            for (int m = 0; m < 4; ++m)
#pragma unroll
                for (int bj = 0; bj < 2; ++bj) { ga[m][bj] = *(const u32x4*)(gpa + GATE_FRAG(ai, bj, m)); gb[m][bj] = *(const u32x4*)(gpb + GATE_FRAG(ai, bj, m)); }
            __builtin_amdgcn_sched_barrier(0);
#pragma unroll
            for (int m = 0; m < 4; ++m)
#pragma unroll
                for (int bj = 0; bj < 2; ++bj) { f32x4 a0, a1, b0, b1; up8(ga[m][bj], a0, a1); up8(gb[m][bj], b0, b1);
                    acc[ai][bj][m][0] = acc[ai][bj][m][0] * (b0 * rcp4(a0)); acc[ai][bj][m][1] = acc[ai][bj][m][1] * (b1 * rcp4(a1)); }
            __builtin_amdgcn_sched_barrier(0);
        }
    }
};
struct GEpiBranch {
    unsigned char* ws;
    static constexpr int NST = 8;
    __device__ __forceinline__ void operator()(const f32x4 (&acc)[2][2][4][2], const pg8::Unit& u, int wr, int wc, int fr, int fq) const {
        const LaneTr ltr(fr, fq); const int row0 = u.pm * 256 + wr * 64 + ltr.tr, col0 = u.pn * 256 + 32 * wc + 8 * ltr.tq;
#pragma unroll
        for (int ai = 0; ai < 2; ++ai) {
            u32x4 g[4][2];
#pragma unroll
            for (int m = 0; m < 4; ++m)
#pragma unroll
                for (int bj = 0; bj < 2; ++bj) g[m][bj] = *(const u32x4*)(ws + WS_GTE + gate_off(u.pm, u.pn + 8, wr * 4 + wc, fq * 16 + fr) + GATE_FRAG(ai, bj, m));
#pragma unroll
            for (int m = 0; m < 4; ++m) { const int row = row0 + ai * 128 + m * 16;
#pragma unroll
                for (int bj = 0; bj < 2; ++bj) { const int col = col0 + bj * 128;
                    f32x4 g0, g1; up8(g[m][bj], g0, g1);
                    *(u32x4*)((bf16_t*)(ws + WS_MG) + (size_t)row * D + col) = ltr(pk8(acc[ai][bj][m][0] * rcp4(g0), acc[ai][bj][m][1] * rcp4(g1))); } }
        }
    }
};
struct GEpiResid {
    unsigned char* ws; bool q8; float ascale;
    static constexpr int NST = 16;
    __device__ __forceinline__ void operator()(const f32x4 (&acc)[2][2][4][2], const pg8::Unit& u, int wr, int wc, int fr, int fq) const {
        const int row0 = u.pm * 256 + wr * 64 + fr, col0 = u.pn * 256 + 32 * wc + 8 * fq;
#pragma unroll
        for (int ai = 0; ai < 2; ++ai) {
            u32x4 xin[4][2];
#pragma unroll
            for (int m = 0; m < 4; ++m)
#pragma unroll
                for (int bj = 0; bj < 2; ++bj) xin[m][bj] = *(const u32x4*)((const bf16_t*)(ws + WS_XB) + (size_t)(row0 + ai * 128 + m * 16) * D + col0 + bj * 128);
#pragma unroll
            for (int m = 0; m < 4; ++m) { const int row = row0 + ai * 128 + m * 16; float part = 0.f;
#pragma unroll
                for (int bj = 0; bj < 2; ++bj) { f32x4 x0, x1; up8(xin[m][bj], x0, x1);
                    const u32x4 w = pk8(acc[ai][bj][m][0] * ascale + x0, acc[ai][bj][m][1] * ascale + x1);
                    *(u32x4*)((bf16_t*)(ws + WS_XB) + (size_t)row * D + col0 + bj * 128) = w;
                    f32x4 v0, v1; up8(w, v0, v1);
                    if (q8) { int q0 = __builtin_amdgcn_cvt_pk_fp8_f32(v0[0] * XS, v0[1] * XS, 0, false); q0 = __builtin_amdgcn_cvt_pk_fp8_f32(v0[2] * XS, v0[3] * XS, q0, true);
                        int q1 = __builtin_amdgcn_cvt_pk_fp8_f32(v1[0] * XS, v1[1] * XS, 0, false); q1 = __builtin_amdgcn_cvt_pk_fp8_f32(v1[2] * XS, v1[3] * XS, q1, true);
                        *(u32x2*)(ws + WS_XQ8 + (size_t)row * D + col0 + bj * 128) = (u32x2){(unsigned)q0, (unsigned)q1}; }
                    part += (v0[0] * v0[0] + v0[1] * v0[1]) + (v0[2] * v0[2] + v0[3] * v0[3]) + (v1[0] * v1[0] + v1[1] * v1[1]) + (v1[2] * v1[2] + v1[3] * v1[3]); }
                part += lx16(part); part = add_x32(part);
                if (fq == 0) ((float*)(ws + WS_SSP))[(size_t)row * 16 + u.pn * 4 + wc] = part; }
        }
    }
};
typedef _Float16 f16x8 __attribute__((ext_vector_type(8)));
struct GEpiScaleF16 {
    unsigned char* ws; _Float16* o; int ld;
    static constexpr int NST = 16;
    __device__ __forceinline__ void operator()(const f32x4 (&acc)[2][2][4][2], const pg8::Unit& u, int wr, int wc, int fr, int fq) const {
        const int row0 = u.pm * 256 + wr * 64 + fr;
        const LaneTr ltr(fr, fq); const int rowt = u.pm * 256 + wr * 64 + ltr.tr, col0 = u.pn * 256 + 32 * wc + 8 * ltr.tq;
        float rs8[2][4]; rstd8((const float*)(ws + WS_SSP), row0, fq, 1.f, rs8);
#pragma unroll
        for (int ai = 0; ai < 2; ++ai)
#pragma unroll
            for (int m = 0; m < 4; ++m) { const int row = rowt + ai * 128 + m * 16; const float rs = rs8[ai][m];
#pragma unroll
                for (int bj = 0; bj < 2; ++bj) { const f32x4 a = acc[ai][bj][m][0] * rs, b = acc[ai][bj][m][1] * rs;
                    const f16x8 h = (f16x8){(_Float16)a[0], (_Float16)a[1], (_Float16)a[2], (_Float16)a[3], (_Float16)b[0], (_Float16)b[1], (_Float16)b[2], (_Float16)b[3]};
                    *(u32x4*)(o + (size_t)row * ld + col0 + bj * 128) = ltr(__builtin_bit_cast(u32x4, h)); } }
    }
};
typedef PG8_LAS unsigned char* lds_t;
struct GEpiXSoftmax {
    unsigned char* ws; lds_t part;
    static constexpr int NST = 16;
    __device__ __forceinline__ void operator()(const f32x4 (&acc)[2][2][4][2], const pg8::Unit& u, int wr, int wc, int fr, int fq) const {
        const int row0 = u.pm * 256 + wr * 64 + fr, col0 = u.pn * 256 + 32 * wc + 8 * fq;
        f32x4 (&ex)[2][2][4][2] = const_cast<f32x4 (&)[2][2][4][2]>(acc);
        PG8_LAS f32x2* pt = (PG8_LAS f32x2*)part;
        float rs[2][4], mw[2][4];
#pragma unroll
        for (int ai = 0; ai < 2; ++ai)
#pragma unroll
            for (int m = 0; m < 4; ++m) { const int row = row0 + ai * 128 + m * 16; rs[ai][m] = rstd_q((const float*)(ws + WS_SSP), row, fq) * (1.4426950408889634f / (16.f * XS * GS));
                float mx = -INFINITY;
#pragma unroll
                for (int bj = 0; bj < 2; ++bj)
#pragma unroll
                    for (int n = 0; n < 2; ++n)
#pragma unroll
                        for (int e = 0; e < 4; ++e) mx = fmaxf(mx, acc[ai][bj][m][n][e]);
                mx *= rs[ai][m];
                mx = fmaxf(mx, lx16(mx)); mx = max_x32(mx);
                float sm = 0.f;
#pragma unroll
                for (int bj = 0; bj < 2; ++bj)
#pragma unroll
                    for (int n = 0; n < 2; ++n)
#pragma unroll
                        for (int e = 0; e < 4; ++e) { const float x = __builtin_amdgcn_exp2f(acc[ai][bj][m][n][e] * rs[ai][m] - mx); ex[ai][bj][m][n][e] = x; sm += x; }
                sm += lx16(sm); sm = add_x32(sm);
                mw[ai][m] = mx;
                if (fq == 0) pt[(wr * 64 + fr + ai * 128 + m * 16) * 4 + wc] = (f32x2){mx, sm}; }
        asm volatile("s_waitcnt lgkmcnt(0)" ::: "memory");
        __builtin_amdgcn_s_barrier();
#pragma unroll
        for (int ai = 0; ai < 2; ++ai)
#pragma unroll
            for (int m = 0; m < 4; ++m) { const int row = row0 + ai * 128 + m * 16;
                const PG8_LAS f32x2* pr = pt + (wr * 64 + fr + ai * 128 + m * 16) * 4;
                const f32x2 p0 = pr[0], p1 = pr[1], p2 = pr[2], p3 = pr[3];
                const float M = fmaxf(fmaxf(p0.x, p1.x), fmaxf(p2.x, p3.x));
                const float tot = (p0.y * __builtin_amdgcn_exp2f(p0.x - M) + p1.y * __builtin_amdgcn_exp2f(p1.x - M)) + (p2.y * __builtin_amdgcn_exp2f(p2.x - M) + p3.y * __builtin_amdgcn_exp2f(p3.x - M));
                const float f = __builtin_amdgcn_exp2f(mw[ai][m] - M) * (PS / tot);
#pragma unroll
                for (int bj = 0; bj < 2; ++bj) *(u32x2*)(ws + WS_PM + (size_t)row * D + col0 + bj * 128) = pk8_fp8(ex[ai][bj][m][0], ex[ai][bj][m][1], f); }
    }
};
__device__ __forceinline__ void fstage_win(const Params& p, int l, lds_t lds, int bid, int nb) {
    { pg8::Order O; O.init(T, 3072, nb, bid, p.ws + WS_XB, D, p.ws + WS_WIN + (size_t)l * 3072 * D * 2, D);
      pg8::gemm_phase<GEpiWin, pg8::Order, true>(lds, D, D, D, O, GEpiWin{p.ws}); }
    { pg8::Order O; O.init(T, 3072, nb, bid, p.ws + WS_XQ8, D / 2, p.ws + WS_WIN + 24 * MiB + (size_t)l * 3072 * D, D / 2);
      pg8::gemm_phase<GEpiGate, pg8::Order, true, pg8::NoHook, 1 << 20, true>(lds, D / 2, D / 2, D / 2, O, GEpiGate{p.ws}); }
}
template <bool HOOKS = true>
__device__ __forceinline__ void fstage_branch(const Params& p, int l, lds_t lds, int bid, int nb) {
    pg8::Order O; O.init(T, D, nb, bid, p.ws + WS_AO, 512, p.ws + WS_WB0 + (size_t)l * D * 1536 * 2, 1536);
    const long d1 = (long)WS_DP - (long)WS_AO - 8 * 128, d2 = (long)WS_SO - (long)WS_AO - 16 * 128;
    if constexpr (HOOKS) pg8::gemm_phase<GEpiBranch, pg8::Order, true, BranchHook, 8>(lds, 1536, 512, 1536, O, GEpiBranch{p.ws}, d1, d2, BranchHook{p.ws});
    else pg8::gemm_phase<GEpiBranch, pg8::Order, true, pg8::NoHook, 8>(lds, 1536, 512, 1536, O, GEpiBranch{p.ws}, d1, d2);
}
__device__ __forceinline__ void fstage_resid_out(const Params& p, int l, lds_t lds, int bid, int nb) {
    pg8::Order O; O.init(T, D, nb, bid, p.ws + WS_MG, D, p.ws + WS_WOUT + (size_t)l * D * D * 2, D);
    pg8::gemm_phase<GEpiResid, pg8::Order, true>(lds, D, D, D, O, GEpiResid{p.ws, true, 1.f});
}
__device__ __forceinline__ void fstage_resid_cross(const Params& p, int l, lds_t lds, int bid, int nb) {
    pg8::Order O; O.init(T, D, nb, bid, p.ws + WS_PM, D / 2, p.ws + WS_YT + (size_t)l * NB * D * D, D / 2, (size_t)D * D, S / 256);
    pg8::gemm_phase<GEpiResid, pg8::Order, true, pg8::NoHook, 1 << 20, true>(lds, D / 2, D / 2, D / 2, O, GEpiResid{p.ws, true, 1.f / (PS * YS)});
}
__device__ __forceinline__ void fstage_xscore(const Params& p, int l, lds_t lds, int bid, int nb) {
    pg8::Order O; O.init(T, D, nb, bid, p.ws + WS_XQ8, D / 2, p.ws + WS_GT + (size_t)l * NB * D * D, D / 2, (size_t)D * D, S / 256);
    pg8::gemm_phase<GEpiXSoftmax, pg8::Order, true, pg8::NoHook, 1 << 20, true>(lds, D / 2, D / 2, D / 2, O, GEpiXSoftmax{p.ws, lds + 131072});
}


struct GEpiKV {
    unsigned char* ws;
    static constexpr int NST = 16;
    __device__ __forceinline__ void operator()(const f32x4 (&acc)[2][2][4][2], const pg8::Unit& u, int wr, int wc, int fr, int fq) const {
        asm volatile("" : "+v"(fr), "+v"(fq));
        const int row0 = u.pm * 256 + wr * 64 + fr, l = u.pn >> 3, col0 = (u.pn & 7) * 256 + 32 * wc + 8 * fq;
        float rs8[2][4];
#pragma unroll
        for (int ai = 0; ai < 2; ++ai)
#pragma unroll
            for (int m = 0; m < 4; ++m) rs8[ai][m] = ((const float*)(ws + WS_RSTDM))[row0 + ai * 128 + m * 16];
#pragma unroll
        for (int ai = 0; ai < 2; ++ai)
#pragma unroll
            for (int m = 0; m < 4; ++m) { const int row = row0 + ai * 128 + m * 16; const float rs = rs8[ai][m];
#pragma unroll
                for (int bj = 0; bj < 2; ++bj) *(u32x4*)((bf16_t*)(ws + WS_KV) + ((size_t)l * MROWS + row) * 2048 + col0 + bj * 128) = pk8(acc[ai][bj][m][0] * rs, acc[ai][bj][m][1] * rs); }
    }
};
struct OrderG : pg8::Order {
    unsigned char* ws;
    __device__ __forceinline__ const char* a_ptr(const pg8::Unit& u) const { const int l = u.pm >> 5, b = (u.pm >> 2) & 7, h = u.pm & 3; return (const char*)(ws + WS_KV) + (((size_t)l * MROWS + b * 256) * 2048 + h * 256) * 2; }
    __device__ __forceinline__ const char* b_ptr(const pg8::Unit& u) const { const int l = u.pm >> 5, h = u.pm & 3; return (const char*)(ws + WS_WXQB) + (((size_t)l * D + u.pn * 256) * D + h * 256) * 2; }
};
struct GEpiG {
    unsigned char* ws;
    static constexpr int NST = 16;
    __device__ __forceinline__ void operator()(const f32x4 (&acc)[2][2][4][2], const pg8::Unit& u, int wr, int wc, int fr, int fq) const {
        asm volatile("" : "+v"(fr), "+v"(fq));
        const int lb = u.pm >> 2, h = u.pm & 3, r0 = wr * 64 + fr, col0 = u.pn * 256 + 32 * wc + 8 * fq;
#pragma unroll
        for (int ai = 0; ai < 2; ++ai)
#pragma unroll
            for (int m = 0; m < 4; ++m)
#pragma unroll
                for (int bj = 0; bj < 2; ++bj) *(u32x2*)(ws + WS_GT + ((size_t)lb * D + h * 256 + r0 + ai * 128 + m * 16) * D + col0 + bj * 128) = pk8_fp8(acc[ai][bj][m][0], acc[ai][bj][m][1], GS);
    }
};
struct OrderY : pg8::Order {
    unsigned char* ws;
    __device__ __forceinline__ const char* a_ptr(const pg8::Unit& u) const { const int l = u.pn >> 5, h = u.pn & 3; return (const char*)(ws + WS_WXOT) + (((size_t)l * D + u.pm * 256) * D + h * 256) * 2; }
    __device__ __forceinline__ const char* b_ptr(const pg8::Unit& u) const { const int l = u.pn >> 5, b = (u.pn >> 2) & 7, h = u.pn & 3; return (const char*)(ws + WS_KV) + (((size_t)l * MROWS + b * 256) * 2048 + 1024 + h * 256) * 2; }
};
struct GEpiY {
    unsigned char* ws;
    static constexpr int NST = 16;
    __device__ __forceinline__ void operator()(const f32x4 (&acc)[2][2][4][2], const pg8::Unit& u, int wr, int wc, int fr, int fq) const {
        asm volatile("" : "+v"(fr), "+v"(fq));
        const int lb = u.pn >> 2, h = u.pn & 3, row0 = u.pm * 256 + wr * 64 + fr, col0 = h * 256 + 32 * wc + 8 * fq;
#pragma unroll
        for (int ai = 0; ai < 2; ++ai)
#pragma unroll
            for (int m = 0; m < 4; ++m)
#pragma unroll
                for (int bj = 0; bj < 2; ++bj) *(u32x2*)(ws + WS_YT + ((size_t)lb * D + row0 + ai * 128 + m * 16) * D + col0 + bj * 128) = pk8_fp8(acc[ai][bj][m][0], acc[ai][bj][m][1], YS);
    }
};
__device__ __forceinline__ void fstage_kv(const Params& p, lds_t lds, int bid, int nb) {
    pg8::Order O; O.init(MROWS, L * 2048, nb, bid, p.ws + WS_MEMB, D, p.ws + WS_WXKVT, D);
    pg8::gemm_phase<GEpiKV, pg8::Order, true>(lds, D, D, D, O, GEpiKV{p.ws});
}
__device__ __forceinline__ void fstage_g(const Params& p, lds_t lds, int bid, int nb) {
    OrderG O; O.init(128 * 256, D, nb, bid, nullptr, 2048, nullptr, D); O.ws = p.ws;
    pg8::gemm_phase<GEpiG, OrderG, true>(lds, 256, 2048, D, O, GEpiG{p.ws});
}
__device__ __forceinline__ void fstage_y(const Params& p, lds_t lds, int bid, int nb) {
    OrderY O; O.init(D, 128 * 256, nb, bid, nullptr, D, nullptr, 2048); O.ws = p.ws;
    pg8::gemm_phase<GEpiY, OrderY, true>(lds, 256, D, 2048, O, GEpiY{p.ws});
}

#include <hip/hip_bf16.h>
namespace attn_body {
using bf16=__hip_bfloat16;
using bf16x8=__attribute__((ext_vector_type(8)))short;
using s16x4=__attribute__((ext_vector_type(4)))short;
using f32x16=__attribute__((ext_vector_type(16)))float;
using u32x4=__attribute__((ext_vector_type(4)))unsigned;
constexpr int SEQ=4096,D=64,DM=512;
constexpr int NW=8,QBLK=32,QB=QBLK*NW,KVBLK=64,NQB=SEQ/QB;
constexpr int ATTN_PITCH=DM, ATTN_UNIT_ROWS=QB;
__device__ __forceinline__ int crow(int r,int hi){return (r&3)+8*(r>>2)+4*hi;}
#define SBAR() __builtin_amdgcn_sched_barrier(0)
__device__ __forceinline__ void cmask(f32x16&p0,f32x16&p1,int jb,int qrel,int hi){
  const float NEG=-INFINITY; int kb=64*jb+4*hi;
  #pragma unroll
  for(int r=0;r<16;++r){int kv=kb+(r&3)+8*(r>>2); if(kv>qrel)p0[r]=NEG; if(kv+32>qrel)p1[r]=NEG;}
}

constexpr int NSLOT=3, SLOTB=8192;
constexpr int LDS_K=0, LDS_V=NSLOT*SLOTB, LDS_WS=3*NSLOT*SLOTB, LDS_OST=LDS_WS+NW*64*4, LDS_BYTES=LDS_OST+NW*8192;
constexpr float C2=0.125f*1.4426950408889634f;
__device__ __forceinline__ void glds16(const void*gsrc,unsigned lds_dst){unsigned keep;
  asm volatile("s_mov_b32 %0, m0\n\ts_mov_b32 m0, %2\n\ts_nop 0\n\tglobal_load_lds_dwordx4 %1, off\n\ts_mov_b32 m0, %0":"=&s"(keep):"v"(gsrc),"s"(lds_dst):"memory");}
__device__ __forceinline__ float max3f(float a,float b,float c){float r;asm("v_max3_f32 %0, %1, %2, %3":"=v"(r):"v"(a),"v"(b),"v"(c));return r;}
__device__ __forceinline__ float max2f(float a,float b){float r;asm("v_max_f32_e32 %0, %1, %2":"=v"(r):"v"(a),"v"(b));return r;}
__device__ __forceinline__ float fadd_s(float a,float b){float r;asm("v_add_f32_e32 %0, %1, %2":"=v"(r):"v"(a),"v"(b));return r;}
__device__ __forceinline__ float fsub_s(float a,float b){float r;asm("v_sub_f32_e32 %0, %1, %2":"=v"(r):"v"(a),"v"(b));return r;}
typedef float f32x2_t __attribute__((ext_vector_type(2))); typedef __bf16 bf16x2_t __attribute__((ext_vector_type(2)));
__device__ __forceinline__ unsigned cvtpk_s(float lo,float hi){f32x2_t v={lo,hi};bf16x2_t b=__builtin_convertvector(v,bf16x2_t);return __builtin_bit_cast(unsigned,b);}
#define WAIT_BAR(N) asm volatile("s_waitcnt vmcnt(" #N ") lgkmcnt(0)\n\ts_barrier":::"memory")

__device__ __forceinline__ void qkt(f32x16&p0,f32x16&p1,const char*Kslot,const bf16x8*qr,const f32x16&negm,int r32,int hi){
  const char*kb=Kslot+hi*1024+r32*16;
  #pragma unroll
  for(int d0=0;d0<4;++d0){
    const bf16x8 b0=*reinterpret_cast<const bf16x8*>(kb+d0*2048);
    const bf16x8 b1=*reinterpret_cast<const bf16x8*>(kb+d0*2048+512);
    if(d0==0){p0=__builtin_amdgcn_mfma_f32_32x32x16_bf16(b0,qr[0],negm,0,0,0);p1=__builtin_amdgcn_mfma_f32_32x32x16_bf16(b1,qr[0],negm,0,0,0);}
    else{p0=__builtin_amdgcn_mfma_f32_32x32x16_bf16(b0,qr[d0],p0,0,0,0);p1=__builtin_amdgcn_mfma_f32_32x32x16_bf16(b1,qr[d0],p1,0,0,0);}}
}
typedef __attribute__((address_space(3))) const char* lds_cptr;
typedef short v4i16_t __attribute__((ext_vector_type(4)));
__device__ __forceinline__ void kload8(bf16x8*kf,lds_cptr kp){
  kf[0]=*(const __attribute__((address_space(3))) bf16x8*)(kp);      kf[1]=*(const __attribute__((address_space(3))) bf16x8*)(kp+512);
  kf[2]=*(const __attribute__((address_space(3))) bf16x8*)(kp+2048); kf[3]=*(const __attribute__((address_space(3))) bf16x8*)(kp+2560);
  kf[4]=*(const __attribute__((address_space(3))) bf16x8*)(kp+4096); kf[5]=*(const __attribute__((address_space(3))) bf16x8*)(kp+4608);
  kf[6]=*(const __attribute__((address_space(3))) bf16x8*)(kp+6144); kf[7]=*(const __attribute__((address_space(3))) bf16x8*)(kp+6656);
}
__device__ __forceinline__ void kload2(bf16x8*kf,lds_cptr kp,int j){ kf[2*j]=*(const __attribute__((address_space(3))) bf16x8*)(kp+j*2048); kf[2*j+1]=*(const __attribute__((address_space(3))) bf16x8*)(kp+j*2048+512); }
__device__ __forceinline__ s16x4 vtr(lds_cptr p){ return __builtin_bit_cast(s16x4,__builtin_amdgcn_ds_read_tr16_b64_v4i16((__attribute__((address_space(3))) v4i16_t*)p)); }
__device__ __forceinline__ float rowmax(const f32x16&p0,const f32x16&p1){
  float a=max3f(p0[0],p0[1],p1[0]),b=max3f(p0[2],p0[3],p1[1]);a=max3f(a,p1[2],p1[3]);
  #pragma unroll
  for(int r=4;r<16;r+=4){a=max3f(a,p0[r],p0[r+1]);b=max3f(b,p0[r+2],p0[r+3]);a=max3f(a,p1[r],p1[r+1]);b=max3f(b,p1[r+2],p1[r+3]);}
  const float m=max2f(a,b);
  auto rr=__builtin_amdgcn_permlane32_swap(__float_as_uint(m),__float_as_uint(m),false,false);
  return max2f(__uint_as_float(rr[0]),__uint_as_float(rr[1]));
}
__device__ __forceinline__ void pv(f32x16*o,int vb,bf16x8 pa0,bf16x8 pa1,bf16x8 pa2,bf16x8 pa3){
  #pragma unroll
  for(int d0=0;d0<4;++d0){s16x4 lo[4],hi[4];
    #pragma unroll
    for(int ks=0;ks<4;++ks){
      asm volatile("ds_read_b64_tr_b16 %0,%1 offset:%c2":"=&v"(lo[ks]):"v"(vb),"i"(d0*4096+ks*1024):"memory");
      asm volatile("ds_read_b64_tr_b16 %0,%1 offset:%c2":"=&v"(hi[ks]):"v"(vb),"i"(d0*4096+ks*1024+512):"memory");}
    asm volatile("s_waitcnt lgkmcnt(0)":::"memory");SBAR();
    #define PK(k) (bf16x8){lo[k][0],lo[k][1],lo[k][2],lo[k][3],hi[k][0],hi[k][1],hi[k][2],hi[k][3]}
    o[d0]=__builtin_amdgcn_mfma_f32_32x32x16_bf16(pa0,PK(0),o[d0],0,0,0);
    o[d0]=__builtin_amdgcn_mfma_f32_32x32x16_bf16(pa1,PK(1),o[d0],0,0,0);
    o[d0]=__builtin_amdgcn_mfma_f32_32x32x16_bf16(pa2,PK(2),o[d0],0,0,0);
    o[d0]=__builtin_amdgcn_mfma_f32_32x32x16_bf16(pa3,PK(3),o[d0],0,0,0);
    #undef PK
  }
}

#ifndef ATTN_STORE16
#define ATTN_STORE16(p,v) (*(u32x4*)(p)=(v))
#endif
template<int THRL> __device__ __forceinline__ void attn_unit(int b,int qcol,int kcol,int vcol,int ocol,int qb,const bf16*Q,const bf16*__restrict__ K,const bf16*__restrict__ V,bf16*O,char*shm,const bf16*O1f=nullptr,float lam=0.f){
  const int tid=tid_fresh(),lane=tid&63,r32=lane&31,hi=lane>>5; const int wid=__builtin_amdgcn_readfirstlane(tid>>6);
  const long rowbase=(long)b*SEQ; const int q0=qb*QB;
  const bf16*Qw=Q+(rowbase+q0+wid*QBLK)*DM+qcol;
  const bf16*Kh=K+rowbase*DM+kcol,*Vh=V+rowbase*DM+vcol;
  const unsigned lds0=(unsigned)(uintptr_t)shm;
  float*wsf=(float*)(shm+LDS_WS)+wid*64;
  const bf16*ksrc=Kh+(long)lane*DM+wid*8;
  const bf16*vsrc=Vh+(long)(16*(wid&3)+(lane>>2))*DM+(wid>>2)*32+(lane&3)*8;
  const unsigned kdst=lds0+LDS_K+wid*1024, vdst=lds0+LDS_V+wid*1024;
  #define DMA_K(t,slot) glds16(ksrc+(long)(t)*KVBLK*DM,(unsigned)__builtin_amdgcn_readfirstlane(kdst+(slot)))
  #define DMA_V(t,slot) do{ glds16(vsrc+(long)(t)*KVBLK*DM,(unsigned)__builtin_amdgcn_readfirstlane(vdst+2*(slot))); glds16(vsrc+64+(long)(t)*KVBLK*DM,(unsigned)__builtin_amdgcn_readfirstlane(vdst+2*(slot)+8192)); }while(0)
  const int vb0=(int)(lds0+LDS_V)+((lane>>4)&1)*32+(lane&3)*8+(4*hi+((lane&15)>>2))*64;
  const char*Kbase=shm+LDS_K; bf16x8 kf[8];
  const lds_cptr shm3=(lds_cptr)shm; const lds_cptr kp0=shm3+LDS_K+hi*1024+r32*16; const lds_cptr vp0=shm3+LDS_V+((lane>>4)&1)*32+(lane&3)*8+(4*hi+((lane&15)>>2))*64;
  const int NT=(q0+QB)/KVBLK;
  DMA_K(0,0);DMA_V(0,0);DMA_K(1,SLOTB);
  bf16x8 qr[4];
  #pragma unroll
  for(int d0=0;d0<4;++d0)qr[d0]=*reinterpret_cast<const bf16x8*>(&Qw[(long)r32*DM+d0*16+hi*8]);
  float mhat=0.f,l_reg=0.f;f32x16 o[4];f32x16 negm;{float z_=0.f;asm volatile("":"+v"(z_));o[0]=(f32x16)(z_);o[1]=(f32x16)(z_);o[2]=(f32x16)(z_);o[3]=(f32x16)(z_);negm=(f32x16)(z_);}asm volatile("":"+v"(negm));
  const int qrel=wid*QBLK+r32;
  #define CMASK(P0,P1,t) do{int jb_=(t)-(NT-4); if(jb_>=0)cmask(P0,P1,jb_,qrel,hi);}while(0)
  bool resc=false;
  #define START(P0,P1) do{ const float rm=rowmax(P0,P1); resc=false; \
    { const float dl=rm; mhat=fadd_s(mhat,dl); \
      _Pragma("unroll") for(int r=0;r<16;++r){P0[r]=fsub_s(P0[r],dl);P1[r]=fsub_s(P1[r],dl);} \
      _Pragma("unroll") for(int r=0;r<16;++r)negm[r]=-mhat; asm volatile("":"+v"(negm)); } \
    _Pragma("unroll") for(int r=0;r<16;++r)P0[r]=__builtin_amdgcn_exp2f(P0[r]); }while(0)
  #define RESC() do{ if(resc){ asm volatile("s_waitcnt lgkmcnt(0)":::"memory"); \
      _Pragma("unroll") for(int d_=0;d_<4;++d_) _Pragma("unroll") for(int r=0;r<16;++r)o[d_][r]*=wsf[crow(r,hi)]; } }while(0)
  f32x16 pA0,pA1,pB0,pB1;
  int sl_prev=0,sl_cur=0,sl_next=SLOTB;
  #define ROT() do{sl_prev=sl_cur;sl_cur=sl_next;sl_next=(sl_next==(NSLOT-1)*SLOTB)?0:sl_next+SLOTB;}while(0)
  DMA_K(2,2*SLOTB);
  WAIT_BAR(4);
  qkt(pA0,pA1,Kbase,qr,negm,r32,hi);asm volatile("s_nop 15\n\ts_nop 7":"+v"(pA0),"+v"(pA1));CMASK(pA0,pA1,0);
  START(pA0,pA1);
  _Pragma("unroll") for(int r=0;r<16;++r)pA1[r]=__builtin_amdgcn_exp2f(pA1[r]);
  WAIT_BAR(0);
  DMA_K(3,0);DMA_V(1,SLOTB);
  ROT();
  kload8(kf,kp0+sl_cur);
  WAIT_BAR(3);
  s16x4 vlo[8],vhi[8]; u32x4 pw0,pw1,pw2,pw3;
  #define PKW(P,B) cvtpk_s(P[B],P[B+1])
  #define PAF(k) __builtin_bit_cast(bf16x8,pw##k)
  #define VFR(i) (bf16x8){vlo[i][0],vlo[i][1],vlo[i][2],vlo[i][3],vhi[i][0],vhi[i][1],vhi[i][2],vhi[i][3]}
  #define PIN(x) asm volatile("":"+v"(x))
  #define MX3(a,b,c) __builtin_fmaxf(__builtin_fmaxf((a),(b)),(c))
  #define GAPA(MF,A0,A1,A2,A3,W0,W1,PW) do{ MF; sacc+=A0; sacc+=A1; sacc+=A2; sacc+=A3; PIN(sacc); W0; W1; PIN(PW); SBAR(); }while(0)
  #define EX(v) __builtin_amdgcn_exp2f(v)
  #define GAPB(MF,X,B) do{ MF; X[B]=EX(X[B]); X[B+1]=EX(X[B+1]); X[B+2]=EX(X[B+2]); X[B+3]=EX(X[B+3]); PIN(X); SBAR(); }while(0)
  #define VRD(i) do{ vlo[i]=vtr(vp_+(((i)>>2)*4096+((i)&3)*1024)); vhi[i]=vtr(vp_+(((i)>>2)*4096+((i)&3)*1024+512)); }while(0)
  #define VRD2(i) do{ vlo[i]=vtr(vp_+((((i)>>2)+2)*4096+((i)&3)*1024)); vhi[i]=vtr(vp_+((((i)>>2)+2)*4096+((i)&3)*1024+512)); SBAR(); }while(0)
  #define KRD(G,j) do{ if(G){ kload2(kf,kp0+sl_next,j); SBAR(); } }while(0)
  #define STEP(C0,C1,P0,P1,t,GK,GV,GL) do{ SBAR(); \
    const lds_cptr vp_=vp0+2*sl_prev; \
    VRD(0); SBAR(); float sacc=(P0[0]+P0[1]); \
    GAPA(C0=__builtin_amdgcn_mfma_f32_32x32x16_bf16(kf[0],qr[0],negm,0,0,0), P0[2],P0[3],P0[4],P0[5],     pw0[0]=PKW(P0,0), pw0[1]=PKW(P0,2), pw0); \
    VRD(4); SBAR(); GAPA(C1=__builtin_amdgcn_mfma_f32_32x32x16_bf16(kf[1],qr[0],negm,0,0,0), P0[6],P0[7],P0[8],P0[9],     pw0[2]=PKW(P0,4), pw0[3]=PKW(P0,6), pw0); \
    VRD(1); SBAR(); GAPA(C0=__builtin_amdgcn_mfma_f32_32x32x16_bf16(kf[2],qr[1],C0,0,0,0),   P0[10],P0[11],P0[12],P0[13], pw1[0]=PKW(P0,8), pw1[1]=PKW(P0,10), pw1); \
    VRD(5); SBAR(); GAPA(C1=__builtin_amdgcn_mfma_f32_32x32x16_bf16(kf[3],qr[1],C1,0,0,0),   P0[14],P0[15],P1[0],P1[1],   pw1[2]=PKW(P0,12),pw1[3]=PKW(P0,14), pw1); \
    VRD(2); SBAR(); GAPA(C0=__builtin_amdgcn_mfma_f32_32x32x16_bf16(kf[4],qr[2],C0,0,0,0),   P1[2],P1[3],P1[4],P1[5],     pw2[0]=PKW(P1,0), pw2[1]=PKW(P1,2), pw2); \
    VRD(6); SBAR(); GAPA(C1=__builtin_amdgcn_mfma_f32_32x32x16_bf16(kf[5],qr[2],C1,0,0,0),   P1[6],P1[7],P1[8],P1[9],     pw2[2]=PKW(P1,4), pw2[3]=PKW(P1,6), pw2); \
    VRD(3); SBAR(); GAPA(C0=__builtin_amdgcn_mfma_f32_32x32x16_bf16(kf[6],qr[3],C0,0,0,0),   P1[10],P1[11],P1[12],P1[13], pw3[0]=PKW(P1,8), pw3[1]=PKW(P1,10), pw3); \
    VRD(7); SBAR(); GAPA(C1=__builtin_amdgcn_mfma_f32_32x32x16_bf16(kf[7],qr[3],C1,0,0,0),   P1[14],P1[15],0.f,0.f,       pw3[2]=PKW(P1,12),pw3[3]=PKW(P1,14), pw3); \
    l_reg+=sacc; \
    if(GK){DMA_K((t)+3,sl_cur);} if(GV){DMA_V((t)+1,sl_next);} \
    CMASK(C0,C1,t); \
    { float a=MX3(C0[0],C0[1],C1[0]),b=MX3(C0[2],C0[3],C1[1]); a=MX3(a,C1[2],C1[3]); \
      _Pragma("unroll") for(int r=4;r<16;r+=4){a=MX3(a,C0[r],C0[r+1]);b=MX3(b,C0[r+2],C0[r+3]);a=MX3(a,C1[r],C1[r+1]);b=MX3(b,C1[r+2],C1[r+3]);} \
      float rm=__builtin_fmaxf(a,b); { auto rr=__builtin_amdgcn_permlane32_swap(__float_as_uint(rm),__float_as_uint(rm),false,false); rm=__builtin_fmaxf(__uint_as_float(rr[0]),__uint_as_float(rr[1])); } \
      resc=false; \
      if(__builtin_expect(__any(rm>(float)THRL),0)){ const float dl=__builtin_fmaxf(rm,0.f); mhat+=dl; \
        _Pragma("unroll") for(int r=0;r<16;++r){C0[r]-=dl;C1[r]-=dl;} \
        _Pragma("unroll") for(int r=0;r<16;++r)negm[r]=-mhat; asm volatile("":"+v"(negm)); \
        const float f=__builtin_amdgcn_exp2f(-dl); l_reg*=f; if(hi==0)wsf[r32]=f; resc=true; } } \
    SBAR(); \
    GAPB(o[0]=__builtin_amdgcn_mfma_f32_32x32x16_bf16(PAF(0),VFR(0),o[0],0,0,0), C0,0); VRD2(0); \
    GAPB(o[1]=__builtin_amdgcn_mfma_f32_32x32x16_bf16(PAF(0),VFR(4),o[1],0,0,0), C0,4); VRD2(4); \
    KRD(GL,0); GAPB(o[0]=__builtin_amdgcn_mfma_f32_32x32x16_bf16(PAF(1),VFR(1),o[0],0,0,0), C0,8); VRD2(1); \
    KRD(GL,1); GAPB(o[1]=__builtin_amdgcn_mfma_f32_32x32x16_bf16(PAF(1),VFR(5),o[1],0,0,0), C0,12); VRD2(5); \
    KRD(GL,2); GAPB(o[0]=__builtin_amdgcn_mfma_f32_32x32x16_bf16(PAF(2),VFR(2),o[0],0,0,0), C1,0); VRD2(2); \
    KRD(GL,3); GAPB(o[1]=__builtin_amdgcn_mfma_f32_32x32x16_bf16(PAF(2),VFR(6),o[1],0,0,0), C1,4); VRD2(6); \
    GAPB(o[0]=__builtin_amdgcn_mfma_f32_32x32x16_bf16(PAF(3),VFR(3),o[0],0,0,0), C1,8); VRD2(3); \
    GAPB(o[1]=__builtin_amdgcn_mfma_f32_32x32x16_bf16(PAF(3),VFR(7),o[1],0,0,0), C1,12); VRD2(7); \
    o[2]=__builtin_amdgcn_mfma_f32_32x32x16_bf16(PAF(0),VFR(0),o[2],0,0,0); o[3]=__builtin_amdgcn_mfma_f32_32x32x16_bf16(PAF(0),VFR(4),o[3],0,0,0); SBAR(); \
    o[2]=__builtin_amdgcn_mfma_f32_32x32x16_bf16(PAF(1),VFR(1),o[2],0,0,0); o[3]=__builtin_amdgcn_mfma_f32_32x32x16_bf16(PAF(1),VFR(5),o[3],0,0,0); SBAR(); \
    o[2]=__builtin_amdgcn_mfma_f32_32x32x16_bf16(PAF(2),VFR(2),o[2],0,0,0); o[3]=__builtin_amdgcn_mfma_f32_32x32x16_bf16(PAF(2),VFR(6),o[3],0,0,0); SBAR(); \
    o[2]=__builtin_amdgcn_mfma_f32_32x32x16_bf16(PAF(3),VFR(3),o[2],0,0,0); o[3]=__builtin_amdgcn_mfma_f32_32x32x16_bf16(PAF(3),VFR(7),o[3],0,0,0); SBAR(); \
    }while(0)
  int t=1;
  #undef CMASK
  #define CMASK(P0,P1,t) do{}while(0)
  for(;t+5<NT;t+=2){
    STEP(pB0,pB1,pA0,pA1,t,true,true,true);     WAIT_BAR(3); RESC(); ROT();
    STEP(pA0,pA1,pB0,pB1,t+1,true,true,true);   WAIT_BAR(3); RESC(); ROT();
  }
  #undef CMASK
  #define CMASK(P0,P1,t) do{int jb_=(t)-(NT-4); if(jb_>=0)cmask(P0,P1,jb_,qrel,hi);}while(0)
  #define ENDW(tt) do{ if((tt)+3<NT){WAIT_BAR(3);} else if((tt)+2<NT){WAIT_BAR(2);} else {WAIT_BAR(0);} }while(0)
  for(;t+1<NT;t+=2){
    STEP(pB0,pB1,pA0,pA1,t,(t+3<NT),(t+1<NT),(t+1<NT));       ENDW(t);   RESC(); ROT();
    STEP(pA0,pA1,pB0,pB1,t+1,(t+4<NT),(t+2<NT),(t+2<NT));     ENDW(t+1); RESC(); ROT();
  }
  STEP(pB0,pB1,pA0,pA1,NT-1,false,false,false); RESC();
  { float sacc=pB0[0]+pB0[1]; _Pragma("unroll") for(int r=2;r<16;++r)sacc+=pB0[r]; _Pragma("unroll") for(int r=0;r<16;++r)sacc+=pB1[r]; l_reg+=sacc;
    pw0=(u32x4){PKW(pB0,0),PKW(pB0,2),PKW(pB0,4),PKW(pB0,6)};pw1=(u32x4){PKW(pB0,8),PKW(pB0,10),PKW(pB0,12),PKW(pB0,14)};pw2=(u32x4){PKW(pB1,0),PKW(pB1,2),PKW(pB1,4),PKW(pB1,6)};pw3=(u32x4){PKW(pB1,8),PKW(pB1,10),PKW(pB1,12),PKW(pB1,14)};
    SBAR(); pv(o,vb0+2*sl_cur,PAF(0),PAF(1),PAF(2),PAF(3)); }
  #undef PKW
  #undef PAF
  #undef VFR
  #undef PIN
  #undef MX3
  #undef GAPA
  #undef GAPB
  #undef EX
  #undef VRD
  #undef VRD2
  #undef KRD
  #undef STEP
  #undef ENDW
  {auto rr=__builtin_amdgcn_permlane32_swap(__float_as_uint(l_reg),__float_as_uint(l_reg),false,false);l_reg=__uint_as_float(rr[0])+__uint_as_float(rr[1]);}
  if(hi==0)wsf[32+r32]=l_reg;asm volatile("s_waitcnt lgkmcnt(0)":::"memory");
  float rli[16];
  #pragma unroll
  for(int r=0;r<16;++r)rli[r]=__builtin_amdgcn_rcpf(wsf[32+crow(r,hi)]);
  bf16*Ow=O+(rowbase+q0+wid*QBLK)*DM+ocol;
  { bf16*stg=(bf16*)(shm+LDS_OST)+wid*4096;
    #pragma unroll
    for(int r=0;r<16;++r){const int orow=crow(r,hi);
      #pragma unroll
      for(int d0=0;d0<4;++d0)stg[orow*128+d0*32+r32]=__float2bfloat16(o[d0][r]*rli[r]);}
    asm volatile("s_waitcnt lgkmcnt(0)":::"memory");
    if(O1f==nullptr){
      #pragma unroll
      for(int i=0;i<8;++i){const int row=i*4+(lane>>4),ch=lane&15; const u32x4 v=*(const u32x4*)(stg+row*128+ch*8); ATTN_STORE16(Ow+(long)row*DM+ch*8,v);} }
    else{ const bf16*O1w=O1f+(rowbase+q0+wid*QBLK)*DM+ocol; u32x4 a1[8];
      #pragma unroll
      for(int i=0;i<8;++i){const int row=i*4+(lane>>4),ch=lane&15; a1[i]=*(const u32x4*)(O1w+(long)row*DM+ch*8);}
      #pragma unroll
      for(int i=0;i<8;++i){const int row=i*4+(lane>>4),ch=lane&15; const u32x4 v=*(const u32x4*)(stg+row*128+ch*8); float x[8];
        #pragma unroll
        for(int e=0;e<4;++e){x[2*e]=__uint_as_float(a1[i][e]<<16)-lam*__uint_as_float(v[e]<<16);x[2*e+1]=__uint_as_float(a1[i][e]&0xffff0000u)-lam*__uint_as_float(v[e]&0xffff0000u);}
        float ss=0.f;
        #pragma unroll
        for(int e=0;e<8;++e)ss+=x[e]*x[e];
        ss=::sum16(ss);
        const float rs=rsqrtf(ss*(1.f/128.f)+1e-6f); u32x4 w;
        #pragma unroll
        for(int e=0;e<4;++e)w[e]=cvtpk_s(x[2*e]*rs,x[2*e+1]*rs);
        ATTN_STORE16(Ow+(long)row*DM+ch*8,w);} } }
  asm volatile("s_waitcnt lgkmcnt(0)\n\ts_barrier":::"memory");
  #undef DMA_K
  #undef DMA_V
  #undef CMASK
  #undef START
  #undef RESC
  #undef ROT
}
constexpr int ATTN_LDS_BYTES=LDS_BYTES;
#undef SBAR
#undef WAIT_BAR
}

__device__ __forceinline__ void fstage_attn(const Params& p, int l, char* lds) {
    const int G = gridDim.x, bx = blockIdx.x;
    const int vcu = (G % 8 == 0) ? (bx % 8) * (G / 8) + bx / 8 : bx;
    const attn_body::bf16* Q = (const attn_body::bf16*)(p.ws + WS_QB); const attn_body::bf16* K = (const attn_body::bf16*)(p.ws + WS_KB); const attn_body::bf16* V = (const attn_body::bf16*)(p.ws + WS_VB);
    float lam;
    { const int lane = tid_fresh() & 63; const float* lq = (const float*)p.in[5] + l * 256;
      float d1 = lq[lane] * lq[64 + lane], d2 = lq[128 + lane] * lq[192 + lane];
      d1 = wave_sum(d1); d2 = wave_sum(d2);
      lam = __uint_as_float((unsigned)__builtin_amdgcn_readfirstlane((int)__float_as_uint(expf(d1) - expf(d2) + lam_init_of(l)))); }
    for (int k = vcu; k < 256; k += G) {
        const int s = k & 7, h = (k >> 3) & 3, b = k >> 5;
#pragma unroll 1
        for (int i = 0; i < 4; ++i) {
            const int qb = (i & 2) ? 15 - s : s, m = i & 1;
            attn_body::bf16* O = (attn_body::bf16*)(p.ws + (m == 0 ? WS_O1 : WS_AO));
            const attn_body::bf16* O1f = (m == 0) ? nullptr : (const attn_body::bf16*)(p.ws + WS_O1);
            attn_body::attn_unit<8>(b, (2 * h + m) * 64, (2 * h + m) * 64, h * 128, h * 128, qb, Q, K, V, O, lds, O1f, lam);
        }
    }
}


__device__ __forceinline__ void fstage_sgate(const Params& p, int l, lds_t lds) {
    unsigned char* ws = p.ws;
    const int tid = tid_fresh(), lane = tid & 63, wid = __builtin_amdgcn_readfirstlane(tid >> 6), fr = lane & 15, fq = lane >> 4;
    constexpr int PV = 1056;
    PG8_LAS unsigned char* vn = lds;
    const bf16_t* vin = (const bf16_t*)(ws + WS_VIN); const bf16_t* uin = (const bf16_t*)(ws + WS_UIN); bf16_t* so = (bf16_t*)(ws + WS_SO);
    const float* lng = (const float*)p.in[9] + l * 512; const float* lnb = (const float*)p.in[10] + l * 512; const float* bsp = (const float*)p.in[12] + l * 512;
    const bf16_t* wsm = (const bf16_t*)(ws + WS_WSPT) + (size_t)l * 4 * 16384;
    for (int ch = blockIdx.x; ch < T / 128; ch += gridDim.x) {
        const int t0 = ch * 128;
        __syncthreads();
        {
            u32x4 rw[16];
#pragma unroll
            for (int i = 0; i < 16; ++i) rw[i] = *(const u32x4*)(vin + (size_t)(t0 + wid * 16 + i) * 512 + lane * 8);
            const f32x4 g0 = *(const f32x4*)(lng + lane * 8), g1 = *(const f32x4*)(lng + lane * 8 + 4), b0 = *(const f32x4*)(lnb + lane * 8), b1 = *(const f32x4*)(lnb + lane * 8 + 4);
#pragma unroll
            for (int i = 0; i < 16; ++i) {
                f32x4 a, b; up8(rw[i], a, b);
                const float mu = wave_sum((a[0] + a[1]) + (a[2] + a[3]) + (b[0] + b[1]) + (b[2] + b[3])) * (1.f / 512.f);
                a = a - mu; b = b - mu;
                const float vr = wave_sum((a[0] * a[0] + a[1] * a[1]) + (a[2] * a[2] + a[3] * a[3]) + (b[0] * b[0] + b[1] * b[1]) + (b[2] * b[2] + b[3] * b[3])) * (1.f / 512.f);
                const float rs = rsqrtf(vr + EPS);
                *(PG8_LAS u32x4*)(vn + (wid * 16 + i) * PV + lane * 16) = pk8(a * rs * g0 + b0, b * rs * g1 + b1);
            }
        }
        __syncthreads();
        const int nks = (16 * wid + 16 + 31) >> 5;
        const int trow = t0 + 16 * wid + fr;
#pragma unroll 1
        for (int g = 0; g < 4; ++g) {
            f32x4 acc[8];
#pragma unroll
            for (int nt = 0; nt < 8; ++nt) acc[nt] = (f32x4){0.f, 0.f, 0.f, 0.f};
            const bf16_t* wrow = wsm + ((size_t)g * 128 + 16 * wid + fr) * 128 + fq * 8;
#pragma unroll 1
            for (int ks = 0; ks < nks; ++ks) {
                const bf16x8 af = *(const bf16x8*)(wrow + ks * 32);
                const PG8_LAS unsigned char* vb = vn + (ks * 32 + fq * 8 + (fr >> 2)) * PV + (fr & 3) * 8 + g * 256;
#pragma unroll
                for (int nt = 0; nt < 8; ++nt) {
                    typedef short v4i16s __attribute__((ext_vector_type(4)));
                    const v4i16s lo = __builtin_amdgcn_ds_read_tr16_b64_v4i16((PG8_LAS v4i16s*)(vb + nt * 32)), hi = __builtin_amdgcn_ds_read_tr16_b64_v4i16((PG8_LAS v4i16s*)(vb + nt * 32 + 4 * PV));
                    const bf16x8 bf = (bf16x8){lo[0], lo[1], lo[2], lo[3], hi[0], hi[1], hi[2], hi[3]};
                    acc[nt] = __builtin_amdgcn_mfma_f32_16x16x32_bf16(bf, af, acc[nt], 0, 0, 0);
                }
            }
            const float bs = bsp[g * 128 + 16 * wid + fr];
#pragma unroll
            for (int nt = 0; nt < 8; ++nt) { const size_t o = (size_t)trow * 512 + g * 128 + nt * 16 + fq * 4; st_bf4(so + o, ld_bf4(uin + o) * (acc[nt] + bs)); }
        }
    }
}

__device__ __forceinline__ void stage_pool_d(const Params& p, int bid, int nb) {
    const int tidx = tid_fresh();
    unsigned char* ws = p.ws;
    const unsigned char* pin = ws + WS_PIN; unsigned char* dp = ws + WS_DP;
    for (int i = bid * NT + tidx; i < (T / 8) * 64; i += nb * NT) {
        const int c8 = (i & 63) * 8, t0 = (i >> 6) * 8, s0 = t0 & (S - 1), g = c8 >> 7, w = 2 << g;
        const unsigned ob = (unsigned)(t0 * 512 + c8) * 2u;
        u32x4 pv[16], cv[8];
#pragma unroll
        for (int k = 1; k <= 16; ++k) pv[k - 1] = (k <= w && k <= s0) ? *(const u32x4*)(pin + (ob - (unsigned)k * 1024u)) : (u32x4){0u, 0u, 0u, 0u};
#pragma unroll
        for (int j = 0; j < 8; ++j) cv[j] = *(const u32x4*)(pin + (ob + (unsigned)j * 1024u));
        f32x4 s0v = (f32x4){0.f, 0.f, 0.f, 0.f}, s1v = s0v, a, b;
#pragma unroll
        for (int k = 0; k < 16; ++k) { up8(pv[k], a, b); s0v = s0v + a; s1v = s1v + b; }
#pragma unroll
        for (int j = 0; j < 8; ++j) {
            f32x4 ca, cb; up8(cv[j], ca, cb); s0v = s0v + ca; s1v = s1v + cb;
            u32x4 lv = pv[(15 - j) & 15];
            if (g == 2) lv = pv[7 - j];
            if (g == 1) lv = (j < 4) ? pv[3 - (j & 3)] : cv[(j - 4) & 7];
            if (g == 0) lv = (j < 2) ? pv[1 - (j & 1)] : cv[(j - 2) & 7];
            up8(lv, a, b); s0v = s0v - a; s1v = s1v - b;
            const int sj = s0 + j + 1; const float inv = 1.f / (float)(sj < w ? sj : w);
            *(u32x4*)(dp + (ob + (unsigned)j * 1024u)) = pk8(s0v * inv - ca, s1v * inv - cb);
        }
    }
}
__device__ __forceinline__ void stage_aout(const Params& p, int l, int bid, int nb) {
    const int tidx = tid_fresh();
    unsigned char* ws = p.ws;
    const int lane = tidx & 63, wid = tidx >> 6;
    const float* lq = (const float*)p.in[5] + l * 256;
    float d1 = lq[lane] * lq[64 + lane], d2 = lq[128 + lane] * lq[192 + lane];
    d1 = wave_sum(d1); d2 = wave_sum(d2);
    const float lam = expf(d1) - expf(d2) + lam_init_of(l);
    for (int t = bid * 8 + wid; t < T; t += nb * 8) {
        const u32x4 a = *(const u32x4*)((const bf16_t*)(ws + WS_O1) + (size_t)t * 512 + lane * 8), b = *(const u32x4*)((const bf16_t*)(ws + WS_O2) + (size_t)t * 512 + lane * 8);
        float x[8];
#pragma unroll
        for (int e = 0; e < 4; ++e) { x[2 * e] = __uint_as_float(a[e] << 16) - lam * __uint_as_float(b[e] << 16); x[2 * e + 1] = __uint_as_float(a[e] & 0xffff0000u) - lam * __uint_as_float(b[e] & 0xffff0000u); }
        float ss = 0.f;
#pragma unroll
        for (int e = 0; e < 8; ++e) ss += x[e] * x[e];
        ss = sum16(ss);
        const float rs = rsqrtf(ss * (1.f / 128.f) + EPS);
        u32x4 w;
#pragma unroll
        for (int e = 0; e < 4; ++e) w[e] = pk2(x[2 * e] * rs, x[2 * e + 1] * rs);
        *(u32x4*)((bf16_t*)(ws + WS_AO) + (size_t)t * 512 + lane * 8) = w;
    }
}
__device__ __forceinline__ unsigned key_of(float s, unsigned low) { const unsigned u = __float_as_uint(s); const unsigned k = (u & 0x80000000u) ? ~u : (u | 0x80000000u); return (k & ~255u) | low; }
__device__ __forceinline__ float val_of(unsigned key) { const unsigned k = key & ~255u; const unsigned u = (k & 0x80000000u) ? (k & 0x7fffffffu) : ~k; return __uint_as_float(u); }
__device__ __forceinline__ void sort16_desc(unsigned (&a)[16]) {
#pragma unroll
    for (int k = 2; k <= 16; k <<= 1)
#pragma unroll
        for (int j = k >> 1; j > 0; j >>= 1)
#pragma unroll
            for (int i = 0; i < 16; ++i) { const int l = i ^ j; if (l > i) { const unsigned hi = a[i] > a[l] ? a[i] : a[l], lo = a[i] > a[l] ? a[l] : a[i];
                if ((i & k) == 0) { a[i] = hi; a[l] = lo; } else { a[i] = lo; a[l] = hi; } } }
}
__device__ __forceinline__ void merge_top16(unsigned (&r)[16], const unsigned (&b)[16]) {
#pragma unroll
    for (int i = 0; i < 16; ++i) r[i] = r[i] > b[15 - i] ? r[i] : b[15 - i];
#pragma unroll
    for (int j = 8; j > 0; j >>= 1)
#pragma unroll
        for (int i = 0; i < 16; ++i) { const int l = i ^ j; if (l > i) { const unsigned hi = r[i] > r[l] ? r[i] : r[l], lo = r[i] > r[l] ? r[l] : r[i]; r[i] = hi; r[l] = lo; } }
}
__device__ __forceinline__ constexpr int cand_pair(int q) {
    int c = 0;
    for (int a = 0; a < 16; ++a) for (int b = 0; b < 16; ++b) if ((a + 1) * (b + 1) <= 16) { if (c == q) return a * 16 + b; ++c; }
    return -1;
}
template <class Sched>
__device__ __forceinline__ void topk_local(const Params& p, const Sched& O, lds_t lds) {
    const int tidx = tid_fresh(), lane = tidx & 63, wid = __builtin_amdgcn_readfirstlane(tidx >> 6);
    unsigned char* ws = p.ws;
    const _Float16* sc = (const _Float16*)(ws + WS_SC);
    constexpr int PITCH = 272;
    PG8_LAS unsigned char* st = lds + wid * (64 * PITCH);
#pragma unroll 1
    for (int bi = wid; ; bi += 8) {
        pg8::Unit u; if (!O.next(bi >> 2, u)) break;
        const int t0 = u.pm * 256 + (bi & 3) * 64, head = u.pn;
        unsigned la[16], lb[16], blk[16];
#pragma unroll
        for (int h = 0; h < 2; ++h) {
            unsigned (&top)[16] = h == 0 ? la : lb;
            u32x4 w[16];
#pragma unroll
            for (int q = 0; q < 16; ++q) w[q] = *(const u32x4*)(sc + (size_t)(t0 + 4 * q + (lane >> 4)) * 2048 + head * 256 + h * 128 + (lane & 15) * 8);
#pragma unroll
            for (int q = 0; q < 16; ++q) *(PG8_LAS u32x4*)(st + (4 * q + (lane >> 4)) * PITCH + (lane & 15) * 16) = w[q];
#pragma unroll
            for (int n0 = 0; n0 < 128; n0 += 16) {
                const f16x8 h0 = *(const PG8_LAS f16x8*)(st + lane * PITCH + n0 * 2), h1 = *(const PG8_LAS f16x8*)(st + lane * PITCH + n0 * 2 + 16);
#pragma unroll
                for (int e = 0; e < 8; ++e) { blk[e] = key_of((float)h0[e], 255u - (unsigned)(n0 + e)); blk[8 + e] = key_of((float)h1[e], 255u - (unsigned)(n0 + 8 + e)); }
                sort16_desc(blk);
                if (n0 == 0) {
#pragma unroll
                    for (int e = 0; e < 16; ++e) top[e] = blk[e];
                } else merge_top16(top, blk);
            }
        }
        const int i = (t0 + lane) * 8 + head;
        float sa[16], sb[16];
#pragma unroll
        for (int j = 0; j < 16; ++j) { sa[j] = val_of(la[j]); sb[j] = val_of(lb[j]); }
        unsigned lc[16];
#pragma unroll
        for (int q0 = 0; q0 < 64; q0 += 16) {
#pragma unroll
            for (int e = 0; e < 16; ++e) { const int ab = cand_pair(q0 + e); blk[e] = (ab >= 0) ? key_of(sa[ab >= 0 ? (ab >> 4) : 0] + sb[ab >= 0 ? (ab & 15) : 0], 255u - (unsigned)(ab >= 0 ? ab : 0)) : 0u; }
            sort16_desc(blk);
            if (q0 == 0) {
#pragma unroll
                for (int e = 0; e < 16; ++e) lc[e] = blk[e];
            } else merge_top16(lc, blk);
        }
        float g[16]; const float mx = val_of(lc[0]); float sum = 0.f;
#pragma unroll
        for (int j = 0; j < 16; ++j) { g[j] = __expf(val_of(lc[j]) - mx); sum += g[j]; }
        const float inv = 1.f / sum;
        int* ti = (int*)(ws + WS_TI) + (size_t)i * 16;
        int eo[16];
#pragma unroll
        for (int j = 0; j < 16; ++j) {
            const int c = 255 - (int)(lc[j] & 255u), a = c >> 4, b = c & 15;
            unsigned ka = la[0], kb = lb[0];
#pragma unroll
            for (int q = 1; q < 16; ++q) { ka = (a == q) ? la[q] : ka; kb = (b == q) ? lb[q] : kb; }
            const _Float16 gh = (_Float16)(g[j] * inv);
            eo[j] = ((255 - (int)(ka & 255u)) * 128 + (255 - (int)(kb & 255u))) | ((int)__builtin_bit_cast(unsigned short, gh) << 16);
        }
#pragma unroll
        for (int j = 0; j < 16; j += 4) *(int __attribute__((ext_vector_type(4)))*)(ti + j) = (int __attribute__((ext_vector_type(4)))){eo[j], eo[j + 1], eo[j + 2], eo[j + 3]};
    }
}
__device__ __forceinline__ void fstage_pscore(const Params& p, int l, lds_t lds, int bid, int nb) {
    pg8::Order O; O.init(T, 2048, nb, bid, p.ws + WS_XB, D, p.ws + WS_SKT + (size_t)l * 2048 * D * 2, D);
    pg8::gemm_phase<GEpiScaleF16, pg8::Order, true>(lds, D, D, D, O, GEpiScaleF16{p.ws, (_Float16*)(p.ws + WS_SC), 2048});
    topk_local(p, O, lds);
}
#define XB_TMO      128
#define XB_XCNT(j)  (256  + 64 * (j))
#define XB_XSUB(j)  (1280 + 64 * (j))
#define XB_XGEN(j)  (2304 + 64 * (j))
#define XB_TOP      3328
#define XB_TOPGEN   3392
#define XCD_BAR_WORDS 3456
#define XB_SPIN_CAP (1u << 18)
#define LAS __attribute__((address_space(3)))

__device__ __forceinline__ unsigned xb_ld(unsigned* p)              { return __hip_atomic_load(p, __ATOMIC_RELAXED, __HIP_MEMORY_SCOPE_AGENT); }
__device__ __forceinline__ unsigned xb_add(unsigned* p, unsigned v) { return __hip_atomic_fetch_add(p, v, __ATOMIC_RELAXED, __HIP_MEMORY_SCOPE_AGENT); }
__device__ __forceinline__ unsigned xb_xcc_id() { return (unsigned)__builtin_amdgcn_s_getreg((3 << 11) | 20) & 0xFu; }
#define XB_SPIN(cond, bar) do { unsigned _sp = 0; while (cond) { __builtin_amdgcn_s_sleep(1); \
    if ((++_sp & 255u) == 0u) { if (xb_ld(&(bar)[XB_TMO])) break; if (_sp > XB_SPIN_CAP) { atomicAdd(&(bar)[XB_TMO], 1u); break; } } } } while (0)

struct XcdBarrier {
    unsigned* bar; unsigned x;
    volatile LAS unsigned* st;
};

__device__ __forceinline__ XcdBarrier xcd_barrier_post(unsigned* bar, volatile LAS unsigned* st) {
    XcdBarrier b; b.bar = bar; b.x = xb_xcc_id(); b.st = st;
    if (tid_fresh() == 0) (void)xb_add(&bar[XB_XCNT(b.x)], 1u);
    return b;
}
__device__ __forceinline__ void xcd_barrier_complete(unsigned* bar, unsigned x, unsigned& nloc, unsigned& nx) {
    const unsigned G = gridDim.x * gridDim.y * gridDim.z;
    unsigned sum, cnt, mine, sp = 0u;
    for (;;) {
        sum = 0u; cnt = 0u; mine = 0u;
#pragma unroll
        for (unsigned j = 0; j < 16; ++j) { const unsigned c = xb_ld(&bar[XB_XCNT(j)]); sum += c; cnt += (c > 0u) ? 1u : 0u; mine = (j == x) ? c : mine; }
        if (sum == G) break;
        __builtin_amdgcn_s_sleep(1);
        if ((++sp & 255u) == 0u) { if (xb_ld(&bar[XB_TMO])) break; if (sp > XB_SPIN_CAP) { atomicAdd(&bar[XB_TMO], 1u); break; } }
    }
    nloc = mine > 0u ? mine : 1u; nx = cnt > 0u ? cnt : 1u;
}

__device__ __forceinline__ void xcd_barrier(const XcdBarrier& b) {
    asm volatile("s_waitcnt vmcnt(0)" ::: "memory");
    __syncthreads();
    if (tid_fresh() == 0) {
        unsigned* bar = b.bar;
        __builtin_amdgcn_s_waitcnt(0);
        unsigned nloc = b.st[0], nx = b.st[1];
        if (nloc == 0u) { xcd_barrier_complete(bar, b.x, nloc, nx); b.st[0] = nloc; b.st[1] = nx; }
        const unsigned old = xb_add(&bar[XB_XSUB(b.x)], 1u);
        const unsigned gen = old / nloc;
        if (old + 1u == (gen + 1u) * nloc) {
            __builtin_amdgcn_fence(__ATOMIC_RELEASE, "agent");
            asm volatile("s_waitcnt vmcnt(0)" ::: "memory");
            const unsigned og = xb_add(&bar[XB_TOP], 1u);
            const unsigned tg = og / nx;
            if (og + 1u == (tg + 1u) * nx) xb_add(&bar[XB_TOPGEN], 1u);
            else XB_SPIN(xb_ld(&bar[XB_TOPGEN]) == tg, bar);
            __builtin_amdgcn_fence(__ATOMIC_ACQUIRE, "agent");
            xb_add(&bar[XB_XGEN(b.x)], 1u);
            asm volatile("s_waitcnt vmcnt(0)" ::: "memory");
        } else {
            XB_SPIN(xb_ld(&bar[XB_XGEN(b.x)]) == gen, bar);
            __builtin_amdgcn_fence(__ATOMIC_ACQUIRE, "agent");
            asm volatile("s_waitcnt vmcnt(0)" ::: "memory");
        }
    }
    __syncthreads();
}


constexpr int PQ_CH = 16, PQ_NCH = T / PQ_CH;
constexpr int CW_PQ = 16384;
constexpr size_t CTL_ZERO_BYTES = 131072;
__device__ __forceinline__ unsigned pq_pull(unsigned* head, int lane) {
    unsigned c = 0; if (lane == 0) c = __hip_atomic_fetch_add(head, 1u, __ATOMIC_RELAXED, __HIP_MEMORY_SCOPE_AGENT);
    return (unsigned)__builtin_amdgcn_readfirstlane((int)c);
}
__device__ __forceinline__ f32x2 gelu_pk(f32x2 v) {
    const f32x2 av = __builtin_elementwise_abs(v), d = av * 0.2316418882f + 1.0f;
    f32x2 t; t.x = __builtin_amdgcn_rcpf(d.x); t.y = __builtin_amdgcn_rcpf(d.y);
    f32x2 q = t * 0.5307027145f + (-0.7265760135f); q = q * t + 0.7107068705f; q = q * t + (-0.142248368f); q = q * t + 0.127414796f; q = q * t;
    const f32x2 s = (v * v) * (-0.72134752044f);
    f32x2 e; e.x = __builtin_amdgcn_exp2f(s.x); e.y = __builtin_amdgcn_exp2f(s.y);
    const f32x2 m = v * (q * e), r = v - m;
    f32x2 o; o.x = v.x < 0.f ? m.x : r.x; o.y = v.y < 0.f ? m.y : r.y; return o;
}
__device__ __forceinline__ float gelu_erf(float d) { return 0.5f * d * (1.f + erff(d * 0.70710678118654752f)); }

constexpr unsigned ENT_INVALID = 0xffffffffu;
typedef long i64x2 __attribute__((ext_vector_type(2)));
__device__ __forceinline__ void fstage_peer_u(const Params& p, int l, int qsel, lds_t lds, unsigned imask = 16383u, size_t aoff = 0, bool skipg = false) {
    unsigned char* ws = p.ws;
    const int tid = tid_fresh(), lane = tid & 63, wid = __builtin_amdgcn_readfirstlane(tid >> 6), n = lane & 15, kq = lane >> 4;
    const unsigned char* u8 = ws + WS_U8 + (size_t)l * NEXP * D;
    unsigned* heads = (unsigned*)(ws + WS_CTL) + CW_PQ + ((qsel * 2 + 0) * 8) * 64;
    const int myx = (int)(xb_xcc_id() & 7u);
    float* Aout = (float*)(ws + WS_PA + aoff);
    constexpr int RB_BYTES = 16 * 1024, LIST_MAX = 400, WREG = RB_BYTES + (LIST_MAX + 16) * 8;
    PG8_LAS unsigned char* rbuf = lds + wid * WREG;
    PG8_LAS unsigned* ent = (PG8_LAS unsigned*)(rbuf + RB_BYTES);
    PG8_LAS float* gl = (PG8_LAS float*)(rbuf + RB_BYTES + (LIST_MAX + 16) * 4);
#pragma unroll 1
    for (int s8 = 0; s8 < 8; ++s8) {
        const int k = (myx + s8) & 7;
        unsigned c = pq_pull(heads + k * 64, lane);
#pragma unroll 1
        for (;;) {
            if (c >= (unsigned)PQ_NCH) break;
            const int t0 = (int)c * PQ_CH;
            unsigned c_next = c; bool pulled = false;
            int mxs = 0x7f7f7f7f; asm volatile("" : "+v"(mxs));
            pg8::i32x8_t xf8[8];
            { const unsigned char* xp = ws + WS_XQ8 + (size_t)(t0 + n) * D + kq * 16;
#pragma unroll
              for (int i = 0; i < 8; ++i) { const pg8::i32x4_t lo = *(const pg8::i32x4_t*)(xp + (2 * i) * 64), hi = *(const pg8::i32x4_t*)(xp + (2 * i + 1) * 64); xf8[i] = __builtin_shufflevector(lo, hi, 0, 1, 2, 3, 4, 5, 6, 7); } }
            const float rs = row_rstd((const float*)(ws + WS_SSP), t0 + n) * (1.f / (SU * XS));
            float* ao = Aout + (size_t)(t0 + n) * 128;
            int i_next = 0;
#pragma unroll 1
            while (i_next < 16) {
                int e0v[16], e1v[16];
                { const int* ti = (const int*)(ws + WS_TI) + (size_t)t0 * 128;
#pragma unroll
                  for (int i = 0; i < 16; ++i) { e0v[i] = ti[i * 128 + lane]; e1v[i] = ti[i * 128 + 64 + lane]; } }
                int cnt = 0; int i_end = 16;
#pragma unroll
                for (int i = 0; i < 16; ++i) {
                    if (i >= i_next && i < i_end) {
                        if (cnt > LIST_MAX - 128) { i_end = i; }
                        else {
                            const int e0 = e0v[i] & 16383, e1 = e1v[i] & 16383;
                            const bool s0 = (e0 >> 11) == k, s1 = (e1 >> 11) == k;
                            const unsigned long long m0 = __ballot(s0), m1 = __ballot(s1);
                            const int b0 = (int)__builtin_amdgcn_mbcnt_hi((unsigned)(m0 >> 32), __builtin_amdgcn_mbcnt_lo((unsigned)m0, 0u));
                            const int b1 = (int)__builtin_amdgcn_mbcnt_hi((unsigned)(m1 >> 32), __builtin_amdgcn_mbcnt_lo((unsigned)m1, 0u));
                            const int c0 = __builtin_popcountll(m0);
                            if (s0) { ent[cnt + b0] = ((unsigned)i << 21) | ((unsigned)lane << 14) | (unsigned)e0; gl[cnt + b0] = (float)__builtin_bit_cast(_Float16, (unsigned short)((unsigned)e0v[i] >> 16)); }
                            if (s1) { ent[cnt + c0 + b1] = ((unsigned)i << 21) | ((unsigned)(64 + lane) << 14) | (unsigned)e1; gl[cnt + c0 + b1] = (float)__builtin_bit_cast(_Float16, (unsigned short)((unsigned)e1v[i] >> 16)); }
                            cnt += c0 + __builtin_popcountll(m1);
                        }
                    }
                }
                i_next = i_end;
                if (cnt == 0) continue;
                if (lane < 16) ent[cnt + lane] = ENT_INVALID;
                const int ng = skipg ? 0 : ((cnt + 15) >> 4);
                u32x4 W[16];
#define PU_LOAD(g_) do { const PG8_LAS u32x4* ep_ = (const PG8_LAS u32x4*)(ent + (g_) * 16); const u32x4 q0_ = ep_[0], q1_ = ep_[1], q2_ = ep_[2], q3_ = ep_[3]; \
                    _Pragma("unroll") for (int q = 0; q < 16; ++q) { const unsigned e_ = (q < 4) ? q0_[q & 3] : (q < 8) ? q1_[q & 3] : (q < 12) ? q2_[q & 3] : q3_[q & 3]; \
                        const unsigned iq_ = (e_ == ENT_INVALID) ? 0u : (e_ & imask); W[q] = *(const u32x4*)(u8 + (size_t)iq_ * D + lane * 16); } } while (0)
                if (!pulled) { pulled = true; c_next = pq_pull(heads + k * 64, lane); }
                if (ng > 0) PU_LOAD(0);
#pragma unroll 1
                for (int g = 0; g < ng; ++g) {
#pragma unroll
                    for (int q = 0; q < 16; ++q) *(PG8_LAS u32x4*)(rbuf + q * 1024 + ((lane ^ q) * 16)) = W[q];
                    if (g + 1 < ng) PU_LOAD(g + 1);
                    f32x4 acc;
                    const PG8_LAS unsigned char* fp = rbuf + n * 1024;
#pragma unroll
                    for (int Lb = 0; Lb < 16; Lb += 4) {
                        pg8::i32x4_t fa[4];
#pragma unroll
                        for (int L = 0; L < 4; ++L) fa[L] = *(const PG8_LAS pg8::i32x4_t*)(fp + ((((Lb + L) * 4 + kq) ^ n) * 16));
                        __builtin_amdgcn_sched_barrier(0);
                        const pg8::i32x8_t a0 = __builtin_shufflevector(fa[0], fa[1], 0, 1, 2, 3, 4, 5, 6, 7), a1 = __builtin_shufflevector(fa[2], fa[3], 0, 1, 2, 3, 4, 5, 6, 7);
                        if (Lb == 0) asm volatile("v_mfma_scale_f32_16x16x128_f8f6f4 %0, %1, %2, 0, %3, %3 op_sel_hi:[0,0,0]" : "=v"(acc) : "v"(a0), "v"(xf8[0]), "v"(mxs));
                        else asm volatile("v_mfma_scale_f32_16x16x128_f8f6f4 %0, %1, %2, %0, %3, %3 op_sel_hi:[0,0,0]" : "+v"(acc) : "v"(a0), "v"(xf8[Lb >> 1]), "v"(mxs));
                        asm volatile("v_mfma_scale_f32_16x16x128_f8f6f4 %0, %1, %2, %0, %3, %3 op_sel_hi:[0,0,0]" : "+v"(acc) : "v"(a1), "v"(xf8[(Lb >> 1) + 1]), "v"(mxs));
                        __builtin_amdgcn_sched_barrier(0);
                    }
                    asm volatile("s_nop 15\n\ts_nop 7" : "+v"(acc) :: "memory");
                    {
                        const u32x4 e4 = *(const PG8_LAS u32x4*)(ent + g * 16 + 4 * kq); const f32x4 g4 = *(const PG8_LAS f32x4*)(gl + g * 16 + 4 * kq);
#pragma unroll
                        for (int r = 0; r < 4; r += 2) { const f32x2 ge = gelu_pk((f32x2){acc[r] * rs, acc[r + 1] * rs});
                            if (e4[r] != ENT_INVALID && (int)(e4[r] >> 21) == n) ao[(e4[r] >> 14) & 127u] = ge.x * g4[r];
                            if (e4[r + 1] != ENT_INVALID && (int)(e4[r + 1] >> 21) == n) ao[(e4[r + 1] >> 14) & 127u] = ge.y * g4[r + 1]; }
                    }
                }
#undef PU_LOAD
            }
            if (!pulled) c_next = pq_pull(heads + k * 64, lane);
            c = c_next;
        }
    }
}

constexpr float AS = 32.f;
__device__ __forceinline__ void tr4x4(unsigned a, unsigned b, unsigned c, unsigned d, unsigned& o0, unsigned& o1, unsigned& o2, unsigned& o3) {
    const unsigned p0 = __builtin_amdgcn_perm(b, a, 0x05010400u), p1 = __builtin_amdgcn_perm(b, a, 0x07030602u), p2 = __builtin_amdgcn_perm(d, c, 0x05010400u), p3 = __builtin_amdgcn_perm(d, c, 0x07030602u);
    o0 = __builtin_amdgcn_perm(p2, p0, 0x05040100u); o1 = __builtin_amdgcn_perm(p2, p0, 0x07060302u); o2 = __builtin_amdgcn_perm(p3, p1, 0x05040100u); o3 = __builtin_amdgcn_perm(p3, p1, 0x07060302u);
}
__device__ __forceinline__ void fstage_peer_v(const Params& p, int l, int qsel, bool dry, lds_t lds, int imask = 16383) {
    unsigned char* ws = p.ws;
    const int tid = tid_fresh(), lane = tid & 63, wid = __builtin_amdgcn_readfirstlane(tid >> 6), n = lane & 15, kq = lane >> 4, n8 = n & 7, h = n >> 3;
    const unsigned char* v8 = ws + WS_V8 + (size_t)l * NEXP * D;
    unsigned* heads = (unsigned*)(ws + WS_CTL) + CW_PQ + ((qsel * 2 + 1) * 8) * 64;
    const int myx = (int)(xb_xcc_id() & 7u);
    PG8_LAS int* til = (PG8_LAS int*)(lds + wid * 8192);
#pragma unroll 1
    for (int s8 = 0; s8 < 8; ++s8) {
        const int k = (myx + s8) & 7;
#pragma unroll 1
        for (;;) {
            const unsigned c = pq_pull(heads + k * 64, lane);
            if (c >= (unsigned)PQ_NCH) break;
            const int t0 = (int)c * PQ_CH;
            unsigned koff = (unsigned)n8 * 16u; asm volatile("" : "+v"(koff));
            const unsigned char* vb = v8 + (size_t)k * NEXP * 128;
            { const int* ti = (const int*)(ws + WS_TI) + (size_t)t0 * 128; int ev[32];
#pragma unroll
              for (int i = 0; i < 32; ++i) ev[i] = ti[i * 64 + lane];
#pragma unroll
              for (int i = 0; i < 32; ++i) til[i * 64 + lane] = ev[i] & (imask & 16383); }
            u32x4 R[4][8];
            typedef int i32x4 __attribute__((ext_vector_type(4)));
#define PV_ISSUE(b, slot) do { const PG8_LAS i32x4* ip_ = (const PG8_LAS i32x4*)(til + ((b) >> 1) * 128 + ((b) & 1) * 64 + h * 32 + kq * 8); const i32x4 i0_ = ip_[0], i1_ = ip_[1]; \
                _Pragma("unroll") for (int e_ = 0; e_ < 4; ++e_) { R[slot][e_] = *(const u32x4*)(vb + ((unsigned)i0_[e_] * 128u + koff)); R[slot][4 + e_] = *(const u32x4*)(vb + ((unsigned)i1_[e_] * 128u + koff)); } } while (0)
#define PV_COMPUTE(tok8, aq, slot) do { const long aop_ = ((n >> 1) == (tok8)) ? (aq) : 0l; \
                _Pragma("unroll") for (int c_ = 0; c_ < 4; ++c_) { unsigned lo_[4], hi_[4]; \
                    tr4x4(R[slot][0][c_], R[slot][1][c_], R[slot][2][c_], R[slot][3][c_], lo_[0], lo_[1], lo_[2], lo_[3]); \
                    tr4x4(R[slot][4][c_], R[slot][5][c_], R[slot][6][c_], R[slot][7][c_], hi_[0], hi_[1], hi_[2], hi_[3]); \
                    _Pragma("unroll") for (int j_ = 0; j_ < 4; ++j_) { const long b_ = (long)(((unsigned long)hi_[j_] << 32) | (unsigned long)lo_[j_]); \
                        acc[4 * c_ + j_] = __builtin_amdgcn_mfma_f32_16x16x32_fp8_fp8(aop_, b_, acc[4 * c_ + j_], 0, 0, 0); } } } while (0)
#pragma unroll
            for (int b = 0; b < 3; ++b) PV_ISSUE(b, b);
#pragma unroll 1
            for (int ps = 0; ps < 2; ++ps) {
                f32x4 acc[16];
#pragma unroll
                for (int j = 0; j < 16; ++j) acc[j] = (f32x4){0.f, 0.f, 0.f, 0.f};
                long aq0, aq1;
                { const float* ap = (const float*)(ws + WS_PA) + (size_t)(t0 + ps * 8 + (n >> 1)) * 128 + (n & 1) * 32 + kq * 8;
                  const f32x4 a0 = *(const f32x4*)ap, a1 = *(const f32x4*)(ap + 4), a2 = *(const f32x4*)(ap + 64), a3 = *(const f32x4*)(ap + 68);
                  int w0 = __builtin_amdgcn_cvt_pk_fp8_f32(a0[0] * AS, a0[1] * AS, 0, false); w0 = __builtin_amdgcn_cvt_pk_fp8_f32(a0[2] * AS, a0[3] * AS, w0, true);
                  int w1 = __builtin_amdgcn_cvt_pk_fp8_f32(a1[0] * AS, a1[1] * AS, 0, false); w1 = __builtin_amdgcn_cvt_pk_fp8_f32(a1[2] * AS, a1[3] * AS, w1, true);
                  int w2 = __builtin_amdgcn_cvt_pk_fp8_f32(a2[0] * AS, a2[1] * AS, 0, false); w2 = __builtin_amdgcn_cvt_pk_fp8_f32(a2[2] * AS, a2[3] * AS, w2, true);
                  int w3 = __builtin_amdgcn_cvt_pk_fp8_f32(a3[0] * AS, a3[1] * AS, 0, false); w3 = __builtin_amdgcn_cvt_pk_fp8_f32(a3[2] * AS, a3[3] * AS, w3, true);
                  aq0 = (long)(((unsigned long)(unsigned)w1 << 32) | (unsigned long)(unsigned)w0); aq1 = (long)(((unsigned long)(unsigned)w3 << 32) | (unsigned long)(unsigned)w2); }
#pragma unroll 1
                for (int b0 = 0; b0 < 16; b0 += 4) {
#pragma unroll
                    for (int s = 0; s < 4; ++s) {
                        const int bn = ps * 16 + b0 + s + 3;
                        if (bn < 32) PV_ISSUE(bn, (s + 3) & 3);
                        PV_COMPUTE((b0 + s) >> 1, (s & 1) ? aq1 : aq0, s);
                    }
                }
                int n8e = n8, kqe = kq; asm volatile("" : "+v"(n8e), "+v"(kqe));
                const int t = t0 + ps * 8 + 2 * kqe + h;
                float o[16];
#pragma unroll
                for (int j = 0; j < 16; ++j) { const float send = h ? acc[j][1] : acc[j][2]; const float recv = dppf<DPP_X8>(send); o[j] = (h ? acc[j][3] : acc[j][0]) + recv; }
                bf16_t* xr = (bf16_t*)(ws + WS_XB) + (size_t)t * D + k * 128 + n8e * 16;
                const float sc = 1.f / (SV * AS);
                float ss = 0.f;
#pragma unroll
                for (int g = 0; g < 2; ++g) {
                    f32x4 v0, v1; up8(*(const u32x4*)(xr + g * 8), v0, v1);
                    v0[0] += o[8 * g + 0] * sc; v0[1] += o[8 * g + 1] * sc; v0[2] += o[8 * g + 2] * sc; v0[3] += o[8 * g + 3] * sc;
                    v1[0] += o[8 * g + 4] * sc; v1[1] += o[8 * g + 5] * sc; v1[2] += o[8 * g + 6] * sc; v1[3] += o[8 * g + 7] * sc;
                    const u32x4 wq = pk8(v0, v1); up8(wq, v0, v1);
                    if (!dry) { *(u32x4*)(xr + g * 8) = wq; *(u32x2*)(ws + WS_XQ8 + (size_t)t * D + k * 128 + n8e * 16 + g * 8) = pk8_fp8(v0, v1, XS); }
                    ss += (v0[0] * v0[0] + v0[1] * v0[1]) + (v0[2] * v0[2] + v0[3] * v0[3]) + (v1[0] * v1[0] + v1[1] * v1[1]) + (v1[2] * v1[2] + v1[3] * v1[3]);
                }
                ss += dppf<DPP_X1>(ss); ss += dppf<DPP_X2>(ss); ss += dppf<DPP_HMIR>(ss);
                if (n8e < 2 && !dry) ((float*)(ws + WS_SSP))[(size_t)t * 16 + 2 * k + n8e] = (n8e == 0) ? ss : 0.f;
            }
#undef PV_ISSUE
#undef PV_COMPUTE
        }
    }
}
__device__ __forceinline__ void fstage_final_norm(const Params& p) {
    const int tid = tid_fresh(), lane = tid & 63, wid = tid >> 6;
    const float* gfin = (const float*)p.in[25];
    for (int t = blockIdx.x * 8 + wid; t < T; t += gridDim.x * 8) {
        const float r = row_rstd((const float*)(p.ws + WS_SSP), t);
        const bf16_t* xr = (const bf16_t*)(p.ws + WS_XB) + (size_t)t * D; float* o = p.out + (size_t)t * D;
#pragma unroll
        for (int i = 0; i < 2; ++i) { f32x4 a, b; up8(*(const u32x4*)(xr + (lane + 64 * i) * 8), a, b);
            const f32x4 g0 = *(const f32x4*)(gfin + (lane + 64 * i) * 8), g1 = *(const f32x4*)(gfin + (lane + 64 * i) * 8 + 4);
            *(f32x4*)(o + (lane + 64 * i) * 8) = a * r * g0; *(f32x4*)(o + (lane + 64 * i) * 8 + 4) = b * r * g1; }
    }
}

extern __shared__ __attribute__((aligned(16))) unsigned char dyn_lds[];
constexpr int LDS_BYTES = 163840;
constexpr int LDS_BARW = LDS_BYTES - 64;

__device__ __forceinline__ Params ldp() {
    Params r;
#if defined(__HIP_DEVICE_COMPILE__)
    const __attribute__((address_space(4))) unsigned long long* k = (const __attribute__((address_space(4))) unsigned long long*)__builtin_amdgcn_kernarg_segment_ptr();
    asm volatile("" : "+s"(k));
#pragma unroll
    for (int i = 0; i < 26; ++i) r.in[i] = (const void*)(const __attribute__((address_space(1))) void*)k[i];
    r.out = (float*)(__attribute__((address_space(1))) float*)k[26]; r.ws = (unsigned char*)(__attribute__((address_space(1))) unsigned char*)k[27];
#endif
    return r;
}
__device__ __forceinline__ int rep_of(int k) { int n = (PROBE == k) ? 2 : 1; asm volatile("" : "+s"(n)); return n; }
#if PROBE == 0
#define REP(k) for (int r_ = 0, n_ = 1; r_ < 1; ++r_)
#else
#define REP(k) for (int r_ = 0, n_ = rep_of(k); r_ < n_; ++r_)
#endif
#define PH(call) do { const Params q = ldp(); int bid = bid0, nb = nb0, l = l0; asm volatile("" : "+s"(bid), "+s"(nb), "+s"(l)); (void)l; call; } while (0)
__global__ void __launch_bounds__(NT, 2) mega(Params p_unused) {
    const int bid0 = blockIdx.x, nb0 = gridDim.x; int l0 = 0;
    float* lds = (float*)dyn_lds; const lds_t ldsp = (lds_t)dyn_lds;
    { const int w0_ = __builtin_amdgcn_readfirstlane((int)(threadIdx.x >> 6)); asm volatile("s_mov_b32 m0, %0" :: "s"(w0_)); }
    if (tid_fresh() == 0) *(uint4*)(dyn_lds + LDS_BARW) = make_uint4(0u, 0u, 0u, 0u);
    __syncthreads();
    { const Params q = ldp(); (void)xcd_barrier_post((unsigned*)(q.ws + WS_CTL), (volatile LAS unsigned*)(dyn_lds + LDS_BARW)); }
#define GRID_BAR() do { const Params q = ldp(); XcdBarrier b_; b_.bar = (unsigned*)(q.ws + WS_CTL); b_.x = xb_xcc_id(); b_.st = (volatile LAS unsigned*)(dyn_lds + LDS_BARW); xcd_barrier(b_); if (PROBE == 20) xcd_barrier(b_); } while (0)
    REP(1) { PH(stage_prologue0(q, bid, nb, lds)); GRID_BAR(); }
    REP(2) { PH(stage_prologue1(q, bid, nb)); PH(fstage_kv(q, ldsp, bid, nb)); GRID_BAR();
    PH(fstage_g(q, ldsp, bid, nb)); PH(fstage_y(q, ldsp, bid, nb));     GRID_BAR(); }

#pragma unroll 1
    for (l0 = 0; l0 < L; ++l0) {
        REP(9) { PH(fstage_win(q, l, ldsp, bid, nb)); GRID_BAR(); }
        REP(7) { PH(fstage_attn(q, l, (char*)dyn_lds)); } REP(4) { PH(stage_pool_d(q, bid, nb)); PH(fstage_sgate(q, l, ldsp)); } GRID_BAR();
#if PROBE == 21
        PH(fstage_branch<false>(q, l, ldsp, bid, nb)); GRID_BAR();
#endif
        REP(10) { PH(fstage_branch(q, l, ldsp, bid, nb)); GRID_BAR(); }
        PH(fstage_resid_out(q, l, ldsp, bid, nb)); GRID_BAR();
        REP(11) { PH(fstage_xscore(q, l, ldsp, bid, nb)); GRID_BAR(); }
        PH(fstage_resid_cross(q, l, ldsp, bid, nb)); GRID_BAR();
        REP(12) { PH(fstage_pscore(q, l, ldsp, bid, nb)); GRID_BAR(); }
        REP(13) { PH(fstage_peer_u(q, l, l + 4 * r_, ldsp)); GRID_BAR(); }
#if PROBE == 15
        PH(fstage_peer_u(q, l, l + 4, ldsp, 255u, 16 * MiB)); GRID_BAR();
#endif
#if PROBE == 17
        { int sk_ = 1; asm volatile("" : "+s"(sk_)); PH(fstage_peer_u(q, l, l + 4, ldsp, 16383u, 16 * MiB, sk_ != 0)); GRID_BAR(); }
#endif
        REP(14) { bool dry_ = (r_ == 0 && n_ == 2); PH(fstage_peer_v(q, l, l + 4 * r_, dry_, ldsp)); GRID_BAR(); }
#if PROBE == 16
        PH(fstage_peer_v(q, l, l + 4, true, ldsp, 255)); GRID_BAR();
#endif
    }
    PH(fstage_final_norm(q));
}

extern "C" void kernel_launch(void* const* d_in, const int* in_sizes, int n_in, void* d_out, int out_size, void* d_ws, size_t ws_size, hipStream_t stream) {
    Params p{};
    for (int i = 0; i < 26; ++i) p.in[i] = d_in[i];
    p.out = (float*)d_out; p.ws = (unsigned char*)d_ws;
    static int grid = 0;
    if (!grid) {
        int dev = 0, cus = 0, per_cu = 0;
        (void)hipGetDevice(&dev);
        (void)hipDeviceGetAttribute(&cus, hipDeviceAttributeMultiprocessorCount, dev);
        (void)hipFuncSetAttribute((const void*)mega, hipFuncAttributeMaxDynamicSharedMemorySize, LDS_BYTES);
        (void)hipOccupancyMaxActiveBlocksPerMultiprocessor(&per_cu, mega, NT, LDS_BYTES);
        grid = cus * (per_cu < 1 ? per_cu : 1);
    }
    (void)hipMemsetAsync(p.ws + WS_CTL, 0, CTL_ZERO_BYTES, stream);
    mega<<<grid, NT, LDS_BYTES, stream>>>(p);
}
```

```cpp
#include <hip/hip_runtime.h>
#ifndef PROBE
#define PROBE 0
#endif
#include <stdint.h>
#include <math.h>

typedef unsigned short bf16_t;
typedef short bf16x8 __attribute__((ext_vector_type(8)));
typedef float f32x4 __attribute__((ext_vector_type(4)));
typedef float f32x2 __attribute__((ext_vector_type(2)));
typedef unsigned u32x4 __attribute__((ext_vector_type(4)));
typedef unsigned u32x2 __attribute__((ext_vector_type(2)));

constexpr int D = 1024, NB = 8, S = 4096, T = NB * S, L = 4, MEM = 256, MROWS = NB * MEM;
constexpr int INW = 6144, NEXP = 16384;
constexpr float EPS = 1e-6f;
constexpr float C2 = 0.125f * 1.4426950408889634f;
constexpr float SU = 256.f, SV = 32.f;
constexpr float XS = 8.f;
constexpr float W8S = 256.f;
constexpr float GS = 16.f, YS = 16.f, PS = 256.f;
constexpr int NT = 512;

constexpr size_t MiB = 1u << 20;
constexpr size_t WS_CTL = 0, WS_ROPE = 1 * MiB, WS_SSP = 3 * MiB, WS_WSPT = 5 * MiB, WS_RSTDM = 6 * MiB, WS_WPOOLS = 7 * MiB, WS_KEYSB = 8 * MiB;
constexpr size_t WS_WIN = 10 * MiB, WS_WB0 = 58 * MiB, WS_WEFF = 62 * MiB, WS_WB2 = 66 * MiB, WS_WOUT = 70 * MiB, WS_GT = 78 * MiB, WS_YT = 142 * MiB;
constexpr size_t WS_SKT = 206 * MiB, WS_U8 = 222 * MiB, WS_V8 = 286 * MiB, WS_XB = 350 * MiB, WS_TI = 414 * MiB, WS_TG = 430 * MiB, WS_MX = 446 * MiB;
constexpr size_t WS_GTE = WS_MX, WS_QB = WS_MX + 192 * MiB, WS_KB = WS_MX + 224 * MiB, WS_VB = WS_MX + 256 * MiB, WS_PIN = WS_MX + 288 * MiB, WS_DP = WS_MX + 320 * MiB;
constexpr size_t WS_UIN = WS_MX + 352 * MiB, WS_VIN = WS_MX + 384 * MiB, WS_O1 = WS_MX + 416 * MiB, WS_O2 = WS_MX + 448 * MiB, WS_SO = WS_MX + 480 * MiB, WS_END = WS_MX + 512 * MiB;
constexpr size_t WS_PA = WS_END;
constexpr size_t WS_XQ8 = WS_PA + 32 * MiB;
constexpr size_t WS_AO = WS_QB, WS_MG = WS_KB, WS_SX = WS_MX, WS_PM = WS_O1, WS_SC = WS_MX;
constexpr size_t WS_MEMB = WS_MX, WS_WXQB = WS_MX + 4 * MiB, WS_WXOT = WS_MX + 12 * MiB, WS_WXKVT = WS_MX + 20 * MiB, WS_KV = WS_MX + 36 * MiB, WS_WB1T = WS_MX + 68 * MiB, WS_WPQB = WS_MX + 72 * MiB;
static_assert(WS_XQ8 + 32 * MiB <= 1024 * MiB, "workspace map");

struct Params { const void* in[26]; float* out; unsigned char* ws; };

__device__ __forceinline__ float bf2f(bf16_t v) { return __uint_as_float(((unsigned)v) << 16); }
__device__ __forceinline__ bf16_t f2bf(float f) { unsigned u = __float_as_uint(f); return (bf16_t)((u + 0x7fffu + ((u >> 16) & 1u)) >> 16); }
typedef __bf16 hwbf16x2 __attribute__((ext_vector_type(2)));
__device__ __forceinline__ unsigned pk2(float lo, float hi) { const f32x2 v = {lo, hi}; return __builtin_bit_cast(unsigned, __builtin_convertvector(v, hwbf16x2)); }
template <int CTRL> __device__ __forceinline__ float dppf(float v) { return __builtin_bit_cast(float, __builtin_amdgcn_update_dpp(0, __builtin_bit_cast(int, v), CTRL, 0xF, 0xF, true)); }
constexpr int DPP_X1 = 0xB1, DPP_X2 = 0x4E, DPP_HMIR = 0x141, DPP_MIR = 0x140, DPP_X8 = 0x128;
__device__ __forceinline__ float lx16(float v) { float r; asm volatile("ds_swizzle_b32 %0, %1 offset:swizzle(SWAP,16)\n\ts_waitcnt lgkmcnt(0)" : "=v"(r) : "v"(v)); return r; }
__device__ __forceinline__ float add_x32(float v) { const auto rr = __builtin_amdgcn_permlane32_swap(__float_as_uint(v), __float_as_uint(v), false, false); return __uint_as_float(rr[0]) + __uint_as_float(rr[1]); }
__device__ __forceinline__ float max_x32(float v) { const auto rr = __builtin_amdgcn_permlane32_swap(__float_as_uint(v), __float_as_uint(v), false, false); return fmaxf(__uint_as_float(rr[0]), __uint_as_float(rr[1])); }
__device__ __forceinline__ float sum16(float v) { v += dppf<DPP_X1>(v); v += dppf<DPP_X2>(v); v += dppf<DPP_HMIR>(v); v += dppf<DPP_MIR>(v); return v; }
__device__ __forceinline__ float max16(float v) { v = fmaxf(v, dppf<DPP_X1>(v)); v = fmaxf(v, dppf<DPP_X2>(v)); v = fmaxf(v, dppf<DPP_HMIR>(v)); v = fmaxf(v, dppf<DPP_MIR>(v)); return v; }
__device__ __forceinline__ float wave_sum(float v) { v = sum16(v); v += lx16(v); return add_x32(v); }
__device__ __forceinline__ float wave_max(float v) { v = max16(v); v = fmaxf(v, lx16(v)); return max_x32(v); }
__device__ __forceinline__ int tid_fresh() { unsigned w, ln; asm volatile("s_mov_b32 %0, m0\n\tv_mbcnt_lo_u32_b32 %1, -1, 0\n\tv_mbcnt_hi_u32_b32 %1, -1, %1" : "=s"(w), "=v"(ln)); return (int)((w << 6) | ln); }
__device__ __forceinline__ float row_rstd(const float* ssp, int row) {
    const f32x4* p = (const f32x4*)(ssp + (size_t)row * 16);
    f32x4 a = p[0], b = p[1], c = p[2], d = p[3];
    float s = (a[0] + a[1] + a[2] + a[3]) + (b[0] + b[1] + b[2] + b[3]) + (c[0] + c[1] + c[2] + c[3]) + (d[0] + d[1] + d[2] + d[3]);
    return rsqrtf(s * (1.f / D) + EPS);
}
__device__ __forceinline__ float lam_init_of(int l) { return 0.8f - 0.6f * expf(-0.3f * (float)l); }

__device__ __forceinline__ u32x2 pk8_fp8(f32x4 a, f32x4 b, float sc);
__device__ __forceinline__ u32x4 pk8(f32x4 a, f32x4 b);
__device__ __forceinline__ void tr_conv(const float* __restrict__ src, bf16_t* __restrict__ dst, int K, int N, const float* gain, int gmask, float gmul, int bid, int nb, float* tile, int ldd = 0, int lds_src = 0) {
    const int tidx = tid_fresh();
    const int tx = tidx & 63, ty = tidx >> 6;
    const int tn = N / 64, nt = (K / 64) * tn, sp = lds_src ? lds_src : N;
    float r[8], rn[8];
    int it = bid;
    if (it < nt) { const int k0 = (it / tn) * 64, n0 = (it % tn) * 64;
#pragma unroll
        for (int i = 0; i < 8; ++i) { const int k = ty + 8 * i; r[i] = src[(size_t)(k0 + k) * sp + n0 + tx]; if (gain) r[i] *= gain[(k0 + k) & gmask] * gmul; } }
    while (it < nt) {
        const int k0 = (it / tn) * 64, n0 = (it % tn) * 64, nx = it + nb;
        if (nx < nt) { const int k1 = (nx / tn) * 64, n1 = (nx % tn) * 64;
#pragma unroll
            for (int i = 0; i < 8; ++i) { const int k = ty + 8 * i; rn[i] = src[(size_t)(k1 + k) * sp + n1 + tx]; if (gain) rn[i] *= gain[(k1 + k) & gmask] * gmul; } }
        __syncthreads();
#pragma unroll
        for (int i = 0; i < 8; ++i) tile[(ty + 8 * i) * 65 + tx] = r[i];
        __syncthreads();
        { const int n = tidx >> 3, kq = (tidx & 7) * 8;
          f32x4 a, b;
#pragma unroll
          for (int e = 0; e < 4; ++e) { a[e] = tile[(kq + e) * 65 + n]; b[e] = tile[(kq + 4 + e) * 65 + n]; }
          *(u32x4*)(dst + (size_t)(n0 + n) * (ldd ? ldd : K) + k0 + kq) = pk8(a, b); }
#pragma unroll
        for (int i = 0; i < 8; ++i) r[i] = rn[i];
        it = nx;
    }
}
__device__ __forceinline__ void tr_conv8(const float* __restrict__ src, unsigned char* __restrict__ dst, int K, int N, const float* gain, float scale, int sp, int bid, int nb, float* tile) {
    const int tidx = tid_fresh();
    const int tx = tidx & 63, ty = tidx >> 6;
    const int tn = N / 64, nt = (K / 64) * tn;
    float r[8], rn[8];
    int it = bid;
    if (it < nt) { const int k0 = (it / tn) * 64, n0 = (it % tn) * 64;
#pragma unroll
        for (int i = 0; i < 8; ++i) { const int k = ty + 8 * i; r[i] = src[(size_t)(k0 + k) * sp + n0 + tx] * gain[k0 + k] * scale; } }
    while (it < nt) {
        const int k0 = (it / tn) * 64, n0 = (it % tn) * 64, nx = it + nb;
        if (nx < nt) { const int k1 = (nx / tn) * 64, n1 = (nx % tn) * 64;
#pragma unroll
            for (int i = 0; i < 8; ++i) { const int k = ty + 8 * i; rn[i] = src[(size_t)(k1 + k) * sp + n1 + tx] * gain[k1 + k] * scale; } }
        __syncthreads();
#pragma unroll
        for (int i = 0; i < 8; ++i) tile[(ty + 8 * i) * 65 + tx] = r[i];
        __syncthreads();
        { const int n = tidx >> 3, kq = (tidx & 7) * 8;
          f32x4 a, b;
#pragma unroll
          for (int e = 0; e < 4; ++e) { a[e] = tile[(kq + e) * 65 + n]; b[e] = tile[(kq + 4 + e) * 65 + n]; }
          *(u32x2*)(dst + (size_t)(n0 + n) * K + k0 + kq) = pk8_fp8(a, b, 1.f); }
#pragma unroll
        for (int i = 0; i < 8; ++i) r[i] = rn[i];
        it = nx;
    }
}
__device__ __forceinline__ void conv_plain(const float* __restrict__ src, bf16_t* __restrict__ dst, size_t n, int bid, int nb, const float* rowgain = nullptr) {
    const int tidx = tid_fresh();
    const size_t n4 = n / 4, st = (size_t)nb * NT;
    for (size_t i0 = (size_t)bid * NT + tidx; i0 < n4; i0 += 8 * st) {
        f32x4 v[8];
#pragma unroll
        for (int u = 0; u < 8; ++u) { const size_t i = i0 + u * st; v[u] = (i < n4) ? ((const f32x4*)src)[i] : (f32x4){0.f, 0.f, 0.f, 0.f}; }
#pragma unroll
        for (int u = 0; u < 8; ++u) { const size_t i = i0 + u * st; if (i < n4) { f32x4 x = v[u]; if (rowgain) x = x * rowgain[i >> 8];
            u32x2 w; w.x = pk2(x[0], x[1]); w.y = pk2(x[2], x[3]); ((u32x2*)dst)[i] = w; } }
    }
}
__device__ __forceinline__ void conv_fp8(const float* __restrict__ src, unsigned* __restrict__ dst, const float* gain, float scale, bool slice_major, int bid, int nb) {
    const int tidx = tid_fresh();
    const size_t n4 = (size_t)NEXP * D / 4, st = (size_t)nb * NT;
    for (size_t i0 = (size_t)bid * NT + tidx; i0 < n4; i0 += 8 * st) {
        f32x4 v[8];
#pragma unroll
        for (int u = 0; u < 8; ++u) { const size_t i = i0 + u * st; v[u] = (i < n4) ? ((const f32x4*)src)[i] : (f32x4){0.f, 0.f, 0.f, 0.f}; }
#pragma unroll
        for (int u = 0; u < 8; ++u) { const size_t i = i0 + u * st; if (i < n4) { f32x4 x = v[u];
            if (gain) { const f32x4 g = ((const f32x4*)gain)[i & (D / 4 - 1)]; x = x * g; }
            x = x * scale;
            int w = __builtin_amdgcn_cvt_pk_fp8_f32(x[0], x[1], 0, false);
            w = __builtin_amdgcn_cvt_pk_fp8_f32(x[2], x[3], w, true);
            size_t o = i;
            if (slice_major) { const size_t d = (i * 4) & (D - 1), e = (i * 4) >> 10; o = (((d >> 7) * NEXP + e) * 128 + (d & 127)) >> 2; }
            dst[o] = (unsigned)w; } }
    }
}

__device__ __forceinline__ void stage_prologue0(const Params& p, int bid, int nb, float* lds) {
    const int tidx = tid_fresh();
    unsigned char* ws = p.ws;
    const int tid = tidx, lane = tid & 63, wid = tid >> 6;
    for (int l = 0; l < L; ++l) {
        tr_conv((const float*)p.in[4] + (size_t)l * D * INW, (bf16_t*)(ws + WS_WIN) + (size_t)l * 3072 * D, D, 3072, (const float*)p.in[3] + l * D, D - 1, 1.f, bid, nb, lds, 0, INW);
        tr_conv8((const float*)p.in[4] + (size_t)l * D * INW + 3072, ws + WS_WIN + 24 * MiB + (size_t)l * 3072 * D, D, 3072, (const float*)p.in[3] + l * D, W8S, INW, bid, nb, lds);
        const float* wb = (const float*)p.in[13] + (size_t)l * 3 * 512 * D;
        bf16_t* wbr = (bf16_t*)(ws + WS_WB0) + (size_t)l * D * 1536;
        tr_conv(wb, wbr, 512, D, (const float*)p.in[6] + l * 128, 127, 1.f - lam_init_of(l), bid, nb, lds, 1536);
        tr_conv(wb + 512 * D, (bf16_t*)(ws + WS_WB1T) + (size_t)l * D * 512, 512, D, nullptr, 0, 1.f, bid, nb, lds);
        tr_conv(wb + 2 * 512 * D, wbr + 1024, 512, D, nullptr, 0, 1.f, bid, nb, lds, 1536);
        tr_conv((const float*)p.in[14] + (size_t)l * D * D, (bf16_t*)(ws + WS_WOUT) + (size_t)l * D * D, D, D, nullptr, 0, 1.f, bid, nb, lds);
        tr_conv((const float*)p.in[19] + (size_t)l * D * D, (bf16_t*)(ws + WS_WXOT) + (size_t)l * D * D, D, D, nullptr, 0, 1.f, bid, nb, lds);
        tr_conv((const float*)p.in[18] + (size_t)l * D * 2 * D, (bf16_t*)(ws + WS_WXKVT) + (size_t)l * 2 * D * D, D, 2 * D, (const float*)p.in[16] + l * D, D - 1, 1.f, bid, nb, lds);
        conv_fp8((const float*)p.in[23] + (size_t)l * NEXP * D, (unsigned*)(ws + WS_U8) + (size_t)l * NEXP * D / 4, (const float*)p.in[20] + l * D, SU, false, bid, nb);
        conv_fp8((const float*)p.in[24] + (size_t)l * NEXP * D, (unsigned*)(ws + WS_V8) + (size_t)l * NEXP * D / 4, nullptr, SV, true, bid, nb);
    }
    conv_plain((const float*)p.in[17], (bf16_t*)(ws + WS_WXQB), (size_t)L * D * D, bid, nb, (const float*)p.in[15]);
    conv_plain((const float*)p.in[21], (bf16_t*)(ws + WS_WPQB), (size_t)L * D * 2048, bid, nb);
    conv_plain((const float*)p.in[22], (bf16_t*)(ws + WS_KEYSB), (size_t)L * 8 * 2 * 128 * 128, bid, nb);
    for (int i = bid * NT + tid; i < L * 4 * 128 * 128; i += nb * NT) {
        const int e = i & 127, g = (i >> 14) & 3, l = i >> 16;
        ((bf16_t*)(ws + WS_WPOOLS))[i] = f2bf(((const float*)p.in[7])[i] * ((const float*)p.in[8])[l * 512 + g * 128 + e]);
        const int sx = i & 127, tx = (i >> 7) & 127;
        ((bf16_t*)(ws + WS_WSPT))[i] = f2bf((sx <= tx) ? ((const float*)p.in[11])[i] : 0.f);
    }
    for (int i = bid * NT + tid; i < T * 8; i += nb * NT) {
        const int j = i & 7, t = i >> 3;
        const double ang = (double)((const int*)p.in[2])[t] * pow(500000.0, -(double)j / 8.0);
        _Float16* r = (_Float16*)(ws + WS_ROPE) + (size_t)t * 16;
        r[j] = (_Float16)(float)cos(ang); r[8 + j] = (_Float16)(float)sin(ang);
    }
    for (int row = bid * 8 + wid; row < T + MROWS; row += nb * 8) {
        const bool ismem = row >= T; const int r = ismem ? row - T : row;
        const float* src = (ismem ? (const float*)p.in[1] : (const float*)p.in[0]) + (size_t)r * D;
        bf16_t* dstb = (bf16_t*)(ws + (ismem ? WS_MEMB : WS_XB)) + (size_t)r * D;
        float ss = 0.f;
#pragma unroll
        for (int i = 0; i < 4; ++i) {
            const f32x4 v = ((const f32x4*)src)[lane + 64 * i];
            ss += v[0] * v[0] + v[1] * v[1] + v[2] * v[2] + v[3] * v[3];
            u32x2 w; w.x = pk2(v[0], v[1]); w.y = pk2(v[2], v[3]); ((u32x2*)dstb)[lane + 64 * i] = w;
            if (!ismem) { int q = __builtin_amdgcn_cvt_pk_fp8_f32(v[0] * XS, v[1] * XS, 0, false); q = __builtin_amdgcn_cvt_pk_fp8_f32(v[2] * XS, v[3] * XS, q, true); ((unsigned*)(ws + WS_XQ8 + (size_t)r * D))[lane + 64 * i] = (unsigned)q; }
        }
        ss = wave_sum(ss);
        if (ismem) { if (lane == 0) ((float*)(ws + WS_RSTDM))[r] = rsqrtf(ss * (1.f / D) + EPS); }
        else if (lane < 16) ((float*)(ws + WS_SSP))[(size_t)r * 16 + lane] = (lane == 0) ? ss : 0.f;
    }
}

template <class Geom, class Epi>
__device__ __forceinline__ void gemm_simple(int nitems, int K, const Geom& geom, const Epi& epi, int bid, int nb) {
    const int tidx = tid_fresh();
    const int tid = tidx, lane = tid & 63, wid = tid >> 6, wm = wid >> 1, wn = wid & 1, fr = lane & 15, fq = lane >> 4;
    for (int it = bid; it < nitems; it += nb) {
        const bf16_t* A; const bf16_t* Bt; int lda, ldb, grp, row0, col0;
        geom(it, A, lda, Bt, ldb, grp, row0, col0);
        f32x4 acc[2][4];
#pragma unroll
        for (int i = 0; i < 2; ++i)
#pragma unroll
            for (int j = 0; j < 4; ++j) acc[i][j] = (f32x4){0.f, 0.f, 0.f, 0.f};
        const bf16_t* ap = A + (size_t)(wm * 32 + fr) * lda + fq * 8;
        const bf16_t* bp = Bt + (size_t)(wn * 64 + fr) * ldb + fq * 8;
#pragma unroll 2
        for (int k0 = 0; k0 < K; k0 += 32) {
            bf16x8 a[2], b[4];
#pragma unroll
            for (int i = 0; i < 2; ++i) a[i] = *(const bf16x8*)(ap + (size_t)(i * 16) * lda + k0);
#pragma unroll
            for (int j = 0; j < 4; ++j) b[j] = *(const bf16x8*)(bp + (size_t)(j * 16) * ldb + k0);
#pragma unroll
            for (int i = 0; i < 2; ++i)
#pragma unroll
                for (int j = 0; j < 4; ++j) acc[i][j] = __builtin_amdgcn_mfma_f32_16x16x32_bf16(b[j], a[i], acc[i][j], 0, 0, 0);
        }
#pragma unroll
        for (int i = 0; i < 2; ++i) {
            const int row = row0 + wm * 32 + i * 16 + fr;
            const float rs = epi.prep(grp, row);
            float part = 0.f;
#pragma unroll
            for (int j = 0; j < 4; ++j) part += epi.apply(grp, row, col0 + wn * 64 + j * 16 + fq * 4, acc[i][j], rs, lane);
            epi.rowdone(grp, row, col0 + wn * 64, part, lane);
        }
    }
}

__device__ __forceinline__ void st_bf4(bf16_t* p, f32x4 v) { u32x2 w; w.x = pk2(v[0], v[1]); w.y = pk2(v[2], v[3]); *(u32x2*)p = w; }
__device__ __forceinline__ f32x4 ld_bf4(const bf16_t* p) { const u32x2 w = *(const u32x2*)p; return (f32x4){__uint_as_float(w.x << 16), __uint_as_float(w.x & 0xffff0000u), __uint_as_float(w.y << 16), __uint_as_float(w.y & 0xffff0000u)}; }

struct EpiColGain {
    bf16_t* o; size_t gstride; int ld; const float* gain; int gdiv;
    __device__ __forceinline__ float prep(int, int) const { return 1.f; }
    __device__ __forceinline__ float apply(int grp, int row, int col, f32x4 v, float, int) const {
        if (gain) v = v * *(const f32x4*)(gain + (size_t)(grp / gdiv) * D + col);
        st_bf4(o + (size_t)grp * gstride + (size_t)row * ld + col, v);
        return 0.f;
    }
    __device__ __forceinline__ void rowdone(int, int, int, float, int) const {}
};

__device__ __forceinline__ void stage_prologue1(const Params& p, int bid, int nb) {
    unsigned char* ws = p.ws;
    {
        auto geom = [=](int it, const bf16_t*& A, int& lda, const bf16_t*& Bt, int& ldb, int& grp, int& row0, int& col0) {
            const int g = it >> 3, tn = it & 7, l = g >> 4, hp = g & 15; grp = g; row0 = 0; col0 = tn * 128; lda = 128; ldb = 2048;
            A = (const bf16_t*)(ws + WS_KEYSB) + (size_t)g * 16384; Bt = (const bf16_t*)(ws + WS_WPQB) + ((size_t)l * D + col0) * 2048 + hp * 128; };
        gemm_simple(L * 16 * 8, 128, geom, EpiColGain{(bf16_t*)(ws + WS_SKT), (size_t)128 * D, D, (const float*)p.in[20], 16}, bid, nb);
    }
    {
        auto geom = [=](int it, const bf16_t*& A, int& lda, const bf16_t*& Bt, int& ldb, int& grp, int& row0, int& col0) {
            const int lg = it >> 3, tm = it & 7, l = lg >> 2, g = lg & 3; grp = lg; row0 = tm * 128; col0 = 0; lda = 512; ldb = 128;
            A = (const bf16_t*)(ws + WS_WB1T) + ((size_t)l * D + row0) * 512 + g * 128; Bt = (const bf16_t*)(ws + WS_WPOOLS) + (size_t)lg * 16384; };
        struct EpiWeff { bf16_t* o; __device__ __forceinline__ float prep(int, int) const { return 1.f; }
            __device__ __forceinline__ float apply(int lg, int row, int col, f32x4 v, float, int) const { st_bf4(o + ((size_t)(lg >> 2) * D + row) * 1536 + 512 + (lg & 3) * 128 + col, v); return 0.f; }
            __device__ __forceinline__ void rowdone(int, int, int, float, int) const {} };
        gemm_simple(L * 4 * 8, 128, geom, EpiWeff{(bf16_t*)(ws + WS_WB0)}, bid, nb);
    }
}
namespace pg8 {
#define PG8_LAS __attribute__((address_space(3)))
constexpr int BM = 256, BK = 64, HALF = 128, HTB = HALF * BK * 2, STAGE_BYTES = 8 * HTB, NXCD = 8, WGM = 8;
__host__ __device__ __forceinline__ int lds_byte(int r, int c) { const int st = (r >> 4) * 2 + (c >> 5), rr = r & 15, cc = c & 31, ob = rr * 64 + cc * 2; return st * 1024 + (ob ^ (((ob >> 9) & 1) << 5)); }
__host__ __device__ __forceinline__ void stage_rc(int b, int& R, int& C) { const int st = b / 1024, sb = b % 1024, swz = sb ^ (((sb >> 9) & 1) << 5); R = (st >> 1) * 16 + swz / 64; C = (st & 1) * 32 + (swz % 64) / 2; }
__host__ __device__ __forceinline__ int perm32(int rho) { const int n = rho >> 4, i = rho & 15; return 8 * (i >> 2) + 4 * n + (i & 3); }
struct Unit { int pm, pn; };
struct Order {
    int nM, nN, nwg, G, c; const char* A; const char* Bt; size_t a_tile, b_tile, b_batch; int pm_per_batch;
    __device__ __forceinline__ void init(int M, int N, int G_, int c_, const void* A_, int lda, const void* Bt_, int ldb, size_t b_batch_bytes = 0, int pmpb = 1 << 30) {
        nM = M / BM; nN = N / BM; nwg = nM * nN; G = G_; c = c_; A = (const char*)A_; Bt = (const char*)Bt_; a_tile = (size_t)BM * lda * 2; b_tile = (size_t)BM * ldb * 2; b_batch = b_batch_bytes; pm_per_batch = pmpb; }
    __device__ __forceinline__ bool next(int i, Unit& u) const {
        const long Lx = (long)i * G + c; if (Lx >= nwg) return false;
        int wgid = (int)Lx; { const int q = nwg / NXCD, r = nwg % NXCD, xcd = wgid % NXCD, off = wgid / NXCD; wgid = (xcd < r ? xcd * (q + 1) : r * (q + 1) + (xcd - r) * q) + off; }
        const int nig = WGM * nN, gid = wgid / nig, fm = gid * WGM, gsz = (nM - fm) < WGM ? (nM - fm) : WGM;
        u.pm = fm + ((wgid % nig) % gsz); u.pn = (wgid % nig) / gsz; return true;
    }
    __device__ __forceinline__ const char* a_ptr(const Unit& u) const { return A + (size_t)u.pm * a_tile; }
    __device__ __forceinline__ const char* b_ptr(const Unit& u) const { return Bt + (size_t)u.pn * b_tile + (size_t)(u.pm / pm_per_batch) * b_batch; }
};
typedef int i32x8_t __attribute__((ext_vector_type(8))); typedef int i32x4_t __attribute__((ext_vector_type(4)));
__device__ __forceinline__ i32x8_t ld8_lds(const PG8_LAS unsigned char* p) { const i32x4_t lo = *(const PG8_LAS i32x4_t*)p, hi = *(const PG8_LAS i32x4_t*)(p + 1024); return __builtin_shufflevector(lo, hi, 0, 1, 2, 3, 4, 5, 6, 7); }
__device__ __forceinline__ void glds_s(const void* sbase, unsigned voff, unsigned lds_dst) { unsigned keep;
    asm volatile("s_mov_b32 %0, m0\n\ts_mov_b32 m0, %3\n\ts_nop 0\n\tglobal_load_lds_dwordx4 %1, %2\n\ts_mov_b32 m0, %0" : "=&s"(keep) : "v"(voff), "s"(sbase), "s"(lds_dst) : "memory"); }
struct NoHook { static constexpr bool ACTIVE = false; __device__ __forceinline__ void operator()(f32x4 (&)[2][2][4][2], const Unit&, int, int, int, int, int) const {} };
template <class Epi, class Sched, bool ALIGN_EPI, class Hook = NoHook, int SEG = 1 << 20, bool FP8 = false>
__device__ __forceinline__ void gemm_phase(PG8_LAS unsigned char* lds, const int K, const int lda, const int ldb, const Sched& S, const Epi& E, const long dA1 = 0, const long dA2 = 0, const Hook& H = Hook()) {
    const int tid = tid_fresh(), wid = __builtin_amdgcn_readfirstlane(tid >> 6), lane = tid & 63, wr = wid >> 2, wc = wid & 3, fr = lane & 15, fq = lane >> 4;
    const int nt = K / BK;
    int mxs = 0x7f7f7f7f; asm volatile("" : "+v"(mxs));
    (void)mxs;
    unsigned voffA, voffB;
    { int R, C; stage_rc(tid * 16, R, C); const int Rb = (R & ~31) + perm32(R & 31);
      voffA = (unsigned)(R * lda + C) * 2u; voffB = (unsigned)(Rb * ldb + C) * 2u; }
    const size_t p2A = (size_t)64 * lda * 2, p2B = (size_t)64 * ldb * 2;
    const size_t kstep = (size_t)(BK * 2);
    const size_t hstepA = (size_t)HALF * lda * 2, hstepB = (size_t)HALF * ldb * 2;
    const unsigned ldsw = (unsigned)wid * 1024u, ldsu = (unsigned)(unsigned long)lds;
    const int aoff = lds_byte(wr * 64 + fr, fq * 8), boff = lds_byte(wc * 32 + fr, fq * 8);
#define PG8_SA(b, h) (((b) * 2 + (h)) * HTB)
#define PG8_SB(b, h) ((4 + (b) * 2 + (h)) * HTB)
#define PG8_STAGE(bufoff, gbase, X) do { _Pragma("unroll") for (int _i = 0; _i < 2; ++_i) \
        pg8::glds_s((const void*)((const char*)(gbase) + _i * p2##X), voff##X, ldsu + (unsigned)(bufoff) + ldsw + (unsigned)(_i * 8192)); } while (0)
#define PG8_LD8(p_) pg8::ld8_lds((p_))
#define PG8_LDA(dst, b, h) do { _Pragma("unroll") for (int m = 0; m < 4; ++m) { if constexpr (FP8) dst##8[m] = PG8_LD8(lds + PG8_SA(b, h) + aoff + m * 2048); else { _Pragma("unroll") for (int k = 0; k < 2; ++k) dst[m][k] = *(const PG8_LAS bf16x8*)(lds + PG8_SA(b, h) + aoff + m * 2048 + k * 1024); } } } while (0)
#define PG8_LDB(dst, b, h) do { _Pragma("unroll") for (int n = 0; n < 2; ++n) { if constexpr (FP8) dst##8[n] = PG8_LD8(lds + PG8_SB(b, h) + boff + n * 2048); else { _Pragma("unroll") for (int k = 0; k < 2; ++k) dst[n][k] = *(const PG8_LAS bf16x8*)(lds + PG8_SB(b, h) + boff + n * 2048 + k * 1024); } } } while (0)
#define PG8_MMA(ai, bj, At, Bt) do { __builtin_amdgcn_s_setprio(1); _Pragma("unroll") for (int m = 0; m < 4; ++m) _Pragma("unroll") for (int n = 0; n < 2; ++n) { \
        if constexpr (FP8) asm volatile("v_mfma_scale_f32_16x16x128_f8f6f4 %0, %1, %2, %0, %3, %3 op_sel_hi:[0,0,0]" : "+v"(acc[ai][bj][m][n]) : "v"(Bt##8[n]), "v"(At##8[m]), "v"(mxs)); \
        else { _Pragma("unroll") for (int k = 0; k < 2; ++k) acc[ai][bj][m][n] = __builtin_amdgcn_mfma_f32_16x16x32_bf16(Bt[n][k], At[m][k], acc[ai][bj][m][n], 0, 0, 0); } } \
        __builtin_amdgcn_s_setprio(0); } while (0)
#define PG8_WAIT_V(n) asm volatile("s_waitcnt vmcnt(" #n ")" ::: "memory")
#define PG8_WAIT_L(n) asm volatile("s_waitcnt lgkmcnt(" #n ")" ::: "memory")
#define PG8_BAR __builtin_amdgcn_s_barrier()
#define PG8_SCHED __builtin_amdgcn_sched_barrier(0)
    Unit cur, nxt; int ui = 0;
    if (!S.next(0, cur)) return;
    f32x4 acc[2][2][4][2];
#pragma unroll
    for (int a = 0; a < 2; ++a)
#pragma unroll
        for (int b = 0; b < 2; ++b)
#pragma unroll
            for (int m = 0; m < 4; ++m)
#pragma unroll
                for (int n = 0; n < 2; ++n) acc[a][b][m][n] = (f32x4){0.f, 0.f, 0.f, 0.f};
    typedef int i32x8_ __attribute__((ext_vector_type(8))); typedef int i32x4_ __attribute__((ext_vector_type(4)));
    bf16x8 At[4][2], B0[2][2], B1[2][2]; i32x8_ At8[4], B08[2], B18[2];
    (void)At; (void)B0; (void)B1; (void)At8; (void)B08; (void)B18;
    const char* cA = S.a_ptr(cur); const char* cB = S.b_ptr(cur);
    PG8_STAGE(PG8_SB(0, 0), cB, B); PG8_STAGE(PG8_SB(0, 1), cB + hstepB, B); PG8_STAGE(PG8_SA(0, 0), cA, A); PG8_STAGE(PG8_SA(0, 1), cA + hstepA, A);
    if (wr == 1) PG8_BAR;
    PG8_WAIT_V(2); PG8_BAR;
    PG8_STAGE(PG8_SB(1, 0), cB + kstep, B); PG8_STAGE(PG8_SA(1, 0), cA + kstep, A); PG8_STAGE(PG8_SB(1, 1), cB + hstepB + kstep, B); PG8_STAGE(PG8_SA(1, 1), cA + kstep + hstepA, A);
    PG8_WAIT_V(8); PG8_BAR;
    bool stores = false;
    for (;;) {
        const bool has_next = S.next(ui + 1, nxt);
        const char* nA = has_next ? S.a_ptr(nxt) : cA; const char* nB = has_next ? S.b_ptr(nxt) : cB;
        for (int t = 0; t < nt; t += 2) {
            const bool last = (t == nt - 2);
#define PG8_AOFF(tile) ((long)(tile) * (long)kstep + ((tile) >= 2 * SEG ? dA2 : (tile) >= SEG ? dA1 : 0l))
            if (Hook::ACTIVE && (t == SEG || t == 2 * SEG)) { const int th = tid_fresh(); H(acc, cur, t, wr, wc, th & 15, (th >> 4) & 3); }
            const char* a1 = cA + PG8_AOFF(t + 1);
            const char* a2 = last ? nA : cA + PG8_AOFF(t + 2); const char* b2 = last ? nB : cB + (size_t)(t + 2) * kstep;
            const char* a3 = last ? nA + kstep : cA + PG8_AOFF(t + 3); const char* b3 = b2 + kstep;
            const bool head = (t == 0), drain = head && stores;
            PG8_LDB(B0, 0, 0); PG8_LDB(B1, 0, 1); PG8_SCHED; PG8_LDA(At, 0, 0); if (!head) PG8_STAGE(PG8_SA(1, 1), a1 + hstepA, A);
            if (drain) { if constexpr (Epi::NST >= 16) PG8_WAIT_V(16); else if constexpr (Epi::NST >= 8) PG8_WAIT_V(8); else PG8_WAIT_V(0); } else PG8_WAIT_V(8);
            PG8_WAIT_L(0); PG8_BAR; PG8_MMA(0, 0, At, B0); PG8_MMA(0, 1, At, B1); PG8_BAR; PG8_SCHED;
            PG8_LDA(At, 0, 1); PG8_STAGE(PG8_SB(0, 0), b2, B); PG8_STAGE(PG8_SB(0, 1), b2 + hstepB, B); PG8_STAGE(PG8_SA(0, 0), a2, A);
            if (!drain) PG8_WAIT_V(8);
            PG8_WAIT_L(0); PG8_BAR; PG8_MMA(1, 0, At, B0); PG8_MMA(1, 1, At, B1); PG8_BAR; PG8_SCHED;
            PG8_LDB(B0, 1, 0); PG8_LDB(B1, 1, 1); PG8_SCHED; PG8_LDA(At, 1, 0); PG8_STAGE(PG8_SA(0, 1), a2 + hstepA, A);
            if (!drain) PG8_WAIT_V(8);
            PG8_WAIT_L(0); PG8_BAR; PG8_MMA(0, 0, At, B0); PG8_MMA(0, 1, At, B1); PG8_BAR; PG8_SCHED;
            PG8_LDA(At, 1, 1); PG8_STAGE(PG8_SB(1, 0), b3, B); PG8_STAGE(PG8_SB(1, 1), b3 + hstepB, B); PG8_STAGE(PG8_SA(1, 0), a3, A);
            PG8_WAIT_V(8);
            PG8_WAIT_L(0); PG8_BAR; PG8_MMA(1, 0, At, B0); PG8_MMA(1, 1, At, B1); PG8_BAR; PG8_SCHED;
        }
        PG8_STAGE(PG8_SA(1, 1), nA + kstep + hstepA, A); PG8_SCHED;
        if constexpr (FP8) asm volatile("s_nop 15\n\ts_nop 7" ::: "memory");
        if constexpr (ALIGN_EPI) { if (wr == 0) PG8_BAR; }
        { const int te = tid_fresh(); E(acc, cur, wr, wc, te & 15, (te >> 4) & 3); }
        if (!has_next) break;
        stores = true;
#pragma unroll
        for (int a = 0; a < 2; ++a)
#pragma unroll
            for (int b = 0; b < 2; ++b)
#pragma unroll
                for (int m = 0; m < 4; ++m)
#pragma unroll
                    for (int n = 0; n < 2; ++n) acc[a][b][m][n] = (f32x4){0.f, 0.f, 0.f, 0.f};
        cur = nxt; cA = nA; cB = nB; ++ui;
        if constexpr (ALIGN_EPI) { if (wr == 1) PG8_BAR; }
    }
    PG8_WAIT_V(0);
    if constexpr (!ALIGN_EPI) { if (wr == 0) PG8_BAR; }
    PG8_BAR;
#undef PG8_AOFF
#undef PG8_SA
#undef PG8_SB
#undef PG8_STAGE
#undef PG8_LDA
#undef PG8_LD8
#undef PG8_LDB
#undef PG8_MMA
#undef PG8_WAIT_V
#undef PG8_WAIT_L
#undef PG8_BAR
#undef PG8_SCHED
}
}

__device__ __forceinline__ float rstd_q(const float* ssp, int row, int fq) {
    const f32x4 a = *(const f32x4*)(ssp + (size_t)row * 16 + 4 * fq);
    float s = (a[0] + a[1]) + (a[2] + a[3]); s += lx16(s); s = add_x32(s);
    return rsqrtf(s * (1.f / D) + EPS);
}
__device__ __forceinline__ void rstd8(const float* ssp, int row0, int fq, float mul, float (&rs)[2][4]) {
    f32x4 a[2][4];
#pragma unroll
    for (int ai = 0; ai < 2; ++ai)
#pragma unroll
        for (int m = 0; m < 4; ++m) a[ai][m] = *(const f32x4*)(ssp + (size_t)(row0 + ai * 128 + m * 16) * 16 + 4 * fq);
#pragma unroll
    for (int ai = 0; ai < 2; ++ai)
#pragma unroll
        for (int m = 0; m < 4; ++m) { float s = (a[ai][m][0] + a[ai][m][1]) + (a[ai][m][2] + a[ai][m][3]); s += lx16(s); s = add_x32(s); rs[ai][m] = rsqrtf(s * (1.f / D) + EPS) * mul; }
}
__device__ __forceinline__ u32x4 pk8(f32x4 a, f32x4 b) { u32x4 w; w.x = pk2(a[0], a[1]); w.y = pk2(a[2], a[3]); w.z = pk2(b[0], b[1]); w.w = pk2(b[2], b[3]); return w; }
__device__ __forceinline__ u32x2 pk8_fp8(f32x4 a, f32x4 b, float sc) {
    int q0 = __builtin_amdgcn_cvt_pk_fp8_f32(a[0] * sc, a[1] * sc, 0, false); q0 = __builtin_amdgcn_cvt_pk_fp8_f32(a[2] * sc, a[3] * sc, q0, true);
    int q1 = __builtin_amdgcn_cvt_pk_fp8_f32(b[0] * sc, b[1] * sc, 0, false); q1 = __builtin_amdgcn_cvt_pk_fp8_f32(b[2] * sc, b[3] * sc, q1, true);
    return (u32x2){(unsigned)q0, (unsigned)q1};
}
__device__ __forceinline__ void up8(u32x4 w, f32x4& a, f32x4& b) {
    a = (f32x4){__uint_as_float(w.x << 16), __uint_as_float(w.x & 0xffff0000u), __uint_as_float(w.y << 16), __uint_as_float(w.y & 0xffff0000u)};
    b = (f32x4){__uint_as_float(w.z << 16), __uint_as_float(w.z & 0xffff0000u), __uint_as_float(w.w << 16), __uint_as_float(w.w & 0xffff0000u)}; }
struct LaneTr {
    int addr, tr, tq;
    __device__ __forceinline__ LaneTr(int fr, int fq) { const int L = fq * 16 + fr; tr = L >> 2; tq = L & 3; addr = (tq * 16 + tr) * 4; }
    __device__ __forceinline__ u32x4 operator()(u32x4 w) const {
        return (u32x4){(unsigned)__builtin_amdgcn_ds_bpermute(addr, (int)w.x), (unsigned)__builtin_amdgcn_ds_bpermute(addr, (int)w.y), (unsigned)__builtin_amdgcn_ds_bpermute(addr, (int)w.z), (unsigned)__builtin_amdgcn_ds_bpermute(addr, (int)w.w)}; }
};
typedef _Float16 f16x2_t __attribute__((ext_vector_type(2)));
__device__ __forceinline__ u32x4 swz16x4(u32x4 a) { unsigned r0, r1, r2, r3;
    asm volatile("ds_swizzle_b32 %0, %4 offset:swizzle(SWAP,16)\n\tds_swizzle_b32 %1, %5 offset:swizzle(SWAP,16)\n\tds_swizzle_b32 %2, %6 offset:swizzle(SWAP,16)\n\tds_swizzle_b32 %3, %7 offset:swizzle(SWAP,16)\n\ts_waitcnt lgkmcnt(0)"
                 : "=&v"(r0), "=&v"(r1), "=&v"(r2), "=&v"(r3) : "v"(a.x), "v"(a.y), "v"(a.z), "v"(a.w));
    return (u32x4){r0, r1, r2, r3}; }
__device__ __forceinline__ f32x4 swz16f4(f32x4 a) { return __builtin_bit_cast(f32x4, swz16x4(__builtin_bit_cast(u32x4, a))); }
__device__ __forceinline__ float h2f_lo(unsigned w) { return (float)__builtin_bit_cast(f16x2_t, w)[0]; }
__device__ __forceinline__ float h2f_hi(unsigned w) { return (float)__builtin_bit_cast(f16x2_t, w)[1]; }
struct GEpiWin {
    unsigned char* ws;
    static constexpr int NST = 16;
    __device__ __forceinline__ void operator()(const f32x4 (&acc)[2][2][4][2], const pg8::Unit& u, int wr, int wc, int fr, int fq) const {
        const int pn = u.pn, row0 = u.pm * 256 + wr * 64 + fr;
        const LaneTr ltr(fr, fq); const int rowt = u.pm * 256 + wr * 64 + ltr.tr, ct = 32 * wc + 8 * ltr.tq;
        const float* ssp = (const float*)(ws + WS_SSP);
        if (pn < 4) {
            const bool rot = (wc & 1) == 0;
            bf16_t* dst = (bf16_t*)(ws + (pn < 2 ? WS_QB : WS_KB)) + (pn & 1) * 256 + ct;
            float rs8[2][4]; rstd8(ssp, row0, fq, pn < 2 ? C2 : 1.f, rs8);
            u32x4 tb[2][4];
#pragma unroll
            for (int ai = 0; ai < 2; ++ai)
#pragma unroll
                for (int m = 0; m < 4; ++m) tb[ai][m] = rot ? *(const u32x4*)(ws + WS_ROPE + (size_t)(row0 + ai * 128 + m * 16) * 32 + (fq & 1) * 16) : (u32x4){0u, 0u, 0u, 0u};
#pragma unroll
            for (int ai = 0; ai < 2; ++ai)
#pragma unroll
                for (int m = 0; m < 4; ++m) { const int row = rowt + ai * 128 + m * 16; const float rs = rs8[ai][m];
                    f32x4 c0 = (f32x4){1.f, 1.f, 1.f, 1.f}, c1 = c0, s0 = (f32x4){0.f, 0.f, 0.f, 0.f}, s1 = s0;
                    if (rot) { const u32x4 mine = tb[ai][m]; const u32x4 oth = swz16x4(mine);
                        const u32x4 cw = (fq & 1) ? oth : mine, sw = (fq & 1) ? mine : oth;
                        c0 = (f32x4){h2f_lo(cw.x), h2f_hi(cw.x), h2f_lo(cw.y), h2f_hi(cw.y)}; c1 = (f32x4){h2f_lo(cw.z), h2f_hi(cw.z), h2f_lo(cw.w), h2f_hi(cw.w)};
                        s0 = (f32x4){h2f_lo(sw.x), h2f_hi(sw.x), h2f_lo(sw.y), h2f_hi(sw.y)}; s1 = (f32x4){h2f_lo(sw.z), h2f_hi(sw.z), h2f_lo(sw.w), h2f_hi(sw.w)}; }
#pragma unroll
                    for (int bj = 0; bj < 2; ++bj) { f32x4 v0 = acc[ai][bj][m][0], v1 = acc[ai][bj][m][1];
                        if (rot) { const f32x4 o0 = swz16f4(v0), o1 = swz16f4(v1);
                            if (fq == 0) { v0 = v0 * c0 - o0 * s0; v1 = v1 * c1 - o1 * s1; } else if (fq == 1) { v0 = o0 * s0 + v0 * c0; v1 = o1 * s1 + v1 * c1; } }
                        *(u32x4*)(dst + (size_t)row * 512 + bj * 128) = ltr(pk8(v0 * rs, v1 * rs)); } }
        } else if (pn < 12) {
            const int seg = (pn - 4) >> 1; const size_t base = seg == 0 ? WS_VB : seg == 1 ? WS_PIN : seg == 2 ? WS_UIN : WS_VIN;
            bf16_t* dst = (bf16_t*)(ws + base) + (pn & 1) * 256 + ct;
            float rs[2][4]; rstd8(ssp, row0, fq, 1.f, rs);
#pragma unroll
            for (int ai = 0; ai < 2; ++ai)
#pragma unroll
                for (int m = 0; m < 4; ++m) { const int row = rowt + ai * 128 + m * 16;
#pragma unroll
                    for (int bj = 0; bj < 2; ++bj) *(u32x4*)(dst + (size_t)row * 512 + bj * 128) = ltr(pk8(acc[ai][bj][m][0] * rs[ai][m], acc[ai][bj][m][1] * rs[ai][m])); }
        }
    }
};
__device__ __forceinline__ size_t gate_off(int pm, int pn, int wid, int lane) { return (((size_t)(pm * 12 + pn) * 8 + wid) << 14) + (size_t)lane * 16; }
#define GATE_FRAG(ai, bj, m) ((((ai) * 2 + (bj)) * 4 + (m)) * 1024)
struct GEpiGate {
    unsigned char* ws;
    static constexpr int NST = 16;
    __device__ __forceinline__ void operator()(const f32x4 (&acc)[2][2][4][2], const pg8::Unit& u, int wr, int wc, int fr, int fq) const {
        const int row0 = u.pm * 256 + wr * 64 + fr;
        unsigned char* dst = ws + WS_GTE + gate_off(u.pm, u.pn, wr * 4 + wc, fq * 16 + fr);
        float rs8[2][4]; rstd8((const float*)(ws + WS_SSP), row0, fq, -1.4426950408889634f / (XS * W8S), rs8);
#pragma unroll
        for (int ai = 0; ai < 2; ++ai)
#pragma unroll
            for (int m = 0; m < 4; ++m) { const float rs = rs8[ai][m];
#pragma unroll
                for (int bj = 0; bj < 2; ++bj) { f32x4 v0 = acc[ai][bj][m][0] * rs, v1 = acc[ai][bj][m][1] * rs;
#pragma unroll
                    for (int e = 0; e < 4; ++e) { v0[e] = 1.f + __builtin_amdgcn_exp2f(fminf(v0[e], 60.f)); v1[e] = 1.f + __builtin_amdgcn_exp2f(fminf(v1[e], 60.f)); }
                    *(u32x4*)(dst + GATE_FRAG(ai, bj, m)) = pk8(v0, v1); } }
    }
};
__device__ __forceinline__ f32x4 rcp4(f32x4 v) { return (f32x4){__builtin_amdgcn_rcpf(fmaxf(v[0], 1e-30f)), __builtin_amdgcn_rcpf(fmaxf(v[1], 1e-30f)), __builtin_amdgcn_rcpf(fmaxf(v[2], 1e-30f)), __builtin_amdgcn_rcpf(fmaxf(v[3], 1e-30f))}; }
struct BranchHook {
    static constexpr bool ACTIVE = true; unsigned char* ws;
    __device__ __forceinline__ void operator()(f32x4 (&acc)[2][2][4][2], const pg8::Unit& u, int t, int wr, int wc, int fr, int fq) const {
        int lane = fq * 16 + fr;
        asm volatile("" : "+v"(lane));
        const unsigned char* gpa = ws + WS_GTE + gate_off(u.pm, u.pn + ((t == 8) ? 0 : 4), wr * 4 + wc, lane); const unsigned char* gpb = gpa + ((size_t)4 * 8 << 14);
#pragma unroll
        for (int ai = 0; ai < 2; ++ai) {
            u32x4 ga[4][2], gb[4][2];
#pragma unroll
            for (int m = 0; m < 4; ++m)
#pragma unroll
                for (int bj = 0; bj < 2; ++bj) { ga[m][bj] = *(const u32x4*)(gpa + GATE_FRAG(ai, bj, m)); gb[m][bj] = *(const u32x4*)(gpb + GATE_FRAG(ai, bj, m)); }
            __builtin_amdgcn_sched_barrier(0);
#pragma unroll
            for (int m = 0; m < 4; ++m)
#pragma unroll
                for (int bj = 0; bj < 2; ++bj) { f32x4 a0, a1, b0, b1; up8(ga[m][bj], a0, a1); up8(gb[m][bj], b0, b1);
                    acc[ai][bj][m][0] = acc[ai][bj][m][0] * (b0 * rcp4(a0)); acc[ai][bj][m][1] = acc[ai][bj][m][1] * (b1 * rcp4(a1)); }
            __builtin_amdgcn_sched_barrier(0);
        }
    }
};
struct GEpiBranch {
    unsigned char* ws;
    static constexpr int NST = 8;
    __device__ __forceinline__ void operator()(const f32x4 (&acc)[2][2][4][2], const pg8::Unit& u, int wr, int wc, int fr, int fq) const {
        const LaneTr ltr(fr, fq); const int row0 = u.pm * 256 + wr * 64 + ltr.tr, col0 = u.pn * 256 + 32 * wc + 8 * ltr.tq;
#pragma unroll
        for (int ai = 0; ai < 2; ++ai) {
            u32x4 g[4][2];
#pragma unroll
            for (int m = 0; m < 4; ++m)
#pragma unroll
                for (int bj = 0; bj < 2; ++bj) g[m][bj] = *(const u32x4*)(ws + WS_GTE + gate_off(u.pm, u.pn + 8, wr * 4 + wc, fq * 16 + fr) + GATE_FRAG(ai, bj, m));
#pragma unroll
            for (int m = 0; m < 4; ++m) { const int row = row0 + ai * 128 + m * 16;
#pragma unroll
                for (int bj = 0; bj < 2; ++bj) { const int col = col0 + bj * 128;
                    f32x4 g0, g1; up8(g[m][bj], g0, g1);
                    *(u32x4*)((bf16_t*)(ws + WS_MG) + (size_t)row * D + col) = ltr(pk8(acc[ai][bj][m][0] * rcp4(g0), acc[ai][bj][m][1] * rcp4(g1))); } }
        }
    }
};
struct GEpiResid {
    unsigned char* ws; bool q8; float ascale;
    static constexpr int NST = 16;
    __device__ __forceinline__ void operator()(const f32x4 (&acc)[2][2][4][2], const pg8::Unit& u, int wr, int wc, int fr, int fq) const {
        const int row0 = u.pm * 256 + wr * 64 + fr, col0 = u.pn * 256 + 32 * wc + 8 * fq;
#pragma unroll
        for (int ai = 0; ai < 2; ++ai) {
            u32x4 xin[4][2];
#pragma unroll
            for (int m = 0; m < 4; ++m)
#pragma unroll
                for (int bj = 0; bj < 2; ++bj) xin[m][bj] = *(const u32x4*)((const bf16_t*)(ws + WS_XB) + (size_t)(row0 + ai * 128 + m * 16) * D + col0 + bj * 128);
#pragma unroll
            for (int m = 0; m < 4; ++m) { const int row = row0 + ai * 128 + m * 16; float part = 0.f;
#pragma unroll
                for (int bj = 0; bj < 2; ++bj) { f32x4 x0, x1; up8(xin[m][bj], x0, x1);
                    const u32x4 w = pk8(acc[ai][bj][m][0] * ascale + x0, acc[ai][bj][m][1] * ascale + x1);
                    *(u32x4*)((bf16_t*)(ws + WS_XB) + (size_t)row * D + col0 + bj * 128) = w;
                    f32x4 v0, v1; up8(w, v0, v1);
                    if (q8) { int q0 = __builtin_amdgcn_cvt_pk_fp8_f32(v0[0] * XS, v0[1] * XS, 0, false); q0 = __builtin_amdgcn_cvt_pk_fp8_f32(v0[2] * XS, v0[3] * XS, q0, true);
                        int q1 = __builtin_amdgcn_cvt_pk_fp8_f32(v1[0] * XS, v1[1] * XS, 0, false); q1 = __builtin_amdgcn_cvt_pk_fp8_f32(v1[2] * XS, v1[3] * XS, q1, true);
                        *(u32x2*)(ws + WS_XQ8 + (size_t)row * D + col0 + bj * 128) = (u32x2){(unsigned)q0, (unsigned)q1}; }
                    part += (v0[0] * v0[0] + v0[1] * v0[1]) + (v0[2] * v0[2] + v0[3] * v0[3]) + (v1[0] * v1[0] + v1[1] * v1[1]) + (v1[2] * v1[2] + v1[3] * v1[3]); }
                part += lx16(part); part = add_x32(part);
                if (fq == 0) ((float*)(ws + WS_SSP))[(size_t)row * 16 + u.pn * 4 + wc] = part; }
        }
    }
};
typedef _Float16 f16x8 __attribute__((ext_vector_type(8)));
struct GEpiScaleF16 {
    unsigned char* ws; _Float16* o; int ld;
    static constexpr int NST = 16;
    __device__ __forceinline__ void operator()(const f32x4 (&acc)[2][2][4][2], const pg8::Unit& u, int wr, int wc, int fr, int fq) const {
        const int row0 = u.pm * 256 + wr * 64 + fr;
        const LaneTr ltr(fr, fq); const int rowt = u.pm * 256 + wr * 64 + ltr.tr, col0 = u.pn * 256 + 32 * wc + 8 * ltr.tq;
        float rs8[2][4]; rstd8((const float*)(ws + WS_SSP), row0, fq, 1.f, rs8);
#pragma unroll
        for (int ai = 0; ai < 2; ++ai)
#pragma unroll
            for (int m = 0; m < 4; ++m) { const int row = rowt + ai * 128 + m * 16; const float rs = rs8[ai][m];
#pragma unroll
                for (int bj = 0; bj < 2; ++bj) { const f32x4 a = acc[ai][bj][m][0] * rs, b = acc[ai][bj][m][1] * rs;
                    const f16x8 h = (f16x8){(_Float16)a[0], (_Float16)a[1], (_Float16)a[2], (_Float16)a[3], (_Float16)b[0], (_Float16)b[1], (_Float16)b[2], (_Float16)b[3]};
                    *(u32x4*)(o + (size_t)row * ld + col0 + bj * 128) = ltr(__builtin_bit_cast(u32x4, h)); } }
    }
};
typedef PG8_LAS unsigned char* lds_t;
struct GEpiXSoftmax {
    unsigned char* ws; lds_t part;
    static constexpr int NST = 16;
    __device__ __forceinline__ void operator()(const f32x4 (&acc)[2][2][4][2], const pg8::Unit& u, int wr, int wc, int fr, int fq) const {
        const int row0 = u.pm * 256 + wr * 64 + fr, col0 = u.pn * 256 + 32 * wc + 8 * fq;
        f32x4 (&ex)[2][2][4][2] = const_cast<f32x4 (&)[2][2][4][2]>(acc);
        PG8_LAS f32x2* pt = (PG8_LAS f32x2*)part;
        float rs[2][4], mw[2][4];
#pragma unroll
        for (int ai = 0; ai < 2; ++ai)
#pragma unroll
            for (int m = 0; m < 4; ++m) { const int row = row0 + ai * 128 + m * 16; rs[ai][m] = rstd_q((const float*)(ws + WS_SSP), row, fq) * (1.4426950408889634f / (16.f * XS * GS));
                float mx = -INFINITY;
#pragma unroll
                for (int bj = 0; bj < 2; ++bj)
#pragma unroll
                    for (int n = 0; n < 2; ++n)
#pragma unroll
                        for (int e = 0; e < 4; ++e) mx = fmaxf(mx, acc[ai][bj][m][n][e]);
                mx *= rs[ai][m];
                mx = fmaxf(mx, lx16(mx)); mx = max_x32(mx);
                float sm = 0.f;
#pragma unroll
                for (int bj = 0; bj < 2; ++bj)
#pragma unroll
                    for (int n = 0; n < 2; ++n)
#pragma unroll
                        for (int e = 0; e < 4; ++e) { const float x = __builtin_amdgcn_exp2f(acc[ai][bj][m][n][e] * rs[ai][m] - mx); ex[ai][bj][m][n][e] = x; sm += x; }
                sm += lx16(sm); sm = add_x32(sm);
                mw[ai][m] = mx;
                if (fq == 0) pt[(wr * 64 + fr + ai * 128 + m * 16) * 4 + wc] = (f32x2){mx, sm}; }
        asm volatile("s_waitcnt lgkmcnt(0)" ::: "memory");
        __builtin_amdgcn_s_barrier();
#pragma unroll
        for (int ai = 0; ai < 2; ++ai)
#pragma unroll
            for (int m = 0; m < 4; ++m) { const int row = row0 + ai * 128 + m * 16;
                const PG8_LAS f32x2* pr = pt + (wr * 64 + fr + ai * 128 + m * 16) * 4;
                const f32x2 p0 = pr[0], p1 = pr[1], p2 = pr[2], p3 = pr[3];
                const float M = fmaxf(fmaxf(p0.x, p1.x), fmaxf(p2.x, p3.x));
                const float tot = (p0.y * __builtin_amdgcn_exp2f(p0.x - M) + p1.y * __builtin_amdgcn_exp2f(p1.x - M)) + (p2.y * __builtin_amdgcn_exp2f(p2.x - M) + p3.y * __builtin_amdgcn_exp2f(p3.x - M));
                const float f = __builtin_amdgcn_exp2f(mw[ai][m] - M) * (PS / tot);
#pragma unroll
                for (int bj = 0; bj < 2; ++bj) *(u32x2*)(ws + WS_PM + (size_t)row * D + col0 + bj * 128) = pk8_fp8(ex[ai][bj][m][0], ex[ai][bj][m][1], f); }
    }
};
__device__ __forceinline__ void fstage_win(const Params& p, int l, lds_t lds, int bid, int nb) {
    pg8::Order O; O.init(T, 3072, nb, bid, p.ws + WS_XB, D, p.ws + WS_WIN + (size_t)l * 3072 * D * 2, D);
    pg8::gemm_phase<GEpiWin, pg8::Order, true>(lds, D, D, D, O, GEpiWin{p.ws});
}
__device__ __forceinline__ void fstage_gates(const Params& p, int l, lds_t lds, int bid, int nb) {
    __syncthreads();
    pg8::Order O; O.init(T, 3072, nb, bid, p.ws + WS_XQ8, D / 2, p.ws + WS_WIN + 24 * MiB + (size_t)l * 3072 * D, D / 2);
    pg8::gemm_phase<GEpiGate, pg8::Order, true, pg8::NoHook, 1 << 20, true>(lds, D / 2, D / 2, D / 2, O, GEpiGate{p.ws});
}

template <bool HOOKS = true>
__device__ __forceinline__ void fstage_branch(const Params& p, int l, lds_t lds, int bid, int nb) {
    pg8::Order O; O.init(T, D, nb, bid, p.ws + WS_AO, 512, p.ws + WS_WB0 + (size_t)l * D * 1536 * 2, 1536);
    const long d1 = (long)WS_DP - (long)WS_AO - 8 * 128, d2 = (long)WS_SO - (long)WS_AO - 16 * 128;
    if constexpr (HOOKS) pg8::gemm_phase<GEpiBranch, pg8::Order, true, BranchHook, 8>(lds, 1536, 512, 1536, O, GEpiBranch{p.ws}, d1, d2, BranchHook{p.ws});
    else pg8::gemm_phase<GEpiBranch, pg8::Order, true, pg8::NoHook, 8>(lds, 1536, 512, 1536, O, GEpiBranch{p.ws}, d1, d2);
}
__device__ __forceinline__ void fstage_resid_out(const Params& p, int l, lds_t lds, int bid, int nb) {
    pg8::Order O; O.init(T, D, nb, bid, p.ws + WS_MG, D, p.ws + WS_WOUT + (size_t)l * D * D * 2, D);
    pg8::gemm_phase<GEpiResid, pg8::Order, true>(lds, D, D, D, O, GEpiResid{p.ws, true, 1.f});
}
__device__ __forceinline__ void fstage_resid_cross(const Params& p, int l, lds_t lds, int bid, int nb) {
    pg8::Order O; O.init(T, D, nb, bid, p.ws + WS_PM, D / 2, p.ws + WS_YT + (size_t)l * NB * D * D, D / 2, (size_t)D * D, S / 256);
    pg8::gemm_phase<GEpiResid, pg8::Order, true, pg8::NoHook, 1 << 20, true>(lds, D / 2, D / 2, D / 2, O, GEpiResid{p.ws, true, 1.f / (PS * YS)});
}
__device__ __forceinline__ void fstage_xscore(const Params& p, int l, lds_t lds, int bid, int nb) {
    pg8::Order O; O.init(T, D, nb, bid, p.ws + WS_XQ8, D / 2, p.ws + WS_GT + (size_t)l * NB * D * D, D / 2, (size_t)D * D, S / 256);
    pg8::gemm_phase<GEpiXSoftmax, pg8::Order, true, pg8::NoHook, 1 << 20, true>(lds, D / 2, D / 2, D / 2, O, GEpiXSoftmax{p.ws, lds + 131072});
}


struct GEpiKV {
    unsigned char* ws;
    static constexpr int NST = 16;
    __device__ __forceinline__ void operator()(const f32x4 (&acc)[2][2][4][2], const pg8::Unit& u, int wr, int wc, int fr, int fq) const {
        asm volatile("" : "+v"(fr), "+v"(fq));
        const int row0 = u.pm * 256 + wr * 64 + fr, l = u.pn >> 3, col0 = (u.pn & 7) * 256 + 32 * wc + 8 * fq;
        float rs8[2][4];
#pragma unroll
        for (int ai = 0; ai < 2; ++ai)
#pragma unroll
            for (int m = 0; m < 4; ++m) rs8[ai][m] = ((const float*)(ws + WS_RSTDM))[row0 + ai * 128 + m * 16];
#pragma unroll
        for (int ai = 0; ai < 2; ++ai)
#pragma unroll
            for (int m = 0; m < 4; ++m) { const int row = row0 + ai * 128 + m * 16; const float rs = rs8[ai][m];
#pragma unroll
                for (int bj = 0; bj < 2; ++bj) *(u32x4*)((bf16_t*)(ws + WS_KV) + ((size_t)l * MROWS + row) * 2048 + col0 + bj * 128) = pk8(acc[ai][bj][m][0] * rs, acc[ai][bj][m][1] * rs); }
    }
};
struct OrderG : pg8::Order {
    unsigned char* ws;
    __device__ __forceinline__ const char* a_ptr(const pg8::Unit& u) const { const int l = u.pm >> 5, b = (u.pm >> 2) & 7, h = u.pm & 3; return (const char*)(ws + WS_KV) + (((size_t)l * MROWS + b * 256) * 2048 + h * 256) * 2; }
    __device__ __forceinline__ const char* b_ptr(const pg8::Unit& u) const { const int l = u.pm >> 5, h = u.pm & 3; return (const char*)(ws + WS_WXQB) + (((size_t)l * D + u.pn * 256) * D + h * 256) * 2; }
};
struct GEpiG {
    unsigned char* ws;
    static constexpr int NST = 16;
    __device__ __forceinline__ void operator()(const f32x4 (&acc)[2][2][4][2], const pg8::Unit& u, int wr, int wc, int fr, int fq) const {
        asm volatile("" : "+v"(fr), "+v"(fq));
        const int lb = u.pm >> 2, h = u.pm & 3, r0 = wr * 64 + fr, col0 = u.pn * 256 + 32 * wc + 8 * fq;
#pragma unroll
        for (int ai = 0; ai < 2; ++ai)
#pragma unroll
            for (int m = 0; m < 4; ++m)
#pragma unroll
                for (int bj = 0; bj < 2; ++bj) *(u32x2*)(ws + WS_GT + ((size_t)lb * D + h * 256 + r0 + ai * 128 + m * 16) * D + col0 + bj * 128) = pk8_fp8(acc[ai][bj][m][0], acc[ai][bj][m][1], GS);
    }
};
struct OrderY : pg8::Order {
    unsigned char* ws;
    __device__ __forceinline__ const char* a_ptr(const pg8::Unit& u) const { const int l = u.pn >> 5, h = u.pn & 3; return (const char*)(ws + WS_WXOT) + (((size_t)l * D + u.pm * 256) * D + h * 256) * 2; }
    __device__ __forceinline__ const char* b_ptr(const pg8::Unit& u) const { const int l = u.pn >> 5, b = (u.pn >> 2) & 7, h = u.pn & 3; return (const char*)(ws + WS_KV) + (((size_t)l * MROWS + b * 256) * 2048 + 1024 + h * 256) * 2; }
};
struct GEpiY {
    unsigned char* ws;
    static constexpr int NST = 16;
    __device__ __forceinline__ void operator()(const f32x4 (&acc)[2][2][4][2], const pg8::Unit& u, int wr, int wc, int fr, int fq) const {
        asm volatile("" : "+v"(fr), "+v"(fq));
        const int lb = u.pn >> 2, h = u.pn & 3, row0 = u.pm * 256 + wr * 64 + fr, col0 = h * 256 + 32 * wc + 8 * fq;
#pragma unroll
        for (int ai = 0; ai < 2; ++ai)
#pragma unroll
            for (int m = 0; m < 4; ++m)
#pragma unroll
                for (int bj = 0; bj < 2; ++bj) *(u32x2*)(ws + WS_YT + ((size_t)lb * D + row0 + ai * 128 + m * 16) * D + col0 + bj * 128) = pk8_fp8(acc[ai][bj][m][0], acc[ai][bj][m][1], YS);
    }
};
__device__ __forceinline__ void fstage_kv(const Params& p, lds_t lds, int bid, int nb) {
    pg8::Order O; O.init(MROWS, L * 2048, nb, bid, p.ws + WS_MEMB, D, p.ws + WS_WXKVT, D);
    pg8::gemm_phase<GEpiKV, pg8::Order, true>(lds, D, D, D, O, GEpiKV{p.ws});
}
__device__ __forceinline__ void fstage_g(const Params& p, lds_t lds, int bid, int nb) {
    OrderG O; O.init(128 * 256, D, nb, bid, nullptr, 2048, nullptr, D); O.ws = p.ws;
    pg8::gemm_phase<GEpiG, OrderG, true>(lds, 256, 2048, D, O, GEpiG{p.ws});
}
__device__ __forceinline__ void fstage_y(const Params& p, lds_t lds, int bid, int nb) {
    OrderY O; O.init(D, 128 * 256, nb, bid, nullptr, D, nullptr, 2048); O.ws = p.ws;
    pg8::gemm_phase<GEpiY, OrderY, true>(lds, 256, D, 2048, O, GEpiY{p.ws});
}

#include <hip/hip_bf16.h>
namespace attn_body {
using bf16=__hip_bfloat16;
using bf16x8=__attribute__((ext_vector_type(8)))short;
using s16x4=__attribute__((ext_vector_type(4)))short;
using f32x16=__attribute__((ext_vector_type(16)))float;
using u32x4=__attribute__((ext_vector_type(4)))unsigned;
constexpr int SEQ=4096,D=64,DM=512;
constexpr int NW=8,QBLK=32,QB=QBLK*NW,KVBLK=64,NQB=SEQ/QB;
constexpr int ATTN_PITCH=DM, ATTN_UNIT_ROWS=QB;
__device__ __forceinline__ int crow(int r,int hi){return (r&3)+8*(r>>2)+4*hi;}
#define SBAR() __builtin_amdgcn_sched_barrier(0)
__device__ __forceinline__ void cmask(f32x16&p0,f32x16&p1,int jb,int qrel,int hi){
  const float NEG=-INFINITY; int kb=64*jb+4*hi;
  #pragma unroll
  for(int r=0;r<16;++r){int kv=kb+(r&3)+8*(r>>2); if(kv>qrel)p0[r]=NEG; if(kv+32>qrel)p1[r]=NEG;}
}

constexpr int NSLOT=3, SLOTB=8192;
constexpr int LDS_K=0, LDS_V=NSLOT*SLOTB, LDS_WS=3*NSLOT*SLOTB, LDS_OST=LDS_WS+NW*64*4, LDS_BYTES=LDS_OST+NW*8192;
constexpr float C2=0.125f*1.4426950408889634f;
__device__ __forceinline__ void glds16(const void*gsrc,unsigned lds_dst){unsigned keep;
  asm volatile("s_mov_b32 %0, m0\n\ts_mov_b32 m0, %2\n\ts_nop 0\n\tglobal_load_lds_dwordx4 %1, off\n\ts_mov_b32 m0, %0":"=&s"(keep):"v"(gsrc),"s"(lds_dst):"memory");}
__device__ __forceinline__ float max3f(float a,float b,float c){float r;asm("v_max3_f32 %0, %1, %2, %3":"=v"(r):"v"(a),"v"(b),"v"(c));return r;}
__device__ __forceinline__ float max2f(float a,float b){float r;asm("v_max_f32_e32 %0, %1, %2":"=v"(r):"v"(a),"v"(b));return r;}
__device__ __forceinline__ float fadd_s(float a,float b){float r;asm("v_add_f32_e32 %0, %1, %2":"=v"(r):"v"(a),"v"(b));return r;}
__device__ __forceinline__ float fsub_s(float a,float b){float r;asm("v_sub_f32_e32 %0, %1, %2":"=v"(r):"v"(a),"v"(b));return r;}
typedef float f32x2_t __attribute__((ext_vector_type(2))); typedef __bf16 bf16x2_t __attribute__((ext_vector_type(2)));
__device__ __forceinline__ unsigned cvtpk_s(float lo,float hi){f32x2_t v={lo,hi};bf16x2_t b=__builtin_convertvector(v,bf16x2_t);return __builtin_bit_cast(unsigned,b);}
#define WAIT_BAR(N) asm volatile("s_waitcnt vmcnt(" #N ") lgkmcnt(0)\n\ts_barrier":::"memory")

__device__ __forceinline__ void qkt(f32x16&p0,f32x16&p1,const char*Kslot,const bf16x8*qr,const f32x16&negm,int r32,int hi){
  const char*kb=Kslot+hi*1024+r32*16;
  #pragma unroll
  for(int d0=0;d0<4;++d0){
    const bf16x8 b0=*reinterpret_cast<const bf16x8*>(kb+d0*2048);
    const bf16x8 b1=*reinterpret_cast<const bf16x8*>(kb+d0*2048+512);
    if(d0==0){p0=__builtin_amdgcn_mfma_f32_32x32x16_bf16(b0,qr[0],negm,0,0,0);p1=__builtin_amdgcn_mfma_f32_32x32x16_bf16(b1,qr[0],negm,0,0,0);}
    else{p0=__builtin_amdgcn_mfma_f32_32x32x16_bf16(b0,qr[d0],p0,0,0,0);p1=__builtin_amdgcn_mfma_f32_32x32x16_bf16(b1,qr[d0],p1,0,0,0);}}
}
typedef __attribute__((address_space(3))) const char* lds_cptr;
typedef short v4i16_t __attribute__((ext_vector_type(4)));
__device__ __forceinline__ void kload8(bf16x8*kf,lds_cptr kp){
  kf[0]=*(const __attribute__((address_space(3))) bf16x8*)(kp);      kf[1]=*(const __attribute__((address_space(3))) bf16x8*)(kp+512);
  kf[2]=*(const __attribute__((address_space(3))) bf16x8*)(kp+2048); kf[3]=*(const __attribute__((address_space(3))) bf16x8*)(kp+2560);
  kf[4]=*(const __attribute__((address_space(3))) bf16x8*)(kp+4096); kf[5]=*(const __attribute__((address_space(3))) bf16x8*)(kp+4608);
  kf[6]=*(const __attribute__((address_space(3))) bf16x8*)(kp+6144); kf[7]=*(const __attribute__((address_space(3))) bf16x8*)(kp+6656);
}
__device__ __forceinline__ void kload2(bf16x8*kf,lds_cptr kp,int j){ kf[2*j]=*(const __attribute__((address_space(3))) bf16x8*)(kp+j*2048); kf[2*j+1]=*(const __attribute__((address_space(3))) bf16x8*)(kp+j*2048+512); }
__device__ __forceinline__ s16x4 vtr(lds_cptr p){ return __builtin_bit_cast(s16x4,__builtin_amdgcn_ds_read_tr16_b64_v4i16((__attribute__((address_space(3))) v4i16_t*)p)); }
__device__ __forceinline__ float rowmax(const f32x16&p0,const f32x16&p1){
  float a=max3f(p0[0],p0[1],p1[0]),b=max3f(p0[2],p0[3],p1[1]);a=max3f(a,p1[2],p1[3]);
  #pragma unroll
  for(int r=4;r<16;r+=4){a=max3f(a,p0[r],p0[r+1]);b=max3f(b,p0[r+2],p0[r+3]);a=max3f(a,p1[r],p1[r+1]);b=max3f(b,p1[r+2],p1[r+3]);}
  const float m=max2f(a,b);
  auto rr=__builtin_amdgcn_permlane32_swap(__float_as_uint(m),__float_as_uint(m),false,false);
  return max2f(__uint_as_float(rr[0]),__uint_as_float(rr[1]));
}
__device__ __forceinline__ void pv(f32x16*o,int vb,bf16x8 pa0,bf16x8 pa1,bf16x8 pa2,bf16x8 pa3){
  #pragma unroll
  for(int d0=0;d0<4;++d0){s16x4 lo[4],hi[4];
    #pragma unroll
    for(int ks=0;ks<4;++ks){
      asm volatile("ds_read_b64_tr_b16 %0,%1 offset:%c2":"=&v"(lo[ks]):"v"(vb),"i"(d0*4096+ks*1024):"memory");
      asm volatile("ds_read_b64_tr_b16 %0,%1 offset:%c2":"=&v"(hi[ks]):"v"(vb),"i"(d0*4096+ks*1024+512):"memory");}
    asm volatile("s_waitcnt lgkmcnt(0)":::"memory");SBAR();
    #define PK(k) (bf16x8){lo[k][0],lo[k][1],lo[k][2],lo[k][3],hi[k][0],hi[k][1],hi[k][2],hi[k][3]}
    o[d0]=__builtin_amdgcn_mfma_f32_32x32x16_bf16(pa0,PK(0),o[d0],0,0,0);
    o[d0]=__builtin_amdgcn_mfma_f32_32x32x16_bf16(pa1,PK(1),o[d0],0,0,0);
    o[d0]=__builtin_amdgcn_mfma_f32_32x32x16_bf16(pa2,PK(2),o[d0],0,0,0);
    o[d0]=__builtin_amdgcn_mfma_f32_32x32x16_bf16(pa3,PK(3),o[d0],0,0,0);
    #undef PK
  }
}

#ifndef ATTN_STORE16
#define ATTN_STORE16(p,v) (*(u32x4*)(p)=(v))
#endif
template<int THRL> __device__ __forceinline__ void attn_unit(int b,int qcol,int kcol,int vcol,int ocol,int qb,const bf16*Q,const bf16*__restrict__ K,const bf16*__restrict__ V,bf16*O,char*shm,const bf16*O1f=nullptr,float lam=0.f){
  const int tid=tid_fresh(),lane=tid&63,r32=lane&31,hi=lane>>5; const int wid=__builtin_amdgcn_readfirstlane(tid>>6);
  const long rowbase=(long)b*SEQ; const int q0=qb*QB;
  const bf16*Qw=Q+(rowbase+q0+wid*QBLK)*DM+qcol;
  const bf16*Kh=K+rowbase*DM+kcol,*Vh=V+rowbase*DM+vcol;
  const unsigned lds0=(unsigned)(uintptr_t)shm;
  float*wsf=(float*)(shm+LDS_WS)+wid*64;
  const bf16*ksrc=Kh+(long)lane*DM+wid*8;
  const bf16*vsrc=Vh+(long)(16*(wid&3)+(lane>>2))*DM+(wid>>2)*32+(lane&3)*8;
  const unsigned kdst=lds0+LDS_K+wid*1024, vdst=lds0+LDS_V+wid*1024;
  #define DMA_K(t,slot) glds16(ksrc+(long)(t)*KVBLK*DM,(unsigned)__builtin_amdgcn_readfirstlane(kdst+(slot)))
  #define DMA_V(t,slot) do{ glds16(vsrc+(long)(t)*KVBLK*DM,(unsigned)__builtin_amdgcn_readfirstlane(vdst+2*(slot))); glds16(vsrc+64+(long)(t)*KVBLK*DM,(unsigned)__builtin_amdgcn_readfirstlane(vdst+2*(slot)+8192)); }while(0)
  const int vb0=(int)(lds0+LDS_V)+((lane>>4)&1)*32+(lane&3)*8+(4*hi+((lane&15)>>2))*64;
  const char*Kbase=shm+LDS_K; bf16x8 kf[8];
  const lds_cptr shm3=(lds_cptr)shm; const lds_cptr kp0=shm3+LDS_K+hi*1024+r32*16; const lds_cptr vp0=shm3+LDS_V+((lane>>4)&1)*32+(lane&3)*8+(4*hi+((lane&15)>>2))*64;
  const int NT=(q0+QB)/KVBLK;
  DMA_K(0,0);DMA_V(0,0);DMA_K(1,SLOTB);
  bf16x8 qr[4];
  #pragma unroll
  for(int d0=0;d0<4;++d0)qr[d0]=*reinterpret_cast<const bf16x8*>(&Qw[(long)r32*DM+d0*16+hi*8]);
  float mhat=0.f,l_reg=0.f;f32x16 o[4];f32x16 negm;{float z_=0.f;asm volatile("":"+v"(z_));o[0]=(f32x16)(z_);o[1]=(f32x16)(z_);o[2]=(f32x16)(z_);o[3]=(f32x16)(z_);negm=(f32x16)(z_);}asm volatile("":"+v"(negm));
  const int qrel=wid*QBLK+r32;
  #define CMASK(P0,P1,t) do{int jb_=(t)-(NT-4); if(jb_>=0)cmask(P0,P1,jb_,qrel,hi);}while(0)
  bool resc=false;
  #define START(P0,P1) do{ const float rm=rowmax(P0,P1); resc=false; \
    { const float dl=rm; mhat=fadd_s(mhat,dl); \
      _Pragma("unroll") for(int r=0;r<16;++r){P0[r]=fsub_s(P0[r],dl);P1[r]=fsub_s(P1[r],dl);} \
      _Pragma("unroll") for(int r=0;r<16;++r)negm[r]=-mhat; asm volatile("":"+v"(negm)); } \
    _Pragma("unroll") for(int r=0;r<16;++r)P0[r]=__builtin_amdgcn_exp2f(P0[r]); }while(0)
  #define RESC() do{ if(resc){ asm volatile("s_waitcnt lgkmcnt(0)":::"memory"); \
      _Pragma("unroll") for(int d_=0;d_<4;++d_) _Pragma("unroll") for(int r=0;r<16;++r)o[d_][r]*=wsf[crow(r,hi)]; } }while(0)
  f32x16 pA0,pA1,pB0,pB1;
  int sl_prev=0,sl_cur=0,sl_next=SLOTB;
  #define ROT() do{sl_prev=sl_cur;sl_cur=sl_next;sl_next=(sl_next==(NSLOT-1)*SLOTB)?0:sl_next+SLOTB;}while(0)
  DMA_K(2,2*SLOTB);
  WAIT_BAR(4);
  qkt(pA0,pA1,Kbase,qr,negm,r32,hi);asm volatile("s_nop 15\n\ts_nop 7":"+v"(pA0),"+v"(pA1));CMASK(pA0,pA1,0);
  START(pA0,pA1);
  _Pragma("unroll") for(int r=0;r<16;++r)pA1[r]=__builtin_amdgcn_exp2f(pA1[r]);
  WAIT_BAR(0);
  DMA_K(3,0);DMA_V(1,SLOTB);
  ROT();
  kload8(kf,kp0+sl_cur);
  WAIT_BAR(3);
  s16x4 vlo[8],vhi[8]; u32x4 pw0,pw1,pw2,pw3;
  #define PKW(P,B) cvtpk_s(P[B],P[B+1])
  #define PAF(k) __builtin_bit_cast(bf16x8,pw##k)
  #define VFR(i) (bf16x8){vlo[i][0],vlo[i][1],vlo[i][2],vlo[i][3],vhi[i][0],vhi[i][1],vhi[i][2],vhi[i][3]}
  #define PIN(x) asm volatile("":"+v"(x))
  #define MX3(a,b,c) __builtin_fmaxf(__builtin_fmaxf((a),(b)),(c))
  #define GAPA(MF,A0,A1,A2,A3,W0,W1,PW) do{ MF; sacc+=A0; sacc+=A1; sacc+=A2; sacc+=A3; PIN(sacc); W0; W1; PIN(PW); SBAR(); }while(0)
  #define EX(v) __builtin_amdgcn_exp2f(v)
  #define GAPB(MF,X,B) do{ MF; X[B]=EX(X[B]); X[B+1]=EX(X[B+1]); X[B+2]=EX(X[B+2]); X[B+3]=EX(X[B+3]); PIN(X); SBAR(); }while(0)
  #define VRD(i) do{ vlo[i]=vtr(vp_+(((i)>>2)*4096+((i)&3)*1024)); vhi[i]=vtr(vp_+(((i)>>2)*4096+((i)&3)*1024+512)); }while(0)
  #define VRD2(i) do{ vlo[i]=vtr(vp_+((((i)>>2)+2)*4096+((i)&3)*1024)); vhi[i]=vtr(vp_+((((i)>>2)+2)*4096+((i)&3)*1024+512)); SBAR(); }while(0)
  #define KRD(G,j) do{ if(G){ kload2(kf,kp0+sl_next,j); SBAR(); } }while(0)
  #define STEP(C0,C1,P0,P1,t,GK,GV,GL) do{ SBAR(); \
    const lds_cptr vp_=vp0+2*sl_prev; \
    VRD(0); SBAR(); float sacc=(P0[0]+P0[1]); \
    GAPA(C0=__builtin_amdgcn_mfma_f32_32x32x16_bf16(kf[0],qr[0],negm,0,0,0), P0[2],P0[3],P0[4],P0[5],     pw0[0]=PKW(P0,0), pw0[1]=PKW(P0,2), pw0); \
    VRD(4); SBAR(); GAPA(C1=__builtin_amdgcn_mfma_f32_32x32x16_bf16(kf[1],qr[0],negm,0,0,0), P0[6],P0[7],P0[8],P0[9],     pw0[2]=PKW(P0,4), pw0[3]=PKW(P0,6), pw0); \
    VRD(1); SBAR(); GAPA(C0=__builtin_amdgcn_mfma_f32_32x32x16_bf16(kf[2],qr[1],C0,0,0,0),   P0[10],P0[11],P0[12],P0[13], pw1[0]=PKW(P0,8), pw1[1]=PKW(P0,10), pw1); \
    VRD(5); SBAR(); GAPA(C1=__builtin_amdgcn_mfma_f32_32x32x16_bf16(kf[3],qr[1],C1,0,0,0),   P0[14],P0[15],P1[0],P1[1],   pw1[2]=PKW(P0,12),pw1[3]=PKW(P0,14), pw1); \
    VRD(2); SBAR(); GAPA(C0=__builtin_amdgcn_mfma_f32_32x32x16_bf16(kf[4],qr[2],C0,0,0,0),   P1[2],P1[3],P1[4],P1[5],     pw2[0]=PKW(P1,0), pw2[1]=PKW(P1,2), pw2); \
    VRD(6); SBAR(); GAPA(C1=__builtin_amdgcn_mfma_f32_32x32x16_bf16(kf[5],qr[2],C1,0,0,0),   P1[6],P1[7],P1[8],P1[9],     pw2[2]=PKW(P1,4), pw2[3]=PKW(P1,6), pw2); \
    VRD(3); SBAR(); GAPA(C0=__builtin_amdgcn_mfma_f32_32x32x16_bf16(kf[6],qr[3],C0,0,0,0),   P1[10],P1[11],P1[12],P1[13], pw3[0]=PKW(P1,8), pw3[1]=PKW(P1,10), pw3); \
    VRD(7); SBAR(); GAPA(C1=__builtin_amdgcn_mfma_f32_32x32x16_bf16(kf[7],qr[3],C1,0,0,0),   P1[14],P1[15],0.f,0.f,       pw3[2]=PKW(P1,12),pw3[3]=PKW(P1,14), pw3); \
    l_reg+=sacc; \
    if(GK){DMA_K((t)+3,sl_cur);} if(GV){DMA_V((t)+1,sl_next);} \
    CMASK(C0,C1,t); \
    { float a=MX3(C0[0],C0[1],C1[0]),b=MX3(C0[2],C0[3],C1[1]); a=MX3(a,C1[2],C1[3]); \
      _Pragma("unroll") for(int r=4;r<16;r+=4){a=MX3(a,C0[r],C0[r+1]);b=MX3(b,C0[r+2],C0[r+3]);a=MX3(a,C1[r],C1[r+1]);b=MX3(b,C1[r+2],C1[r+3]);} \
      float rm=__builtin_fmaxf(a,b); { auto rr=__builtin_amdgcn_permlane32_swap(__float_as_uint(rm),__float_as_uint(rm),false,false); rm=__builtin_fmaxf(__uint_as_float(rr[0]),__uint_as_float(rr[1])); } \
      resc=false; \
      if(__builtin_expect(__any(rm>(float)THRL),0)){ const float dl=__builtin_fmaxf(rm,0.f); mhat+=dl; \
        _Pragma("unroll") for(int r=0;r<16;++r){C0[r]-=dl;C1[r]-=dl;} \
        _Pragma("unroll") for(int r=0;r<16;++r)negm[r]=-mhat; asm volatile("":"+v"(negm)); \
        const float f=__builtin_amdgcn_exp2f(-dl); l_reg*=f; if(hi==0)wsf[r32]=f; resc=true; } } \
    SBAR(); \
    GAPB(o[0]=__builtin_amdgcn_mfma_f32_32x32x16_bf16(PAF(0),VFR(0),o[0],0,0,0), C0,0); VRD2(0); \
    GAPB(o[1]=__builtin_amdgcn_mfma_f32_32x32x16_bf16(PAF(0),VFR(4),o[1],0,0,0), C0,4); VRD2(4); \
    KRD(GL,0); GAPB(o[0]=__builtin_amdgcn_mfma_f32_32x32x16_bf16(PAF(1),VFR(1),o[0],0,0,0), C0,8); VRD2(1); \
    KRD(GL,1); GAPB(o[1]=__builtin_amdgcn_mfma_f32_32x32x16_bf16(PAF(1),VFR(5),o[1],0,0,0), C0,12); VRD2(5); \
    KRD(GL,2); GAPB(o[0]=__builtin_amdgcn_mfma_f32_32x32x16_bf16(PAF(2),VFR(2),o[0],0,0,0), C1,0); VRD2(2); \
    KRD(GL,3); GAPB(o[1]=__builtin_amdgcn_mfma_f32_32x32x16_bf16(PAF(2),VFR(6),o[1],0,0,0), C1,4); VRD2(6); \
    GAPB(o[0]=__builtin_amdgcn_mfma_f32_32x32x16_bf16(PAF(3),VFR(3),o[0],0,0,0), C1,8); VRD2(3); \
    GAPB(o[1]=__builtin_amdgcn_mfma_f32_32x32x16_bf16(PAF(3),VFR(7),o[1],0,0,0), C1,12); VRD2(7); \
    o[2]=__builtin_amdgcn_mfma_f32_32x32x16_bf16(PAF(0),VFR(0),o[2],0,0,0); o[3]=__builtin_amdgcn_mfma_f32_32x32x16_bf16(PAF(0),VFR(4),o[3],0,0,0); SBAR(); \
    o[2]=__builtin_amdgcn_mfma_f32_32x32x16_bf16(PAF(1),VFR(1),o[2],0,0,0); o[3]=__builtin_amdgcn_mfma_f32_32x32x16_bf16(PAF(1),VFR(5),o[3],0,0,0); SBAR(); \
    o[2]=__builtin_amdgcn_mfma_f32_32x32x16_bf16(PAF(2),VFR(2),o[2],0,0,0); o[3]=__builtin_amdgcn_mfma_f32_32x32x16_bf16(PAF(2),VFR(6),o[3],0,0,0); SBAR(); \
    o[2]=__builtin_amdgcn_mfma_f32_32x32x16_bf16(PAF(3),VFR(3),o[2],0,0,0); o[3]=__builtin_amdgcn_mfma_f32_32x32x16_bf16(PAF(3),VFR(7),o[3],0,0,0); SBAR(); \
    }while(0)
  int t=1;
  #undef CMASK
  #define CMASK(P0,P1,t) do{}while(0)
  for(;t+5<NT;t+=2){
    STEP(pB0,pB1,pA0,pA1,t,true,true,true);     WAIT_BAR(3); RESC(); ROT();
    STEP(pA0,pA1,pB0,pB1,t+1,true,true,true);   WAIT_BAR(3); RESC(); ROT();
  }
  #undef CMASK
  #define CMASK(P0,P1,t) do{int jb_=(t)-(NT-4); if(jb_>=0)cmask(P0,P1,jb_,qrel,hi);}while(0)
  #define ENDW(tt) do{ if((tt)+3<NT){WAIT_BAR(3);} else if((tt)+2<NT){WAIT_BAR(2);} else {WAIT_BAR(0);} }while(0)
  for(;t+1<NT;t+=2){
    STEP(pB0,pB1,pA0,pA1,t,(t+3<NT),(t+1<NT),(t+1<NT));       ENDW(t);   RESC(); ROT();
    STEP(pA0,pA1,pB0,pB1,t+1,(t+4<NT),(t+2<NT),(t+2<NT));     ENDW(t+1); RESC(); ROT();
  }
  STEP(pB0,pB1,pA0,pA1,NT-1,false,false,false); RESC();
  { float sacc=pB0[0]+pB0[1]; _Pragma("unroll") for(int r=2;r<16;++r)sacc+=pB0[r]; _Pragma("unroll") for(int r=0;r<16;++r)sacc+=pB1[r]; l_reg+=sacc;
    pw0=(u32x4){PKW(pB0,0),PKW(pB0,2),PKW(pB0,4),PKW(pB0,6)};pw1=(u32x4){PKW(pB0,8),PKW(pB0,10),PKW(pB0,12),PKW(pB0,14)};pw2=(u32x4){PKW(pB1,0),PKW(pB1,2),PKW(pB1,4),PKW(pB1,6)};pw3=(u32x4){PKW(pB1,8),PKW(pB1,10),PKW(pB1,12),PKW(pB1,14)};
    SBAR(); pv(o,vb0+2*sl_cur,PAF(0),PAF(1),PAF(2),PAF(3)); }
  #undef PKW
  #undef PAF
  #undef VFR
  #undef PIN
  #undef MX3
  #undef GAPA
  #undef GAPB
  #undef EX
  #undef VRD
  #undef VRD2
  #undef KRD
  #undef STEP
  #undef ENDW
  {auto rr=__builtin_amdgcn_permlane32_swap(__float_as_uint(l_reg),__float_as_uint(l_reg),false,false);l_reg=__uint_as_float(rr[0])+__uint_as_float(rr[1]);}
  if(hi==0)wsf[32+r32]=l_reg;asm volatile("s_waitcnt lgkmcnt(0)":::"memory");
  float rli[16];
  #pragma unroll
  for(int r=0;r<16;++r)rli[r]=__builtin_amdgcn_rcpf(wsf[32+crow(r,hi)]);
  bf16*Ow=O+(rowbase+q0+wid*QBLK)*DM+ocol;
  { bf16*stg=(bf16*)(shm+LDS_OST)+wid*4096;
    #pragma unroll
    for(int r=0;r<16;++r){const int orow=crow(r,hi);
      #pragma unroll
      for(int d0=0;d0<4;++d0)stg[orow*128+d0*32+r32]=__float2bfloat16(o[d0][r]*rli[r]);}
    asm volatile("s_waitcnt lgkmcnt(0)":::"memory");
    if(O1f==nullptr){
      #pragma unroll
      for(int i=0;i<8;++i){const int row=i*4+(lane>>4),ch=lane&15; const u32x4 v=*(const u32x4*)(stg+row*128+ch*8); ATTN_STORE16(Ow+(long)row*DM+ch*8,v);} }
    else{ const bf16*O1w=O1f+(rowbase+q0+wid*QBLK)*DM+ocol; u32x4 a1[8];
      #pragma unroll
      for(int i=0;i<8;++i){const int row=i*4+(lane>>4),ch=lane&15; a1[i]=*(const u32x4*)(O1w+(long)row*DM+ch*8);}
      #pragma unroll
      for(int i=0;i<8;++i){const int row=i*4+(lane>>4),ch=lane&15; const u32x4 v=*(const u32x4*)(stg+row*128+ch*8); float x[8];
        #pragma unroll
        for(int e=0;e<4;++e){x[2*e]=__uint_as_float(a1[i][e]<<16)-lam*__uint_as_float(v[e]<<16);x[2*e+1]=__uint_as_float(a1[i][e]&0xffff0000u)-lam*__uint_as_float(v[e]&0xffff0000u);}
        float ss=0.f;
        #pragma unroll
        for(int e=0;e<8;++e)ss+=x[e]*x[e];
        ss=::sum16(ss);
        const float rs=rsqrtf(ss*(1.f/128.f)+1e-6f); u32x4 w;
        #pragma unroll
        for(int e=0;e<4;++e)w[e]=cvtpk_s(x[2*e]*rs,x[2*e+1]*rs);
        ATTN_STORE16(Ow+(long)row*DM+ch*8,w);} } }
  asm volatile("s_waitcnt lgkmcnt(0)\n\ts_barrier":::"memory");
  #undef DMA_K
  #undef DMA_V
  #undef CMASK
  #undef START
  #undef RESC
  #undef ROT
}
constexpr int ATTN_LDS_BYTES=LDS_BYTES;
#undef SBAR
#undef WAIT_BAR
}

__device__ __forceinline__ void fstage_attn(const Params& p, int l, char* lds) {
    const int G = gridDim.x, bx = blockIdx.x;
    const int vcu = (G % 8 == 0) ? (bx % 8) * (G / 8) + bx / 8 : bx;
    const attn_body::bf16* Q = (const attn_body::bf16*)(p.ws + WS_QB); const attn_body::bf16* K = (const attn_body::bf16*)(p.ws + WS_KB); const attn_body::bf16* V = (const attn_body::bf16*)(p.ws + WS_VB);
    __syncthreads();
    float lam;
    { const int lane = tid_fresh() & 63; const float* lq = (const float*)p.in[5] + l * 256;
      float d1 = lq[lane] * lq[64 + lane], d2 = lq[128 + lane] * lq[192 + lane];
      d1 = wave_sum(d1); d2 = wave_sum(d2);
      lam = __uint_as_float((unsigned)__builtin_amdgcn_readfirstlane((int)__float_as_uint(expf(d1) - expf(d2) + lam_init_of(l)))); }
    for (int k = vcu; k < 256; k += G) {
        const int s = k & 7, h = (k >> 3) & 3, b = k >> 5;
#pragma unroll 1
        for (int i = 0; i < 4; ++i) {
            const int qb = (i & 2) ? 15 - s : s, m = i & 1;
            attn_body::bf16* O = (attn_body::bf16*)(p.ws + (m == 0 ? WS_O1 : WS_AO));
            const attn_body::bf16* O1f = (m == 0) ? nullptr : (const attn_body::bf16*)(p.ws + WS_O1);
            attn_body::attn_unit<8>(b, (2 * h + m) * 64, (2 * h + m) * 64, h * 128, h * 128, qb, Q, K, V, O, lds, O1f, lam);
        }
    }
}


__device__ __forceinline__ void fstage_sgate(const Params& p, int l, lds_t lds) {
    unsigned char* ws = p.ws;
    const int tid = tid_fresh(), lane = tid & 63, wid = __builtin_amdgcn_readfirstlane(tid >> 6), fr = lane & 15, fq = lane >> 4;
    constexpr int PV = 1056;
    PG8_LAS unsigned char* vn = lds;
    const bf16_t* vin = (const bf16_t*)(ws + WS_VIN); const bf16_t* uin = (const bf16_t*)(ws + WS_UIN); bf16_t* so = (bf16_t*)(ws + WS_SO);
    const float* lng = (const float*)p.in[9] + l * 512; const float* lnb = (const float*)p.in[10] + l * 512; const float* bsp = (const float*)p.in[12] + l * 512;
    const bf16_t* wsm = (const bf16_t*)(ws + WS_WSPT) + (size_t)l * 4 * 16384;
    for (int ch = blockIdx.x; ch < T / 128; ch += gridDim.x) {
        const int t0 = ch * 128;
        __syncthreads();
        {
            u32x4 rw[16];
#pragma unroll
            for (int i = 0; i < 16; ++i) rw[i] = *(const u32x4*)(vin + (size_t)(t0 + wid * 16 + i) * 512 + lane * 8);
            const f32x4 g0 = *(const f32x4*)(lng + lane * 8), g1 = *(const f32x4*)(lng + lane * 8 + 4), b0 = *(const f32x4*)(lnb + lane * 8), b1 = *(const f32x4*)(lnb + lane * 8 + 4);
#pragma unroll
            for (int i = 0; i < 16; ++i) {
                f32x4 a, b; up8(rw[i], a, b);
                const float mu = wave_sum((a[0] + a[1]) + (a[2] + a[3]) + (b[0] + b[1]) + (b[2] + b[3])) * (1.f / 512.f);
                a = a - mu; b = b - mu;
                const float vr = wave_sum((a[0] * a[0] + a[1] * a[1]) + (a[2] * a[2] + a[3] * a[3]) + (b[0] * b[0] + b[1] * b[1]) + (b[2] * b[2] + b[3] * b[3])) * (1.f / 512.f);
                const float rs = rsqrtf(vr + EPS);
                *(PG8_LAS u32x4*)(vn + (wid * 16 + i) * PV + lane * 16) = pk8(a * rs * g0 + b0, b * rs * g1 + b1);
            }
        }
        __syncthreads();
        const int nks = (16 * wid + 16 + 31) >> 5;
        const int trow = t0 + 16 * wid + fr;
#pragma unroll 1
        for (int g = 0; g < 4; ++g) {
            f32x4 acc[8];
#pragma unroll
            for (int nt = 0; nt < 8; ++nt) acc[nt] = (f32x4){0.f, 0.f, 0.f, 0.f};
            const bf16_t* wrow = wsm + ((size_t)g * 128 + 16 * wid + fr) * 128 + fq * 8;
#pragma unroll 1
            for (int ks = 0; ks < nks; ++ks) {
                const bf16x8 af = *(const bf16x8*)(wrow + ks * 32);
                const PG8_LAS unsigned char* vb = vn + (ks * 32 + fq * 8 + (fr >> 2)) * PV + (fr & 3) * 8 + g * 256;
#pragma unroll
                for (int nt = 0; nt < 8; ++nt) {
                    typedef short v4i16s __attribute__((ext_vector_type(4)));
                    const v4i16s lo = __builtin_amdgcn_ds_read_tr16_b64_v4i16((PG8_LAS v4i16s*)(vb + nt * 32)), hi = __builtin_amdgcn_ds_read_tr16_b64_v4i16((PG8_LAS v4i16s*)(vb + nt * 32 + 4 * PV));
                    const bf16x8 bf = (bf16x8){lo[0], lo[1], lo[2], lo[3], hi[0], hi[1], hi[2], hi[3]};
                    acc[nt] = __builtin_amdgcn_mfma_f32_16x16x32_bf16(bf, af, acc[nt], 0, 0, 0);
                }
            }
            const float bs = bsp[g * 128 + 16 * wid + fr];
#pragma unroll
            for (int nt = 0; nt < 8; ++nt) { const size_t o = (size_t)trow * 512 + g * 128 + nt * 16 + fq * 4; st_bf4(so + o, ld_bf4(uin + o) * (acc[nt] + bs)); }
        }
    }
}

__device__ __forceinline__ void stage_pool_d(const Params& p, int bid, int nb) {
    const int tidx = tid_fresh();
    unsigned char* ws = p.ws;
    const unsigned char* pin = ws + WS_PIN; unsigned char* dp = ws + WS_DP;
    for (int i = bid * NT + tidx; i < (T / 8) * 64; i += nb * NT) {
        const int c8 = (i & 63) * 8, t0 = (i >> 6) * 8, s0 = t0 & (S - 1), g = c8 >> 7, w = 2 << g;
        const unsigned ob = (unsigned)(t0 * 512 + c8) * 2u;
        u32x4 pv[16], cv[8];
#pragma unroll
        for (int k = 1; k <= 16; ++k) pv[k - 1] = (k <= w && k <= s0) ? *(const u32x4*)(pin + (ob - (unsigned)k * 1024u)) : (u32x4){0u, 0u, 0u, 0u};
#pragma unroll
        for (int j = 0; j < 8; ++j) cv[j] = *(const u32x4*)(pin + (ob + (unsigned)j * 1024u));
        f32x4 s0v = (f32x4){0.f, 0.f, 0.f, 0.f}, s1v = s0v, a, b;
#pragma unroll
        for (int k = 0; k < 16; ++k) { up8(pv[k], a, b); s0v = s0v + a; s1v = s1v + b; }
#pragma unroll
        for (int j = 0; j < 8; ++j) {
            f32x4 ca, cb; up8(cv[j], ca, cb); s0v = s0v + ca; s1v = s1v + cb;
            u32x4 lv = pv[(15 - j) & 15];
            if (g == 2) lv = pv[7 - j];
            if (g == 1) lv = (j < 4) ? pv[3 - (j & 3)] : cv[(j - 4) & 7];
            if (g == 0) lv = (j < 2) ? pv[1 - (j & 1)] : cv[(j - 2) & 7];
            up8(lv, a, b); s0v = s0v - a; s1v = s1v - b;
            const int sj = s0 + j + 1; const float inv = 1.f / (float)(sj < w ? sj : w);
            *(u32x4*)(dp + (ob + (unsigned)j * 1024u)) = pk8(s0v * inv - ca, s1v * inv - cb);
        }
    }
}
__device__ __forceinline__ void stage_aout(const Params& p, int l, int bid, int nb) {
    const int tidx = tid_fresh();
    unsigned char* ws = p.ws;
    const int lane = tidx & 63, wid = tidx >> 6;
    const float* lq = (const float*)p.in[5] + l * 256;
    float d1 = lq[lane] * lq[64 + lane], d2 = lq[128 + lane] * lq[192 + lane];
    d1 = wave_sum(d1); d2 = wave_sum(d2);
    const float lam = expf(d1) - expf(d2) + lam_init_of(l);
    for (int t = bid * 8 + wid; t < T; t += nb * 8) {
        const u32x4 a = *(const u32x4*)((const bf16_t*)(ws + WS_O1) + (size_t)t * 512 + lane * 8), b = *(const u32x4*)((const bf16_t*)(ws + WS_O2) + (size_t)t * 512 + lane * 8);
        float x[8];
#pragma unroll
        for (int e = 0; e < 4; ++e) { x[2 * e] = __uint_as_float(a[e] << 16) - lam * __uint_as_float(b[e] << 16); x[2 * e + 1] = __uint_as_float(a[e] & 0xffff0000u) - lam * __uint_as_float(b[e] & 0xffff0000u); }
        float ss = 0.f;
#pragma unroll
        for (int e = 0; e < 8; ++e) ss += x[e] * x[e];
        ss = sum16(ss);
        const float rs = rsqrtf(ss * (1.f / 128.f) + EPS);
        u32x4 w;
#pragma unroll
        for (int e = 0; e < 4; ++e) w[e] = pk2(x[2 * e] * rs, x[2 * e + 1] * rs);
        *(u32x4*)((bf16_t*)(ws + WS_AO) + (size_t)t * 512 + lane * 8) = w;
    }
}
__device__ __forceinline__ unsigned key_of(float s, unsigned low) { const unsigned u = __float_as_uint(s); const unsigned k = (u & 0x80000000u) ? ~u : (u | 0x80000000u); return (k & ~255u) | low; }
__device__ __forceinline__ float val_of(unsigned key) { const unsigned k = key & ~255u; const unsigned u = (k & 0x80000000u) ? (k & 0x7fffffffu) : ~k; return __uint_as_float(u); }
typedef short s16x2_t __attribute__((ext_vector_type(2)));
__device__ __forceinline__ unsigned sortable2(unsigned w) { const s16x2_t m = __builtin_bit_cast(s16x2_t, w) >> (short)15; return w ^ (__builtin_bit_cast(unsigned, m) | 0x80008000u); }
__device__ __forceinline__ float val16_of(unsigned key) { const unsigned k = key >> 16; const unsigned hbits = (k & 0x8000u) ? (k & 0x7fffu) : (~k & 0xffffu); return (float)__builtin_bit_cast(_Float16, (unsigned short)hbits); }
__device__ __forceinline__ void sort16_desc(unsigned (&a)[16]) {
#define CE_(i, l) { const unsigned hi_ = a[i] > a[l] ? a[i] : a[l], lo_ = a[i] > a[l] ? a[l] : a[i]; a[i] = hi_; a[l] = lo_; }
    CE_(0, 13) CE_(1, 12) CE_(2, 15) CE_(3, 14) CE_(4, 8) CE_(5, 6) CE_(7, 11) CE_(9, 10)
    CE_(0, 5) CE_(1, 7) CE_(2, 9) CE_(3, 4) CE_(6, 13) CE_(8, 14) CE_(10, 15) CE_(11, 12)
    CE_(0, 1) CE_(2, 3) CE_(4, 5) CE_(6, 8) CE_(7, 9) CE_(10, 11) CE_(12, 13) CE_(14, 15)
    CE_(0, 2) CE_(1, 3) CE_(4, 10) CE_(5, 11) CE_(6, 7) CE_(8, 9) CE_(12, 14) CE_(13, 15)
    CE_(1, 2) CE_(3, 12) CE_(4, 6) CE_(5, 7) CE_(8, 10) CE_(9, 11) CE_(13, 14)
    CE_(1, 4) CE_(2, 6) CE_(5, 8) CE_(7, 10) CE_(9, 13) CE_(11, 14)
    CE_(2, 4) CE_(3, 6) CE_(9, 12) CE_(11, 13)
    CE_(3, 5) CE_(6, 8) CE_(7, 9) CE_(10, 12)
    CE_(3, 4) CE_(5, 6) CE_(7, 8) CE_(9, 10) CE_(11, 12)
    CE_(6, 7) CE_(8, 9)
#undef CE_
}
__device__ __forceinline__ void merge_top16(unsigned (&r)[16], const unsigned (&b)[16]) {
#pragma unroll
    for (int i = 0; i < 16; ++i) r[i] = r[i] > b[15 - i] ? r[i] : b[15 - i];
#pragma unroll
    for (int j = 8; j > 0; j >>= 1)
#pragma unroll
        for (int i = 0; i < 16; ++i) { const int l = i ^ j; if (l > i) { const unsigned hi = r[i] > r[l] ? r[i] : r[l], lo = r[i] > r[l] ? r[l] : r[i]; r[i] = hi; r[l] = lo; } }
}
__device__ __forceinline__ constexpr int cand_pair(int q) {
    int c = 0;
    for (int a = 0; a < 16; ++a) for (int b = 0; b < 16; ++b) if ((a + 1) * (b + 1) <= 16) { if (c == q) return a * 16 + b; ++c; }
    return -1;
}
template <class Sched>
__device__ __forceinline__ void topk_local(const Params& p, const Sched& O, lds_t lds) {
    const int tidx = tid_fresh(), lane = tidx & 63, wid = __builtin_amdgcn_readfirstlane(tidx >> 6);
    unsigned char* ws = p.ws;
    const _Float16* sc = (const _Float16*)(ws + WS_SC);
    constexpr int PITCH = 272;
    PG8_LAS unsigned char* st = lds + wid * (64 * PITCH);
#pragma unroll 1
    for (int bi = wid; ; bi += 8) {
        pg8::Unit u; if (!O.next(bi >> 2, u)) break;
        const int t0 = u.pm * 256 + (bi & 3) * 64, head = u.pn;
        unsigned la[16], lb[16], blk[16];
#pragma unroll
        for (int h = 0; h < 2; ++h) {
            unsigned (&top)[16] = h == 0 ? la : lb;
            u32x4 w[16];
#pragma unroll
            for (int q = 0; q < 16; ++q) w[q] = *(const u32x4*)(sc + (size_t)(t0 + 4 * q + (lane >> 4)) * 2048 + head * 256 + h * 128 + (lane & 15) * 8);
#pragma unroll
            for (int q = 0; q < 16; ++q) *(PG8_LAS u32x4*)(st + (4 * q + (lane >> 4)) * PITCH + (lane & 15) * 16) = w[q];
#pragma unroll
            for (int n0 = 0; n0 < 128; n0 += 16) {
                const u32x4 h0 = *(const PG8_LAS u32x4*)(st + lane * PITCH + n0 * 2), h1 = *(const PG8_LAS u32x4*)(st + lane * PITCH + n0 * 2 + 16);
#pragma unroll
                for (int e = 0; e < 4; ++e) { const unsigned k0 = sortable2(h0[e]), k1 = sortable2(h1[e]);
                    blk[2 * e] = (k0 << 16) | (255u - (unsigned)(n0 + 2 * e)); blk[2 * e + 1] = (k0 & 0xffff0000u) | (255u - (unsigned)(n0 + 2 * e + 1));
                    blk[8 + 2 * e] = (k1 << 16) | (255u - (unsigned)(n0 + 8 + 2 * e)); blk[8 + 2 * e + 1] = (k1 & 0xffff0000u) | (255u - (unsigned)(n0 + 8 + 2 * e + 1)); }
                sort16_desc(blk);
                if (n0 == 0) {
#pragma unroll
                    for (int e = 0; e < 16; ++e) top[e] = blk[e];
                } else merge_top16(top, blk);
            }
        }
        const int i = (t0 + lane) * 8 + head;
        float sa[16], sb[16];
#pragma unroll
        for (int j = 0; j < 16; ++j) { sa[j] = val16_of(la[j]); sb[j] = val16_of(lb[j]); }
        unsigned lc[16];
#pragma unroll
        for (int q0 = 0; q0 < 64; q0 += 16) {
#pragma unroll
            for (int e = 0; e < 16; ++e) { const int ab = cand_pair(q0 + e); blk[e] = (ab >= 0) ? key_of(sa[ab >= 0 ? (ab >> 4) : 0] + sb[ab >= 0 ? (ab & 15) : 0], 255u - (unsigned)(ab >= 0 ? ab : 0)) : 0u; }
            if (q0 == 0) {
#pragma unroll
                for (int e = 0; e < 16; ++e) lc[e] = blk[e];
            } else { sort16_desc(blk); merge_top16(lc, blk); }
        }
        float g[16]; const float mx = val_of(lc[0]); float sum = 0.f;
#pragma unroll
        for (int j = 0; j < 16; ++j) { g[j] = __expf(val_of(lc[j]) - mx); sum += g[j]; }
        const float inv = 1.f / sum;
        int* ti = (int*)(ws + WS_TI) + (size_t)i * 16;
        int eo[16];
        unsigned ta[4] = {0u, 0u, 0u, 0u}, tb[4] = {0u, 0u, 0u, 0u};
#pragma unroll
        for (int q = 0; q < 16; ++q) { ta[q >> 2] |= (255u - (la[q] & 255u)) << ((q & 3) * 8); tb[q >> 2] |= (255u - (lb[q] & 255u)) << ((q & 3) * 8); }
#pragma unroll
        for (int j = 0; j < 16; ++j) {
            const unsigned c = 255u - (lc[j] & 255u), a = c >> 4, b = c & 15u;
            const unsigned wa = (a & 8u) ? ((a & 4u) ? ta[3] : ta[2]) : ((a & 4u) ? ta[1] : ta[0]);
            const unsigned wb = (b & 8u) ? ((b & 4u) ? tb[3] : tb[2]) : ((b & 4u) ? tb[1] : tb[0]);
            const unsigned ia = __builtin_amdgcn_ubfe(wa, (a & 3u) * 8u, 8u), ib = __builtin_amdgcn_ubfe(wb, (b & 3u) * 8u, 8u);
            const _Float16 gh = (_Float16)(g[j] * inv);
            eo[j] = (int)(ia * 128u + ib) | ((int)__builtin_bit_cast(unsigned short, gh) << 16);
        }
#pragma unroll
        for (int j = 0; j < 16; j += 4) *(int __attribute__((ext_vector_type(4)))*)(ti + j) = (int __attribute__((ext_vector_type(4)))){eo[j], eo[j + 1], eo[j + 2], eo[j + 3]};
    }
}
__device__ __forceinline__ void fstage_pscore(const Params& p, int l, lds_t lds, int bid, int nb) {
    pg8::Order O; O.init(T, 2048, nb, bid, p.ws + WS_XB, D, p.ws + WS_SKT + (size_t)l * 2048 * D * 2, D);
    pg8::gemm_phase<GEpiScaleF16, pg8::Order, true>(lds, D, D, D, O, GEpiScaleF16{p.ws, (_Float16*)(p.ws + WS_SC), 2048});
    topk_local(p, O, lds);
}
#define XB_TMO      128
#define XB_XCNT(j)  (256  + 64 * (j))
#define XB_XSUB(j)  (1280 + 64 * (j))
#define XB_XGEN(j)  (2304 + 64 * (j))
#define XB_TOP      3328
#define XB_TOPGEN   3392
#define XCD_BAR_WORDS 3456
#define XB_SPIN_CAP (1u << 18)
#define LAS __attribute__((address_space(3)))

__device__ __forceinline__ unsigned xb_ld(unsigned* p)              { return __hip_atomic_load(p, __ATOMIC_RELAXED, __HIP_MEMORY_SCOPE_AGENT); }
__device__ __forceinline__ unsigned xb_add(unsigned* p, unsigned v) { return __hip_atomic_fetch_add(p, v, __ATOMIC_RELAXED, __HIP_MEMORY_SCOPE_AGENT); }
__device__ __forceinline__ unsigned xb_xcc_id() { return (unsigned)__builtin_amdgcn_s_getreg((3 << 11) | 20) & 0xFu; }
#define XB_SPIN(cond, bar) do { unsigned _sp = 0; while (cond) { __builtin_amdgcn_s_sleep(1); \
    if ((++_sp & 255u) == 0u) { if (xb_ld(&(bar)[XB_TMO])) break; if (_sp > XB_SPIN_CAP) { atomicAdd(&(bar)[XB_TMO], 1u); break; } } } } while (0)

struct XcdBarrier {
    unsigned* bar; unsigned x;
    volatile LAS unsigned* st;
};

__device__ __forceinline__ XcdBarrier xcd_barrier_post(unsigned* bar, volatile LAS unsigned* st) {
    XcdBarrier b; b.bar = bar; b.x = xb_xcc_id(); b.st = st;
    if (tid_fresh() == 0) (void)xb_add(&bar[XB_XCNT(b.x)], 1u);
    return b;
}
__device__ __forceinline__ void xcd_barrier_complete(unsigned* bar, unsigned x, unsigned& nloc, unsigned& nx) {
    const unsigned G = gridDim.x * gridDim.y * gridDim.z;
    unsigned sum, cnt, mine, sp = 0u;
    for (;;) {
        sum = 0u; cnt = 0u; mine = 0u;
#pragma unroll
        for (unsigned j = 0; j < 16; ++j) { const unsigned c = xb_ld(&bar[XB_XCNT(j)]); sum += c; cnt += (c > 0u) ? 1u : 0u; mine = (j == x) ? c : mine; }
        if (sum == G) break;
        __builtin_amdgcn_s_sleep(1);
        if ((++sp & 255u) == 0u) { if (xb_ld(&bar[XB_TMO])) break; if (sp > XB_SPIN_CAP) { atomicAdd(&bar[XB_TMO], 1u); break; } }
    }
    nloc = mine > 0u ? mine : 1u; nx = cnt > 0u ? cnt : 1u;
}

__device__ __forceinline__ void xcd_barrier(const XcdBarrier& b) {
    asm volatile("s_waitcnt vmcnt(0)" ::: "memory");
    __syncthreads();
    if (tid_fresh() == 0) {
        unsigned* bar = b.bar;
        __builtin_amdgcn_s_waitcnt(0);
        unsigned nloc = b.st[0], nx = b.st[1];
        if (nloc == 0u) { xcd_barrier_complete(bar, b.x, nloc, nx); b.st[0] = nloc; b.st[1] = nx; }
        const unsigned old = xb_add(&bar[XB_XSUB(b.x)], 1u);
        const unsigned gen = old / nloc;
        if (old + 1u == (gen + 1u) * nloc) {
            __builtin_amdgcn_fence(__ATOMIC_RELEASE, "agent");
            asm volatile("s_waitcnt vmcnt(0)" ::: "memory");
            const unsigned og = xb_add(&bar[XB_TOP], 1u);
            const unsigned tg = og / nx;
            if (og + 1u == (tg + 1u) * nx) xb_add(&bar[XB_TOPGEN], 1u);
            else XB_SPIN(xb_ld(&bar[XB_TOPGEN]) == tg, bar);
            __builtin_amdgcn_fence(__ATOMIC_ACQUIRE, "agent");
            xb_add(&bar[XB_XGEN(b.x)], 1u);
            asm volatile("s_waitcnt vmcnt(0)" ::: "memory");
        } else {
            XB_SPIN(xb_ld(&bar[XB_XGEN(b.x)]) == gen, bar);
            __builtin_amdgcn_fence(__ATOMIC_ACQUIRE, "agent");
            asm volatile("s_waitcnt vmcnt(0)" ::: "memory");
        }
    }
    __syncthreads();
}


constexpr int PQ_CH = 16, PQ_NCH = T / PQ_CH;
constexpr int CW_PQ = 16384;
constexpr size_t CTL_ZERO_BYTES = 131072;
__device__ __forceinline__ unsigned pq_pull(unsigned* head, int lane) {
    unsigned c = 0; if (lane == 0) c = __hip_atomic_fetch_add(head, 1u, __ATOMIC_RELAXED, __HIP_MEMORY_SCOPE_AGENT);
    return (unsigned)__builtin_amdgcn_readfirstlane((int)c);
}
__device__ __forceinline__ f32x2 gelu_pk(f32x2 v) {
    const f32x2 av = __builtin_elementwise_abs(v), d = av * 0.2316418882f + 1.0f;
    f32x2 t; t.x = __builtin_amdgcn_rcpf(d.x); t.y = __builtin_amdgcn_rcpf(d.y);
    f32x2 q = t * 0.5307027145f + (-0.7265760135f); q = q * t + 0.7107068705f; q = q * t + (-0.142248368f); q = q * t + 0.127414796f; q = q * t;
    const f32x2 s = (v * v) * (-0.72134752044f);
    f32x2 e; e.x = __builtin_amdgcn_exp2f(s.x); e.y = __builtin_amdgcn_exp2f(s.y);
    const f32x2 m = v * (q * e), r = v - m;
    f32x2 o; o.x = v.x < 0.f ? m.x : r.x; o.y = v.y < 0.f ? m.y : r.y; return o;
}
__device__ __forceinline__ float gelu_erf(float d) { return 0.5f * d * (1.f + erff(d * 0.70710678118654752f)); }

constexpr unsigned ENT_INVALID = 0xffffffffu;
typedef long i64x2 __attribute__((ext_vector_type(2)));
__device__ __forceinline__ void fstage_peer_u(const Params& p, int l, int qsel, lds_t lds, unsigned imask = 16383u, size_t aoff = 0, bool skipg = false) {
    unsigned char* ws = p.ws;
    const int tid = tid_fresh(), lane = tid & 63, wid = __builtin_amdgcn_readfirstlane(tid >> 6), n = lane & 15, kq = lane >> 4;
    const unsigned char* u8 = ws + WS_U8 + (size_t)l * NEXP * D;
    unsigned* heads = (unsigned*)(ws + WS_CTL) + CW_PQ + ((qsel * 2 + 0) * 8) * 64;
    const int myx = (int)(xb_xcc_id() & 7u);
    float* Aout = (float*)(ws + WS_PA + aoff);
    constexpr int RB_BYTES = 16 * 1024, LIST_MAX = 400, WREG = RB_BYTES + (LIST_MAX + 16) * 8;
    PG8_LAS unsigned char* rbuf = lds + wid * WREG;
    PG8_LAS unsigned* ent = (PG8_LAS unsigned*)(rbuf + RB_BYTES);
    PG8_LAS float* gl = (PG8_LAS float*)(rbuf + RB_BYTES + (LIST_MAX + 16) * 4);
#pragma unroll 1
    for (int s8 = 0; s8 < 8; ++s8) {
        const int k = (myx + s8) & 7;
        unsigned c = pq_pull(heads + k * 64, lane);
#pragma unroll 1
        for (;;) {
            if (c >= (unsigned)PQ_NCH) break;
            const int t0 = (int)c * PQ_CH;
            unsigned c_next = c; bool pulled = false;
            int mxs = 0x7f7f7f7f; asm volatile("" : "+v"(mxs));
            pg8::i32x8_t xf8[8];
            { const unsigned char* xp = ws + WS_XQ8 + (size_t)(t0 + n) * D + kq * 16;
#pragma unroll
              for (int i = 0; i < 8; ++i) { const pg8::i32x4_t lo = *(const pg8::i32x4_t*)(xp + (2 * i) * 64), hi = *(const pg8::i32x4_t*)(xp + (2 * i + 1) * 64); xf8[i] = __builtin_shufflevector(lo, hi, 0, 1, 2, 3, 4, 5, 6, 7); } }
            const float rs = row_rstd((const float*)(ws + WS_SSP), t0 + n) * (1.f / (SU * XS));
            float* ao = Aout + (size_t)(t0 + n) * 128;
            int i_next = 0;
#pragma unroll 1
            while (i_next < 16) {
                int e0v[16], e1v[16];
                { const int* ti = (const int*)(ws + WS_TI) + (size_t)t0 * 128;
#pragma unroll
                  for (int i = 0; i < 16; ++i) { e0v[i] = ti[i * 128 + lane]; e1v[i] = ti[i * 128 + 64 + lane]; } }
                int cnt = 0; int i_end = 16;
#pragma unroll
                for (int i = 0; i < 16; ++i) {
                    if (i >= i_next && i < i_end) {
                        if (cnt > LIST_MAX - 128) { i_end = i; }
                        else {
                            const int e0 = e0v[i] & 16383, e1 = e1v[i] & 16383;
                            const bool s0 = (e0 >> 11) == k, s1 = (e1 >> 11) == k;
                            const unsigned long long m0 = __ballot(s0), m1 = __ballot(s1);
                            const int b0 = (int)__builtin_amdgcn_mbcnt_hi((unsigned)(m0 >> 32), __builtin_amdgcn_mbcnt_lo((unsigned)m0, 0u));
                            const int b1 = (int)__builtin_amdgcn_mbcnt_hi((unsigned)(m1 >> 32), __builtin_amdgcn_mbcnt_lo((unsigned)m1, 0u));
                            const int c0 = __builtin_popcountll(m0);
                            if (s0) { ent[cnt + b0] = ((unsigned)i << 21) | ((unsigned)lane << 14) | (unsigned)e0; gl[cnt + b0] = (float)__builtin_bit_cast(_Float16, (unsigned short)((unsigned)e0v[i] >> 16)); }
                            if (s1) { ent[cnt + c0 + b1] = ((unsigned)i << 21) | ((unsigned)(64 + lane) << 14) | (unsigned)e1; gl[cnt + c0 + b1] = (float)__builtin_bit_cast(_Float16, (unsigned short)((unsigned)e1v[i] >> 16)); }
                            cnt += c0 + __builtin_popcountll(m1);
                        }
                    }
                }
                i_next = i_end;
                if (cnt == 0) continue;
                if (lane < 16) ent[cnt + lane] = ENT_INVALID;
                const int ng = skipg ? 0 : ((cnt + 15) >> 4);
                u32x4 W[16];
#define PU_LOAD(g_) do { const PG8_LAS u32x4* ep_ = (const PG8_LAS u32x4*)(ent + (g_) * 16); const u32x4 q0_ = ep_[0], q1_ = ep_[1], q2_ = ep_[2], q3_ = ep_[3]; \
                    _Pragma("unroll") for (int q = 0; q < 16; ++q) { const unsigned e_ = (q < 4) ? q0_[q & 3] : (q < 8) ? q1_[q & 3] : (q < 12) ? q2_[q & 3] : q3_[q & 3]; \
                        const unsigned iq_ = (e_ == ENT_INVALID) ? 0u : (e_ & imask); W[q] = *(const u32x4*)(u8 + (size_t)iq_ * D + lane * 16); } } while (0)
                if (!pulled) { pulled = true; c_next = pq_pull(heads + k * 64, lane); }
                if (ng > 0) PU_LOAD(0);
#pragma unroll 1
                for (int g = 0; g < ng; ++g) {
#pragma unroll
                    for (int q = 0; q < 16; ++q) *(PG8_LAS u32x4*)(rbuf + q * 1024 + ((lane ^ q) * 16)) = W[q];
                    if (g + 1 < ng) PU_LOAD(g + 1);
                    f32x4 acc;
                    const PG8_LAS unsigned char* fp = rbuf + n * 1024;
#pragma unroll
                    for (int Lb = 0; Lb < 16; Lb += 4) {
                        pg8::i32x4_t fa[4];
#pragma unroll
                        for (int L = 0; L < 4; ++L) fa[L] = *(const PG8_LAS pg8::i32x4_t*)(fp + ((((Lb + L) * 4 + kq) ^ n) * 16));
                        __builtin_amdgcn_sched_barrier(0);
                        const pg8::i32x8_t a0 = __builtin_shufflevector(fa[0], fa[1], 0, 1, 2, 3, 4, 5, 6, 7), a1 = __builtin_shufflevector(fa[2], fa[3], 0, 1, 2, 3, 4, 5, 6, 7);
                        if (Lb == 0) asm volatile("v_mfma_scale_f32_16x16x128_f8f6f4 %0, %1, %2, 0, %3, %3 op_sel_hi:[0,0,0]" : "=v"(acc) : "v"(a0), "v"(xf8[0]), "v"(mxs));
                        else asm volatile("v_mfma_scale_f32_16x16x128_f8f6f4 %0, %1, %2, %0, %3, %3 op_sel_hi:[0,0,0]" : "+v"(acc) : "v"(a0), "v"(xf8[Lb >> 1]), "v"(mxs));
                        asm volatile("v_mfma_scale_f32_16x16x128_f8f6f4 %0, %1, %2, %0, %3, %3 op_sel_hi:[0,0,0]" : "+v"(acc) : "v"(a1), "v"(xf8[(Lb >> 1) + 1]), "v"(mxs));
                        __builtin_amdgcn_sched_barrier(0);
                    }
                    asm volatile("s_nop 15\n\ts_nop 7" : "+v"(acc) :: "memory");
                    {
                        const u32x4 e4 = *(const PG8_LAS u32x4*)(ent + g * 16 + 4 * kq); const f32x4 g4 = *(const PG8_LAS f32x4*)(gl + g * 16 + 4 * kq);
#pragma unroll
                        for (int r = 0; r < 4; r += 2) { const f32x2 ge = gelu_pk((f32x2){acc[r] * rs, acc[r + 1] * rs});
                            if (e4[r] != ENT_INVALID && (int)(e4[r] >> 21) == n) ao[(e4[r] >> 14) & 127u] = ge.x * g4[r];
                            if (e4[r + 1] != ENT_INVALID && (int)(e4[r + 1] >> 21) == n) ao[(e4[r + 1] >> 14) & 127u] = ge.y * g4[r + 1]; }
                    }
                }
#undef PU_LOAD
            }
            if (!pulled) c_next = pq_pull(heads + k * 64, lane);
            c = c_next;
        }
    }
}

constexpr float AS = 32.f;
__device__ __forceinline__ void tr4x4(unsigned a, unsigned b, unsigned c, unsigned d, unsigned& o0, unsigned& o1, unsigned& o2, unsigned& o3) {
    const unsigned p0 = __builtin_amdgcn_perm(b, a, 0x05010400u), p1 = __builtin_amdgcn_perm(b, a, 0x07030602u), p2 = __builtin_amdgcn_perm(d, c, 0x05010400u), p3 = __builtin_amdgcn_perm(d, c, 0x07030602u);
    o0 = __builtin_amdgcn_perm(p2, p0, 0x05040100u); o1 = __builtin_amdgcn_perm(p2, p0, 0x07060302u); o2 = __builtin_amdgcn_perm(p3, p1, 0x05040100u); o3 = __builtin_amdgcn_perm(p3, p1, 0x07060302u);
}
__device__ __forceinline__ void fstage_peer_v(const Params& p, int l, int qsel, bool dry, lds_t lds, int imask = 16383) {
    unsigned char* ws = p.ws;
    const int tid = tid_fresh(), lane = tid & 63, wid = __builtin_amdgcn_readfirstlane(tid >> 6), n = lane & 15, kq = lane >> 4, n8 = n & 7, h = n >> 3;
    const unsigned char* v8 = ws + WS_V8 + (size_t)l * NEXP * D;
    unsigned* heads = (unsigned*)(ws + WS_CTL) + CW_PQ + ((qsel * 2 + 1) * 8) * 64;
    const int myx = (int)(xb_xcc_id() & 7u);
#pragma unroll 1
    for (int s8 = 0; s8 < 8; ++s8) {
        const int k = (myx + s8) & 7;
#define PV_IDS_DMA(cc, buf) do { const unsigned char* tg_ = ws + WS_TI + (size_t)(cc) * (PQ_CH * 512); \
            _Pragma("unroll") for (int j_ = 0; j_ < 8; ++j_) pg8::glds_s(tg_ + j_ * 1024, (unsigned)lc_ * 16u, (unsigned)(size_t)(lds) + (unsigned)(buf) * 65536u + (unsigned)wid * 8192u + (unsigned)j_ * 1024u); } while (0)
        unsigned c = pq_pull(heads + k * 64, lane);
        int bs = 0;
        if (c < (unsigned)PQ_NCH) { int lc_ = lane; asm volatile("" : "+v"(lc_)); PV_IDS_DMA(c, 0); asm volatile("s_waitcnt vmcnt(0)" ::: "memory"); }
#pragma unroll 1
        for (;;) {
            if (c >= (unsigned)PQ_NCH) break;
            const int t0 = (int)c * PQ_CH;
            unsigned koff = (unsigned)n8 * 16u; asm volatile("" : "+v"(koff));
            const unsigned char* vb = v8 + (size_t)k * NEXP * 128;
            PG8_LAS int* til = (PG8_LAS int*)(lds + bs * 65536 + wid * 8192);
            const int imk = imask & 16383;
            u32x4 R[4][8];
            typedef int i32x4 __attribute__((ext_vector_type(4)));
#define PV_ISSUE(b, slot) do { const PG8_LAS i32x4* ip_ = (const PG8_LAS i32x4*)(til + ((b) >> 1) * 128 + ((b) & 1) * 64 + h * 32 + kq * 8); const i32x4 i0_ = ip_[0], i1_ = ip_[1]; \
                _Pragma("unroll") for (int e_ = 0; e_ < 4; ++e_) { R[slot][e_] = *(const u32x4*)(vb + ((unsigned)(i0_[e_] & imk) * 128u + koff)); R[slot][4 + e_] = *(const u32x4*)(vb + ((unsigned)(i1_[e_] & imk) * 128u + koff)); } } while (0)
#define PV_COMPUTE(tok8, aq, slot) do { const long aop_ = ((n >> 1) == (tok8)) ? (aq) : 0l; \
                _Pragma("unroll") for (int c_ = 0; c_ < 4; ++c_) { unsigned lo_[4], hi_[4]; \
                    tr4x4(R[slot][0][c_], R[slot][1][c_], R[slot][2][c_], R[slot][3][c_], lo_[0], lo_[1], lo_[2], lo_[3]); \
                    tr4x4(R[slot][4][c_], R[slot][5][c_], R[slot][6][c_], R[slot][7][c_], hi_[0], hi_[1], hi_[2], hi_[3]); \
                    _Pragma("unroll") for (int j_ = 0; j_ < 4; ++j_) { const long b_ = (long)(((unsigned long)hi_[j_] << 32) | (unsigned long)lo_[j_]); \
                        acc[4 * c_ + j_] = __builtin_amdgcn_mfma_f32_16x16x32_fp8_fp8(aop_, b_, acc[4 * c_ + j_], 0, 0, 0); } } } while (0)
#pragma unroll
            for (int b = 0; b < 3; ++b) PV_ISSUE(b, b);
            const unsigned c1 = pq_pull(heads + k * 64, lane);
            if (c1 < (unsigned)PQ_NCH) { int lc_ = lane; asm volatile("" : "+v"(lc_)); PV_IDS_DMA(c1, bs ^ 1); }
#pragma unroll 1
            for (int ps = 0; ps < 2; ++ps) {
                f32x4 acc[16];
#pragma unroll
                for (int j = 0; j < 16; ++j) acc[j] = (f32x4){0.f, 0.f, 0.f, 0.f};
                long aq0, aq1;
                { const float* ap = (const float*)(ws + WS_PA) + (size_t)(t0 + ps * 8 + (n >> 1)) * 128 + (n & 1) * 32 + kq * 8;
                  const f32x4 a0 = *(const f32x4*)ap, a1 = *(const f32x4*)(ap + 4), a2 = *(const f32x4*)(ap + 64), a3 = *(const f32x4*)(ap + 68);
                  int w0 = __builtin_amdgcn_cvt_pk_fp8_f32(a0[0] * AS, a0[1] * AS, 0, false); w0 = __builtin_amdgcn_cvt_pk_fp8_f32(a0[2] * AS, a0[3] * AS, w0, true);
                  int w1 = __builtin_amdgcn_cvt_pk_fp8_f32(a1[0] * AS, a1[1] * AS, 0, false); w1 = __builtin_amdgcn_cvt_pk_fp8_f32(a1[2] * AS, a1[3] * AS, w1, true);
                  int w2 = __builtin_amdgcn_cvt_pk_fp8_f32(a2[0] * AS, a2[1] * AS, 0, false); w2 = __builtin_amdgcn_cvt_pk_fp8_f32(a2[2] * AS, a2[3] * AS, w2, true);
                  int w3 = __builtin_amdgcn_cvt_pk_fp8_f32(a3[0] * AS, a3[1] * AS, 0, false); w3 = __builtin_amdgcn_cvt_pk_fp8_f32(a3[2] * AS, a3[3] * AS, w3, true);
                  aq0 = (long)(((unsigned long)(unsigned)w1 << 32) | (unsigned long)(unsigned)w0); aq1 = (long)(((unsigned long)(unsigned)w3 << 32) | (unsigned long)(unsigned)w2); }
                u32x4 xin0, xin1;
                { int n8p = n8, kqp = kq; asm volatile("" : "+v"(n8p), "+v"(kqp));
                  const bf16_t* xrp = (const bf16_t*)(ws + WS_XB) + (size_t)(t0 + ps * 8 + 2 * kqp + h) * D + k * 128 + n8p * 16; xin0 = *(const u32x4*)xrp; xin1 = *(const u32x4*)(xrp + 8); }
#pragma unroll 1
                for (int b0 = 0; b0 < 16; b0 += 4) {
#pragma unroll
                    for (int s = 0; s < 4; ++s) {
                        const int bn = ps * 16 + b0 + s + 3;
                        if (bn < 32) PV_ISSUE(bn, (s + 3) & 3);
                        PV_COMPUTE((b0 + s) >> 1, (s & 1) ? aq1 : aq0, s);
                    }
                }
                int n8e = n8, kqe = kq; asm volatile("" : "+v"(n8e), "+v"(kqe));
                const int t = t0 + ps * 8 + 2 * kqe + h;
                float o[16];
#pragma unroll
                for (int j = 0; j < 16; ++j) { const float send = h ? acc[j][1] : acc[j][2]; const float recv = dppf<DPP_X8>(send); o[j] = (h ? acc[j][3] : acc[j][0]) + recv; }
                bf16_t* xr = (bf16_t*)(ws + WS_XB) + (size_t)t * D + k * 128 + n8e * 16;
                const float sc = 1.f / (SV * AS);
                float ss = 0.f;
#pragma unroll
                for (int g = 0; g < 2; ++g) {
                    f32x4 v0, v1; up8(g == 0 ? xin0 : xin1, v0, v1);
                    v0[0] += o[8 * g + 0] * sc; v0[1] += o[8 * g + 1] * sc; v0[2] += o[8 * g + 2] * sc; v0[3] += o[8 * g + 3] * sc;
                    v1[0] += o[8 * g + 4] * sc; v1[1] += o[8 * g + 5] * sc; v1[2] += o[8 * g + 6] * sc; v1[3] += o[8 * g + 7] * sc;
                    const u32x4 wq = pk8(v0, v1); up8(wq, v0, v1);
                    if (!dry) { *(u32x4*)(xr + g * 8) = wq; *(u32x2*)(ws + WS_XQ8 + (size_t)t * D + k * 128 + n8e * 16 + g * 8) = pk8_fp8(v0, v1, XS); }
                    ss += (v0[0] * v0[0] + v0[1] * v0[1]) + (v0[2] * v0[2] + v0[3] * v0[3]) + (v1[0] * v1[0] + v1[1] * v1[1]) + (v1[2] * v1[2] + v1[3] * v1[3]);
                }
                ss += dppf<DPP_X1>(ss); ss += dppf<DPP_X2>(ss); ss += dppf<DPP_HMIR>(ss);
                if (n8e < 2 && !dry) ((float*)(ws + WS_SSP))[(size_t)t * 16 + 2 * k + n8e] = (n8e == 0) ? ss : 0.f;
            }
#undef PV_ISSUE
#undef PV_COMPUTE
            c = c1; bs ^= 1;
        }
#undef PV_IDS_DMA
    }
}
__device__ __forceinline__ void fstage_final_norm(const Params& p) {
    const int tid = tid_fresh(), lane = tid & 63, wid = tid >> 6;
    const float* gfin = (const float*)p.in[25];
    for (int t = blockIdx.x * 8 + wid; t < T; t += gridDim.x * 8) {
        const float r = row_rstd((const float*)(p.ws + WS_SSP), t);
        const bf16_t* xr = (const bf16_t*)(p.ws + WS_XB) + (size_t)t * D; float* o = p.out + (size_t)t * D;
#pragma unroll
        for (int i = 0; i < 2; ++i) { f32x4 a, b; up8(*(const u32x4*)(xr + (lane + 64 * i) * 8), a, b);
            const f32x4 g0 = *(const f32x4*)(gfin + (lane + 64 * i) * 8), g1 = *(const f32x4*)(gfin + (lane + 64 * i) * 8 + 4);
            *(f32x4*)(o + (lane + 64 * i) * 8) = a * r * g0; *(f32x4*)(o + (lane + 64 * i) * 8 + 4) = b * r * g1; }
    }
}

extern __shared__ __attribute__((aligned(16))) unsigned char dyn_lds[];
constexpr int LDS_BYTES = 163840;
constexpr int LDS_BARW = LDS_BYTES - 64;

__device__ __forceinline__ Params ldp() {
    Params r;
#if defined(__HIP_DEVICE_COMPILE__)
    const __attribute__((address_space(4))) unsigned long long* k = (const __attribute__((address_space(4))) unsigned long long*)__builtin_amdgcn_kernarg_segment_ptr();
    asm volatile("" : "+s"(k));
#pragma unroll
    for (int i = 0; i < 26; ++i) r.in[i] = (const void*)(const __attribute__((address_space(1))) void*)k[i];
    r.out = (float*)(__attribute__((address_space(1))) float*)k[26]; r.ws = (unsigned char*)(__attribute__((address_space(1))) unsigned char*)k[27];
#endif
    return r;
}
__device__ __forceinline__ int rep_of(int k) { int n = (PROBE == k) ? 2 : 1; asm volatile("" : "+s"(n)); return n; }
#if PROBE == 0
#define REP(k) for (int r_ = 0, n_ = 1; r_ < 1; ++r_)
#else
#define REP(k) for (int r_ = 0, n_ = rep_of(k); r_ < n_; ++r_)
#endif
#define PH(call) do { const Params q = ldp(); int bid = bid0, nb = nb0, l = l0; asm volatile("" : "+s"(bid), "+s"(nb), "+s"(l)); (void)l; call; } while (0)
__global__ void __launch_bounds__(NT, 2) mega(Params p_unused) {
    const int bid0 = blockIdx.x, nb0 = gridDim.x; int l0 = 0;
    float* lds = (float*)dyn_lds; const lds_t ldsp = (lds_t)dyn_lds;
    { const int w0_ = __builtin_amdgcn_readfirstlane((int)(threadIdx.x >> 6)); asm volatile("s_mov_b32 m0, %0" :: "s"(w0_)); }
    if (tid_fresh() == 0) *(uint4*)(dyn_lds + LDS_BARW) = make_uint4(0u, 0u, 0u, 0u);
    __syncthreads();
    { const Params q = ldp(); (void)xcd_barrier_post((unsigned*)(q.ws + WS_CTL), (volatile LAS unsigned*)(dyn_lds + LDS_BARW)); }
#define GRID_BAR() do { const Params q = ldp(); XcdBarrier b_; b_.bar = (unsigned*)(q.ws + WS_CTL); b_.x = xb_xcc_id(); b_.st = (volatile LAS unsigned*)(dyn_lds + LDS_BARW); xcd_barrier(b_); if (PROBE == 20) xcd_barrier(b_); } while (0)
    REP(1) { PH(stage_prologue0(q, bid, nb, lds)); GRID_BAR(); }
    REP(2) { PH(stage_prologue1(q, bid, nb)); PH(fstage_kv(q, ldsp, bid, nb)); GRID_BAR();
    PH(fstage_g(q, ldsp, bid, nb)); PH(fstage_y(q, ldsp, bid, nb));     GRID_BAR(); }

#pragma unroll 1
    for (l0 = 0; l0 < L; ++l0) {
        REP(9) { PH(fstage_win(q, l, ldsp, bid, nb)); GRID_BAR(); }
        REP(4) { PH(stage_pool_d(q, bid, nb)); PH(fstage_sgate(q, l, ldsp)); } REP(7) { PH(fstage_attn(q, l, (char*)dyn_lds)); } PH(fstage_gates(q, l, ldsp, bid, nb)); GRID_BAR();
#if PROBE == 21
        PH(fstage_branch<false>(q, l, ldsp, bid, nb)); GRID_BAR();
#endif
        REP(10) { PH(fstage_branch(q, l, ldsp, bid, nb)); GRID_BAR(); }
        PH(fstage_resid_out(q, l, ldsp, bid, nb)); GRID_BAR();
        REP(11) { PH(fstage_xscore(q, l, ldsp, bid, nb)); GRID_BAR(); }
        PH(fstage_resid_cross(q, l, ldsp, bid, nb)); GRID_BAR();
        REP(12) { PH(fstage_pscore(q, l, ldsp, bid, nb)); GRID_BAR(); }
        REP(13) { PH(fstage_peer_u(q, l, l + 4 * r_, ldsp)); GRID_BAR(); }
#if PROBE == 15
        PH(fstage_peer_u(q, l, l + 4, ldsp, 255u, 16 * MiB)); GRID_BAR();
#endif
#if PROBE == 17
        { int sk_ = 1; asm volatile("" : "+s"(sk_)); PH(fstage_peer_u(q, l, l + 4, ldsp, 16383u, 16 * MiB, sk_ != 0)); GRID_BAR(); }
#endif
        REP(14) { bool dry_ = (r_ == 0 && n_ == 2); PH(fstage_peer_v(q, l, l + 4 * r_, dry_, ldsp)); GRID_BAR(); }
#if PROBE == 16
        PH(fstage_peer_v(q, l, l + 4, true, ldsp, 255)); GRID_BAR();
#endif
    }
    PH(fstage_final_norm(q));
}

extern "C" void kernel_launch(void* const* d_in, const int* in_sizes, int n_in, void* d_out, int out_size, void* d_ws, size_t ws_size, hipStream_t stream) {
    Params p{};
    for (int i = 0; i < 26; ++i) p.in[i] = d_in[i];
    p.out = (float*)d_out; p.ws = (unsigned char*)d_ws;
    static int grid = 0;
    if (!grid) {
        int dev = 0, cus = 0, per_cu = 0;
        (void)hipGetDevice(&dev);
        (void)hipDeviceGetAttribute(&cus, hipDeviceAttributeMultiprocessorCount, dev);
        (void)hipFuncSetAttribute((const void*)mega, hipFuncAttributeMaxDynamicSharedMemorySize, LDS_BYTES);
        (void)hipOccupancyMaxActiveBlocksPerMultiprocessor(&per_cu, mega, NT, LDS_BYTES);
        grid = cus * (per_cu < 1 ? per_cu : 1);
    }
    (void)hipMemsetAsync(p.ws + WS_CTL, 0, CTL_ZERO_BYTES, stream);
    mega<<<grid, NT, LDS_BYTES, stream>>>(p);
}
```
